# Optimizing an MI355X kernel written in HIP

```python
import math
import jax, jax.numpy as jnp
from jax import lax
import numpy as np

D_MODEL = 1024
BATCH = 8
SEQ = 2048
DEPTH = 2
DEC_BATCH = 128
DEC_SEQ = 4
PAST_LEN = 16384
PAGE_SIZE = 128

N_POOL_GROUPS = 4
POOL_WINDOWS = (2, 4, 8, 16)
POOL_GROUP = D_MODEL // N_POOL_GROUPS
POOL_HIST = max(POOL_WINDOWS) - 1
D_CONV = D_MODEL
CONV_W = 3
D_FF = ((8 * D_MODEL // 3 + 127) // 128) * 128
N_POOL = (DEPTH + 1) // 2
N_CONV = DEPTH // 2
ALPHA = (2.0 * DEPTH) ** 0.25
BETA = (8.0 * DEPTH) ** -0.25
LN_EPS = 1e-5

kernel_name = "pool_shortconv_convffn_deepnorm_step"


def layer_norm(x, g, b):
    xf = x.astype(jnp.float32)
    mu = jnp.mean(xf, axis=-1, keepdims=True)
    var = jnp.mean(jnp.square(xf - mu), axis=-1, keepdims=True)
    return ((xf - mu) * lax.rsqrt(var + LN_EPS)).astype(x.dtype) * g + b


def causal_conv3(ext, k, kb):
    t = ext.shape[1] - (CONV_W - 1)
    return ext[:, :t] * k[0] + ext[:, 1:t + 1] * k[1] + ext[:, 2:t + 2] * k[2] + kb


def pool_mixer(x, buf, start, w_groups, scale):
    bsz, t, _ = x.shape
    ext_raw = jnp.concatenate([buf, x], axis=1)
    ext = ext_raw.astype(jnp.float32)
    cs = jnp.concatenate([jnp.zeros((bsz, 1, D_MODEL), jnp.float32), jnp.cumsum(ext, axis=1)], axis=1)
    pos = start + jnp.arange(t, dtype=jnp.int32)
    p = POOL_HIST
    outs = []
    for g, w in enumerate(POOL_WINDOWS):
        sl = slice(g * POOL_GROUP, (g + 1) * POOL_GROUP)
        hi = cs[:, p + 1:p + t + 1, sl]
        lo = cs[:, p + 1 - w:p + t + 1 - w, sl]
        cnt = jnp.minimum(w, pos + 1).astype(jnp.float32)[None, :, None]
        outs.append((hi - lo) / cnt - ext[:, p:, sl])
    d = jnp.stack(outs, axis=2).astype(x.dtype)
    y = jnp.einsum('btgc,gcd->btgd', d, w_groups).reshape(bsz, t, D_MODEL) * scale
    return y, ext_raw[:, -POOL_HIST:]


def short_conv_mixer(x, buf, w_in, k, kb, w_out):
    proj = jnp.einsum('btd,de->bte', x, w_in)
    gate_b, gate_c, h = jnp.split(proj, 3, axis=-1)
    ext = jnp.concatenate([buf, gate_c * h], axis=1)
    z = causal_conv3(ext, k, kb)
    y = jnp.einsum('btc,cd->btd', gate_b * z, w_out)
    return y, ext[:, -(CONV_W - 1):]


def conv_ffn(x, buf, w_up, k, kb, w_down):
    h = jnp.einsum('btd,df->btf', x, w_up)
    ext = jnp.concatenate([buf, h], axis=1)
    z = causal_conv3(ext, k, kb)
    g, v = jnp.split(z, 2, axis=-1)
    y = jnp.einsum('btf,fd->btd', jax.nn.silu(g) * v, w_down)
    return y, ext[:, -(CONV_W - 1):]


def trunk(x, pool_bufs, conv_bufs, ffn_bufs, start,
          ln_mix_g, ln_mix_b, pool_w, pool_scale,
          conv_w_in, conv_k, conv_kb, conv_w_out,
          ffn_w_up, ffn_k, ffn_kb, ffn_w_down, ln_ffn_g, ln_ffn_b):
    new_pool, new_conv, new_ffn = [], [], []
    for i in range(DEPTH):
        j = i // 2
        if i % 2 == 0:
            mix, nb = pool_mixer(x, pool_bufs[j], start, pool_w[j], pool_scale[j])
            new_pool.append(nb)
        else:
            mix, nb = short_conv_mixer(x, conv_bufs[j], conv_w_in[j], conv_k[j], conv_kb[j], conv_w_out[j])
            new_conv.append(nb)
        x = layer_norm(ALPHA * x + mix, ln_mix_g[i], ln_mix_b[i])
        f, nb = conv_ffn(x, ffn_bufs[i], ffn_w_up[i], ffn_k[i], ffn_kb[i], ffn_w_down[i])
        new_ffn.append(nb)
        x = layer_norm(ALPHA * x + f, ln_ffn_g[i], ln_ffn_b[i])
    return x, jnp.stack(new_pool), jnp.stack(new_conv), jnp.stack(new_ffn)


def setup_inputs(seed: int = 0) -> dict:
    key = jax.random.key(seed)
    ks = jax.random.split(key, 20)
    f32 = jnp.float32
    nrm = lambda k, s: jax.random.normal(k, s, f32)
    return {
        "x_prompt": nrm(ks[0], (BATCH, SEQ, D_MODEL)),
        "x_sample": nrm(ks[1], (DEC_BATCH, DEC_SEQ, D_MODEL)),
        "state_pool": nrm(ks[2], (N_POOL, DEC_BATCH, POOL_HIST, D_MODEL)),
        "state_conv": nrm(ks[3], (N_CONV, DEC_BATCH, CONV_W - 1, D_CONV)),
        "state_ffn": nrm(ks[4], (DEPTH, DEC_BATCH, CONV_W - 1, 2 * D_FF)),
        "ln_mix_g": 1.0 + 0.02 * nrm(ks[5], (DEPTH, D_MODEL)),
        "ln_mix_b": 0.02 * nrm(ks[6], (DEPTH, D_MODEL)),
        "pool_w": nrm(ks[7], (N_POOL, N_POOL_GROUPS, POOL_GROUP, POOL_GROUP)) * (POOL_GROUP ** -0.5) * BETA,
        "pool_scale": 1.0 + 0.02 * nrm(ks[8], (N_POOL, D_MODEL)),
        "conv_w_in": nrm(ks[9], (N_CONV, D_MODEL, 3 * D_CONV)) * (D_MODEL ** -0.5),
        "conv_k": nrm(ks[10], (N_CONV, CONV_W, D_CONV)) * (CONV_W ** -0.5),
        "conv_kb": 0.01 * nrm(ks[11], (N_CONV, D_CONV)),
        "conv_w_out": nrm(ks[12], (N_CONV, D_CONV, D_MODEL)) * (D_CONV ** -0.5) * BETA,
        "ffn_w_up": nrm(ks[13], (DEPTH, D_MODEL, 2 * D_FF)) * (D_MODEL ** -0.5),
        "ffn_k": nrm(ks[14], (DEPTH, CONV_W, 2 * D_FF)) * (CONV_W ** -0.5),
        "ffn_kb": 0.01 * nrm(ks[15], (DEPTH, 2 * D_FF)),
        "ffn_w_down": nrm(ks[16], (DEPTH, D_FF, D_MODEL)) * (D_FF ** -0.5) * BETA,
        "ln_ffn_g": 1.0 + 0.02 * nrm(ks[17], (DEPTH, D_MODEL)),
        "ln_ffn_b": 0.02 * nrm(ks[18], (DEPTH, D_MODEL)),
    }


def reference(x_prompt, x_sample, state_pool, state_conv, state_ffn,
              ln_mix_g, ln_mix_b, pool_w, pool_scale,
              conv_w_in, conv_k, conv_kb, conv_w_out,
              ffn_w_up, ffn_k, ffn_kb, ffn_w_down, ln_ffn_g, ln_ffn_b):
    dt = x_prompt.dtype
    b = x_prompt.shape[0]
    zero_pool = jnp.zeros((N_POOL, b, POOL_HIST, D_MODEL), dt)
    zero_conv = jnp.zeros((N_CONV, b, CONV_W - 1, D_CONV), dt)
    zero_ffn = jnp.zeros((DEPTH, b, CONV_W - 1, 2 * D_FF), dt)
    y_prompt, pool_prompt, conv_prompt, ffn_prompt = trunk(
        x_prompt, zero_pool, zero_conv, zero_ffn, 0,
        ln_mix_g, ln_mix_b, pool_w, pool_scale, conv_w_in, conv_k, conv_kb, conv_w_out,
        ffn_w_up, ffn_k, ffn_kb, ffn_w_down, ln_ffn_g, ln_ffn_b)
    y_sample, pool_sample, conv_sample, ffn_sample = trunk(
        x_sample, state_pool, state_conv, state_ffn, PAST_LEN,
        ln_mix_g, ln_mix_b, pool_w, pool_scale, conv_w_in, conv_k, conv_kb, conv_w_out,
        ffn_w_up, ffn_k, ffn_kb, ffn_w_down, ln_ffn_g, ln_ffn_b)
    return (y_prompt, y_sample, pool_prompt, pool_sample, conv_prompt, conv_sample, ffn_prompt, ffn_sample)
```

```cpp
#include <hip/hip_runtime.h>
#include <hip/hip_cooperative_groups.h>
#include <cstdio>
#include <cstdint>
namespace cg = cooperative_groups;
#ifndef DIAG
#define DIAG 1023
#endif

#define LAS __attribute__((address_space(3)))
typedef unsigned short bf16_t;
typedef short bf16x8 __attribute__((ext_vector_type(8)));
typedef float f32x4 __attribute__((ext_vector_type(4)));
typedef float f32x2 __attribute__((ext_vector_type(2)));
typedef unsigned u32x4 __attribute__((ext_vector_type(4)));
typedef unsigned u32x2 __attribute__((ext_vector_type(2)));

constexpr int D = 1024, FF = 2816, FF2 = 5632, SEQ = 2048, NB_P = 8, NB_S = 128, TS = 4;
constexpr int NTOK_P = NB_P * SEQ;
constexpr int NTOK_S = NB_S * TS;
constexpr int MROWS = NTOK_P + NTOK_S;
constexpr int NPANEL = MROWS / 256;
constexpr int NPANEL_P = NTOK_P / 256;
constexpr float ALPHA = 1.41421356237309515f;
constexpr float LN_EPS = 1e-5f;

constexpr size_t O_Y = 0;
constexpr size_t O_POOL_P = (size_t)MROWS * D;
constexpr size_t O_POOL_S = O_POOL_P + (size_t)NB_P * 15 * D;
constexpr size_t O_CONV_P = O_POOL_S + (size_t)NB_S * 15 * D;
constexpr size_t O_CONV_S = O_CONV_P + (size_t)NB_P * 2 * D;
constexpr size_t O_FFN_P = O_CONV_S + (size_t)NB_S * 2 * D;
constexpr size_t O_FFN_S = O_FFN_P + (size_t)2 * NB_P * 2 * FF2;
constexpr size_t O_END = O_FFN_S + (size_t)2 * NB_S * 2 * FF2;

constexpr size_t WS_WUP = 0;
constexpr size_t WS_WDN = WS_WUP + (size_t)2 * FF2 * D * 2;
constexpr size_t WS_WIN = WS_WDN + (size_t)2 * D * FF * 2;
constexpr size_t WS_WOUT = WS_WIN + (size_t)3 * D * D * 2;
constexpr size_t WS_WPOOL = WS_WOUT + (size_t)D * D * 2;
constexpr size_t WS_CSP_UP = WS_WPOOL + (size_t)4 * 256 * 256 * 2;
constexpr size_t WS_CBP_UP = WS_CSP_UP + (size_t)2 * 16 * FF2 * 4;
constexpr size_t WS_CSP_IN = WS_CBP_UP + (size_t)2 * 16 * FF2 * 4;
constexpr size_t WS_CBP_IN = WS_CSP_IN + (size_t)16 * 3072 * 4;
constexpr size_t WS_CS_UP = WS_CBP_IN + (size_t)16 * 3072 * 4;
constexpr size_t WS_CB_UP = WS_CS_UP + (size_t)2 * FF2 * 4;
constexpr size_t WS_KC_UP = WS_CB_UP + (size_t)2 * FF2 * 4;
constexpr size_t WS_CS_IN = WS_KC_UP + (size_t)2 * 4 * FF2 * 4;
constexpr size_t WS_CB_IN = WS_CS_IN + (size_t)3072 * 4;
constexpr size_t WS_PART = WS_CB_IN + (size_t)3072 * 4;
constexpr size_t PART_BYTES = (size_t)MROWS * 4 * 8;
constexpr size_t WS_HF = WS_PART + 3 * PART_BYTES;
constexpr size_t HALO_BYTES = (size_t)132 * 2 * FF2 * 4;
constexpr size_t WS_HL = WS_HF + HALO_BYTES;
constexpr size_t WS_H1 = WS_HL + HALO_BYTES;
constexpr size_t WS_ACT = WS_H1 + (size_t)MROWS * D * 2;
constexpr size_t WS_END = WS_ACT + (size_t)MROWS * FF * 2;
static_assert(WS_END <= (size_t)256 * 1024 * 1024, "workspace");
static_assert(WS_WDN % 256 == 0 && WS_WIN % 256 == 0 && WS_WOUT % 256 == 0 && WS_WPOOL % 256 == 0 && WS_PART % 256 == 0 && WS_HF % 256 == 0 && WS_H1 % 256 == 0 && WS_ACT % 256 == 0, "align");

constexpr int STAGE_BYTES = 131072;
constexpr int EPI_OFF = STAGE_BYTES;
constexpr int LDS_BYTES = 147456;

struct Params {
    const float* in[19];
    float* out;
    unsigned char* ws;
};

__device__ __forceinline__ unsigned f2bf(float f) { unsigned u = __builtin_bit_cast(unsigned, f); return (u + 0x7fffu + ((u >> 16) & 1u)) >> 16; }
__device__ __forceinline__ float bf2f(unsigned b) { return __builtin_bit_cast(float, b << 16); }
__device__ __forceinline__ unsigned pk2(float lo, float hi) { return f2bf(lo) | (f2bf(hi) << 16); }
__device__ __forceinline__ float dpp_shr1(float v) {
    return __builtin_bit_cast(float, __builtin_amdgcn_update_dpp(0, __builtin_bit_cast(int, v), 0x111, 0xf, 0xf, true));
}
__device__ __forceinline__ float silu_mul(float g, float v) { return g * v * __builtin_amdgcn_rcpf(1.0f + __expf(-g)); }
__device__ __forceinline__ int tid_fresh() { int t = threadIdx.x; asm volatile("" : "+v"(t)); return t; }
__device__ __forceinline__ int row_of_tok(int tok) {
    const int pm = tok >> 8, tau = tok & 255;
    return pm * 256 + 128 * ((tau >> 2) & 1) + 64 * (tau >> 7) + 16 * (tau & 3) + ((tau >> 3) & 15);
}
__device__ __forceinline__ f32x2 row_stats(const f32x2* part, int R) {
    const f32x4 a = *(const f32x4*)(part + (size_t)R * 4), b = *(const f32x4*)(part + (size_t)R * 4 + 2);
    const float mean = ((a[0] + a[2]) + (b[0] + b[2])) * 0.25f;
    const float d0 = a[0] - mean, d1 = a[2] - mean, d2 = b[0] - mean, d3 = b[2] - mean;
    const float m2 = ((a[1] + a[3]) + (b[1] + b[3])) + 256.0f * ((d0 * d0 + d1 * d1) + (d2 * d2 + d3 * d3));
    f32x2 r; r.x = mean; r.y = __builtin_amdgcn_rsqf(m2 * (1.0f / 1024.0f) + LN_EPS); return r;
}
__device__ __forceinline__ void stats_to_lds(const f32x2* part, int pm, LAS f32x2* S) {
    int tx = threadIdx.x; asm volatile("" : "+v"(tx));
    if (tx < 256) { const f32x2 s = row_stats(part, pm * 256 + tx); f32x2 t; t.x = s.y; t.y = -s.x * s.y; S[tx] = t; }
    asm volatile("s_waitcnt lgkmcnt(0)" ::: "memory"); __builtin_amdgcn_s_barrier(); asm volatile("" ::: "memory");
}
#define KA __attribute__((address_space(4)))
__device__ __forceinline__ const KA Params* kargs() { const KA Params* p = (const KA Params*)__builtin_amdgcn_kernarg_segment_ptr(); asm volatile("" : "+s"(p)); return p; }

namespace pg8 {
constexpr int BM = 256, BK = 64, HALF = 128, HTB = HALF * BK * 2, NXCD = 8, WGM = 8;
__host__ __device__ __forceinline__ int lds_byte(int r, int c) { const int st = (r >> 4) * 2 + (c >> 5), rr = r & 15, cc = c & 31, ob = rr * 64 + cc * 2; return st * 1024 + (ob ^ (((ob >> 9) & 1) << 5)); }
__host__ __device__ __forceinline__ void stage_rc(int b, int& R, int& C) { const int st = b / 1024, sb = b % 1024, swz = sb ^ (((sb >> 9) & 1) << 5); R = (st >> 1) * 16 + swz / 64; C = (st & 1) * 32 + (swz % 64) / 2; }

struct Unit { int pm, pn; };
struct Gemm { const bf16_t* A; const bf16_t* Bt; int K; };

struct StaticOrder {
    int nM, nN, nwg, G, c;
    __device__ void init(int nM_, int nN_, int G_, int c_) { nM = nM_; nN = nN_; nwg = nM * nN; G = G_; c = c_; }
    __device__ bool next(int i, Unit& u) const {
        const long L = (long)i * G + c; if (L >= nwg) return false;
        int wgid = (int)L; { const int q = nwg / NXCD, r = nwg % NXCD, xcd = wgid % NXCD, off = wgid / NXCD; wgid = (xcd < r ? xcd * (q + 1) : r * (q + 1) + (xcd - r) * q) + off; }
        const int nig = WGM * nN, gid = wgid / nig, fm = gid * WGM, gsz = (nM - fm) < WGM ? (nM - fm) : WGM;
        u.pm = fm + ((wgid % nig) % gsz); u.pn = (wgid % nig) / gsz; return true;
    }
};

template <class Epi>
__device__ __forceinline__ void gemm_phase(LAS unsigned char* lds, const Gemm g, const StaticOrder& S, const Epi& E) {
    const int tid = tid_fresh(), wid = __builtin_amdgcn_readfirstlane(tid >> 6), lane = tid & 63, wr = wid >> 2, wc = wid & 3, fr = lane & 15, fq = lane >> 4;
    const int K = g.K, nt = K / BK;
    unsigned voffA[2];
#pragma unroll
    for (int i = 0; i < 2; ++i) { int R, C; stage_rc(tid * 16 + i * 8192, R, C); voffA[i] = (unsigned)(R * K + C) * 2u; }
    const size_t kstep = (size_t)(BK * 2);
    const size_t hstep = (size_t)HALF * K * 2;
    const size_t tstep = 2 * hstep;
    const unsigned ldsw = (unsigned)wid * 1024u;
    const int aoff = lds_byte(wr * 64 + fr, fq * 8), boff = lds_byte(wc * 32 + fr, fq * 8);
#define PG8_SA(b, h) (((b) * 2 + (h)) * HTB)
#define PG8_SB(b, h) ((4 + (b) * 2 + (h)) * HTB)
#define PG8_STAGE(bufoff, gbase) do { _Pragma("unroll") for (int _i = 0; _i < 2; ++_i) \
        __builtin_amdgcn_global_load_lds((const unsigned*)((const char*)(gbase) + voffA[_i]), (LAS unsigned*)(lds + (bufoff) + ldsw + _i * 8192), 16, 0, 0); } while (0)
#define PG8_LDA(dst, b, h) do { _Pragma("unroll") for (int m = 0; m < 4; ++m) _Pragma("unroll") for (int k = 0; k < 2; ++k) dst[m][k] = *(const LAS bf16x8*)(lds + PG8_SA(b, h) + aoff + m * 2048 + k * 1024); } while (0)
#define PG8_LDB(dst, b, h) do { _Pragma("unroll") for (int n = 0; n < 2; ++n) _Pragma("unroll") for (int k = 0; k < 2; ++k) dst[n][k] = *(const LAS bf16x8*)(lds + PG8_SB(b, h) + boff + n * 2048 + k * 1024); } while (0)
#define PG8_MMA(ai, bj, At, Bt) do { __builtin_amdgcn_s_setprio(1); _Pragma("unroll") for (int m = 0; m < 4; ++m) _Pragma("unroll") for (int n = 0; n < 2; ++n) _Pragma("unroll") for (int k = 0; k < 2; ++k) \
        acc[ai][bj][m][n] = __builtin_amdgcn_mfma_f32_16x16x32_bf16(Bt[n][k], At[m][k], acc[ai][bj][m][n], 0, 0, 0); __builtin_amdgcn_s_setprio(0); } while (0)
#define PG8_WAIT_V(n) asm volatile("s_waitcnt vmcnt(" #n ")" ::: "memory")
#define PG8_WAIT_L(n) asm volatile("s_waitcnt lgkmcnt(" #n ")" ::: "memory")
#define PG8_BAR __builtin_amdgcn_s_barrier()
#define PG8_SCHED __builtin_amdgcn_sched_barrier(0)
    Unit cur, nxt; int ui = 0;
    if (!S.next(0, cur)) return;
    f32x4 acc[2][2][4][2];
#pragma unroll
    for (int a = 0; a < 2; ++a)
#pragma unroll
        for (int b = 0; b < 2; ++b)
#pragma unroll
            for (int m = 0; m < 4; ++m)
#pragma unroll
                for (int n = 0; n < 2; ++n) acc[a][b][m][n] = (f32x4){0.f, 0.f, 0.f, 0.f};
    bf16x8 At[4][2], B0[2][2], B1[2][2];
    const char* cA = (const char*)g.A + (size_t)cur.pm * tstep; const char* cB = (const char*)g.Bt + (size_t)cur.pn * tstep;
    PG8_STAGE(PG8_SB(0, 0), cB); PG8_STAGE(PG8_SB(0, 1), cB + hstep); PG8_STAGE(PG8_SA(0, 0), cA); PG8_STAGE(PG8_SA(0, 1), cA + hstep);
    if (wr == 1) PG8_BAR;
    PG8_WAIT_V(2); PG8_BAR;
    PG8_STAGE(PG8_SB(1, 0), cB + kstep); PG8_STAGE(PG8_SA(1, 0), cA + kstep); PG8_STAGE(PG8_SB(1, 1), cB + hstep + kstep);
    PG8_WAIT_V(6); PG8_BAR;
    for (;;) {
        const bool has_next = S.next(ui + 1, nxt);
        const char* nA = has_next ? (const char*)g.A + (size_t)nxt.pm * tstep : cA; const char* nB = has_next ? (const char*)g.Bt + (size_t)nxt.pn * tstep : cB;
        for (int t = 0; t < nt; t += 2) {
            const bool last = (t == nt - 2);
            const char* a1 = cA + (size_t)(t + 1) * kstep;
            const char* a2 = last ? nA : cA + (size_t)(t + 2) * kstep; const char* b2 = last ? nB : cB + (size_t)(t + 2) * kstep;
            const char* a3 = a2 + kstep; const char* b3 = b2 + kstep;
            PG8_LDB(B0, 0, 0); PG8_LDB(B1, 0, 1); PG8_SCHED; PG8_LDA(At, 0, 0); PG8_STAGE(PG8_SA(1, 1), a1 + hstep);
            PG8_WAIT_V(8); PG8_WAIT_L(0); PG8_BAR; PG8_MMA(0, 0, At, B0); PG8_MMA(0, 1, At, B1); PG8_BAR; PG8_SCHED;
            PG8_LDA(At, 0, 1); PG8_STAGE(PG8_SB(0, 0), b2); PG8_STAGE(PG8_SB(0, 1), b2 + hstep); PG8_STAGE(PG8_SA(0, 0), a2);
            PG8_WAIT_V(8); PG8_WAIT_L(0); PG8_BAR; PG8_MMA(1, 0, At, B0); PG8_MMA(1, 1, At, B1); PG8_BAR; PG8_SCHED;
            PG8_LDB(B0, 1, 0); PG8_LDB(B1, 1, 1); PG8_SCHED; PG8_LDA(At, 1, 0); PG8_STAGE(PG8_SA(0, 1), a2 + hstep);
            PG8_WAIT_V(8); PG8_WAIT_L(0); PG8_BAR; PG8_MMA(0, 0, At, B0); PG8_MMA(0, 1, At, B1); PG8_BAR; PG8_SCHED;
            PG8_LDA(At, 1, 1); PG8_STAGE(PG8_SB(1, 0), b3); PG8_STAGE(PG8_SB(1, 1), b3 + hstep); PG8_STAGE(PG8_SA(1, 0), a3);
            PG8_WAIT_V(8); PG8_WAIT_L(0); PG8_BAR; PG8_MMA(1, 0, At, B0); PG8_MMA(1, 1, At, B1); PG8_BAR; PG8_SCHED;
        }
        if (wr == 0) PG8_BAR;
        { int fr_e = fr, fq_e = fq; asm volatile("" : "+v"(fr_e), "+v"(fq_e));
          E(acc, cur, wr, wc, fr_e, fq_e, lds + EPI_OFF); }
        if (!has_next) break;
#pragma unroll
        for (int a = 0; a < 2; ++a)
#pragma unroll
            for (int b = 0; b < 2; ++b)
#pragma unroll
                for (int m = 0; m < 4; ++m)
#pragma unroll
                    for (int n = 0; n < 2; ++n) acc[a][b][m][n] = (f32x4){0.f, 0.f, 0.f, 0.f};
        cur = nxt; cA = nA; cB = nB; ++ui;
        if (wr == 1) PG8_BAR;
    }
    PG8_WAIT_V(0);
    PG8_BAR;
#undef PG8_SA
#undef PG8_SB
#undef PG8_STAGE
#undef PG8_LDA
#undef PG8_LDB
#undef PG8_MMA
#undef PG8_WAIT_V
#undef PG8_WAIT_L
#undef PG8_BAR
#undef PG8_SCHED
}
}

template <int BJ> __device__ __forceinline__ void pin_half(f32x4 (&acc)[2][2][4][2]) {
#pragma unroll
    for (int ai = 0; ai < 2; ++ai)
        asm volatile("" : "+v"(acc[ai][BJ][0][0]), "+v"(acc[ai][BJ][0][1]), "+v"(acc[ai][BJ][1][0]), "+v"(acc[ai][BJ][1][1]), "+v"(acc[ai][BJ][2][0]), "+v"(acc[ai][BJ][2][1]), "+v"(acc[ai][BJ][3][0]), "+v"(acc[ai][BJ][3][1]) :: "memory");
}
template <int BJ, int N> __device__ __forceinline__ void pin_group(f32x4 (&acc)[2][2][4][2]) {
    asm volatile("" : "+v"(acc[0][BJ][0][N]), "+v"(acc[0][BJ][1][N]), "+v"(acc[0][BJ][2][N]), "+v"(acc[0][BJ][3][N]), "+v"(acc[1][BJ][0][N]), "+v"(acc[1][BJ][1][N]), "+v"(acc[1][BJ][2][N]), "+v"(acc[1][BJ][3][N]) :: "memory");
}
template <int N> __device__ __forceinline__ void pin_n(f32x4 (&acc)[2][2][4][2]) {
#pragma unroll
    for (int ai = 0; ai < 2; ++ai)
        asm volatile("" : "+v"(acc[ai][0][0][N]), "+v"(acc[ai][0][1][N]), "+v"(acc[ai][0][2][N]), "+v"(acc[ai][0][3][N]), "+v"(acc[ai][1][0][N]), "+v"(acc[ai][1][1][N]), "+v"(acc[ai][1][2][N]), "+v"(acc[ai][1][3][N]) :: "memory");
}
template <int BJ, int N, int J0, int LEN>
__device__ __forceinline__ void conv_chain(f32x4 (&acc)[2][2][4][2], const f32x4 k0, const f32x4 k1, const f32x4 k2, const f32x4 kb, const f32x4 p1, const f32x4 p2) {
#pragma unroll
    for (int i = LEN - 1; i >= 0; --i) {
        const int j = J0 + i;
        const f32x4 h0 = acc[j >> 2][BJ][j & 3][N];
        const f32x4 h1 = i >= 1 ? acc[(j - 1) >> 2][BJ][(j - 1) & 3][N] : p1;
        const f32x4 h2 = i >= 2 ? acc[(j - 2) >> 2][BJ][(j - 2) & 3][N] : (i == 1 ? p1 : p2);
        acc[j >> 2][BJ][j & 3][N] = k2 * h0 + k1 * h1 + k0 * h2 + kb;
    }
}
struct EpiUp {
    int l;
    template <int N>
    __device__ __forceinline__ void half(f32x4 (&acc)[2][2][4][2], int pm, int pn, int wr, int wc, int fr, int fq) const {
        asm volatile("" : "+v"(fr), "+v"(fq));
        const KA Params* q = kargs(); unsigned char* ws = q->ws;
        const bool sample = pm >= NPANEL_P;
        const int chunk = 2 * pm + wr;
        const int ucol = 256 * pn + 32 * wc + 16 * N;
        const int ufcol = 128 * pn + 32 * wc + 16 * N;
        const char* kcb = (const char*)((const float*)(ws + WS_KC_UP) + (size_t)l * 4 * FF2 + ucol);
        const unsigned lq = (unsigned)(16 * fq);
#define KC4(tap, vhalf) (*(const f32x4*)(kcb + lq + (unsigned)(((tap) * FF2 + (vhalf) * 128) * 4)))
        if (!sample) {
            f32x4 g2, g1;
#pragma unroll
            for (int e = 0; e < 4; ++e) { g2[e] = dpp_shr1(acc[1][0][2][N][e]); g1[e] = dpp_shr1(acc[1][0][3][N][e]); }
            if (fr == 0) {
                char* hf = (char*)((float*)(ws + WS_HF) + (size_t)chunk * 2 * FF2 + ucol) + lq;
                *(f32x4*)(hf) = acc[0][0][0][N]; *(f32x4*)(hf + FF2 * 4) = acc[0][0][1][N];
                *(f32x4*)(hf + 128 * 4) = acc[0][1][0][N]; *(f32x4*)(hf + (FF2 + 128) * 4) = acc[0][1][1][N];
            }
            if (fr == 15) {
                char* hl = (char*)((float*)(ws + WS_HL) + (size_t)chunk * 2 * FF2 + ucol) + lq;
                *(f32x4*)(hl) = acc[1][0][2][N]; *(f32x4*)(hl + FF2 * 4) = acc[1][0][3][N];
                *(f32x4*)(hl + 128 * 4) = acc[1][1][2][N]; *(f32x4*)(hl + (FF2 + 128) * 4) = acc[1][1][3][N];
                if ((pm & 7) == 7 && wr == 1) {
                    char* o = (char*)(q->out + O_FFN_P + ((size_t)l * NB_P + (pm >> 3)) * 2 * FF2 + ufcol) + lq;
                    *(f32x4*)(o) = acc[1][0][2][N]; *(f32x4*)(o + FF2 * 4) = acc[1][0][3][N];
                    *(f32x4*)(o + FF * 4) = acc[1][1][2][N]; *(f32x4*)(o + (FF2 + FF) * 4) = acc[1][1][3][N];
                }
            }
            pin_n<N>(acc);
            { const f32x4 k0 = KC4(0, 0), k1 = KC4(1, 0), k2 = KC4(2, 0), kb = KC4(3, 0); conv_chain<0, N, 0, 8>(acc, k0, k1, k2, kb, g1, g2); }
            pin_n<N>(acc);
            { f32x4 v2, v1;
#pragma unroll
              for (int e = 0; e < 4; ++e) { v2[e] = dpp_shr1(acc[1][1][2][N][e]); v1[e] = dpp_shr1(acc[1][1][3][N][e]); }
              const f32x4 k0 = KC4(0, 1), k1 = KC4(1, 1), k2 = KC4(2, 1), kb = KC4(3, 1); conv_chain<1, N, 0, 8>(acc, k0, k1, k2, kb, v1, v2); }
        } else {
            const int useq0 = 64 * (pm - NPANEL_P) + 32 * wr;
            const unsigned ls = (unsigned)(2 * fr * 2 * FF2 * 4) + lq;
            char* ob = (char*)(q->out + O_FFN_S + ((size_t)l * NB_S + useq0) * 2 * FF2 + ufcol);
#pragma unroll
            for (int ai = 0; ai < 2; ++ai) { char* o = ob + ls + (unsigned)(ai * 2 * FF2 * 4);
                *(f32x4*)(o) = acc[ai][0][2][N]; *(f32x4*)(o + FF2 * 4) = acc[ai][0][3][N];
                *(f32x4*)(o + FF * 4) = acc[ai][1][2][N]; *(f32x4*)(o + (FF2 + FF) * 4) = acc[ai][1][3][N]; }
            pin_n<N>(acc);
            const char* sb = (const char*)(q->in[4] + ((size_t)l * NB_S + useq0) * 2 * FF2 + ufcol);
            { const f32x4 k0 = KC4(0, 0), k1 = KC4(1, 0), k2 = KC4(2, 0), kb = KC4(3, 0);
              conv_chain<0, N, 0, 4>(acc, k0, k1, k2, kb, *(const f32x4*)(sb + ls + FF2 * 4), *(const f32x4*)(sb + ls));
              conv_chain<0, N, 4, 4>(acc, k0, k1, k2, kb, *(const f32x4*)(sb + ls + 3 * FF2 * 4), *(const f32x4*)(sb + ls + 2 * FF2 * 4)); }
            pin_n<N>(acc);
            { const f32x4 k0 = KC4(0, 1), k1 = KC4(1, 1), k2 = KC4(2, 1), kb = KC4(3, 1);
              conv_chain<1, N, 0, 4>(acc, k0, k1, k2, kb, *(const f32x4*)(sb + ls + (FF2 + FF) * 4), *(const f32x4*)(sb + ls + FF * 4));
              conv_chain<1, N, 4, 4>(acc, k0, k1, k2, kb, *(const f32x4*)(sb + ls + (3 * FF2 + FF) * 4), *(const f32x4*)(sb + ls + (2 * FF2 + FF) * 4)); }
        }
#undef KC4
        pin_n<N>(acc);
        char* ab = (char*)((bf16_t*)(ws + WS_ACT) + (size_t)(pm * 256 + 64 * wr) * FF + ufcol);
        const unsigned la = (unsigned)((fr * FF + 4 * fq) * 2);
#pragma unroll
        for (int j = 0; j < 8; ++j) {
            const f32x4 zg = acc[j >> 2][0][j & 3][N], zv = acc[j >> 2][1][j & 3][N];
            u32x2 w; w.x = pk2(silu_mul(zg[0], zv[0]), silu_mul(zg[1], zv[1])); w.y = pk2(silu_mul(zg[2], zv[2]), silu_mul(zg[3], zv[3]));
            *(u32x2*)(ab + la + (unsigned)((128 * (j >> 2) + 16 * (j & 3)) * FF * 2)) = w;
        }
        asm volatile("" ::: "memory");
    }
    __device__ __forceinline__ void operator()(f32x4 (&acc)[2][2][4][2], const pg8::Unit& u, int wr, int wc, int fr, int fq, LAS unsigned char* elds) const {
        const int pm = u.pm, pn = u.pn;
        LAS f32x2* S = (LAS f32x2*)(elds + 8192);
        { const KA Params* q = kargs(); unsigned char* ws = q->ws;
          stats_to_lds((const f32x2*)(ws + WS_PART) + (size_t)(l == 0 ? 0 : 2) * MROWS * 4, pm, S);
          const char* csb = (const char*)((const float*)(ws + WS_CS_UP) + l * FF2 + 256 * pn + 32 * wc); const char* cbb = (const char*)((const float*)(ws + WS_CB_UP) + l * FF2 + 256 * pn + 32 * wc);
          const unsigned lq = (unsigned)(16 * fq);
          f32x2 st[8];
#pragma unroll
          for (int j = 0; j < 8; ++j) st[j] = S[128 * (j >> 2) + 64 * wr + 16 * (j & 3) + fr];
#pragma unroll
          for (int bj = 0; bj < 2; ++bj)
#pragma unroll
              for (int n = 0; n < 2; ++n) { const f32x4 csv = *(const f32x4*)(csb + lq + (unsigned)((128 * bj + 16 * n) * 4)), cbv = *(const f32x4*)(cbb + lq + (unsigned)((128 * bj + 16 * n) * 4));
#pragma unroll
                  for (int j = 0; j < 8; ++j) acc[j >> 2][bj][j & 3][n] = acc[j >> 2][bj][j & 3][n] * st[j].x + (csv * st[j].y + cbv);
                  asm volatile("" ::: "memory"); }
        }
        pin_half<0>(acc); pin_half<1>(acc);
        half<0>(acc, pm, pn, wr, wc, fr, fq);
        half<1>(acc, pm, pn, wr, wc, fr, fq);
    }
};

template <bool FINAL> struct EpiRes {
    int pprev, pnew, gi, goff;
    template <int BJ>
    __device__ __forceinline__ void resid(f32x4 (&acc)[2][2][4][2], int pm, int pn, int wr, int wc, int fr, int fq, LAS f32x2* S) const {
        asm volatile("" : "+v"(fr), "+v"(fq));
        const KA Params* q = kargs();
        const int ucol = 256 * pn + 128 * BJ + 32 * wc;
        const char* vb = (const char*)((const bf16_t*)(q->ws + WS_H1) + (size_t)(pm * 256 + 64 * wr) * D + ucol);
        const unsigned lv = (unsigned)((fr * D + 4 * fq) * 2), lq = (unsigned)(16 * fq);
        const char* gb = (const char*)(q->in[gi] + goff + ucol); const char* bb = (const char*)(q->in[gi + 1] + goff + ucol);
        u32x2 vp[8][2];
#pragma unroll
        for (int j = 0; j < 8; ++j)
#pragma unroll
            for (int n = 0; n < 2; ++n) vp[j][n] = *(const u32x2*)(vb + lv + (unsigned)(((128 * (j >> 2) + 16 * (j & 3)) * D + 16 * n) * 2));
        f32x4 gv[2], bv[2];
#pragma unroll
        for (int n = 0; n < 2; ++n) { gv[n] = *(const f32x4*)(gb + lq + (unsigned)(64 * n)) * ALPHA; bv[n] = *(const f32x4*)(bb + lq + (unsigned)(64 * n)) * ALPHA; }
        const LAS f32x2* Sl = S + 64 * wr + fr;
#pragma unroll
        for (int j = 0; j < 8; ++j) { const f32x2 s = Sl[128 * (j >> 2) + 16 * (j & 3)];
#pragma unroll
            for (int n = 0; n < 2; ++n) { f32x4 v; v[0] = bf2f(vp[j][n].x & 0xffffu); v[1] = bf2f(vp[j][n].x >> 16); v[2] = bf2f(vp[j][n].y & 0xffffu); v[3] = bf2f(vp[j][n].y >> 16);
                acc[j >> 2][BJ][j & 3][n] = (v * s.x + s.y) * gv[n] + bv[n] + acc[j >> 2][BJ][j & 3][n]; } }
        pin_half<BJ>(acc);
    }
    __device__ __forceinline__ void operator()(f32x4 (&acc)[2][2][4][2], const pg8::Unit& u, int wr, int wc, int fr, int fq, LAS unsigned char* elds) const {
        const int pm = u.pm, pn = u.pn;
        LAS f32x2* P = (LAS f32x2*)elds;
        LAS f32x2* S = (LAS f32x2*)(elds + 8192);
        stats_to_lds((const f32x2*)(kargs()->ws + WS_PART) + (size_t)pprev * MROWS * 4, pm, S);
        resid<0>(acc, pm, pn, wr, wc, fr, fq, S);
        resid<1>(acc, pm, pn, wr, wc, fr, fq, S);
        asm volatile("" : "+v"(fr), "+v"(fq));
        const KA Params* q = kargs();
        char* ob; unsigned lo;
        if (FINAL) { ob = (char*)(q->out + O_Y + (size_t)(pm * 256 + 128 * wr) * D + 256 * pn + 32 * wc); lo = (unsigned)((8 * fr * D + 4 * fq) * 4); }
        else { ob = (char*)((bf16_t*)(q->ws + WS_H1) + (size_t)(pm * 256 + 64 * wr) * D + 256 * pn + 32 * wc); lo = (unsigned)((fr * D + 4 * fq) * 2); }
        LAS f32x2* Pl = P + (64 * wr + fr) * 4 + wc;
#pragma unroll
        for (int j = 0; j < 8; ++j) {
            const int ai = j >> 2, m = j & 3;
            float sum = 0.f;
#pragma unroll
            for (int bj = 0; bj < 2; ++bj)
#pragma unroll
                for (int n = 0; n < 2; ++n) { const f32x4 vn = acc[ai][bj][m][n]; sum += (vn[0] + vn[1]) + (vn[2] + vn[3]); }
            sum += __shfl_xor(sum, 16); sum += __shfl_xor(sum, 32);
            const float mw = sum * (1.0f / 64.0f); float qq = 0.f;
#pragma unroll
            for (int bj = 0; bj < 2; ++bj)
#pragma unroll
                for (int n = 0; n < 2; ++n) { const f32x4 d = acc[ai][bj][m][n] - mw; qq += (d[0] * d[0] + d[1] * d[1]) + (d[2] * d[2] + d[3] * d[3]); }
            qq += __shfl_xor(qq, 16); qq += __shfl_xor(qq, 32);
            if (fq == 0) { f32x2 t; t.x = mw; t.y = qq; Pl[(128 * ai + 16 * m) * 4] = t; }
#pragma unroll
            for (int bj = 0; bj < 2; ++bj)
#pragma unroll
                for (int n = 0; n < 2; ++n) { const f32x4 vn = acc[ai][bj][m][n];
                    if (FINAL) *(f32x4*)(ob + lo + (unsigned)(((4 * ai + m) * D + 128 * bj + 16 * n) * 4)) = vn;
                    else { u32x2 w; w.x = pk2(vn[0], vn[1]); w.y = pk2(vn[2], vn[3]); *(u32x2*)(ob + lo + (unsigned)(((128 * ai + 16 * m) * D + 128 * bj + 16 * n) * 2)) = w; } }
        }
        asm volatile("s_waitcnt lgkmcnt(0)" ::: "memory"); __builtin_amdgcn_s_barrier(); asm volatile("" ::: "memory");
        int rl = threadIdx.x; asm volatile("" : "+v"(rl));
        if (rl < 256) {
            const f32x2 a = P[rl * 4 + 0], b2 = P[rl * 4 + 1], c2 = P[rl * 4 + 2], d2 = P[rl * 4 + 3];
            const float mt = (a.x + b2.x + c2.x + d2.x) * 0.25f;
            const float da = a.x - mt, db = b2.x - mt, dc = c2.x - mt, dd = d2.x - mt;
            f32x2 r; r.x = mt; r.y = (a.y + b2.y) + (c2.y + d2.y) + 64.0f * ((da * da + db * db) + (dc * dc + dd * dd));
            char* pb = (char*)((f32x2*)(q->ws + WS_PART) + (size_t)pnew * MROWS * 4 + (size_t)pm * 256 * 4 + pn);
            *(f32x2*)(pb + (unsigned)(rl * 32)) = r;
        }
    }
};

struct EpiIn {
    int dummy;
    __device__ __forceinline__ void operator()(f32x4 (&acc)[2][2][4][2], const pg8::Unit& u, int wr, int wc, int fr, int fq, LAS unsigned char* elds) const {
        const int pm = u.pm, pn = u.pn; const bool sample = pm >= NPANEL_P;
        LAS f32x2* S = (LAS f32x2*)(elds + 8192);
        const KA Params* q = kargs(); unsigned char* ws = q->ws;
        stats_to_lds((const f32x2*)(ws + WS_PART) + (size_t)1 * MROWS * 4, pm, S);
        const unsigned lq = (unsigned)(16 * fq);
        { const char* csb = (const char*)((const float*)(ws + WS_CS_IN) + 256 * pn + 32 * wc); const char* cbb = (const char*)((const float*)(ws + WS_CB_IN) + 256 * pn + 32 * wc);
          f32x2 st[8];
#pragma unroll
          for (int j = 0; j < 8; ++j) st[j] = S[128 * (j >> 2) + 64 * wr + 16 * (j & 3) + fr];
#pragma unroll
          for (int bj = 0; bj < 2; ++bj)
#pragma unroll
              for (int n = 0; n < 2; ++n) { const f32x4 csv = *(const f32x4*)(csb + lq + (unsigned)((128 * bj + 16 * n) * 4)), cbv = *(const f32x4*)(cbb + lq + (unsigned)((128 * bj + 16 * n) * 4));
#pragma unroll
                  for (int j = 0; j < 8; ++j) acc[j >> 2][bj][j & 3][n] = acc[j >> 2][bj][j & 3][n] * st[j].x + (csv * st[j].y + cbv);
                  asm volatile("" ::: "memory"); } }
        pin_half<0>(acc); pin_half<1>(acc);
        asm volatile("" : "+v"(fr), "+v"(fq));
        const unsigned lr = (unsigned)((fr * D + 4 * fq) * 2);
        if (pn < 8) {
            char* ub = (char*)((bf16_t*)(ws + WS_ACT) + (size_t)(pm * 256 + 64 * wr) * D + 128 * pn + 32 * wc);
#pragma unroll
            for (int n = 0; n < 2; ++n) {
#pragma unroll
                for (int j = 0; j < 8; ++j) { const int ai = j >> 2, m = j & 3; const f32x4 uu = acc[ai][0][m][n] * acc[ai][1][m][n];
                    u32x2 w; w.x = pk2(uu[0], uu[1]); w.y = pk2(uu[2], uu[3]); *(u32x2*)(ub + lr + (unsigned)(((128 * ai + 16 * m) * D + 16 * n) * 2)) = w;
                    if (sample) { if (m >= 2) { const int seq = 64 * (pm - NPANEL_P) + 32 * wr + 2 * fr + ai; *(f32x4*)(q->out + O_CONV_S + ((size_t)seq * 2 + (m - 2)) * D + 128 * pn + 32 * wc + 16 * n + 4 * fq) = uu; } }
                    else if ((pm & 7) == 7 && wr == 1 && fr == 15 && j >= 6) { *(f32x4*)(q->out + O_CONV_P + ((size_t)(pm >> 3) * 2 + (j - 6)) * D + 128 * pn + 32 * wc + 16 * n + 4 * fq) = uu; } } }
        } else {
            char* bb = (char*)((bf16_t*)(ws + WS_ACT) + (size_t)MROWS * D + (size_t)(pm * 256 + 64 * wr) * D + 256 * (pn - 8) + 32 * wc);
#pragma unroll
            for (int bj = 0; bj < 2; ++bj)
#pragma unroll
                for (int n = 0; n < 2; ++n) {
#pragma unroll
                    for (int j = 0; j < 8; ++j) { const int ai = j >> 2, m = j & 3; const f32x4 v = acc[ai][bj][m][n];
                        u32x2 w; w.x = pk2(v[0], v[1]); w.y = pk2(v[2], v[3]); *(u32x2*)(bb + lr + (unsigned)(((128 * ai + 16 * m) * D + 128 * bj + 16 * n) * 2)) = w; } }
        }
    }
};

__device__ __forceinline__ void p0_item(const float* W, int K, int N, int kb, int nb, bf16_t* WT, int dest_row0, const float* rowscale, const float* colscale,
                                        float* csp, const float* bvec, float* cbp, int pstride, LAS float* scr, int lane) {
    const int k0 = 64 * kb, n0 = 32 * nb;
#pragma unroll 8
    for (int i = 0; i < 32; ++i) { const int kk = 2 * i + (lane >> 5); scr[kk * 33 + (lane & 31)] = W[(size_t)(k0 + kk) * N + n0 + (lane & 31)]; }
    asm volatile("s_waitcnt lgkmcnt(0)" ::: "memory");
    const int c = lane & 7;
    float rs[8], bb[8];
#pragma unroll
    for (int i = 0; i < 8; ++i) { rs[i] = rowscale ? rowscale[k0 + 8 * c + i] : 1.0f; bb[i] = bvec ? bvec[k0 + 8 * c + i] : 0.0f; }
#pragma unroll
    for (int j = 0; j < 4; ++j) { const int n = (lane >> 3) + 8 * j; const LAS float* s = scr + (8 * c) * 33 + n;
        const float sc = colscale ? colscale[n0 + n] : 1.0f;
        unsigned r[8]; float ps = 0.f, pb = 0.f;
#pragma unroll
        for (int i = 0; i < 8; ++i) { const float w = s[i * 33]; r[i] = f2bf(w * rs[i] * sc); ps += bf2f(r[i]); pb += w * bb[i]; }
        u32x4 o; o.x = r[0] | (r[1] << 16); o.y = r[2] | (r[3] << 16); o.z = r[4] | (r[5] << 16); o.w = r[6] | (r[7] << 16);
        *(u32x4*)(WT + (size_t)(dest_row0 + n) * K + k0 + 8 * c) = o;
        if (csp) {
            ps += __shfl_xor(ps, 1); ps += __shfl_xor(ps, 2); ps += __shfl_xor(ps, 4);
            pb += __shfl_xor(pb, 1); pb += __shfl_xor(pb, 2); pb += __shfl_xor(pb, 4);
            if (c == 0) { csp[(size_t)kb * pstride + dest_row0 + n] = ps; cbp[(size_t)kb * pstride + dest_row0 + n] = pb; }
        }
    }
    asm volatile("s_waitcnt lgkmcnt(0)" ::: "memory");
}
__device__ __forceinline__ int up_dest(int n) { return n < FF ? 256 * (n >> 7) + (n & 127) : 256 * ((n - FF) >> 7) + 128 + ((n - FF) & 127); }
__device__ __forceinline__ int in_dest(int n) { return n < D ? 2048 + n : (n < 2 * D ? 256 * ((n - D) >> 7) + ((n - D) & 127) : 256 * ((n - 2 * D) >> 7) + 128 + ((n - 2 * D) & 127)); }

__device__ __forceinline__ void phase0(LAS unsigned char* lds) {
    const KA Params* q = kargs();
    const int tid = tid_fresh(), lane = tid & 63, wave = tid >> 6;
    LAS float* scr = (LAS float*)(lds + wave * 8704);
    const int gw = blockIdx.x * 8 + wave, NGW = gridDim.x * 8;
    unsigned char* ws = q->ws;
    constexpr int I_UP = 16 * 176, I_IN = 16 * 96, I_OUT = 16 * 32, I_DN = 44 * 32, I_POOL = 4 * 8;
    constexpr int NITEMS = 2 * I_UP + I_IN + I_OUT + 2 * I_DN + 4 * I_POOL;
    for (int it = gw; it < NITEMS; it += NGW) {
        int r = it;
        if (r < 2 * I_UP) { const int l = r / I_UP; r -= l * I_UP; const int kb = r / 176, nb = r % 176;
            p0_item(q->in[13] + (size_t)l * D * FF2, D, FF2, kb, nb, (bf16_t*)(ws + WS_WUP) + (size_t)l * FF2 * D, up_dest(32 * nb), q->in[5] + l * D, nullptr,
                    (float*)(ws + WS_CSP_UP) + (size_t)l * 16 * FF2, q->in[6] + l * D, (float*)(ws + WS_CBP_UP) + (size_t)l * 16 * FF2, FF2, scr, lane); continue; }
        r -= 2 * I_UP;
        if (r < I_IN) { const int kb = r / 96, nb = r % 96;
            p0_item(q->in[9], D, 3 * D, kb, nb, (bf16_t*)(ws + WS_WIN), in_dest(32 * nb), q->in[17], nullptr, (float*)(ws + WS_CSP_IN), q->in[18], (float*)(ws + WS_CBP_IN), 3 * D, scr, lane); continue; }
        r -= I_IN;
        if (r < I_OUT) { const int kb = r / 32, nb = r % 32;
            p0_item(q->in[12], D, D, kb, nb, (bf16_t*)(ws + WS_WOUT), 32 * nb, nullptr, nullptr, nullptr, nullptr, nullptr, 0, scr, lane); continue; }
        r -= I_OUT;
        if (r < 2 * I_DN) { const int l = r / I_DN; r -= l * I_DN; const int kb = r / 32, nb = r % 32;
            p0_item(q->in[16] + (size_t)l * FF * D, FF, D, kb, nb, (bf16_t*)(ws + WS_WDN) + (size_t)l * D * FF, 32 * nb, nullptr, nullptr, nullptr, nullptr, nullptr, 0, scr, lane); continue; }
        r -= 2 * I_DN;
        { const int g = r / I_POOL; r -= g * I_POOL; const int kb = r / 8, nb = r % 8;
            p0_item(q->in[7] + (size_t)g * 256 * 256, 256, 256, kb, nb, (bf16_t*)(ws + WS_WPOOL) + (size_t)g * 256 * 256, 32 * nb, nullptr, q->in[8] + g * 256, nullptr, nullptr, nullptr, 0, scr, lane); }
    }
    const int gt = blockIdx.x * 512 + tid, NGT = gridDim.x * 512;
    for (int i = gt; i < 2 * FF2; i += NGT) { const int l = i / FF2, n = i % FF2, d = up_dest(n); float* kc = (float*)(ws + WS_KC_UP) + (size_t)l * 4 * FF2;
        kc[d] = q->in[14][(size_t)(l * 3 + 0) * FF2 + n]; kc[FF2 + d] = q->in[14][(size_t)(l * 3 + 1) * FF2 + n]; kc[2 * FF2 + d] = q->in[14][(size_t)(l * 3 + 2) * FF2 + n]; kc[3 * FF2 + d] = q->in[15][(size_t)l * FF2 + n]; }
    for (int i = gt; i < NB_P * 15 * (D / 4); i += NGT) { const int c4 = i % (D / 4), rr = (i / (D / 4)) % 15, b = i / (15 * (D / 4));
        ((f32x4*)(q->out + O_POOL_P))[i] = *(const f32x4*)(q->in[0] + ((size_t)b * SEQ + 2033 + rr) * D + c4 * 4); }
    for (int i = gt; i < NB_S * 15 * (D / 4); i += NGT) { const int c4 = i % (D / 4), rr = (i / (D / 4)) % 15, s = i / (15 * (D / 4));
        ((f32x4*)(q->out + O_POOL_S))[i] = rr < 11 ? *(const f32x4*)(q->in[2] + ((size_t)s * 15 + 4 + rr) * D + c4 * 4) : *(const f32x4*)(q->in[1] + ((size_t)s * TS + rr - 11) * D + c4 * 4); }
}

__device__ __forceinline__ void phase1(LAS unsigned char* lds) {
    const KA Params* q = kargs();
    const int tid = tid_fresh(), lane = tid & 63, wave = __builtin_amdgcn_readfirstlane(tid >> 6), fr = lane & 15, fq = lane >> 4;
    unsigned char* ws = q->ws;
    { const int gt = blockIdx.x * 512 + tid, NGT = gridDim.x * 512;
      for (int i = gt; i < 2 * FF2 + 3 * D; i += NGT) {
          float s = 0.f, b = 0.f;
          if (i < 2 * FF2) { const int l = i / FF2, c = i % FF2; const float* sp = (const float*)(ws + WS_CSP_UP) + (size_t)l * 16 * FF2 + c; const float* bp = (const float*)(ws + WS_CBP_UP) + (size_t)l * 16 * FF2 + c;
              for (int k = 0; k < 16; ++k) { s += sp[(size_t)k * FF2]; b += bp[(size_t)k * FF2]; }
              ((float*)(ws + WS_CS_UP))[i] = s; ((float*)(ws + WS_CB_UP))[i] = b; }
          else { const int c = i - 2 * FF2; const float* sp = (const float*)(ws + WS_CSP_IN) + c; const float* bp = (const float*)(ws + WS_CBP_IN) + c;
              for (int k = 0; k < 16; ++k) { s += sp[(size_t)k * 3 * D]; b += bp[(size_t)k * 3 * D]; }
              ((float*)(ws + WS_CS_IN))[c] = s; ((float*)(ws + WS_CB_IN))[c] = b; } } }
    const bf16_t* wpool = (const bf16_t*)(ws + WS_WPOOL);
    bf16_t* vbf = (bf16_t*)(ws + WS_H1);
    f32x2* part = (f32x2*)(ws + WS_PART);
    LAS f32x2* T = (LAS f32x2*)(lds + 65536);
    const int g = wave >> 1, hh = wave & 1, w = 2 << g;
    const int c0 = 2 * tid;
    for (int tile = blockIdx.x; tile < MROWS / 32; tile += gridDim.x) {
        const int tok0 = tile * 32;
        if (tok0 < NTOK_P) {
            const int t0 = tok0 & (SEQ - 1); const float* xb = q->in[0] + (size_t)(tok0 - t0) * D + c0;
            f32x2 s = {0.f, 0.f};
            for (int i = 1; i <= w; ++i) { const int tt = t0 - i; if (tt >= 0) s += *(const f32x2*)(xb + (size_t)tt * D); }
#pragma unroll 8
            for (int j = 0; j < 32; ++j) { const int t = t0 + j; const f32x2 cur = *(const f32x2*)(xb + (size_t)t * D); f32x2 old = {0.f, 0.f}; if (t - w >= 0) old = *(const f32x2*)(xb + (size_t)(t - w) * D);
                s += cur - old; const float inv = 1.0f / (float)(t + 1 < w ? t + 1 : w); const f32x2 d = s * inv - cur;
                *(LAS unsigned*)(lds + j * 2048 + ((((tid >> 2) ^ (j & 15))) << 4) + (tid & 3) * 4) = pk2(d.x, d.y); }
        } else {
            const float inv = 1.0f / (float)w;
            for (int qi = 0; qi < 8; ++qi) { const int sq = ((tok0 - NTOK_P) >> 2) + qi; const float* hb = q->in[2] + (size_t)sq * 15 * D + c0; const float* xb = q->in[1] + (size_t)sq * TS * D + c0;
                f32x2 s = {0.f, 0.f};
                for (int i = 1; i <= w; ++i) { if (i <= 15) s += *(const f32x2*)(hb + (size_t)(15 - i) * D); }
#pragma unroll
                for (int t = 0; t < 4; ++t) { const f32x2 cur = *(const f32x2*)(xb + (size_t)t * D); f32x2 old = {0.f, 0.f}; const int tt = t - w;
                    if (tt >= 0) old = *(const f32x2*)(xb + (size_t)tt * D); else if (tt >= -15) old = *(const f32x2*)(hb + (size_t)(15 + tt) * D);
                    s += cur - old; const f32x2 d = s * inv - cur; const int j = 4 * qi + t;
                    *(LAS unsigned*)(lds + j * 2048 + ((((tid >> 2) ^ (j & 15))) << 4) + (tid & 3) * 4) = pk2(d.x, d.y); } }
        }
        __syncthreads();
        f32x4 acc[2][8];
#pragma unroll
        for (int mb = 0; mb < 2; ++mb)
#pragma unroll
            for (int nb = 0; nb < 8; ++nb) acc[mb][nb] = (f32x4){0.f, 0.f, 0.f, 0.f};
        const bf16_t* wb = wpool + ((size_t)g * 256 + 128 * hh + fr) * 256 + 8 * fq;
#pragma unroll 2
        for (int ks = 0; ks < 8; ++ks) {
            bf16x8 a[2], b[8];
#pragma unroll
            for (int nb = 0; nb < 8; ++nb) b[nb] = *(const bf16x8*)(wb + (size_t)(16 * nb) * 256 + 32 * ks);
#pragma unroll
            for (int mb = 0; mb < 2; ++mb) { const int row = 16 * mb + fr, chunk = 32 * g + 4 * ks + fq; a[mb] = *(const LAS bf16x8*)(lds + row * 2048 + ((chunk ^ (row & 15)) << 4)); }
#pragma unroll
            for (int mb = 0; mb < 2; ++mb)
#pragma unroll
                for (int nb = 0; nb < 8; ++nb) acc[mb][nb] = __builtin_amdgcn_mfma_f32_16x16x32_bf16(b[nb], a[mb], acc[mb][nb], 0, 0, 0);
        }
#pragma unroll
        for (int mb = 0; mb < 2; ++mb) {
            const int tok = tok0 + 16 * mb + fr, R = row_of_tok(tok);
            const float* xr = (tok < NTOK_P ? q->in[0] + (size_t)tok * D : q->in[1] + (size_t)(tok - NTOK_P) * D) + 256 * g + 128 * hh + 4 * fq;
            float sum = 0.f, sq = 0.f;
#pragma unroll
            for (int nb = 0; nb < 8; ++nb) { const f32x4 xv = *(const f32x4*)(xr + 16 * nb); const f32x4 v = xv * ALPHA + acc[mb][nb];
                sum += (v[0] + v[1]) + (v[2] + v[3]); sq += (v[0] * v[0] + v[1] * v[1]) + (v[2] * v[2] + v[3] * v[3]);
                const int c = 256 * g + 128 * hh + 16 * nb + 4 * fq;
                u32x2 wv; wv.x = pk2(v[0], v[1]); wv.y = pk2(v[2], v[3]); *(u32x2*)(vbf + (size_t)R * D + c) = wv; }
            sum += __shfl_xor(sum, 16); sum += __shfl_xor(sum, 32); sq += __shfl_xor(sq, 16); sq += __shfl_xor(sq, 32);
            if (fq == 0) { f32x2 t; t.x = sum; t.y = sq; T[(16 * mb + fr) * 8 + wave] = t; }
        }
        __syncthreads();
        if (tid < 128) { const int row = tid >> 2, gg = tid & 3; const f32x2 a = T[row * 8 + 2 * gg], b = T[row * 8 + 2 * gg + 1];
            const float mt = (a.x + b.x) * (1.0f / 256.0f); f32x2 r; r.x = mt; r.y = (a.y + b.y) - 256.0f * mt * mt;
            part[(size_t)row_of_tok(tok0 + row) * 4 + gg] = r; }
        __syncthreads();
    }
}

__device__ __forceinline__ void phase_fixup(int l) {
    const KA Params* q = kargs();
    const float* kc = (const float*)(q->ws + WS_KC_UP) + (size_t)l * 4 * FF2; bf16_t* act = (bf16_t*)(q->ws + WS_ACT);
    const float* Hf = (const float*)(q->ws + WS_HF); const float* Hl = (const float*)(q->ws + WS_HL);
    const int gt = blockIdx.x * 512 + tid_fresh(), NGT = gridDim.x * 512;
    for (int i = gt; i < 128 * (FF / 4); i += NGT) {
        const int q = i / (FF / 4), f = (i % (FF / 4)) * 4;
        if ((q & 15) == 0) continue;
        const int cg_ = 256 * (f >> 7) + (f & 127), cv_ = cg_ + 128;
        const float* hf = Hf + (size_t)q * 2 * FF2; const float* hl = Hl + (size_t)(q - 1) * 2 * FF2;
        const f32x4 k0g = *(const f32x4*)(kc + cg_), k1g = *(const f32x4*)(kc + FF2 + cg_), k2g = *(const f32x4*)(kc + 2 * FF2 + cg_), kbg = *(const f32x4*)(kc + 3 * FF2 + cg_);
        const f32x4 k0v = *(const f32x4*)(kc + cv_), k1v = *(const f32x4*)(kc + FF2 + cv_), k2v = *(const f32x4*)(kc + 2 * FF2 + cv_), kbv = *(const f32x4*)(kc + 3 * FF2 + cv_);
        const f32x4 g2 = *(const f32x4*)(hl + cg_), g1 = *(const f32x4*)(hl + FF2 + cg_), a0 = *(const f32x4*)(hf + cg_), a1 = *(const f32x4*)(hf + FF2 + cg_);
        const f32x4 v2 = *(const f32x4*)(hl + cv_), v1 = *(const f32x4*)(hl + FF2 + cv_), b0 = *(const f32x4*)(hf + cv_), b1 = *(const f32x4*)(hf + FF2 + cv_);
        const f32x4 zg0 = k2g * a0 + k1g * g1 + k0g * g2 + kbg, zv0 = k2v * b0 + k1v * v1 + k0v * v2 + kbv;
        const f32x4 zg1 = k2g * a1 + k1g * a0 + k0g * g1 + kbg, zv1 = k2v * b1 + k1v * b0 + k0v * v1 + kbv;
        const int R0 = (q >> 1) * 256 + 64 * (q & 1);
        u32x2 w0, w1; w0.x = pk2(silu_mul(zg0[0], zv0[0]), silu_mul(zg0[1], zv0[1])); w0.y = pk2(silu_mul(zg0[2], zv0[2]), silu_mul(zg0[3], zv0[3]));
        w1.x = pk2(silu_mul(zg1[0], zv1[0]), silu_mul(zg1[1], zv1[1])); w1.y = pk2(silu_mul(zg1[2], zv1[2]), silu_mul(zg1[3], zv1[3]));
        *(u32x2*)(act + (size_t)R0 * FF + f) = w0; *(u32x2*)(act + (size_t)(R0 + 16) * FF + f) = w1;
    }
}

__device__ __forceinline__ void phase_conv() {
    const KA Params* q = kargs();
    const bf16_t* ubuf = (const bf16_t*)(q->ws + WS_ACT); const bf16_t* bbuf = ubuf + (size_t)MROWS * D; bf16_t* obuf = (bf16_t*)q->out;
    const float* ck = q->in[10]; const float* ckb = q->in[11]; const float* st = q->in[3];
    const int gt = blockIdx.x * 512 + tid_fresh(), NGT = gridDim.x * 512;
    for (int i = gt; i < MROWS * (D / 8); i += NGT) {
        const int tok = i >> 7, ch = (i & 127) * 8;
        int t, seq = 0; const bool sample = tok >= NTOK_P;
        if (!sample) t = tok & (SEQ - 1); else { seq = (tok - NTOK_P) >> 2; t = tok & 3; }
        const int R = row_of_tok(tok);
        float u0[8], u1[8], u2[8], bb[8];
        { const u32x4 w = *(const u32x4*)(ubuf + (size_t)R * D + ch); const u32x4 wb = *(const u32x4*)(bbuf + (size_t)R * D + ch);
#pragma unroll
          for (int e = 0; e < 4; ++e) { u2[2 * e] = bf2f(w[e] & 0xffffu); u2[2 * e + 1] = bf2f(w[e] >> 16); bb[2 * e] = bf2f(wb[e] & 0xffffu); bb[2 * e + 1] = bf2f(wb[e] >> 16); } }
        if (t >= 1) { const u32x4 w = *(const u32x4*)(ubuf + (size_t)row_of_tok(tok - 1) * D + ch);
#pragma unroll
            for (int e = 0; e < 4; ++e) { u1[2 * e] = bf2f(w[e] & 0xffffu); u1[2 * e + 1] = bf2f(w[e] >> 16); } }
        else if (sample) { const f32x4 a = *(const f32x4*)(st + ((size_t)seq * 2 + 1) * D + ch), b = *(const f32x4*)(st + ((size_t)seq * 2 + 1) * D + ch + 4);
#pragma unroll
            for (int e = 0; e < 4; ++e) { u1[e] = a[e]; u1[4 + e] = b[e]; } }
        else {
#pragma unroll
            for (int e = 0; e < 8; ++e) u1[e] = 0.f; }
        if (t >= 2) { const u32x4 w = *(const u32x4*)(ubuf + (size_t)row_of_tok(tok - 2) * D + ch);
#pragma unroll
            for (int e = 0; e < 4; ++e) { u0[2 * e] = bf2f(w[e] & 0xffffu); u0[2 * e + 1] = bf2f(w[e] >> 16); } }
        else if (sample) { const f32x4 a = *(const f32x4*)(st + ((size_t)seq * 2 + t) * D + ch), b = *(const f32x4*)(st + ((size_t)seq * 2 + t) * D + ch + 4);
#pragma unroll
            for (int e = 0; e < 4; ++e) { u0[e] = a[e]; u0[4 + e] = b[e]; } }
        else {
#pragma unroll
            for (int e = 0; e < 8; ++e) u0[e] = 0.f; }
        float o[8];
#pragma unroll
        for (int e = 0; e < 8; ++e) o[e] = bb[e] * (ck[ch + e] * u0[e] + ck[D + ch + e] * u1[e] + ck[2 * D + ch + e] * u2[e] + ckb[ch + e]);
        u32x4 w; w.x = pk2(o[0], o[1]); w.y = pk2(o[2], o[3]); w.z = pk2(o[4], o[5]); w.w = pk2(o[6], o[7]);
        *(u32x4*)(obuf + (size_t)R * D + ch) = w;
    }
}

__device__ __forceinline__ void phase_final() {
    const KA Params* q = kargs();
    const f32x2* part = (const f32x2*)(q->ws + WS_PART); const float* g = q->in[17] + D; const float* b = q->in[18] + D;
    const int tid = tid_fresh(), lane = tid & 63, gw = blockIdx.x * 8 + (tid >> 6), NGW = gridDim.x * 8;
    f32x4 gv[4], bv[4];
#pragma unroll
    for (int j = 0; j < 4; ++j) { gv[j] = *(const f32x4*)(g + 256 * j + 4 * lane); bv[j] = *(const f32x4*)(b + 256 * j + 4 * lane); }
    for (int tok = gw; tok < MROWS; tok += NGW) {
        const f32x2 s = row_stats(part, row_of_tok(tok));
        float* yr = q->out + (size_t)tok * D + 4 * lane;
#pragma unroll
        for (int j = 0; j < 4; ++j) { const f32x4 v = *(const f32x4*)(yr + 256 * j); *(f32x4*)(yr + 256 * j) = ((v - s.x) * s.y) * gv[j] + bv[j]; }
    }
}

__global__ void __launch_bounds__(512, 2) fwd_megakernel(Params p) {
    extern __shared__ __attribute__((aligned(16))) unsigned char lds_raw[];
    LAS unsigned char* lds = (LAS unsigned char*)lds_raw;
    cg::grid_group grid = cg::this_grid();
    const int G = gridDim.x, cid = blockIdx.x;
#define WSP(off) (kargs()->ws + (off))
#define H1P ((const bf16_t*)WSP(WS_H1))
#define H2P ((const bf16_t*)kargs()->out)
#if DIAG & 1
    phase0(lds);
#endif
    grid.sync();
#if DIAG & 2
    phase1(lds);
#endif
    grid.sync();
#if DIAG & 32
    { pg8::Gemm g{H1P, (const bf16_t*)WSP(WS_WUP), D}; pg8::StaticOrder S; S.init(NPANEL, 22, G, cid); EpiUp E{0}; pg8::gemm_phase(lds, g, S, E); }
#endif
    grid.sync();
#if DIAG & 64
    phase_fixup(0);
#endif
    grid.sync();
#if DIAG & 128
    { pg8::Gemm g{(const bf16_t*)WSP(WS_ACT), (const bf16_t*)WSP(WS_WDN), FF}; pg8::StaticOrder S; S.init(NPANEL, 4, G, cid);
      EpiRes<false> E{0, 1, 5, 0}; pg8::gemm_phase(lds, g, S, E); }
#endif
    grid.sync();
#if DIAG & 4
    { pg8::Gemm g{H1P, (const bf16_t*)WSP(WS_WIN), D}; pg8::StaticOrder S; S.init(NPANEL, 12, G, cid); EpiIn E{0}; pg8::gemm_phase(lds, g, S, E); }
#endif
    grid.sync();
#if DIAG & 8
    phase_conv();
#endif
    grid.sync();
#if DIAG & 16
    { pg8::Gemm g{H2P, (const bf16_t*)WSP(WS_WOUT), D}; pg8::StaticOrder S; S.init(NPANEL, 4, G, cid);
      EpiRes<false> E{1, 2, 17, 0}; pg8::gemm_phase(lds, g, S, E); }
#endif
    grid.sync();
#if DIAG & 32
    { pg8::Gemm g{H1P, (const bf16_t*)WSP(WS_WUP) + (size_t)FF2 * D, D}; pg8::StaticOrder S; S.init(NPANEL, 22, G, cid); EpiUp E{1}; pg8::gemm_phase(lds, g, S, E); }
#endif
    grid.sync();
#if DIAG & 64
    phase_fixup(1);
#endif
    grid.sync();
#if DIAG & 256
    { pg8::Gemm g{(const bf16_t*)WSP(WS_ACT), (const bf16_t*)WSP(WS_WDN) + (size_t)D * FF, FF}; pg8::StaticOrder S; S.init(NPANEL, 4, G, cid);
      EpiRes<true> E{2, 0, 5, D}; pg8::gemm_phase(lds, g, S, E); }
#endif
    grid.sync();
#if DIAG & 512
    phase_final();
#endif
}

extern "C" void kernel_launch(void* const* d_in, const int* in_sizes, int n_in, void* d_out, int out_size, void* d_ws, size_t ws_size, hipStream_t stream) {
    static int grid_blocks = 0;
    if (grid_blocks == 0) {
        if (n_in != 19 || out_size != (int)O_END || ws_size < WS_END) { fprintf(stderr, "kernel_launch: unexpected shapes (n_in %d out %d ws %zu)\n", n_in, out_size, ws_size); grid_blocks = -1; return; }
        int dev = 0, cus = 0, per_cu = 0;
        hipGetDevice(&dev);
        hipDeviceGetAttribute(&cus, hipDeviceAttributeMultiprocessorCount, dev);
        if (hipFuncSetAttribute((const void*)fwd_megakernel, hipFuncAttributeMaxDynamicSharedMemorySize, LDS_BYTES) != hipSuccess) { fprintf(stderr, "kernel_launch: hipFuncSetAttribute failed\n"); grid_blocks = -1; return; }
        hipOccupancyMaxActiveBlocksPerMultiprocessor(&per_cu, (const void*)fwd_megakernel, 512, LDS_BYTES);
        if (per_cu < 1) { fprintf(stderr, "kernel_launch: occupancy query reports %d blocks per CU\n", per_cu); grid_blocks = -1; return; }
        grid_blocks = cus;
    }
    if (grid_blocks < 0) return;
    Params p{};
    for (int i = 0; i < 19; ++i) p.in[i] = (const float*)d_in[i];
    p.out = (float*)d_out; p.ws = (unsigned char*)d_ws;
    void* args[] = {&p};
    hipError_t e = hipLaunchCooperativeKernel((const void*)fwd_megakernel, dim3(grid_blocks), dim3(512), args, LDS_BYTES, stream);
    if (e != hipSuccess) fprintf(stderr, "cooperative launch failed: %s (grid %d)\n", hipGetErrorString(e), grid_blocks);
}
```

```cpp
#include <hip/hip_runtime.h>
#include <hip/hip_cooperative_groups.h>
#include <cstdio>
#include <cstdint>
namespace cg = cooperative_groups;
#ifndef DIAG
#define DIAG 1023
#endif

#define LAS __attribute__((address_space(3)))
typedef unsigned short bf16_t;
typedef short bf16x8 __attribute__((ext_vector_type(8)));
typedef float f32x4 __attribute__((ext_vector_type(4)));
typedef float f32x2 __attribute__((ext_vector_type(2)));
typedef unsigned u32x4 __attribute__((ext_vector_type(4)));
typedef unsigned u32x2 __attribute__((ext_vector_type(2)));

constexpr int D = 1024, FF = 2816, FF2 = 5632, SEQ = 2048, NB_P = 8, NB_S = 128, TS = 4;
constexpr int NTOK_P = NB_P * SEQ;
constexpr int NTOK_S = NB_S * TS;
constexpr int MROWS = NTOK_P + NTOK_S;
constexpr int NPANEL = MROWS / 256;
constexpr int NPANEL_P = NTOK_P / 256;
constexpr float ALPHA = 1.41421356237309515f;
constexpr float LN_EPS = 1e-5f;

constexpr size_t O_Y = 0;
constexpr size_t O_POOL_P = (size_t)MROWS * D;
constexpr size_t O_POOL_S = O_POOL_P + (size_t)NB_P * 15 * D;
constexpr size_t O_CONV_P = O_POOL_S + (size_t)NB_S * 15 * D;
constexpr size_t O_CONV_S = O_CONV_P + (size_t)NB_P * 2 * D;
constexpr size_t O_FFN_P = O_CONV_S + (size_t)NB_S * 2 * D;
constexpr size_t O_FFN_S = O_FFN_P + (size_t)2 * NB_P * 2 * FF2;
constexpr size_t O_END = O_FFN_S + (size_t)2 * NB_S * 2 * FF2;

constexpr size_t WS_WUP = 0;
constexpr size_t WS_WDN = WS_WUP + (size_t)2 * FF2 * D * 2;
constexpr size_t WS_WIN = WS_WDN + (size_t)2 * D * FF * 2;
constexpr size_t WS_WOUT = WS_WIN + (size_t)3 * D * D * 2;
constexpr size_t WS_WPOOL = WS_WOUT + (size_t)D * D * 2;
constexpr size_t WS_CSP_UP = WS_WPOOL + (size_t)4 * 256 * 256 * 2;
constexpr size_t WS_CBP_UP = WS_CSP_UP + (size_t)2 * 16 * FF2 * 4;
constexpr size_t WS_CSP_IN = WS_CBP_UP + (size_t)2 * 16 * FF2 * 4;
constexpr size_t WS_CBP_IN = WS_CSP_IN + (size_t)16 * 3072 * 4;
constexpr size_t WS_CS_UP = WS_CBP_IN + (size_t)16 * 3072 * 4;
constexpr size_t WS_CB_UP = WS_CS_UP + (size_t)2 * FF2 * 4;
constexpr size_t WS_KC_UP = WS_CB_UP + (size_t)2 * FF2 * 4;
constexpr size_t WS_CS_IN = WS_KC_UP + (size_t)2 * 4 * FF2 * 4;
constexpr size_t WS_CB_IN = WS_CS_IN + (size_t)3072 * 4;
constexpr size_t WS_PART = WS_CB_IN + (size_t)3072 * 4;
constexpr size_t PART_BYTES = (size_t)MROWS * 4 * 8;
constexpr size_t WS_HF = WS_PART + 3 * PART_BYTES;
constexpr size_t HALO_BYTES = (size_t)132 * 2 * FF2 * 4;
constexpr size_t WS_HL = WS_HF + HALO_BYTES;
constexpr size_t WS_H1 = WS_HL + HALO_BYTES;
constexpr size_t WS_ACT = WS_H1 + (size_t)MROWS * D * 2;
constexpr size_t WS_BAR = WS_ACT + (size_t)MROWS * FF * 2;
constexpr size_t WS_END = WS_BAR + 16384;
static_assert(WS_END <= (size_t)256 * 1024 * 1024, "workspace");
static_assert(WS_WDN % 256 == 0 && WS_WIN % 256 == 0 && WS_WOUT % 256 == 0 && WS_WPOOL % 256 == 0 && WS_PART % 256 == 0 && WS_HF % 256 == 0 && WS_H1 % 256 == 0 && WS_ACT % 256 == 0, "align");

constexpr int STAGE_BYTES = 131072;
constexpr int EPI_OFF = STAGE_BYTES;
constexpr int BARST_OFF = STAGE_BYTES + 12288;
constexpr int LDS_BYTES = 147456;

struct Params {
    const float* in[19];
    float* out;
    unsigned char* ws;
};

__device__ __forceinline__ unsigned f2bf(float f) { unsigned u = __builtin_bit_cast(unsigned, f); return (u + 0x7fffu + ((u >> 16) & 1u)) >> 16; }
__device__ __forceinline__ float bf2f(unsigned b) { return __builtin_bit_cast(float, b << 16); }
__device__ __forceinline__ unsigned pk2(float lo, float hi) { return f2bf(lo) | (f2bf(hi) << 16); }
__device__ __forceinline__ float dpp_shr1(float v) {
    return __builtin_bit_cast(float, __builtin_amdgcn_update_dpp(0, __builtin_bit_cast(int, v), 0x111, 0xf, 0xf, true));
}
__device__ __forceinline__ float silu_mul(float g, float v) { return g * v * __builtin_amdgcn_rcpf(1.0f + __expf(-g)); }
__device__ __forceinline__ int tid_fresh() { int t = threadIdx.x; asm volatile("" : "+v"(t)); return t; }
__device__ __forceinline__ int row_of_tok(int tok) {
    const int pm = tok >> 8, tau = tok & 255;
    return pm * 256 + 128 * ((tau >> 2) & 1) + 64 * (tau >> 7) + 16 * (tau & 3) + ((tau >> 3) & 15);
}
__device__ __forceinline__ f32x2 row_stats(const f32x2* part, int R) {
    const f32x4 a = *(const f32x4*)(part + (size_t)R * 4), b = *(const f32x4*)(part + (size_t)R * 4 + 2);
    const float mean = ((a[0] + a[2]) + (b[0] + b[2])) * 0.25f;
    const float d0 = a[0] - mean, d1 = a[2] - mean, d2 = b[0] - mean, d3 = b[2] - mean;
    const float m2 = ((a[1] + a[3]) + (b[1] + b[3])) + 256.0f * ((d0 * d0 + d1 * d1) + (d2 * d2 + d3 * d3));
    f32x2 r; r.x = mean; r.y = __builtin_amdgcn_rsqf(m2 * (1.0f / 1024.0f) + LN_EPS); return r;
}
__device__ __forceinline__ void stats_to_lds(const f32x2* part, int pm, LAS f32x2* S) {
    int tx = threadIdx.x; asm volatile("" : "+v"(tx));
    if (tx < 256) { const f32x2 s = row_stats(part, pm * 256 + tx); f32x2 t; t.x = s.y; t.y = -s.x * s.y; S[tx] = t; }
    asm volatile("s_waitcnt lgkmcnt(0)" ::: "memory"); __builtin_amdgcn_s_barrier(); asm volatile("" ::: "memory");
}
#define KA __attribute__((address_space(4)))
__device__ __forceinline__ const KA Params* kargs() { const KA Params* p = (const KA Params*)__builtin_amdgcn_kernarg_segment_ptr(); asm volatile("" : "+s"(p)); return p; }

namespace pg8 {
constexpr int BM = 256, BK = 64, HALF = 128, HTB = HALF * BK * 2, NXCD = 8, WGM = 8;
__host__ __device__ __forceinline__ int lds_byte(int r, int c) { const int st = (r >> 4) * 2 + (c >> 5), rr = r & 15, cc = c & 31, ob = rr * 64 + cc * 2; return st * 1024 + (ob ^ (((ob >> 9) & 1) << 5)); }
__host__ __device__ __forceinline__ void stage_rc(int b, int& R, int& C) { const int st = b / 1024, sb = b % 1024, swz = sb ^ (((sb >> 9) & 1) << 5); R = (st >> 1) * 16 + swz / 64; C = (st & 1) * 32 + (swz % 64) / 2; }

struct Unit { int pm, pn; };
struct Gemm { const bf16_t* A; const bf16_t* Bt; int K; };

struct StaticOrder {
    int nM, nN, nwg, G, c;
    __device__ void init(int nM_, int nN_, int G_, int c_) { nM = nM_; nN = nN_; nwg = nM * nN; G = G_; c = c_; }
    __device__ bool next(int i, Unit& u) const {
        const long L = (long)i * G + c; if (L >= nwg) return false;
        int wgid = (int)L; { const int q = nwg / NXCD, r = nwg % NXCD, xcd = wgid % NXCD, off = wgid / NXCD; wgid = (xcd < r ? xcd * (q + 1) : r * (q + 1) + (xcd - r) * q) + off; }
        const int nig = WGM * nN, gid = wgid / nig, fm = gid * WGM, gsz = (nM - fm) < WGM ? (nM - fm) : WGM;
        u.pm = fm + ((wgid % nig) % gsz); u.pn = (wgid % nig) / gsz; return true;
    }
};

template <class Epi>
__device__ __forceinline__ void gemm_phase(LAS unsigned char* lds, const Gemm g, const StaticOrder& S, const Epi& E) {
    const int tid = tid_fresh(), wid = __builtin_amdgcn_readfirstlane(tid >> 6), lane = tid & 63, wr = wid >> 2, wc = wid & 3, fr = lane & 15, fq = lane >> 4;
    const int K = g.K, nt = K / BK;
    unsigned voffA[2];
#pragma unroll
    for (int i = 0; i < 2; ++i) { int R, C; stage_rc(tid * 16 + i * 8192, R, C); voffA[i] = (unsigned)(R * K + C) * 2u; }
    const size_t kstep = (size_t)(BK * 2);
    const size_t hstep = (size_t)HALF * K * 2;
    const size_t tstep = 2 * hstep;
    const unsigned ldsw = (unsigned)wid * 1024u;
    const int aoff = lds_byte(wr * 64 + fr, fq * 8), boff = lds_byte(wc * 32 + fr, fq * 8);
#define PG8_SA(b, h) (((b) * 2 + (h)) * HTB)
#define PG8_SB(b, h) ((4 + (b) * 2 + (h)) * HTB)
#define PG8_STAGE(bufoff, gbase) do { _Pragma("unroll") for (int _i = 0; _i < 2; ++_i) \
        __builtin_amdgcn_global_load_lds((const unsigned*)((const char*)(gbase) + voffA[_i]), (LAS unsigned*)(lds + (bufoff) + ldsw + _i * 8192), 16, 0, 0); } while (0)
#define PG8_LDA(dst, b, h) do { _Pragma("unroll") for (int m = 0; m < 4; ++m) _Pragma("unroll") for (int k = 0; k < 2; ++k) dst[m][k] = *(const LAS bf16x8*)(lds + PG8_SA(b, h) + aoff + m * 2048 + k * 1024); } while (0)
#define PG8_LDB(dst, b, h) do { _Pragma("unroll") for (int n = 0; n < 2; ++n) _Pragma("unroll") for (int k = 0; k < 2; ++k) dst[n][k] = *(const LAS bf16x8*)(lds + PG8_SB(b, h) + boff + n * 2048 + k * 1024); } while (0)
#define PG8_MMA(ai, bj, At, Bt) do { __builtin_amdgcn_s_setprio(1); _Pragma("unroll") for (int m = 0; m < 4; ++m) _Pragma("unroll") for (int n = 0; n < 2; ++n) _Pragma("unroll") for (int k = 0; k < 2; ++k) \
        acc[ai][bj][m][n] = __builtin_amdgcn_mfma_f32_16x16x32_bf16(Bt[n][k], At[m][k], acc[ai][bj][m][n], 0, 0, 0); __builtin_amdgcn_s_setprio(0); } while (0)
#define PG8_WAIT_V(n) asm volatile("s_waitcnt vmcnt(" #n ")" ::: "memory")
#define PG8_WAIT_L(n) asm volatile("s_waitcnt lgkmcnt(" #n ")" ::: "memory")
#define PG8_BAR __builtin_amdgcn_s_barrier()
#define PG8_SCHED __builtin_amdgcn_sched_barrier(0)
    Unit cur, nxt; int ui = 0;
    if (!S.next(0, cur)) return;
    f32x4 acc[2][2][4][2];
#pragma unroll
    for (int a = 0; a < 2; ++a)
#pragma unroll
        for (int b = 0; b < 2; ++b)
#pragma unroll
            for (int m = 0; m < 4; ++m)
#pragma unroll
                for (int n = 0; n < 2; ++n) acc[a][b][m][n] = (f32x4){0.f, 0.f, 0.f, 0.f};
    bf16x8 At[4][2], B0[2][2], B1[2][2];
    const char* cA = (const char*)g.A + (size_t)cur.pm * tstep; const char* cB = (const char*)g.Bt + (size_t)cur.pn * tstep;
    PG8_STAGE(PG8_SB(0, 0), cB); PG8_STAGE(PG8_SB(0, 1), cB + hstep); PG8_STAGE(PG8_SA(0, 0), cA); PG8_STAGE(PG8_SA(0, 1), cA + hstep);
    if (wr == 1) PG8_BAR;
    PG8_WAIT_V(2); PG8_BAR;
    PG8_STAGE(PG8_SB(1, 0), cB + kstep); PG8_STAGE(PG8_SA(1, 0), cA + kstep); PG8_STAGE(PG8_SB(1, 1), cB + hstep + kstep);
    PG8_WAIT_V(6); PG8_BAR;
    for (;;) {
        const bool has_next = S.next(ui + 1, nxt);
        const char* nA = has_next ? (const char*)g.A + (size_t)nxt.pm * tstep : cA; const char* nB = has_next ? (const char*)g.Bt + (size_t)nxt.pn * tstep : cB;
        for (int t = 0; t < nt; t += 2) {
            const bool last = (t == nt - 2);
            const char* a1 = cA + (size_t)(t + 1) * kstep;
            const char* a2 = last ? nA : cA + (size_t)(t + 2) * kstep; const char* b2 = last ? nB : cB + (size_t)(t + 2) * kstep;
            const char* a3 = a2 + kstep; const char* b3 = b2 + kstep;
            PG8_LDB(B0, 0, 0); PG8_LDB(B1, 0, 1); PG8_SCHED; PG8_LDA(At, 0, 0); PG8_STAGE(PG8_SA(1, 1), a1 + hstep);
            PG8_WAIT_V(8); PG8_WAIT_L(0); PG8_BAR; PG8_MMA(0, 0, At, B0); PG8_MMA(0, 1, At, B1); PG8_BAR; PG8_SCHED;
            PG8_LDA(At, 0, 1); PG8_STAGE(PG8_SB(0, 0), b2); PG8_STAGE(PG8_SB(0, 1), b2 + hstep); PG8_STAGE(PG8_SA(0, 0), a2);
            PG8_WAIT_V(8); PG8_WAIT_L(0); PG8_BAR; PG8_MMA(1, 0, At, B0); PG8_MMA(1, 1, At, B1); PG8_BAR; PG8_SCHED;
            PG8_LDB(B0, 1, 0); PG8_LDB(B1, 1, 1); PG8_SCHED; PG8_LDA(At, 1, 0); PG8_STAGE(PG8_SA(0, 1), a2 + hstep);
            PG8_WAIT_V(8); PG8_WAIT_L(0); PG8_BAR; PG8_MMA(0, 0, At, B0); PG8_MMA(0, 1, At, B1); PG8_BAR; PG8_SCHED;
            PG8_LDA(At, 1, 1); PG8_STAGE(PG8_SB(1, 0), b3); PG8_STAGE(PG8_SB(1, 1), b3 + hstep); PG8_STAGE(PG8_SA(1, 0), a3);
            PG8_WAIT_V(8); PG8_WAIT_L(0); PG8_BAR; PG8_MMA(1, 0, At, B0); PG8_MMA(1, 1, At, B1); PG8_BAR; PG8_SCHED;
        }
        if (wr == 0) PG8_BAR;
        { int fr_e = fr, fq_e = fq; asm volatile("" : "+v"(fr_e), "+v"(fq_e));
          E(acc, cur, wr, wc, fr_e, fq_e, lds + EPI_OFF); }
        if (!has_next) break;
#pragma unroll
        for (int a = 0; a < 2; ++a)
#pragma unroll
            for (int b = 0; b < 2; ++b)
#pragma unroll
                for (int m = 0; m < 4; ++m)
#pragma unroll
                    for (int n = 0; n < 2; ++n) acc[a][b][m][n] = (f32x4){0.f, 0.f, 0.f, 0.f};
        cur = nxt; cA = nA; cB = nB; ++ui;
        if (wr == 1) PG8_BAR;
    }
    PG8_WAIT_V(0);
    PG8_BAR;
#undef PG8_SA
#undef PG8_SB
#undef PG8_STAGE
#undef PG8_LDA
#undef PG8_LDB
#undef PG8_MMA
#undef PG8_WAIT_V
#undef PG8_WAIT_L
#undef PG8_BAR
#undef PG8_SCHED
}
}

template <int BJ> __device__ __forceinline__ void pin_half(f32x4 (&acc)[2][2][4][2]) {
#pragma unroll
    for (int ai = 0; ai < 2; ++ai)
        asm volatile("" : "+v"(acc[ai][BJ][0][0]), "+v"(acc[ai][BJ][0][1]), "+v"(acc[ai][BJ][1][0]), "+v"(acc[ai][BJ][1][1]), "+v"(acc[ai][BJ][2][0]), "+v"(acc[ai][BJ][2][1]), "+v"(acc[ai][BJ][3][0]), "+v"(acc[ai][BJ][3][1]) :: "memory");
}
template <int BJ, int N> __device__ __forceinline__ void pin_group(f32x4 (&acc)[2][2][4][2]) {
    asm volatile("" : "+v"(acc[0][BJ][0][N]), "+v"(acc[0][BJ][1][N]), "+v"(acc[0][BJ][2][N]), "+v"(acc[0][BJ][3][N]), "+v"(acc[1][BJ][0][N]), "+v"(acc[1][BJ][1][N]), "+v"(acc[1][BJ][2][N]), "+v"(acc[1][BJ][3][N]) :: "memory");
}
template <int N> __device__ __forceinline__ void pin_n(f32x4 (&acc)[2][2][4][2]) {
#pragma unroll
    for (int ai = 0; ai < 2; ++ai)
        asm volatile("" : "+v"(acc[ai][0][0][N]), "+v"(acc[ai][0][1][N]), "+v"(acc[ai][0][2][N]), "+v"(acc[ai][0][3][N]), "+v"(acc[ai][1][0][N]), "+v"(acc[ai][1][1][N]), "+v"(acc[ai][1][2][N]), "+v"(acc[ai][1][3][N]) :: "memory");
}
template <int BJ, int N, int J0, int LEN>
__device__ __forceinline__ void conv_chain(f32x4 (&acc)[2][2][4][2], const f32x4 k0, const f32x4 k1, const f32x4 k2, const f32x4 kb, const f32x4 p1, const f32x4 p2) {
#pragma unroll
    for (int i = LEN - 1; i >= 0; --i) {
        const int j = J0 + i;
        const f32x4 h0 = acc[j >> 2][BJ][j & 3][N];
        const f32x4 h1 = i >= 1 ? acc[(j - 1) >> 2][BJ][(j - 1) & 3][N] : p1;
        const f32x4 h2 = i >= 2 ? acc[(j - 2) >> 2][BJ][(j - 2) & 3][N] : (i == 1 ? p1 : p2);
        acc[j >> 2][BJ][j & 3][N] = k2 * h0 + k1 * h1 + k0 * h2 + kb;
    }
}
struct EpiUp {
    int l;
    template <int N>
    __device__ __forceinline__ void half(f32x4 (&acc)[2][2][4][2], int pm, int pn, int wr, int wc, int fr, int fq) const {
        asm volatile("" : "+v"(fr), "+v"(fq));
        const KA Params* q = kargs(); unsigned char* ws = q->ws;
        const bool sample = pm >= NPANEL_P;
        const int chunk = 2 * pm + wr;
        const int ucol = 256 * pn + 32 * wc + 16 * N;
        const int ufcol = 128 * pn + 32 * wc + 16 * N;
        const char* kcb = (const char*)((const float*)(ws + WS_KC_UP) + (size_t)l * 4 * FF2 + ucol);
        const unsigned lq = (unsigned)(16 * fq);
#define KC4(tap, vhalf) (*(const f32x4*)(kcb + lq + (unsigned)(((tap) * FF2 + (vhalf) * 128) * 4)))
        if (!sample) {
            f32x4 g2, g1;
#pragma unroll
            for (int e = 0; e < 4; ++e) { g2[e] = dpp_shr1(acc[1][0][2][N][e]); g1[e] = dpp_shr1(acc[1][0][3][N][e]); }
            if (fr == 0) {
                char* hf = (char*)((float*)(ws + WS_HF) + (size_t)chunk * 2 * FF2 + ucol) + lq;
                *(f32x4*)(hf) = acc[0][0][0][N]; *(f32x4*)(hf + FF2 * 4) = acc[0][0][1][N];
                *(f32x4*)(hf + 128 * 4) = acc[0][1][0][N]; *(f32x4*)(hf + (FF2 + 128) * 4) = acc[0][1][1][N];
            }
            if (fr == 15) {
                char* hl = (char*)((float*)(ws + WS_HL) + (size_t)chunk * 2 * FF2 + ucol) + lq;
                *(f32x4*)(hl) = acc[1][0][2][N]; *(f32x4*)(hl + FF2 * 4) = acc[1][0][3][N];
                *(f32x4*)(hl + 128 * 4) = acc[1][1][2][N]; *(f32x4*)(hl + (FF2 + 128) * 4) = acc[1][1][3][N];
                if ((pm & 7) == 7 && wr == 1) {
                    char* o = (char*)(q->out + O_FFN_P + ((size_t)l * NB_P + (pm >> 3)) * 2 * FF2 + ufcol) + lq;
                    *(f32x4*)(o) = acc[1][0][2][N]; *(f32x4*)(o + FF2 * 4) = acc[1][0][3][N];
                    *(f32x4*)(o + FF * 4) = acc[1][1][2][N]; *(f32x4*)(o + (FF2 + FF) * 4) = acc[1][1][3][N];
                }
            }
            pin_n<N>(acc);
            { const f32x4 k0 = KC4(0, 0), k1 = KC4(1, 0), k2 = KC4(2, 0), kb = KC4(3, 0); conv_chain<0, N, 0, 8>(acc, k0, k1, k2, kb, g1, g2); }
            pin_n<N>(acc);
            { f32x4 v2, v1;
#pragma unroll
              for (int e = 0; e < 4; ++e) { v2[e] = dpp_shr1(acc[1][1][2][N][e]); v1[e] = dpp_shr1(acc[1][1][3][N][e]); }
              const f32x4 k0 = KC4(0, 1), k1 = KC4(1, 1), k2 = KC4(2, 1), kb = KC4(3, 1); conv_chain<1, N, 0, 8>(acc, k0, k1, k2, kb, v1, v2); }
        } else {
            const int useq0 = 64 * (pm - NPANEL_P) + 32 * wr;
            const unsigned ls = (unsigned)(2 * fr * 2 * FF2 * 4) + lq;
            char* ob = (char*)(q->out + O_FFN_S + ((size_t)l * NB_S + useq0) * 2 * FF2 + ufcol);
#pragma unroll
            for (int ai = 0; ai < 2; ++ai) { char* o = ob + ls + (unsigned)(ai * 2 * FF2 * 4);
                *(f32x4*)(o) = acc[ai][0][2][N]; *(f32x4*)(o + FF2 * 4) = acc[ai][0][3][N];
                *(f32x4*)(o + FF * 4) = acc[ai][1][2][N]; *(f32x4*)(o + (FF2 + FF) * 4) = acc[ai][1][3][N]; }
            pin_n<N>(acc);
            const char* sb = (const char*)(q->in[4] + ((size_t)l * NB_S + useq0) * 2 * FF2 + ufcol);
            { const f32x4 k0 = KC4(0, 0), k1 = KC4(1, 0), k2 = KC4(2, 0), kb = KC4(3, 0);
              conv_chain<0, N, 0, 4>(acc, k0, k1, k2, kb, *(const f32x4*)(sb + ls + FF2 * 4), *(const f32x4*)(sb + ls));
              conv_chain<0, N, 4, 4>(acc, k0, k1, k2, kb, *(const f32x4*)(sb + ls + 3 * FF2 * 4), *(const f32x4*)(sb + ls + 2 * FF2 * 4)); }
            pin_n<N>(acc);
            { const f32x4 k0 = KC4(0, 1), k1 = KC4(1, 1), k2 = KC4(2, 1), kb = KC4(3, 1);
              conv_chain<1, N, 0, 4>(acc, k0, k1, k2, kb, *(const f32x4*)(sb + ls + (FF2 + FF) * 4), *(const f32x4*)(sb + ls + FF * 4));
              conv_chain<1, N, 4, 4>(acc, k0, k1, k2, kb, *(const f32x4*)(sb + ls + (3 * FF2 + FF) * 4), *(const f32x4*)(sb + ls + (2 * FF2 + FF) * 4)); }
        }
#undef KC4
        pin_n<N>(acc);
        char* ab = (char*)((bf16_t*)(ws + WS_ACT) + (size_t)(pm * 256 + 64 * wr) * FF + ufcol);
        const unsigned la = (unsigned)((fr * FF + 4 * fq) * 2);
#pragma unroll
        for (int j = 0; j < 8; ++j) {
            const f32x4 zg = acc[j >> 2][0][j & 3][N], zv = acc[j >> 2][1][j & 3][N];
            u32x2 w; w.x = pk2(silu_mul(zg[0], zv[0]), silu_mul(zg[1], zv[1])); w.y = pk2(silu_mul(zg[2], zv[2]), silu_mul(zg[3], zv[3]));
            *(u32x2*)(ab + la + (unsigned)((128 * (j >> 2) + 16 * (j & 3)) * FF * 2)) = w;
        }
        asm volatile("" ::: "memory");
    }
    __device__ __forceinline__ void operator()(f32x4 (&acc)[2][2][4][2], const pg8::Unit& u, int wr, int wc, int fr, int fq, LAS unsigned char* elds) const {
        const int pm = u.pm, pn = u.pn;
        LAS f32x2* S = (LAS f32x2*)(elds + 8192);
        { const KA Params* q = kargs(); unsigned char* ws = q->ws;
          stats_to_lds((const f32x2*)(ws + WS_PART) + (size_t)(l == 0 ? 0 : 2) * MROWS * 4, pm, S);
          const char* csb = (const char*)((const float*)(ws + WS_CS_UP) + l * FF2 + 256 * pn + 32 * wc); const char* cbb = (const char*)((const float*)(ws + WS_CB_UP) + l * FF2 + 256 * pn + 32 * wc);
          const unsigned lq = (unsigned)(16 * fq);
          f32x2 st[8];
#pragma unroll
          for (int j = 0; j < 8; ++j) st[j] = S[128 * (j >> 2) + 64 * wr + 16 * (j & 3) + fr];
#pragma unroll
          for (int bj = 0; bj < 2; ++bj)
#pragma unroll
              for (int n = 0; n < 2; ++n) { const f32x4 csv = *(const f32x4*)(csb + lq + (unsigned)((128 * bj + 16 * n) * 4)), cbv = *(const f32x4*)(cbb + lq + (unsigned)((128 * bj + 16 * n) * 4));
#pragma unroll
                  for (int j = 0; j < 8; ++j) acc[j >> 2][bj][j & 3][n] = acc[j >> 2][bj][j & 3][n] * st[j].x + (csv * st[j].y + cbv);
                  asm volatile("" ::: "memory"); }
        }
        pin_half<0>(acc); pin_half<1>(acc);
        half<0>(acc, pm, pn, wr, wc, fr, fq);
        half<1>(acc, pm, pn, wr, wc, fr, fq);
    }
};

template <bool FINAL> struct EpiRes {
    int pprev, pnew, gi, goff;
    template <int BJ>
    __device__ __forceinline__ void resid(f32x4 (&acc)[2][2][4][2], int pm, int pn, int wr, int wc, int fr, int fq, LAS f32x2* S) const {
        asm volatile("" : "+v"(fr), "+v"(fq));
        const KA Params* q = kargs();
        const int ucol = 256 * pn + 128 * BJ + 32 * wc;
        const char* vb = (const char*)((const bf16_t*)(q->ws + WS_H1) + (size_t)(pm * 256 + 64 * wr) * D + ucol);
        const unsigned lv = (unsigned)((fr * D + 4 * fq) * 2), lq = (unsigned)(16 * fq);
        const char* gb = (const char*)(q->in[gi] + goff + ucol); const char* bb = (const char*)(q->in[gi + 1] + goff + ucol);
        u32x2 vp[8][2];
#pragma unroll
        for (int j = 0; j < 8; ++j)
#pragma unroll
            for (int n = 0; n < 2; ++n) vp[j][n] = *(const u32x2*)(vb + lv + (unsigned)(((128 * (j >> 2) + 16 * (j & 3)) * D + 16 * n) * 2));
        f32x4 gv[2], bv[2];
#pragma unroll
        for (int n = 0; n < 2; ++n) { gv[n] = *(const f32x4*)(gb + lq + (unsigned)(64 * n)) * ALPHA; bv[n] = *(const f32x4*)(bb + lq + (unsigned)(64 * n)) * ALPHA; }
        const LAS f32x2* Sl = S + 64 * wr + fr;
#pragma unroll
        for (int j = 0; j < 8; ++j) { const f32x2 s = Sl[128 * (j >> 2) + 16 * (j & 3)];
#pragma unroll
            for (int n = 0; n < 2; ++n) { f32x4 v; v[0] = bf2f(vp[j][n].x & 0xffffu); v[1] = bf2f(vp[j][n].x >> 16); v[2] = bf2f(vp[j][n].y & 0xffffu); v[3] = bf2f(vp[j][n].y >> 16);
                acc[j >> 2][BJ][j & 3][n] = (v * s.x + s.y) * gv[n] + bv[n] + acc[j >> 2][BJ][j & 3][n]; } }
        pin_half<BJ>(acc);
    }
    __device__ __forceinline__ void operator()(f32x4 (&acc)[2][2][4][2], const pg8::Unit& u, int wr, int wc, int fr, int fq, LAS unsigned char* elds) const {
        const int pm = u.pm, pn = u.pn;
        LAS f32x2* P = (LAS f32x2*)elds;
        LAS f32x2* S = (LAS f32x2*)(elds + 8192);
        stats_to_lds((const f32x2*)(kargs()->ws + WS_PART) + (size_t)pprev * MROWS * 4, pm, S);
        resid<0>(acc, pm, pn, wr, wc, fr, fq, S);
        resid<1>(acc, pm, pn, wr, wc, fr, fq, S);
        asm volatile("" : "+v"(fr), "+v"(fq));
        const KA Params* q = kargs();
        char* ob; unsigned lo;
        if (FINAL) { ob = (char*)(q->out + O_Y + (size_t)(pm * 256 + 128 * wr) * D + 256 * pn + 32 * wc); lo = (unsigned)((8 * fr * D + 4 * fq) * 4); }
        else { ob = (char*)((bf16_t*)(q->ws + WS_H1) + (size_t)(pm * 256 + 64 * wr) * D + 256 * pn + 32 * wc); lo = (unsigned)((fr * D + 4 * fq) * 2); }
        LAS f32x2* Pl = P + (64 * wr + fr) * 4 + wc;
#pragma unroll
        for (int j = 0; j < 8; ++j) {
            const int ai = j >> 2, m = j & 3;
            float sum = 0.f;
#pragma unroll
            for (int bj = 0; bj < 2; ++bj)
#pragma unroll
                for (int n = 0; n < 2; ++n) { const f32x4 vn = acc[ai][bj][m][n]; sum += (vn[0] + vn[1]) + (vn[2] + vn[3]); }
            sum += __shfl_xor(sum, 16); sum += __shfl_xor(sum, 32);
            const float mw = sum * (1.0f / 64.0f); float qq = 0.f;
#pragma unroll
            for (int bj = 0; bj < 2; ++bj)
#pragma unroll
                for (int n = 0; n < 2; ++n) { const f32x4 d = acc[ai][bj][m][n] - mw; qq += (d[0] * d[0] + d[1] * d[1]) + (d[2] * d[2] + d[3] * d[3]); }
            qq += __shfl_xor(qq, 16); qq += __shfl_xor(qq, 32);
            if (fq == 0) { f32x2 t; t.x = mw; t.y = qq; Pl[(128 * ai + 16 * m) * 4] = t; }
#pragma unroll
            for (int bj = 0; bj < 2; ++bj)
#pragma unroll
                for (int n = 0; n < 2; ++n) { const f32x4 vn = acc[ai][bj][m][n];
                    if (FINAL) *(f32x4*)(ob + lo + (unsigned)(((4 * ai + m) * D + 128 * bj + 16 * n) * 4)) = vn;
                    else { u32x2 w; w.x = pk2(vn[0], vn[1]); w.y = pk2(vn[2], vn[3]); *(u32x2*)(ob + lo + (unsigned)(((128 * ai + 16 * m) * D + 128 * bj + 16 * n) * 2)) = w; } }
        }
        asm volatile("s_waitcnt lgkmcnt(0)" ::: "memory"); __builtin_amdgcn_s_barrier(); asm volatile("" ::: "memory");
        int rl = threadIdx.x; asm volatile("" : "+v"(rl));
        if (rl < 256) {
            const f32x2 a = P[rl * 4 + 0], b2 = P[rl * 4 + 1], c2 = P[rl * 4 + 2], d2 = P[rl * 4 + 3];
            const float mt = (a.x + b2.x + c2.x + d2.x) * 0.25f;
            const float da = a.x - mt, db = b2.x - mt, dc = c2.x - mt, dd = d2.x - mt;
            f32x2 r; r.x = mt; r.y = (a.y + b2.y) + (c2.y + d2.y) + 64.0f * ((da * da + db * db) + (dc * dc + dd * dd));
            char* pb = (char*)((f32x2*)(q->ws + WS_PART) + (size_t)pnew * MROWS * 4 + (size_t)pm * 256 * 4 + pn);
            *(f32x2*)(pb + (unsigned)(rl * 32)) = r;
        }
    }
};

struct EpiIn {
    int dummy;
    __device__ __forceinline__ void operator()(f32x4 (&acc)[2][2][4][2], const pg8::Unit& u, int wr, int wc, int fr, int fq, LAS unsigned char* elds) const {
        const int pm = u.pm, pn = u.pn; const bool sample = pm >= NPANEL_P;
        LAS f32x2* S = (LAS f32x2*)(elds + 8192);
        const KA Params* q = kargs(); unsigned char* ws = q->ws;
        stats_to_lds((const f32x2*)(ws + WS_PART) + (size_t)1 * MROWS * 4, pm, S);
        const unsigned lq = (unsigned)(16 * fq);
        { const char* csb = (const char*)((const float*)(ws + WS_CS_IN) + 256 * pn + 32 * wc); const char* cbb = (const char*)((const float*)(ws + WS_CB_IN) + 256 * pn + 32 * wc);
          f32x2 st[8];
#pragma unroll
          for (int j = 0; j < 8; ++j) st[j] = S[128 * (j >> 2) + 64 * wr + 16 * (j & 3) + fr];
#pragma unroll
          for (int bj = 0; bj < 2; ++bj)
#pragma unroll
              for (int n = 0; n < 2; ++n) { const f32x4 csv = *(const f32x4*)(csb + lq + (unsigned)((128 * bj + 16 * n) * 4)), cbv = *(const f32x4*)(cbb + lq + (unsigned)((128 * bj + 16 * n) * 4));
#pragma unroll
                  for (int j = 0; j < 8; ++j) acc[j >> 2][bj][j & 3][n] = acc[j >> 2][bj][j & 3][n] * st[j].x + (csv * st[j].y + cbv);
                  asm volatile("" ::: "memory"); } }
        pin_half<0>(acc); pin_half<1>(acc);
        asm volatile("" : "+v"(fr), "+v"(fq));
        const unsigned lr = (unsigned)((fr * D + 4 * fq) * 2);
        if (pn < 8) {
            char* ub = (char*)((bf16_t*)(ws + WS_ACT) + (size_t)(pm * 256 + 64 * wr) * D + 128 * pn + 32 * wc);
#pragma unroll
            for (int n = 0; n < 2; ++n) {
#pragma unroll
                for (int j = 0; j < 8; ++j) { const int ai = j >> 2, m = j & 3; const f32x4 uu = acc[ai][0][m][n] * acc[ai][1][m][n];
                    u32x2 w; w.x = pk2(uu[0], uu[1]); w.y = pk2(uu[2], uu[3]); *(u32x2*)(ub + lr + (unsigned)(((128 * ai + 16 * m) * D + 16 * n) * 2)) = w;
                    if (sample) { if (m >= 2) { const int seq = 64 * (pm - NPANEL_P) + 32 * wr + 2 * fr + ai; *(f32x4*)(q->out + O_CONV_S + ((size_t)seq * 2 + (m - 2)) * D + 128 * pn + 32 * wc + 16 * n + 4 * fq) = uu; } }
                    else if ((pm & 7) == 7 && wr == 1 && fr == 15 && j >= 6) { *(f32x4*)(q->out + O_CONV_P + ((size_t)(pm >> 3) * 2 + (j - 6)) * D + 128 * pn + 32 * wc + 16 * n + 4 * fq) = uu; } } }
        } else {
            char* bb = (char*)((bf16_t*)(ws + WS_ACT) + (size_t)MROWS * D + (size_t)(pm * 256 + 64 * wr) * D + 256 * (pn - 8) + 32 * wc);
#pragma unroll
            for (int bj = 0; bj < 2; ++bj)
#pragma unroll
                for (int n = 0; n < 2; ++n) {
#pragma unroll
                    for (int j = 0; j < 8; ++j) { const int ai = j >> 2, m = j & 3; const f32x4 v = acc[ai][bj][m][n];
                        u32x2 w; w.x = pk2(v[0], v[1]); w.y = pk2(v[2], v[3]); *(u32x2*)(bb + lr + (unsigned)(((128 * ai + 16 * m) * D + 128 * bj + 16 * n) * 2)) = w; } }
        }
    }
};

__device__ __forceinline__ void p0_item(const float* W, int K, int N, int kb, int nb, bf16_t* WT, int dest_row0, const float* rowscale, const float* colscale,
                                        float* csp, const float* bvec, float* cbp, int pstride, LAS float* scr, int lane) {
    const int k0 = 64 * kb, n0 = 32 * nb;
#pragma unroll 8
    for (int i = 0; i < 32; ++i) { const int kk = 2 * i + (lane >> 5); scr[kk * 33 + (lane & 31)] = W[(size_t)(k0 + kk) * N + n0 + (lane & 31)]; }
    asm volatile("s_waitcnt lgkmcnt(0)" ::: "memory");
    const int c = lane & 7;
    float rs[8], bb[8];
#pragma unroll
    for (int i = 0; i < 8; ++i) { rs[i] = rowscale ? rowscale[k0 + 8 * c + i] : 1.0f; bb[i] = bvec ? bvec[k0 + 8 * c + i] : 0.0f; }
#pragma unroll
    for (int j = 0; j < 4; ++j) { const int n = (lane >> 3) + 8 * j; const LAS float* s = scr + (8 * c) * 33 + n;
        const float sc = colscale ? colscale[n0 + n] : 1.0f;
        unsigned r[8]; float ps = 0.f, pb = 0.f;
#pragma unroll
        for (int i = 0; i < 8; ++i) { const float w = s[i * 33]; r[i] = f2bf(w * rs[i] * sc); ps += bf2f(r[i]); pb += w * bb[i]; }
        u32x4 o; o.x = r[0] | (r[1] << 16); o.y = r[2] | (r[3] << 16); o.z = r[4] | (r[5] << 16); o.w = r[6] | (r[7] << 16);
        *(u32x4*)(WT + (size_t)(dest_row0 + n) * K + k0 + 8 * c) = o;
        if (csp) {
            ps += __shfl_xor(ps, 1); ps += __shfl_xor(ps, 2); ps += __shfl_xor(ps, 4);
            pb += __shfl_xor(pb, 1); pb += __shfl_xor(pb, 2); pb += __shfl_xor(pb, 4);
            if (c == 0) { csp[(size_t)kb * pstride + dest_row0 + n] = ps; cbp[(size_t)kb * pstride + dest_row0 + n] = pb; }
        }
    }
    asm volatile("s_waitcnt lgkmcnt(0)" ::: "memory");
}
__device__ __forceinline__ int up_dest(int n) { return n < FF ? 256 * (n >> 7) + (n & 127) : 256 * ((n - FF) >> 7) + 128 + ((n - FF) & 127); }
__device__ __forceinline__ int in_dest(int n) { return n < D ? 2048 + n : (n < 2 * D ? 256 * ((n - D) >> 7) + ((n - D) & 127) : 256 * ((n - 2 * D) >> 7) + 128 + ((n - 2 * D) & 127)); }

__device__ __forceinline__ void phase0(LAS unsigned char* lds) {
    const KA Params* q = kargs();
    const int tid = tid_fresh(), lane = tid & 63, wave = tid >> 6;
    LAS float* scr = (LAS float*)(lds + wave * 8704);
    const int gw = blockIdx.x * 8 + wave, NGW = gridDim.x * 8;
    unsigned char* ws = q->ws;
    constexpr int I_UP = 16 * 176, I_IN = 16 * 96, I_OUT = 16 * 32, I_DN = 44 * 32, I_POOL = 4 * 8;
    constexpr int NITEMS = 2 * I_UP + I_IN + I_OUT + 2 * I_DN + 4 * I_POOL;
    for (int it = gw; it < NITEMS; it += NGW) {
        int r = it;
        if (r < 2 * I_UP) { const int l = r / I_UP; r -= l * I_UP; const int kb = r / 176, nb = r % 176;
            p0_item(q->in[13] + (size_t)l * D * FF2, D, FF2, kb, nb, (bf16_t*)(ws + WS_WUP) + (size_t)l * FF2 * D, up_dest(32 * nb), q->in[5] + l * D, nullptr,
                    (float*)(ws + WS_CSP_UP) + (size_t)l * 16 * FF2, q->in[6] + l * D, (float*)(ws + WS_CBP_UP) + (size_t)l * 16 * FF2, FF2, scr, lane); continue; }
        r -= 2 * I_UP;
        if (r < I_IN) { const int kb = r / 96, nb = r % 96;
            p0_item(q->in[9], D, 3 * D, kb, nb, (bf16_t*)(ws + WS_WIN), in_dest(32 * nb), q->in[17], nullptr, (float*)(ws + WS_CSP_IN), q->in[18], (float*)(ws + WS_CBP_IN), 3 * D, scr, lane); continue; }
        r -= I_IN;
        if (r < I_OUT) { const int kb = r / 32, nb = r % 32;
            p0_item(q->in[12], D, D, kb, nb, (bf16_t*)(ws + WS_WOUT), 32 * nb, nullptr, nullptr, nullptr, nullptr, nullptr, 0, scr, lane); continue; }
        r -= I_OUT;
        if (r < 2 * I_DN) { const int l = r / I_DN; r -= l * I_DN; const int kb = r / 32, nb = r % 32;
            p0_item(q->in[16] + (size_t)l * FF * D, FF, D, kb, nb, (bf16_t*)(ws + WS_WDN) + (size_t)l * D * FF, 32 * nb, nullptr, nullptr, nullptr, nullptr, nullptr, 0, scr, lane); continue; }
        r -= 2 * I_DN;
        { const int g = r / I_POOL; r -= g * I_POOL; const int kb = r / 8, nb = r % 8;
            p0_item(q->in[7] + (size_t)g * 256 * 256, 256, 256, kb, nb, (bf16_t*)(ws + WS_WPOOL) + (size_t)g * 256 * 256, 32 * nb, nullptr, q->in[8] + g * 256, nullptr, nullptr, nullptr, 0, scr, lane); }
    }
    const int gt = blockIdx.x * 512 + tid, NGT = gridDim.x * 512;
    for (int i = gt; i < 2 * FF2; i += NGT) { const int l = i / FF2, n = i % FF2, d = up_dest(n); float* kc = (float*)(ws + WS_KC_UP) + (size_t)l * 4 * FF2;
        kc[d] = q->in[14][(size_t)(l * 3 + 0) * FF2 + n]; kc[FF2 + d] = q->in[14][(size_t)(l * 3 + 1) * FF2 + n]; kc[2 * FF2 + d] = q->in[14][(size_t)(l * 3 + 2) * FF2 + n]; kc[3 * FF2 + d] = q->in[15][(size_t)l * FF2 + n]; }
    for (int i = gt; i < NB_P * 15 * (D / 4); i += NGT) { const int c4 = i % (D / 4), rr = (i / (D / 4)) % 15, b = i / (15 * (D / 4));
        ((f32x4*)(q->out + O_POOL_P))[i] = *(const f32x4*)(q->in[0] + ((size_t)b * SEQ + 2033 + rr) * D + c4 * 4); }
    for (int i = gt; i < NB_S * 15 * (D / 4); i += NGT) { const int c4 = i % (D / 4), rr = (i / (D / 4)) % 15, s = i / (15 * (D / 4));
        ((f32x4*)(q->out + O_POOL_S))[i] = rr < 11 ? *(const f32x4*)(q->in[2] + ((size_t)s * 15 + 4 + rr) * D + c4 * 4) : *(const f32x4*)(q->in[1] + ((size_t)s * TS + rr - 11) * D + c4 * 4); }
}

__device__ __forceinline__ void phase1(LAS unsigned char* lds) {
    const KA Params* q = kargs();
    const int tid = tid_fresh(), lane = tid & 63, wave = __builtin_amdgcn_readfirstlane(tid >> 6), fr = lane & 15, fq = lane >> 4;
    unsigned char* ws = q->ws;
    { const int gt = blockIdx.x * 512 + tid, NGT = gridDim.x * 512;
      for (int i = gt; i < 2 * FF2 + 3 * D; i += NGT) {
          float s = 0.f, b = 0.f;
          if (i < 2 * FF2) { const int l = i / FF2, c = i % FF2; const float* sp = (const float*)(ws + WS_CSP_UP) + (size_t)l * 16 * FF2 + c; const float* bp = (const float*)(ws + WS_CBP_UP) + (size_t)l * 16 * FF2 + c;
              for (int k = 0; k < 16; ++k) { s += sp[(size_t)k * FF2]; b += bp[(size_t)k * FF2]; }
              ((float*)(ws + WS_CS_UP))[i] = s; ((float*)(ws + WS_CB_UP))[i] = b; }
          else { const int c = i - 2 * FF2; const float* sp = (const float*)(ws + WS_CSP_IN) + c; const float* bp = (const float*)(ws + WS_CBP_IN) + c;
              for (int k = 0; k < 16; ++k) { s += sp[(size_t)k * 3 * D]; b += bp[(size_t)k * 3 * D]; }
              ((float*)(ws + WS_CS_IN))[c] = s; ((float*)(ws + WS_CB_IN))[c] = b; } } }
    const bf16_t* wpool = (const bf16_t*)(ws + WS_WPOOL);
    bf16_t* vbf = (bf16_t*)(ws + WS_H1);
    f32x2* part = (f32x2*)(ws + WS_PART);
    LAS f32x2* T = (LAS f32x2*)(lds + 65536);
    const int g = wave >> 1, hh = wave & 1, w = 2 << g;
    const int c0 = 2 * tid;
    for (int tile = blockIdx.x; tile < MROWS / 32; tile += gridDim.x) {
        const int tok0 = tile * 32;
        if (tok0 < NTOK_P) {
            const int t0 = tok0 & (SEQ - 1); const float* xb = q->in[0] + (size_t)(tok0 - t0) * D + c0;
            f32x2 s = {0.f, 0.f};
            for (int i = 1; i <= w; ++i) { const int tt = t0 - i; if (tt >= 0) s += *(const f32x2*)(xb + (size_t)tt * D); }
#pragma unroll 8
            for (int j = 0; j < 32; ++j) { const int t = t0 + j; const f32x2 cur = *(const f32x2*)(xb + (size_t)t * D); f32x2 old = {0.f, 0.f}; if (t - w >= 0) old = *(const f32x2*)(xb + (size_t)(t - w) * D);
                s += cur - old; const float inv = 1.0f / (float)(t + 1 < w ? t + 1 : w); const f32x2 d = s * inv - cur;
                *(LAS unsigned*)(lds + j * 2048 + ((((tid >> 2) ^ (j & 15))) << 4) + (tid & 3) * 4) = pk2(d.x, d.y); }
        } else {
            const float inv = 1.0f / (float)w;
            for (int qi = 0; qi < 8; ++qi) { const int sq = ((tok0 - NTOK_P) >> 2) + qi; const float* hb = q->in[2] + (size_t)sq * 15 * D + c0; const float* xb = q->in[1] + (size_t)sq * TS * D + c0;
                f32x2 s = {0.f, 0.f};
                for (int i = 1; i <= w; ++i) { if (i <= 15) s += *(const f32x2*)(hb + (size_t)(15 - i) * D); }
#pragma unroll
                for (int t = 0; t < 4; ++t) { const f32x2 cur = *(const f32x2*)(xb + (size_t)t * D); f32x2 old = {0.f, 0.f}; const int tt = t - w;
                    if (tt >= 0) old = *(const f32x2*)(xb + (size_t)tt * D); else if (tt >= -15) old = *(const f32x2*)(hb + (size_t)(15 + tt) * D);
                    s += cur - old; const f32x2 d = s * inv - cur; const int j = 4 * qi + t;
                    *(LAS unsigned*)(lds + j * 2048 + ((((tid >> 2) ^ (j & 15))) << 4) + (tid & 3) * 4) = pk2(d.x, d.y); } }
        }
        __syncthreads();
        f32x4 acc[2][8];
#pragma unroll
        for (int mb = 0; mb < 2; ++mb)
#pragma unroll
            for (int nb = 0; nb < 8; ++nb) acc[mb][nb] = (f32x4){0.f, 0.f, 0.f, 0.f};
        const bf16_t* wb = wpool + ((size_t)g * 256 + 128 * hh + fr) * 256 + 8 * fq;
#pragma unroll 2
        for (int ks = 0; ks < 8; ++ks) {
            bf16x8 a[2], b[8];
#pragma unroll
            for (int nb = 0; nb < 8; ++nb) b[nb] = *(const bf16x8*)(wb + (size_t)(16 * nb) * 256 + 32 * ks);
#pragma unroll
            for (int mb = 0; mb < 2; ++mb) { const int row = 16 * mb + fr, chunk = 32 * g + 4 * ks + fq; a[mb] = *(const LAS bf16x8*)(lds + row * 2048 + ((chunk ^ (row & 15)) << 4)); }
#pragma unroll
            for (int mb = 0; mb < 2; ++mb)
#pragma unroll
                for (int nb = 0; nb < 8; ++nb) acc[mb][nb] = __builtin_amdgcn_mfma_f32_16x16x32_bf16(b[nb], a[mb], acc[mb][nb], 0, 0, 0);
        }
#pragma unroll
        for (int mb = 0; mb < 2; ++mb) {
            const int tok = tok0 + 16 * mb + fr, R = row_of_tok(tok);
            const float* xr = (tok < NTOK_P ? q->in[0] + (size_t)tok * D : q->in[1] + (size_t)(tok - NTOK_P) * D) + 256 * g + 128 * hh + 4 * fq;
            float sum = 0.f, sq = 0.f;
#pragma unroll
            for (int nb = 0; nb < 8; ++nb) { const f32x4 xv = *(const f32x4*)(xr + 16 * nb); const f32x4 v = xv * ALPHA + acc[mb][nb];
                sum += (v[0] + v[1]) + (v[2] + v[3]); sq += (v[0] * v[0] + v[1] * v[1]) + (v[2] * v[2] + v[3] * v[3]);
                const int c = 256 * g + 128 * hh + 16 * nb + 4 * fq;
                u32x2 wv; wv.x = pk2(v[0], v[1]); wv.y = pk2(v[2], v[3]); *(u32x2*)(vbf + (size_t)R * D + c) = wv; }
            sum += __shfl_xor(sum, 16); sum += __shfl_xor(sum, 32); sq += __shfl_xor(sq, 16); sq += __shfl_xor(sq, 32);
            if (fq == 0) { f32x2 t; t.x = sum; t.y = sq; T[(16 * mb + fr) * 8 + wave] = t; }
        }
        __syncthreads();
        if (tid < 128) { const int row = tid >> 2, gg = tid & 3; const f32x2 a = T[row * 8 + 2 * gg], b = T[row * 8 + 2 * gg + 1];
            const float mt = (a.x + b.x) * (1.0f / 256.0f); f32x2 r; r.x = mt; r.y = (a.y + b.y) - 256.0f * mt * mt;
            part[(size_t)row_of_tok(tok0 + row) * 4 + gg] = r; }
        __syncthreads();
    }
}

__device__ __forceinline__ void phase_fixup(int l) {
    const KA Params* q = kargs();
    const float* kc = (const float*)(q->ws + WS_KC_UP) + (size_t)l * 4 * FF2; bf16_t* act = (bf16_t*)(q->ws + WS_ACT);
    const float* Hf = (const float*)(q->ws + WS_HF); const float* Hl = (const float*)(q->ws + WS_HL);
    const int gt = blockIdx.x * 512 + tid_fresh(), NGT = gridDim.x * 512;
    for (int i = gt; i < 128 * (FF / 4); i += NGT) {
        const int q = i / (FF / 4), f = (i % (FF / 4)) * 4;
        if ((q & 15) == 0) continue;
        const int cg_ = 256 * (f >> 7) + (f & 127), cv_ = cg_ + 128;
        const float* hf = Hf + (size_t)q * 2 * FF2; const float* hl = Hl + (size_t)(q - 1) * 2 * FF2;
        const f32x4 k0g = *(const f32x4*)(kc + cg_), k1g = *(const f32x4*)(kc + FF2 + cg_), k2g = *(const f32x4*)(kc + 2 * FF2 + cg_), kbg = *(const f32x4*)(kc + 3 * FF2 + cg_);
        const f32x4 k0v = *(const f32x4*)(kc + cv_), k1v = *(const f32x4*)(kc + FF2 + cv_), k2v = *(const f32x4*)(kc + 2 * FF2 + cv_), kbv = *(const f32x4*)(kc + 3 * FF2 + cv_);
        const f32x4 g2 = *(const f32x4*)(hl + cg_), g1 = *(const f32x4*)(hl + FF2 + cg_), a0 = *(const f32x4*)(hf + cg_), a1 = *(const f32x4*)(hf + FF2 + cg_);
        const f32x4 v2 = *(const f32x4*)(hl + cv_), v1 = *(const f32x4*)(hl + FF2 + cv_), b0 = *(const f32x4*)(hf + cv_), b1 = *(const f32x4*)(hf + FF2 + cv_);
        const f32x4 zg0 = k2g * a0 + k1g * g1 + k0g * g2 + kbg, zv0 = k2v * b0 + k1v * v1 + k0v * v2 + kbv;
        const f32x4 zg1 = k2g * a1 + k1g * a0 + k0g * g1 + kbg, zv1 = k2v * b1 + k1v * b0 + k0v * v1 + kbv;
        const int R0 = (q >> 1) * 256 + 64 * (q & 1);
        u32x2 w0, w1; w0.x = pk2(silu_mul(zg0[0], zv0[0]), silu_mul(zg0[1], zv0[1])); w0.y = pk2(silu_mul(zg0[2], zv0[2]), silu_mul(zg0[3], zv0[3]));
        w1.x = pk2(silu_mul(zg1[0], zv1[0]), silu_mul(zg1[1], zv1[1])); w1.y = pk2(silu_mul(zg1[2], zv1[2]), silu_mul(zg1[3], zv1[3]));
        *(u32x2*)(act + (size_t)R0 * FF + f) = w0; *(u32x2*)(act + (size_t)(R0 + 16) * FF + f) = w1;
    }
}

__device__ __forceinline__ void phase_conv() {
    const KA Params* q = kargs();
    const bf16_t* ubuf = (const bf16_t*)(q->ws + WS_ACT); const bf16_t* bbuf = ubuf + (size_t)MROWS * D; bf16_t* obuf = (bf16_t*)q->out;
    const float* ck = q->in[10]; const float* ckb = q->in[11]; const float* st = q->in[3];
    const int gt = blockIdx.x * 512 + tid_fresh(), NGT = gridDim.x * 512;
    for (int i = gt; i < MROWS * (D / 8); i += NGT) {
        const int tok = i >> 7, ch = (i & 127) * 8;
        int t, seq = 0; const bool sample = tok >= NTOK_P;
        if (!sample) t = tok & (SEQ - 1); else { seq = (tok - NTOK_P) >> 2; t = tok & 3; }
        const int R = row_of_tok(tok);
        float u0[8], u1[8], u2[8], bb[8];
        { const u32x4 w = *(const u32x4*)(ubuf + (size_t)R * D + ch); const u32x4 wb = *(const u32x4*)(bbuf + (size_t)R * D + ch);
#pragma unroll
          for (int e = 0; e < 4; ++e) { u2[2 * e] = bf2f(w[e] & 0xffffu); u2[2 * e + 1] = bf2f(w[e] >> 16); bb[2 * e] = bf2f(wb[e] & 0xffffu); bb[2 * e + 1] = bf2f(wb[e] >> 16); } }
        if (t >= 1) { const u32x4 w = *(const u32x4*)(ubuf + (size_t)row_of_tok(tok - 1) * D + ch);
#pragma unroll
            for (int e = 0; e < 4; ++e) { u1[2 * e] = bf2f(w[e] & 0xffffu); u1[2 * e + 1] = bf2f(w[e] >> 16); } }
        else if (sample) { const f32x4 a = *(const f32x4*)(st + ((size_t)seq * 2 + 1) * D + ch), b = *(const f32x4*)(st + ((size_t)seq * 2 + 1) * D + ch + 4);
#pragma unroll
            for (int e = 0; e < 4; ++e) { u1[e] = a[e]; u1[4 + e] = b[e]; } }
        else {
#pragma unroll
            for (int e = 0; e < 8; ++e) u1[e] = 0.f; }
        if (t >= 2) { const u32x4 w = *(const u32x4*)(ubuf + (size_t)row_of_tok(tok - 2) * D + ch);
#pragma unroll
            for (int e = 0; e < 4; ++e) { u0[2 * e] = bf2f(w[e] & 0xffffu); u0[2 * e + 1] = bf2f(w[e] >> 16); } }
        else if (sample) { const f32x4 a = *(const f32x4*)(st + ((size_t)seq * 2 + t) * D + ch), b = *(const f32x4*)(st + ((size_t)seq * 2 + t) * D + ch + 4);
#pragma unroll
            for (int e = 0; e < 4; ++e) { u0[e] = a[e]; u0[4 + e] = b[e]; } }
        else {
#pragma unroll
            for (int e = 0; e < 8; ++e) u0[e] = 0.f; }
        float o[8];
#pragma unroll
        for (int e = 0; e < 8; ++e) o[e] = bb[e] * (ck[ch + e] * u0[e] + ck[D + ch + e] * u1[e] + ck[2 * D + ch + e] * u2[e] + ckb[ch + e]);
        u32x4 w; w.x = pk2(o[0], o[1]); w.y = pk2(o[2], o[3]); w.z = pk2(o[4], o[5]); w.w = pk2(o[6], o[7]);
        *(u32x4*)(obuf + (size_t)R * D + ch) = w;
    }
}

__device__ __forceinline__ void phase_final() {
    const KA Params* q = kargs();
    const f32x2* part = (const f32x2*)(q->ws + WS_PART); const float* g = q->in[17] + D; const float* b = q->in[18] + D;
    const int tid = tid_fresh(), lane = tid & 63, gw = blockIdx.x * 8 + (tid >> 6), NGW = gridDim.x * 8;
    f32x4 gv[4], bv[4];
#pragma unroll
    for (int j = 0; j < 4; ++j) { gv[j] = *(const f32x4*)(g + 256 * j + 4 * lane); bv[j] = *(const f32x4*)(b + 256 * j + 4 * lane); }
    for (int tok = gw; tok < MROWS; tok += NGW) {
        const f32x2 s = row_stats(part, row_of_tok(tok));
        float* yr = q->out + (size_t)tok * D + 4 * lane;
#pragma unroll
        for (int j = 0; j < 4; ++j) { const f32x4 v = *(const f32x4*)(yr + 256 * j); *(f32x4*)(yr + 256 * j) = ((v - s.x) * s.y) * gv[j] + bv[j]; }
    }
}

#define XB_TMO      128
#define XB_XCNT(j)  (256  + 64 * (j))
#define XB_XSUB(j)  (1280 + 64 * (j))
#define XB_XGEN(j)  (2304 + 64 * (j))
#define XB_TOP      3328
#define XB_TOPGEN   3392
#define XCD_BAR_WORDS 3456
#define XB_SPIN_CAP (1u << 18)

__device__ __forceinline__ unsigned xb_ld(unsigned* p)              { return __hip_atomic_load(p, __ATOMIC_RELAXED, __HIP_MEMORY_SCOPE_AGENT); }
__device__ __forceinline__ unsigned xb_add(unsigned* p, unsigned v) { return __hip_atomic_fetch_add(p, v, __ATOMIC_RELAXED, __HIP_MEMORY_SCOPE_AGENT); }
__device__ __forceinline__ unsigned xb_xcc_id() { return (unsigned)__builtin_amdgcn_s_getreg((3 << 11) | 20) & 0xFu; }
#define XB_SPIN(cond, bar) do { unsigned _sp = 0; while (cond) { __builtin_amdgcn_s_sleep(1); \
    if ((++_sp & 255u) == 0u) { if (xb_ld(&(bar)[XB_TMO])) break; if (_sp > XB_SPIN_CAP) { atomicAdd(&(bar)[XB_TMO], 1u); break; } } } } while (0)

struct XcdBarrier {
    unsigned* bar; unsigned x;
    volatile LAS unsigned* st;
};

__device__ __forceinline__ XcdBarrier xcd_barrier_post(unsigned* bar, volatile LAS unsigned* st) {
    XcdBarrier b; b.bar = bar; b.x = xb_xcc_id(); b.st = st;
    if (threadIdx.x == 0) (void)xb_add(&bar[XB_XCNT(b.x)], 1u);
    return b;
}
__device__ __forceinline__ void xcd_barrier_complete(unsigned* bar, unsigned x, unsigned& nloc, unsigned& nx) {
    const unsigned G = gridDim.x * gridDim.y * gridDim.z;
    unsigned sum, cnt, mine, sp = 0u;
    for (;;) {
        sum = 0u; cnt = 0u; mine = 0u;
#pragma unroll
        for (unsigned j = 0; j < 16; ++j) { const unsigned c = xb_ld(&bar[XB_XCNT(j)]); sum += c; cnt += (c > 0u) ? 1u : 0u; mine = (j == x) ? c : mine; }
        if (sum == G) break;
        __builtin_amdgcn_s_sleep(1);
        if ((++sp & 255u) == 0u) { if (xb_ld(&bar[XB_TMO])) break; if (sp > XB_SPIN_CAP) { atomicAdd(&bar[XB_TMO], 1u); break; } }
    }
    nloc = mine > 0u ? mine : 1u; nx = cnt > 0u ? cnt : 1u;
}

__device__ __forceinline__ void xcd_barrier(const XcdBarrier& b) {
    asm volatile("s_waitcnt vmcnt(0)" ::: "memory");
    __syncthreads();
    if (threadIdx.x == 0) {
        unsigned* bar = b.bar;
        __builtin_amdgcn_s_waitcnt(0);
        unsigned nloc = b.st[0], nx = b.st[1];
        if (nloc == 0u) { xcd_barrier_complete(bar, b.x, nloc, nx); b.st[0] = nloc; b.st[1] = nx; }
        const unsigned old = xb_add(&bar[XB_XSUB(b.x)], 1u);
        const unsigned gen = old / nloc;
        if (old + 1u == (gen + 1u) * nloc) {
            __builtin_amdgcn_fence(__ATOMIC_RELEASE, "agent");
            asm volatile("s_waitcnt vmcnt(0)" ::: "memory");
            const unsigned og = xb_add(&bar[XB_TOP], 1u);
            const unsigned tg = og / nx;
            if (og + 1u == (tg + 1u) * nx) xb_add(&bar[XB_TOPGEN], 1u);
            else XB_SPIN(xb_ld(&bar[XB_TOPGEN]) == tg, bar);
            __builtin_amdgcn_fence(__ATOMIC_ACQUIRE, "agent");
            xb_add(&bar[XB_XGEN(b.x)], 1u);
            asm volatile("s_waitcnt vmcnt(0)" ::: "memory");
        } else {
            XB_SPIN(xb_ld(&bar[XB_XGEN(b.x)]) == gen, bar);
            __builtin_amdgcn_fence(__ATOMIC_ACQUIRE, "agent");
            asm volatile("s_waitcnt vmcnt(0)" ::: "memory");
        }
    }
    __syncthreads();
}


__global__ void __launch_bounds__(512, 2) fwd_megakernel(Params p) {
    extern __shared__ __attribute__((aligned(16))) unsigned char lds_raw[];
    LAS unsigned char* lds = (LAS unsigned char*)lds_raw;
    cg::grid_group grid = cg::this_grid();
    const int G = gridDim.x, cid = blockIdx.x;
    if (threadIdx.x < 2) ((LAS unsigned*)(lds + BARST_OFF))[threadIdx.x] = 0u;
    __syncthreads();
    const XcdBarrier bar = xcd_barrier_post((unsigned*)(kargs()->ws + WS_BAR), (volatile LAS unsigned*)(lds + BARST_OFF));
#define WSP(off) (kargs()->ws + (off))
#define H1P ((const bf16_t*)WSP(WS_H1))
#define H2P ((const bf16_t*)kargs()->out)
#if DIAG & 1
    phase0(lds);
#endif
    grid.sync();
#if DIAG & 2
    phase1(lds);
#endif
    xcd_barrier(bar);
#if DIAG & 32
    { pg8::Gemm g{H1P, (const bf16_t*)WSP(WS_WUP), D}; pg8::StaticOrder S; S.init(NPANEL, 22, G, cid); EpiUp E{0}; pg8::gemm_phase(lds, g, S, E); }
#endif
    xcd_barrier(bar);
#if DIAG & 64
    phase_fixup(0);
#endif
    xcd_barrier(bar);
#if DIAG & 128
    { pg8::Gemm g{(const bf16_t*)WSP(WS_ACT), (const bf16_t*)WSP(WS_WDN), FF}; pg8::StaticOrder S; S.init(NPANEL, 4, G, cid);
      EpiRes<false> E{0, 1, 5, 0}; pg8::gemm_phase(lds, g, S, E); }
#endif
    xcd_barrier(bar);
#if DIAG & 4
    { pg8::Gemm g{H1P, (const bf16_t*)WSP(WS_WIN), D}; pg8::StaticOrder S; S.init(NPANEL, 12, G, cid); EpiIn E{0}; pg8::gemm_phase(lds, g, S, E); }
#endif
    xcd_barrier(bar);
#if DIAG & 8
    phase_conv();
#endif
    xcd_barrier(bar);
#if DIAG & 16
    { pg8::Gemm g{H2P, (const bf16_t*)WSP(WS_WOUT), D}; pg8::StaticOrder S; S.init(NPANEL, 4, G, cid);
      EpiRes<false> E{1, 2, 17, 0}; pg8::gemm_phase(lds, g, S, E); }
#endif
    xcd_barrier(bar);
#if DIAG & 32
    { pg8::Gemm g{H1P, (const bf16_t*)WSP(WS_WUP) + (size_t)FF2 * D, D}; pg8::StaticOrder S; S.init(NPANEL, 22, G, cid); EpiUp E{1}; pg8::gemm_phase(lds, g, S, E); }
#endif
    xcd_barrier(bar);
#if DIAG & 64
    phase_fixup(1);
#endif
    xcd_barrier(bar);
#if DIAG & 256
    { pg8::Gemm g{(const bf16_t*)WSP(WS_ACT), (const bf16_t*)WSP(WS_WDN) + (size_t)D * FF, FF}; pg8::StaticOrder S; S.init(NPANEL, 4, G, cid);
      EpiRes<true> E{2, 0, 5, D}; pg8::gemm_phase(lds, g, S, E); }
#endif
    xcd_barrier(bar);
#if DIAG & 512
    phase_final();
#endif
}

extern "C" void kernel_launch(void* const* d_in, const int* in_sizes, int n_in, void* d_out, int out_size, void* d_ws, size_t ws_size, hipStream_t stream) {
    static int grid_blocks = 0;
    if (grid_blocks == 0) {
        if (n_in != 19 || out_size != (int)O_END || ws_size < WS_END) { fprintf(stderr, "kernel_launch: unexpected shapes (n_in %d out %d ws %zu)\n", n_in, out_size, ws_size); grid_blocks = -1; return; }
        int dev = 0, cus = 0, per_cu = 0;
        hipGetDevice(&dev);
        hipDeviceGetAttribute(&cus, hipDeviceAttributeMultiprocessorCount, dev);
        if (hipFuncSetAttribute((const void*)fwd_megakernel, hipFuncAttributeMaxDynamicSharedMemorySize, LDS_BYTES) != hipSuccess) { fprintf(stderr, "kernel_launch: hipFuncSetAttribute failed\n"); grid_blocks = -1; return; }
        hipOccupancyMaxActiveBlocksPerMultiprocessor(&per_cu, (const void*)fwd_megakernel, 512, LDS_BYTES);
        if (per_cu < 1) { fprintf(stderr, "kernel_launch: occupancy query reports %d blocks per CU\n", per_cu); grid_blocks = -1; return; }
        grid_blocks = cus;
    }
    if (grid_blocks < 0) return;
    if (hipMemsetAsync((char*)d_ws + WS_BAR, 0, 16384, stream) != hipSuccess) { fprintf(stderr, "kernel_launch: hipMemsetAsync failed\n"); return; }
    Params p{};
    for (int i = 0; i < 19; ++i) p.in[i] = (const float*)d_in[i];
    p.out = (float*)d_out; p.ws = (unsigned char*)d_ws;
    void* args[] = {&p};
    hipError_t e = hipLaunchCooperativeKernel((const void*)fwd_megakernel, dim3(grid_blocks), dim3(512), args, LDS_BYTES, stream);
    if (e != hipSuccess) fprintf(stderr, "cooperative launch failed: %s (grid %d)\n", hipGetErrorString(e), grid_blocks);
}
```

```cpp
#include <hip/hip_runtime.h>
#include <hip/hip_cooperative_groups.h>
#include <cstdio>
#include <cstdint>
namespace cg = cooperative_groups;
#ifndef REP
#define REP 0
#endif
#ifndef DIAG
#define DIAG 1023
#endif

#define LAS __attribute__((address_space(3)))
typedef unsigned short bf16_t;
typedef short bf16x8 __attribute__((ext_vector_type(8)));
typedef float f32x4 __attribute__((ext_vector_type(4)));
typedef float f32x2 __attribute__((ext_vector_type(2)));
typedef unsigned u32x4 __attribute__((ext_vector_type(4)));
typedef unsigned u32x2 __attribute__((ext_vector_type(2)));

constexpr int D = 1024, FF = 2816, FF2 = 5632, SEQ = 2048, NB_P = 8, NB_S = 128, TS = 4;
constexpr int NTOK_P = NB_P * SEQ;
constexpr int NTOK_S = NB_S * TS;
constexpr int MROWS = NTOK_P + NTOK_S;
constexpr int NPANEL = MROWS / 256;
constexpr int NPANEL_P = NTOK_P / 256;
constexpr float ALPHA = 1.41421356237309515f;
constexpr float LN_EPS = 1e-5f;

constexpr size_t O_Y = 0;
constexpr size_t O_POOL_P = (size_t)MROWS * D;
constexpr size_t O_POOL_S = O_POOL_P + (size_t)NB_P * 15 * D;
constexpr size_t O_CONV_P = O_POOL_S + (size_t)NB_S * 15 * D;
constexpr size_t O_CONV_S = O_CONV_P + (size_t)NB_P * 2 * D;
constexpr size_t O_FFN_P = O_CONV_S + (size_t)NB_S * 2 * D;
constexpr size_t O_FFN_S = O_FFN_P + (size_t)2 * NB_P * 2 * FF2;
constexpr size_t O_END = O_FFN_S + (size_t)2 * NB_S * 2 * FF2;

constexpr size_t WS_WUP = 0;
constexpr size_t WS_WDN = WS_WUP + (size_t)2 * FF2 * D * 2;
constexpr size_t WS_WIN = WS_WDN + (size_t)2 * D * FF * 2;
constexpr size_t WS_WOUT = WS_WIN + (size_t)3 * D * D * 2;
constexpr size_t WS_WPOOL = WS_WOUT + (size_t)D * D * 2;
constexpr size_t WS_CSP_UP = WS_WPOOL + (size_t)4 * 256 * 256 * 2;
constexpr size_t WS_CBP_UP = WS_CSP_UP + (size_t)2 * 16 * FF2 * 4;
constexpr size_t WS_CSP_IN = WS_CBP_UP + (size_t)2 * 16 * FF2 * 4;
constexpr size_t WS_CBP_IN = WS_CSP_IN + (size_t)16 * 3072 * 4;
constexpr size_t WS_CS_UP = WS_CBP_IN + (size_t)16 * 3072 * 4;
constexpr size_t WS_CB_UP = WS_CS_UP + (size_t)2 * FF2 * 4;
constexpr size_t WS_KC_UP = WS_CB_UP + (size_t)2 * FF2 * 4;
constexpr size_t WS_CS_IN = WS_KC_UP + (size_t)2 * 4 * FF2 * 4;
constexpr size_t WS_CB_IN = WS_CS_IN + (size_t)3072 * 4;
constexpr size_t WS_PART = WS_CB_IN + (size_t)3072 * 4;
constexpr size_t PART_BYTES = (size_t)MROWS * 4 * 8;
constexpr size_t WS_HF = WS_PART + 3 * PART_BYTES;
constexpr size_t HALO_BYTES = (size_t)132 * 2 * FF2 * 4;
constexpr size_t WS_HL = WS_HF + HALO_BYTES;
constexpr size_t WS_H1 = WS_HL + HALO_BYTES;
constexpr size_t WS_ACT = WS_H1 + (size_t)MROWS * D * 2;
constexpr size_t WS_BAR = WS_ACT + (size_t)MROWS * FF * 2;
constexpr size_t WS_END = WS_BAR + 16384;
static_assert(WS_END <= (size_t)256 * 1024 * 1024, "workspace");
static_assert(WS_WDN % 256 == 0 && WS_WIN % 256 == 0 && WS_WOUT % 256 == 0 && WS_WPOOL % 256 == 0 && WS_PART % 256 == 0 && WS_HF % 256 == 0 && WS_H1 % 256 == 0 && WS_ACT % 256 == 0, "align");

constexpr int STAGE_BYTES = 131072;
constexpr int EPI_OFF = STAGE_BYTES;
constexpr int P1_T_OFF = 147456;
constexpr int BARST_OFF = 155648 - 64;
constexpr int LDS_BYTES = 155648;

struct Params {
    const float* in[19];
    float* out;
    unsigned char* ws;
};

__device__ __forceinline__ unsigned f2bf(float f) { unsigned u = __builtin_bit_cast(unsigned, f); return (u + 0x7fffu + ((u >> 16) & 1u)) >> 16; }
__device__ __forceinline__ float bf2f(unsigned b) { return __builtin_bit_cast(float, b << 16); }
__device__ __forceinline__ unsigned pk2(float lo, float hi) { return f2bf(lo) | (f2bf(hi) << 16); }
__device__ __forceinline__ float dpp_shr1(float v) {
    return __builtin_bit_cast(float, __builtin_amdgcn_update_dpp(0, __builtin_bit_cast(int, v), 0x111, 0xf, 0xf, true));
}
__device__ __forceinline__ float silu_mul(float g, float v) { return g * v * __builtin_amdgcn_rcpf(1.0f + __expf(-g)); }
__device__ __forceinline__ int tid_fresh() { int t = threadIdx.x; asm volatile("" : "+v"(t)); return t; }
__device__ __forceinline__ int row_of_tok(int tok) {
    const int pm = tok >> 8, tau = tok & 255;
    return pm * 256 + 128 * ((tau >> 2) & 1) + 64 * (tau >> 7) + 16 * (tau & 3) + ((tau >> 3) & 15);
}
__device__ __forceinline__ f32x2 row_stats(const f32x2* part, int R) {
    const f32x4 a = *(const f32x4*)(part + (size_t)R * 4), b = *(const f32x4*)(part + (size_t)R * 4 + 2);
    const float mean = ((a[0] + a[2]) + (b[0] + b[2])) * 0.25f;
    const float d0 = a[0] - mean, d1 = a[2] - mean, d2 = b[0] - mean, d3 = b[2] - mean;
    const float m2 = ((a[1] + a[3]) + (b[1] + b[3])) + 256.0f * ((d0 * d0 + d1 * d1) + (d2 * d2 + d3 * d3));
    f32x2 r; r.x = mean; r.y = __builtin_amdgcn_rsqf(m2 * (1.0f / 1024.0f) + LN_EPS); return r;
}
__device__ __forceinline__ void stats_to_lds(const f32x2* part, int pm, LAS f32x2* S) {
    int tx = threadIdx.x; asm volatile("" : "+v"(tx));
    if (tx < 256) { const f32x2 s = row_stats(part, pm * 256 + tx); f32x2 t; t.x = s.y; t.y = -s.x * s.y; S[tx] = t; }
    asm volatile("s_waitcnt lgkmcnt(0)" ::: "memory"); __builtin_amdgcn_s_barrier(); asm volatile("" ::: "memory");
}
#define KA __attribute__((address_space(4)))
__device__ __forceinline__ const KA Params* kargs() { const KA Params* p = (const KA Params*)__builtin_amdgcn_kernarg_segment_ptr(); asm volatile("" : "+s"(p)); return p; }

namespace pg8 {
constexpr int BM = 256, BK = 64, HALF = 128, HTB = HALF * BK * 2, NXCD = 8, WGM = 8;
__host__ __device__ __forceinline__ int lds_byte(int r, int c) { const int st = (r >> 4) * 2 + (c >> 5), rr = r & 15, cc = c & 31, ob = rr * 64 + cc * 2; return st * 1024 + (ob ^ (((ob >> 9) & 1) << 5)); }
__host__ __device__ __forceinline__ void stage_rc(int b, int& R, int& C) { const int st = b / 1024, sb = b % 1024, swz = sb ^ (((sb >> 9) & 1) << 5); R = (st >> 1) * 16 + swz / 64; C = (st & 1) * 32 + (swz % 64) / 2; }

struct Unit { int pm, pn; };
struct Gemm { const bf16_t* A; const bf16_t* Bt; int K; };

struct StaticOrder {
    int nM, nN, nwg, G, c;
    __device__ void init(int nM_, int nN_, int G_, int c_) { nM = nM_; nN = nN_; nwg = nM * nN; G = G_; c = c_; }
    __device__ bool next(int i, Unit& u) const {
        const long L = (long)i * G + c; if (L >= nwg) return false;
        int wgid = (int)L; { const int q = nwg / NXCD, r = nwg % NXCD, xcd = wgid % NXCD, off = wgid / NXCD; wgid = (xcd < r ? xcd * (q + 1) : r * (q + 1) + (xcd - r) * q) + off; }
        const int nig = WGM * nN, gid = wgid / nig, fm = gid * WGM, gsz = (nM - fm) < WGM ? (nM - fm) : WGM;
        u.pm = fm + ((wgid % nig) % gsz); u.pn = (wgid % nig) / gsz; return true;
    }
};

template <class Epi>
__device__ __forceinline__ void gemm_phase(LAS unsigned char* lds, const Gemm g, const StaticOrder& S, const Epi& E) {
    const int tid = tid_fresh(), wid = __builtin_amdgcn_readfirstlane(tid >> 6), lane = tid & 63, wr = wid >> 2, wc = wid & 3, fr = lane & 15, fq = lane >> 4;
    const int K = g.K, nt = K / BK;
    unsigned voffA[2];
#pragma unroll
    for (int i = 0; i < 2; ++i) { int R, C; stage_rc(tid * 16 + i * 8192, R, C); voffA[i] = (unsigned)(R * K + C) * 2u; }
    const size_t kstep = (size_t)(BK * 2);
    const size_t hstep = (size_t)HALF * K * 2;
    const size_t tstep = 2 * hstep;
    const unsigned ldsw = (unsigned)wid * 1024u;
    const int aoff = lds_byte(wr * 64 + fr, fq * 8), boff = lds_byte(wc * 32 + fr, fq * 8);
#define PG8_SA(b, h) (((b) * 2 + (h)) * HTB)
#define PG8_SB(b, h) ((4 + (b) * 2 + (h)) * HTB)
#define PG8_STAGE(bufoff, gbase) do { _Pragma("unroll") for (int _i = 0; _i < 2; ++_i) \
        __builtin_amdgcn_global_load_lds((const unsigned*)((const char*)(gbase) + voffA[_i]), (LAS unsigned*)(lds + (bufoff) + ldsw + _i * 8192), 16, 0, 0); } while (0)
#define PG8_LDA(dst, b, h) do { _Pragma("unroll") for (int m = 0; m < 4; ++m) _Pragma("unroll") for (int k = 0; k < 2; ++k) dst[m][k] = *(const LAS bf16x8*)(lds + PG8_SA(b, h) + aoff + m * 2048 + k * 1024); } while (0)
#define PG8_LDB(dst, b, h) do { _Pragma("unroll") for (int n = 0; n < 2; ++n) _Pragma("unroll") for (int k = 0; k < 2; ++k) dst[n][k] = *(const LAS bf16x8*)(lds + PG8_SB(b, h) + boff + n * 2048 + k * 1024); } while (0)
#define PG8_MMA(ai, bj, At, Bt) do { __builtin_amdgcn_s_setprio(1); _Pragma("unroll") for (int m = 0; m < 4; ++m) _Pragma("unroll") for (int n = 0; n < 2; ++n) _Pragma("unroll") for (int k = 0; k < 2; ++k) \
        acc[ai][bj][m][n] = __builtin_amdgcn_mfma_f32_16x16x32_bf16(Bt[n][k], At[m][k], acc[ai][bj][m][n], 0, 0, 0); __builtin_amdgcn_s_setprio(0); } while (0)
#define PG8_WAIT_V(n) asm volatile("s_waitcnt vmcnt(" #n ")" ::: "memory")
#define PG8_WAIT_L(n) asm volatile("s_waitcnt lgkmcnt(" #n ")" ::: "memory")
#define PG8_BAR __builtin_amdgcn_s_barrier()
#define PG8_SCHED __builtin_amdgcn_sched_barrier(0)
    Unit cur, nxt; int ui = 0;
    if (!S.next(0, cur)) return;
    f32x4 acc[2][2][4][2];
#pragma unroll
    for (int a = 0; a < 2; ++a)
#pragma unroll
        for (int b = 0; b < 2; ++b)
#pragma unroll
            for (int m = 0; m < 4; ++m)
#pragma unroll
                for (int n = 0; n < 2; ++n) acc[a][b][m][n] = (f32x4){0.f, 0.f, 0.f, 0.f};
    bf16x8 At[4][2], B0[2][2], B1[2][2];
    const char* cA = (const char*)g.A + (size_t)cur.pm * tstep; const char* cB = (const char*)g.Bt + (size_t)cur.pn * tstep;
    PG8_STAGE(PG8_SB(0, 0), cB); PG8_STAGE(PG8_SB(0, 1), cB + hstep); PG8_STAGE(PG8_SA(0, 0), cA); PG8_STAGE(PG8_SA(0, 1), cA + hstep);
    if (wr == 1) PG8_BAR;
    PG8_WAIT_V(2); PG8_BAR;
    PG8_STAGE(PG8_SB(1, 0), cB + kstep); PG8_STAGE(PG8_SA(1, 0), cA + kstep); PG8_STAGE(PG8_SB(1, 1), cB + hstep + kstep);
    PG8_WAIT_V(6); PG8_BAR;
    for (;;) {
        const bool has_next = S.next(ui + 1, nxt);
        const char* nA = has_next ? (const char*)g.A + (size_t)nxt.pm * tstep : cA; const char* nB = has_next ? (const char*)g.Bt + (size_t)nxt.pn * tstep : cB;
        for (int t = 0; t < nt; t += 2) {
            const bool last = (t == nt - 2);
            const char* a1 = cA + (size_t)(t + 1) * kstep;
            const char* a2 = last ? nA : cA + (size_t)(t + 2) * kstep; const char* b2 = last ? nB : cB + (size_t)(t + 2) * kstep;
            const char* a3 = a2 + kstep; const char* b3 = b2 + kstep;
            PG8_LDB(B0, 0, 0); PG8_LDB(B1, 0, 1); PG8_SCHED; PG8_LDA(At, 0, 0); PG8_STAGE(PG8_SA(1, 1), a1 + hstep);
            PG8_WAIT_V(8); PG8_WAIT_L(0); PG8_BAR; PG8_MMA(0, 0, At, B0); PG8_MMA(0, 1, At, B1); PG8_BAR; PG8_SCHED;
            PG8_LDA(At, 0, 1); PG8_STAGE(PG8_SB(0, 0), b2); PG8_STAGE(PG8_SB(0, 1), b2 + hstep); PG8_STAGE(PG8_SA(0, 0), a2);
            PG8_WAIT_V(8); PG8_WAIT_L(0); PG8_BAR; PG8_MMA(1, 0, At, B0); PG8_MMA(1, 1, At, B1); PG8_BAR; PG8_SCHED;
            PG8_LDB(B0, 1, 0); PG8_LDB(B1, 1, 1); PG8_SCHED; PG8_LDA(At, 1, 0); PG8_STAGE(PG8_SA(0, 1), a2 + hstep);
            PG8_WAIT_V(8); PG8_WAIT_L(0); PG8_BAR; PG8_MMA(0, 0, At, B0); PG8_MMA(0, 1, At, B1); PG8_BAR; PG8_SCHED;
            PG8_LDA(At, 1, 1); PG8_STAGE(PG8_SB(1, 0), b3); PG8_STAGE(PG8_SB(1, 1), b3 + hstep); PG8_STAGE(PG8_SA(1, 0), a3);
            PG8_WAIT_V(8); PG8_WAIT_L(0); PG8_BAR; PG8_MMA(1, 0, At, B0); PG8_MMA(1, 1, At, B1); PG8_BAR; PG8_SCHED;
        }
        if (wr == 0) PG8_BAR;
        { int fr_e = fr, fq_e = fq; asm volatile("" : "+v"(fr_e), "+v"(fq_e));
          E(acc, cur, wr, wc, fr_e, fq_e, lds + EPI_OFF); }
        if (!has_next) break;
#pragma unroll
        for (int a = 0; a < 2; ++a)
#pragma unroll
            for (int b = 0; b < 2; ++b)
#pragma unroll
                for (int m = 0; m < 4; ++m)
#pragma unroll
                    for (int n = 0; n < 2; ++n) acc[a][b][m][n] = (f32x4){0.f, 0.f, 0.f, 0.f};
        cur = nxt; cA = nA; cB = nB; ++ui;
        if (wr == 1) PG8_BAR;
    }
    PG8_WAIT_V(0);
    PG8_BAR;
#undef PG8_SA
#undef PG8_SB
#undef PG8_STAGE
#undef PG8_LDA
#undef PG8_LDB
#undef PG8_MMA
#undef PG8_WAIT_V
#undef PG8_WAIT_L
#undef PG8_BAR
#undef PG8_SCHED
}
}

template <int BJ> __device__ __forceinline__ void pin_half(f32x4 (&acc)[2][2][4][2]) {
#pragma unroll
    for (int ai = 0; ai < 2; ++ai)
        asm volatile("" : "+v"(acc[ai][BJ][0][0]), "+v"(acc[ai][BJ][0][1]), "+v"(acc[ai][BJ][1][0]), "+v"(acc[ai][BJ][1][1]), "+v"(acc[ai][BJ][2][0]), "+v"(acc[ai][BJ][2][1]), "+v"(acc[ai][BJ][3][0]), "+v"(acc[ai][BJ][3][1]) :: "memory");
}
template <int BJ, int N> __device__ __forceinline__ void pin_group(f32x4 (&acc)[2][2][4][2]) {
    asm volatile("" : "+v"(acc[0][BJ][0][N]), "+v"(acc[0][BJ][1][N]), "+v"(acc[0][BJ][2][N]), "+v"(acc[0][BJ][3][N]), "+v"(acc[1][BJ][0][N]), "+v"(acc[1][BJ][1][N]), "+v"(acc[1][BJ][2][N]), "+v"(acc[1][BJ][3][N]) :: "memory");
}
template <int N> __device__ __forceinline__ void pin_n(f32x4 (&acc)[2][2][4][2]) {
#pragma unroll
    for (int ai = 0; ai < 2; ++ai)
        asm volatile("" : "+v"(acc[ai][0][0][N]), "+v"(acc[ai][0][1][N]), "+v"(acc[ai][0][2][N]), "+v"(acc[ai][0][3][N]), "+v"(acc[ai][1][0][N]), "+v"(acc[ai][1][1][N]), "+v"(acc[ai][1][2][N]), "+v"(acc[ai][1][3][N]) :: "memory");
}
template <int BJ, int N, int J0, int LEN>
__device__ __forceinline__ void conv_chain(f32x4 (&acc)[2][2][4][2], const f32x4 k0, const f32x4 k1, const f32x4 k2, const f32x4 kb, const f32x4 p1, const f32x4 p2) {
#pragma unroll
    for (int i = LEN - 1; i >= 0; --i) {
        const int j = J0 + i;
        const f32x4 h0 = acc[j >> 2][BJ][j & 3][N];
        const f32x4 h1 = i >= 1 ? acc[(j - 1) >> 2][BJ][(j - 1) & 3][N] : p1;
        const f32x4 h2 = i >= 2 ? acc[(j - 2) >> 2][BJ][(j - 2) & 3][N] : (i == 1 ? p1 : p2);
        acc[j >> 2][BJ][j & 3][N] = k2 * h0 + k1 * h1 + k0 * h2 + kb;
    }
}
struct EpiUp {
    int l;
    template <int N>
    __device__ __forceinline__ void half(f32x4 (&acc)[2][2][4][2], int pm, int pn, int wr, int wc, int fr, int fq) const {
        asm volatile("" : "+v"(fr), "+v"(fq));
        const KA Params* q = kargs(); unsigned char* ws = q->ws;
        const bool sample = pm >= NPANEL_P;
        const int chunk = 2 * pm + wr;
        const int ucol = 256 * pn + 32 * wc + 16 * N;
        const int ufcol = 128 * pn + 32 * wc + 16 * N;
        const char* kcb = (const char*)((const float*)(ws + WS_KC_UP) + (size_t)l * 4 * FF2 + ucol);
        const unsigned lq = (unsigned)(16 * fq);
#define KC4(tap, vhalf) (*(const f32x4*)(kcb + lq + (unsigned)(((tap) * FF2 + (vhalf) * 128) * 4)))
        if (!sample) {
            f32x4 g2, g1;
#pragma unroll
            for (int e = 0; e < 4; ++e) { g2[e] = dpp_shr1(acc[1][0][2][N][e]); g1[e] = dpp_shr1(acc[1][0][3][N][e]); }
            if (fr == 0) {
                char* hf = (char*)((float*)(ws + WS_HF) + (size_t)chunk * 2 * FF2 + ucol) + lq;
                *(f32x4*)(hf) = acc[0][0][0][N]; *(f32x4*)(hf + FF2 * 4) = acc[0][0][1][N];
                *(f32x4*)(hf + 128 * 4) = acc[0][1][0][N]; *(f32x4*)(hf + (FF2 + 128) * 4) = acc[0][1][1][N];
            }
            if (fr == 15) {
                char* hl = (char*)((float*)(ws + WS_HL) + (size_t)chunk * 2 * FF2 + ucol) + lq;
                *(f32x4*)(hl) = acc[1][0][2][N]; *(f32x4*)(hl + FF2 * 4) = acc[1][0][3][N];
                *(f32x4*)(hl + 128 * 4) = acc[1][1][2][N]; *(f32x4*)(hl + (FF2 + 128) * 4) = acc[1][1][3][N];
                if ((pm & 7) == 7 && wr == 1) {
                    char* o = (char*)(q->out + O_FFN_P + ((size_t)l * NB_P + (pm >> 3)) * 2 * FF2 + ufcol) + lq;
                    *(f32x4*)(o) = acc[1][0][2][N]; *(f32x4*)(o + FF2 * 4) = acc[1][0][3][N];
                    *(f32x4*)(o + FF * 4) = acc[1][1][2][N]; *(f32x4*)(o + (FF2 + FF) * 4) = acc[1][1][3][N];
                }
            }
            pin_n<N>(acc);
            { const f32x4 k0 = KC4(0, 0), k1 = KC4(1, 0), k2 = KC4(2, 0), kb = KC4(3, 0); conv_chain<0, N, 0, 8>(acc, k0, k1, k2, kb, g1, g2); }
            pin_n<N>(acc);
            { f32x4 v2, v1;
#pragma unroll
              for (int e = 0; e < 4; ++e) { v2[e] = dpp_shr1(acc[1][1][2][N][e]); v1[e] = dpp_shr1(acc[1][1][3][N][e]); }
              const f32x4 k0 = KC4(0, 1), k1 = KC4(1, 1), k2 = KC4(2, 1), kb = KC4(3, 1); conv_chain<1, N, 0, 8>(acc, k0, k1, k2, kb, v1, v2); }
        } else {
            const int useq0 = 64 * (pm - NPANEL_P) + 32 * wr;
            const unsigned ls = (unsigned)(2 * fr * 2 * FF2 * 4) + lq;
            char* ob = (char*)(q->out + O_FFN_S + ((size_t)l * NB_S + useq0) * 2 * FF2 + ufcol);
#pragma unroll
            for (int ai = 0; ai < 2; ++ai) { char* o = ob + ls + (unsigned)(ai * 2 * FF2 * 4);
                *(f32x4*)(o) = acc[ai][0][2][N]; *(f32x4*)(o + FF2 * 4) = acc[ai][0][3][N];
                *(f32x4*)(o + FF * 4) = acc[ai][1][2][N]; *(f32x4*)(o + (FF2 + FF) * 4) = acc[ai][1][3][N]; }
            pin_n<N>(acc);
            const char* sb = (const char*)(q->in[4] + ((size_t)l * NB_S + useq0) * 2 * FF2 + ufcol);
            { const f32x4 k0 = KC4(0, 0), k1 = KC4(1, 0), k2 = KC4(2, 0), kb = KC4(3, 0);
              conv_chain<0, N, 0, 4>(acc, k0, k1, k2, kb, *(const f32x4*)(sb + ls + FF2 * 4), *(const f32x4*)(sb + ls));
              conv_chain<0, N, 4, 4>(acc, k0, k1, k2, kb, *(const f32x4*)(sb + ls + 3 * FF2 * 4), *(const f32x4*)(sb + ls + 2 * FF2 * 4)); }
            pin_n<N>(acc);
            { const f32x4 k0 = KC4(0, 1), k1 = KC4(1, 1), k2 = KC4(2, 1), kb = KC4(3, 1);
              conv_chain<1, N, 0, 4>(acc, k0, k1, k2, kb, *(const f32x4*)(sb + ls + (FF2 + FF) * 4), *(const f32x4*)(sb + ls + FF * 4));
              conv_chain<1, N, 4, 4>(acc, k0, k1, k2, kb, *(const f32x4*)(sb + ls + (3 * FF2 + FF) * 4), *(const f32x4*)(sb + ls + (2 * FF2 + FF) * 4)); }
        }
#undef KC4
        pin_n<N>(acc);
        char* ab = (char*)((bf16_t*)(ws + WS_ACT) + (size_t)(pm * 256 + 64 * wr) * FF + ufcol);
        const unsigned la = (unsigned)((fr * FF + 4 * fq) * 2);
#pragma unroll
        for (int j = 0; j < 8; ++j) {
            const f32x4 zg = acc[j >> 2][0][j & 3][N], zv = acc[j >> 2][1][j & 3][N];
            u32x2 w; w.x = pk2(silu_mul(zg[0], zv[0]), silu_mul(zg[1], zv[1])); w.y = pk2(silu_mul(zg[2], zv[2]), silu_mul(zg[3], zv[3]));
            *(u32x2*)(ab + la + (unsigned)((128 * (j >> 2) + 16 * (j & 3)) * FF * 2)) = w;
        }
        asm volatile("" ::: "memory");
    }
    __device__ __forceinline__ void operator()(f32x4 (&acc)[2][2][4][2], const pg8::Unit& u, int wr, int wc, int fr, int fq, LAS unsigned char* elds) const {
        const int pm = u.pm, pn = u.pn;
        LAS f32x2* S = (LAS f32x2*)(elds + 8192);
        { const KA Params* q = kargs(); unsigned char* ws = q->ws;
          stats_to_lds((const f32x2*)(ws + WS_PART) + (size_t)(l == 0 ? 0 : 2) * MROWS * 4, pm, S);
          const char* csb = (const char*)((const float*)(ws + WS_CS_UP) + l * FF2 + 256 * pn + 32 * wc); const char* cbb = (const char*)((const float*)(ws + WS_CB_UP) + l * FF2 + 256 * pn + 32 * wc);
          const unsigned lq = (unsigned)(16 * fq);
          f32x2 st[8];
#pragma unroll
          for (int j = 0; j < 8; ++j) st[j] = S[128 * (j >> 2) + 64 * wr + 16 * (j & 3) + fr];
#pragma unroll
          for (int bj = 0; bj < 2; ++bj)
#pragma unroll
              for (int n = 0; n < 2; ++n) { const f32x4 csv = *(const f32x4*)(csb + lq + (unsigned)((128 * bj + 16 * n) * 4)), cbv = *(const f32x4*)(cbb + lq + (unsigned)((128 * bj + 16 * n) * 4));
#pragma unroll
                  for (int j = 0; j < 8; ++j) acc[j >> 2][bj][j & 3][n] = acc[j >> 2][bj][j & 3][n] * st[j].x + (csv * st[j].y + cbv);
                  asm volatile("" ::: "memory"); }
        }
        pin_half<0>(acc); pin_half<1>(acc);
        half<0>(acc, pm, pn, wr, wc, fr, fq);
        half<1>(acc, pm, pn, wr, wc, fr, fq);
    }
};

template <bool FINAL> struct EpiRes {
    int pprev, pnew, gi, goff;
    template <int BJ>
    __device__ __forceinline__ void resid(f32x4 (&acc)[2][2][4][2], int pm, int pn, int wr, int wc, int fr, int fq, LAS f32x2* S) const {
        asm volatile("" : "+v"(fr), "+v"(fq));
        const KA Params* q = kargs();
        const int ucol = 256 * pn + 128 * BJ + 32 * wc;
        const char* vb = (const char*)((const bf16_t*)(q->ws + WS_H1) + (size_t)(pm * 256 + 64 * wr) * D + ucol);
        const unsigned lv = (unsigned)((fr * D + 4 * fq) * 2), lq = (unsigned)(16 * fq);
        const char* gb = (const char*)(q->in[gi] + goff + ucol); const char* bb = (const char*)(q->in[gi + 1] + goff + ucol);
        u32x2 vp[8][2];
#pragma unroll
        for (int j = 0; j < 8; ++j)
#pragma unroll
            for (int n = 0; n < 2; ++n) vp[j][n] = *(const u32x2*)(vb + lv + (unsigned)(((128 * (j >> 2) + 16 * (j & 3)) * D + 16 * n) * 2));
        f32x4 gv[2], bv[2];
#pragma unroll
        for (int n = 0; n < 2; ++n) { gv[n] = *(const f32x4*)(gb + lq + (unsigned)(64 * n)) * ALPHA; bv[n] = *(const f32x4*)(bb + lq + (unsigned)(64 * n)) * ALPHA; }
        const LAS f32x2* Sl = S + 64 * wr + fr;
#pragma unroll
        for (int j = 0; j < 8; ++j) { const f32x2 s = Sl[128 * (j >> 2) + 16 * (j & 3)];
#pragma unroll
            for (int n = 0; n < 2; ++n) { f32x4 v; v[0] = bf2f(vp[j][n].x & 0xffffu); v[1] = bf2f(vp[j][n].x >> 16); v[2] = bf2f(vp[j][n].y & 0xffffu); v[3] = bf2f(vp[j][n].y >> 16);
                acc[j >> 2][BJ][j & 3][n] = (v * s.x + s.y) * gv[n] + bv[n] + acc[j >> 2][BJ][j & 3][n]; } }
        pin_half<BJ>(acc);
    }
    __device__ __forceinline__ void operator()(f32x4 (&acc)[2][2][4][2], const pg8::Unit& u, int wr, int wc, int fr, int fq, LAS unsigned char* elds) const {
        const int pm = u.pm, pn = u.pn;
        LAS f32x2* P = (LAS f32x2*)elds;
        LAS f32x2* S = (LAS f32x2*)(elds + 8192);
        stats_to_lds((const f32x2*)(kargs()->ws + WS_PART) + (size_t)pprev * MROWS * 4, pm, S);
        resid<0>(acc, pm, pn, wr, wc, fr, fq, S);
        resid<1>(acc, pm, pn, wr, wc, fr, fq, S);
        asm volatile("" : "+v"(fr), "+v"(fq));
        const KA Params* q = kargs();
        char* ob; unsigned lo;
        if (FINAL) { ob = (char*)(q->out + O_Y + (size_t)(pm * 256 + 128 * wr) * D + 256 * pn + 32 * wc); lo = (unsigned)((8 * fr * D + 4 * fq) * 4); }
        else { ob = (char*)((bf16_t*)(q->ws + WS_H1) + (size_t)(pm * 256 + 64 * wr) * D + 256 * pn + 32 * wc); lo = (unsigned)((fr * D + 4 * fq) * 2); }
        LAS f32x2* Pl = P + (64 * wr + fr) * 4 + wc;
#pragma unroll
        for (int j = 0; j < 8; ++j) {
            const int ai = j >> 2, m = j & 3;
            float sum = 0.f;
#pragma unroll
            for (int bj = 0; bj < 2; ++bj)
#pragma unroll
                for (int n = 0; n < 2; ++n) { const f32x4 vn = acc[ai][bj][m][n]; sum += (vn[0] + vn[1]) + (vn[2] + vn[3]); }
            sum += __shfl_xor(sum, 16); sum += __shfl_xor(sum, 32);
            const float mw = sum * (1.0f / 64.0f); float qq = 0.f;
#pragma unroll
            for (int bj = 0; bj < 2; ++bj)
#pragma unroll
                for (int n = 0; n < 2; ++n) { const f32x4 d = acc[ai][bj][m][n] - mw; qq += (d[0] * d[0] + d[1] * d[1]) + (d[2] * d[2] + d[3] * d[3]); }
            qq += __shfl_xor(qq, 16); qq += __shfl_xor(qq, 32);
            if (fq == 0) { f32x2 t; t.x = mw; t.y = qq; Pl[(128 * ai + 16 * m) * 4] = t; }
#pragma unroll
            for (int bj = 0; bj < 2; ++bj)
#pragma unroll
                for (int n = 0; n < 2; ++n) { const f32x4 vn = acc[ai][bj][m][n];
                    if (FINAL) *(f32x4*)(ob + lo + (unsigned)(((4 * ai + m) * D + 128 * bj + 16 * n) * 4)) = vn;
                    else { u32x2 w; w.x = pk2(vn[0], vn[1]); w.y = pk2(vn[2], vn[3]); *(u32x2*)(ob + lo + (unsigned)(((128 * ai + 16 * m) * D + 128 * bj + 16 * n) * 2)) = w; } }
        }
        asm volatile("s_waitcnt lgkmcnt(0)" ::: "memory"); __builtin_amdgcn_s_barrier(); asm volatile("" ::: "memory");
        int rl = threadIdx.x; asm volatile("" : "+v"(rl));
        if (rl < 256) {
            const f32x2 a = P[rl * 4 + 0], b2 = P[rl * 4 + 1], c2 = P[rl * 4 + 2], d2 = P[rl * 4 + 3];
            const float mt = (a.x + b2.x + c2.x + d2.x) * 0.25f;
            const float da = a.x - mt, db = b2.x - mt, dc = c2.x - mt, dd = d2.x - mt;
            f32x2 r; r.x = mt; r.y = (a.y + b2.y) + (c2.y + d2.y) + 64.0f * ((da * da + db * db) + (dc * dc + dd * dd));
            char* pb = (char*)((f32x2*)(q->ws + WS_PART) + (size_t)pnew * MROWS * 4 + (size_t)pm * 256 * 4 + pn);
            *(f32x2*)(pb + (unsigned)(rl * 32)) = r;
        }
    }
};

struct EpiIn {
    int dummy;
    __device__ __forceinline__ void operator()(f32x4 (&acc)[2][2][4][2], const pg8::Unit& u, int wr, int wc, int fr, int fq, LAS unsigned char* elds) const {
        const int pm = u.pm, pn = u.pn; const bool sample = pm >= NPANEL_P;
        LAS f32x2* S = (LAS f32x2*)(elds + 8192);
        const KA Params* q = kargs(); unsigned char* ws = q->ws;
        stats_to_lds((const f32x2*)(ws + WS_PART) + (size_t)1 * MROWS * 4, pm, S);
        const unsigned lq = (unsigned)(16 * fq);
        { const char* csb = (const char*)((const float*)(ws + WS_CS_IN) + 256 * pn + 32 * wc); const char* cbb = (const char*)((const float*)(ws + WS_CB_IN) + 256 * pn + 32 * wc);
          f32x2 st[8];
#pragma unroll
          for (int j = 0; j < 8; ++j) st[j] = S[128 * (j >> 2) + 64 * wr + 16 * (j & 3) + fr];
#pragma unroll
          for (int bj = 0; bj < 2; ++bj)
#pragma unroll
              for (int n = 0; n < 2; ++n) { const f32x4 csv = *(const f32x4*)(csb + lq + (unsigned)((128 * bj + 16 * n) * 4)), cbv = *(const f32x4*)(cbb + lq + (unsigned)((128 * bj + 16 * n) * 4));
#pragma unroll
                  for (int j = 0; j < 8; ++j) acc[j >> 2][bj][j & 3][n] = acc[j >> 2][bj][j & 3][n] * st[j].x + (csv * st[j].y + cbv);
                  asm volatile("" ::: "memory"); } }
        pin_half<0>(acc); pin_half<1>(acc);
        asm volatile("" : "+v"(fr), "+v"(fq));
        const unsigned lr = (unsigned)((fr * D + 4 * fq) * 2);
        if (pn < 8) {
            char* ub = (char*)((bf16_t*)(ws + WS_ACT) + (size_t)(pm * 256 + 64 * wr) * D + 128 * pn + 32 * wc);
#pragma unroll
            for (int n = 0; n < 2; ++n) {
#pragma unroll
                for (int j = 0; j < 8; ++j) { const int ai = j >> 2, m = j & 3; const f32x4 uu = acc[ai][0][m][n] * acc[ai][1][m][n];
                    u32x2 w; w.x = pk2(uu[0], uu[1]); w.y = pk2(uu[2], uu[3]); *(u32x2*)(ub + lr + (unsigned)(((128 * ai + 16 * m) * D + 16 * n) * 2)) = w;
                    if (sample) { if (m >= 2) { const int seq = 64 * (pm - NPANEL_P) + 32 * wr + 2 * fr + ai; *(f32x4*)(q->out + O_CONV_S + ((size_t)seq * 2 + (m - 2)) * D + 128 * pn + 32 * wc + 16 * n + 4 * fq) = uu; } }
                    else if ((pm & 7) == 7 && wr == 1 && fr == 15 && j >= 6) { *(f32x4*)(q->out + O_CONV_P + ((size_t)(pm >> 3) * 2 + (j - 6)) * D + 128 * pn + 32 * wc + 16 * n + 4 * fq) = uu; } } }
        } else {
            char* bb = (char*)((bf16_t*)(ws + WS_ACT) + (size_t)MROWS * D + (size_t)(pm * 256 + 64 * wr) * D + 256 * (pn - 8) + 32 * wc);
#pragma unroll
            for (int bj = 0; bj < 2; ++bj)
#pragma unroll
                for (int n = 0; n < 2; ++n) {
#pragma unroll
                    for (int j = 0; j < 8; ++j) { const int ai = j >> 2, m = j & 3; const f32x4 v = acc[ai][bj][m][n];
                        u32x2 w; w.x = pk2(v[0], v[1]); w.y = pk2(v[2], v[3]); *(u32x2*)(bb + lr + (unsigned)(((128 * ai + 16 * m) * D + 128 * bj + 16 * n) * 2)) = w; } }
        }
    }
};

__device__ __forceinline__ void p0_item(const float* W, int K, int N, int kb, int nb, bf16_t* WT, int dest_row0, const float* rowscale, const float* colscale,
                                        float* csp, const float* bvec, float* cbp, int pstride, LAS float* scr, int lane) {
    const int k0 = 64 * kb, n0 = 32 * nb;
#pragma unroll 8
    for (int i = 0; i < 32; ++i) { const int kk = 2 * i + (lane >> 5); scr[kk * 33 + (lane & 31)] = W[(size_t)(k0 + kk) * N + n0 + (lane & 31)]; }
    asm volatile("s_waitcnt lgkmcnt(0)" ::: "memory");
    const int c = lane & 7;
    float rs[8], bb[8];
#pragma unroll
    for (int i = 0; i < 8; ++i) { rs[i] = rowscale ? rowscale[k0 + 8 * c + i] : 1.0f; bb[i] = bvec ? bvec[k0 + 8 * c + i] : 0.0f; }
#pragma unroll
    for (int j = 0; j < 4; ++j) { const int n = (lane >> 3) + 8 * j; const LAS float* s = scr + (8 * c) * 33 + n;
        const float sc = colscale ? colscale[n0 + n] : 1.0f;
        unsigned r[8]; float ps = 0.f, pb = 0.f;
#pragma unroll
        for (int i = 0; i < 8; ++i) { const float w = s[i * 33]; r[i] = f2bf(w * rs[i] * sc); ps += bf2f(r[i]); pb += w * bb[i]; }
        u32x4 o; o.x = r[0] | (r[1] << 16); o.y = r[2] | (r[3] << 16); o.z = r[4] | (r[5] << 16); o.w = r[6] | (r[7] << 16);
        *(u32x4*)(WT + (size_t)(dest_row0 + n) * K + k0 + 8 * c) = o;
        if (csp) {
            ps += __shfl_xor(ps, 1); ps += __shfl_xor(ps, 2); ps += __shfl_xor(ps, 4);
            pb += __shfl_xor(pb, 1); pb += __shfl_xor(pb, 2); pb += __shfl_xor(pb, 4);
            if (c == 0) { csp[(size_t)kb * pstride + dest_row0 + n] = ps; cbp[(size_t)kb * pstride + dest_row0 + n] = pb; }
        }
    }
    asm volatile("s_waitcnt lgkmcnt(0)" ::: "memory");
}
__device__ __forceinline__ int up_dest(int n) { return n < FF ? 256 * (n >> 7) + (n & 127) : 256 * ((n - FF) >> 7) + 128 + ((n - FF) & 127); }
__device__ __forceinline__ int in_dest(int n) { return n < D ? 2048 + n : (n < 2 * D ? 256 * ((n - D) >> 7) + ((n - D) & 127) : 256 * ((n - 2 * D) >> 7) + 128 + ((n - 2 * D) & 127)); }

__device__ __forceinline__ void phase0(LAS unsigned char* lds) {
    const KA Params* q = kargs();
    const int tid = tid_fresh(), lane = tid & 63, wave = tid >> 6;
    LAS float* scr = (LAS float*)(lds + wave * 8704);
    const int gw = blockIdx.x * 8 + wave, NGW = gridDim.x * 8;
    unsigned char* ws = q->ws;
    constexpr int I_UP = 16 * 176, I_IN = 16 * 96, I_OUT = 16 * 32, I_DN = 44 * 32, I_POOL = 4 * 8;
    constexpr int NITEMS = 2 * I_UP + I_IN + I_OUT + 2 * I_DN + 4 * I_POOL;
    for (int it = gw; it < NITEMS; it += NGW) {
        int r = it;
        if (r < 2 * I_UP) { const int l = r / I_UP; r -= l * I_UP; const int kb = r / 176, nb = r % 176;
            p0_item(q->in[13] + (size_t)l * D * FF2, D, FF2, kb, nb, (bf16_t*)(ws + WS_WUP) + (size_t)l * FF2 * D, up_dest(32 * nb), q->in[5] + l * D, nullptr,
                    (float*)(ws + WS_CSP_UP) + (size_t)l * 16 * FF2, q->in[6] + l * D, (float*)(ws + WS_CBP_UP) + (size_t)l * 16 * FF2, FF2, scr, lane); continue; }
        r -= 2 * I_UP;
        if (r < I_IN) { const int kb = r / 96, nb = r % 96;
            p0_item(q->in[9], D, 3 * D, kb, nb, (bf16_t*)(ws + WS_WIN), in_dest(32 * nb), q->in[17], nullptr, (float*)(ws + WS_CSP_IN), q->in[18], (float*)(ws + WS_CBP_IN), 3 * D, scr, lane); continue; }
        r -= I_IN;
        if (r < I_OUT) { const int kb = r / 32, nb = r % 32;
            p0_item(q->in[12], D, D, kb, nb, (bf16_t*)(ws + WS_WOUT), 32 * nb, nullptr, nullptr, nullptr, nullptr, nullptr, 0, scr, lane); continue; }
        r -= I_OUT;
        if (r < 2 * I_DN) { const int l = r / I_DN; r -= l * I_DN; const int kb = r / 32, nb = r % 32;
            p0_item(q->in[16] + (size_t)l * FF * D, FF, D, kb, nb, (bf16_t*)(ws + WS_WDN) + (size_t)l * D * FF, 32 * nb, nullptr, nullptr, nullptr, nullptr, nullptr, 0, scr, lane); continue; }
        r -= 2 * I_DN;
        { const int g = r / I_POOL; r -= g * I_POOL; const int kb = r / 8, nb = r % 8;
            p0_item(q->in[7] + (size_t)g * 256 * 256, 256, 256, kb, nb, (bf16_t*)(ws + WS_WPOOL) + (size_t)g * 256 * 256, 32 * nb, nullptr, q->in[8] + g * 256, nullptr, nullptr, nullptr, 0, scr, lane); }
    }
    const int gt = blockIdx.x * 512 + tid, NGT = gridDim.x * 512;
    for (int i = gt; i < 2 * FF2; i += NGT) { const int l = i / FF2, n = i % FF2, d = up_dest(n); float* kc = (float*)(ws + WS_KC_UP) + (size_t)l * 4 * FF2;
        kc[d] = q->in[14][(size_t)(l * 3 + 0) * FF2 + n]; kc[FF2 + d] = q->in[14][(size_t)(l * 3 + 1) * FF2 + n]; kc[2 * FF2 + d] = q->in[14][(size_t)(l * 3 + 2) * FF2 + n]; kc[3 * FF2 + d] = q->in[15][(size_t)l * FF2 + n]; }
    for (int i = gt; i < NB_P * 15 * (D / 4); i += NGT) { const int c4 = i % (D / 4), rr = (i / (D / 4)) % 15, b = i / (15 * (D / 4));
        ((f32x4*)(q->out + O_POOL_P))[i] = *(const f32x4*)(q->in[0] + ((size_t)b * SEQ + 2033 + rr) * D + c4 * 4); }
    for (int i = gt; i < NB_S * 15 * (D / 4); i += NGT) { const int c4 = i % (D / 4), rr = (i / (D / 4)) % 15, s = i / (15 * (D / 4));
        ((f32x4*)(q->out + O_POOL_S))[i] = rr < 11 ? *(const f32x4*)(q->in[2] + ((size_t)s * 15 + 4 + rr) * D + c4 * 4) : *(const f32x4*)(q->in[1] + ((size_t)s * TS + rr - 11) * D + c4 * 4); }
}

template <int W>
__device__ __forceinline__ void p1_window_prompt(const float* xseq, int tpos0, LAS unsigned char* lds, int row0, int cq) {
    f32x4 a[16 + W];
#pragma unroll
    for (int k = 0; k < 16 + W; ++k) { const int t = tpos0 - W + k, tc = t < 0 ? 0 : t; const f32x4 v = *(const f32x4*)(xseq + (size_t)tc * D); a[k] = t >= 0 ? v : (f32x4){0.f, 0.f, 0.f, 0.f}; }
    f32x4 s = {0.f, 0.f, 0.f, 0.f};
#pragma unroll
    for (int k = 0; k < W; ++k) s += a[k];
#pragma unroll
    for (int j = 0; j < 16; ++j) { s += a[W + j] - a[j]; const int t = tpos0 + j; const float inv = 1.0f / (float)(t + 1 < W ? t + 1 : W); const f32x4 d = s * inv - a[W + j];
        const int row = row0 + j; u32x2 w; w.x = pk2(d[0], d[1]); w.y = pk2(d[2], d[3]);
        *(LAS u32x2*)(lds + row * 2048 + ((((cq >> 1) ^ (row & 15))) << 4) + (cq & 1) * 8) = w; }
}
template <int W>
__device__ __forceinline__ void p1_window_sample(const float* hist, const float* xs, LAS unsigned char* lds, int row0, int cq) {
    f32x4 a[W + 4];
#pragma unroll
    for (int k = 0; k < W; ++k) { const int i = W - k; a[k] = i <= 15 ? *(const f32x4*)(hist + (size_t)(15 - i) * D) : (f32x4){0.f, 0.f, 0.f, 0.f}; }
#pragma unroll
    for (int t = 0; t < 4; ++t) a[W + t] = *(const f32x4*)(xs + (size_t)t * D);
    f32x4 s = {0.f, 0.f, 0.f, 0.f};
#pragma unroll
    for (int k = 0; k < W; ++k) s += a[k];
#pragma unroll
    for (int t = 0; t < 4; ++t) { s += a[W + t] - a[t]; const f32x4 d = s * (1.0f / (float)W) - a[W + t];
        const int row = row0 + t; u32x2 w; w.x = pk2(d[0], d[1]); w.y = pk2(d[2], d[3]);
        *(LAS u32x2*)(lds + row * 2048 + ((((cq >> 1) ^ (row & 15))) << 4) + (cq & 1) * 8) = w; }
}
__device__ __forceinline__ void phase1(LAS unsigned char* lds) {
    const KA Params* q = kargs();
    const int tid = tid_fresh(), lane = tid & 63, wave = __builtin_amdgcn_readfirstlane(tid >> 6), fr = lane & 15, fq = lane >> 4;
    unsigned char* ws = q->ws;
    { const int gt = blockIdx.x * 512 + tid, NGT = gridDim.x * 512;
      for (int i = gt; i < 2 * FF2 + 3 * D; i += NGT) {
          float s = 0.f, b = 0.f;
          if (i < 2 * FF2) { const int l = i / FF2, c = i % FF2; const float* sp = (const float*)(ws + WS_CSP_UP) + (size_t)l * 16 * FF2 + c; const float* bp = (const float*)(ws + WS_CBP_UP) + (size_t)l * 16 * FF2 + c;
              for (int k = 0; k < 16; ++k) { s += sp[(size_t)k * FF2]; b += bp[(size_t)k * FF2]; }
              ((float*)(ws + WS_CS_UP))[i] = s; ((float*)(ws + WS_CB_UP))[i] = b; }
          else { const int c = i - 2 * FF2; const float* sp = (const float*)(ws + WS_CSP_IN) + c; const float* bp = (const float*)(ws + WS_CBP_IN) + c;
              for (int k = 0; k < 16; ++k) { s += sp[(size_t)k * 3 * D]; b += bp[(size_t)k * 3 * D]; }
              ((float*)(ws + WS_CS_IN))[c] = s; ((float*)(ws + WS_CB_IN))[c] = b; } } }
    const bf16_t* wpool = (const bf16_t*)(ws + WS_WPOOL);
    bf16_t* vbf = (bf16_t*)(ws + WS_H1);
    f32x2* part = (f32x2*)(ws + WS_PART);
    LAS f32x2* T = (LAS f32x2*)(lds + P1_T_OFF);
    const int cq = tid & 255, th = __builtin_amdgcn_readfirstlane(tid >> 8), gw = (wave & 3);
    const int g = wave >> 1, hh = wave & 1;
    for (int tile = blockIdx.x; tile < NTOK_P / 64; tile += gridDim.x) {
        const int tok0 = tile * 64, t0 = tok0 & (SEQ - 1);
        const bool host = (tile & 3) == 0; const int seq0 = 2 * (tile >> 2);
        { const float* xseq = q->in[0] + (size_t)(tok0 - t0) * D + 4 * cq;
#pragma unroll 1
          for (int st = 0; st < 2; ++st) { const int r0 = 32 * th + 16 * st;
              if (gw == 0) p1_window_prompt<2>(xseq, t0 + r0, lds, r0, cq); else if (gw == 1) p1_window_prompt<4>(xseq, t0 + r0, lds, r0, cq);
              else if (gw == 2) p1_window_prompt<8>(xseq, t0 + r0, lds, r0, cq); else p1_window_prompt<16>(xseq, t0 + r0, lds, r0, cq); }
          if (host) { const float* hist = q->in[2] + (size_t)(seq0 + th) * 15 * D + 4 * cq; const float* xs = q->in[1] + (size_t)(seq0 + th) * TS * D + 4 * cq;
              if (gw == 0) p1_window_sample<2>(hist, xs, lds, 64 + 4 * th, cq); else if (gw == 1) p1_window_sample<4>(hist, xs, lds, 64 + 4 * th, cq);
              else if (gw == 2) p1_window_sample<8>(hist, xs, lds, 64 + 4 * th, cq); else p1_window_sample<16>(hist, xs, lds, 64 + 4 * th, cq); } }
        float rsum[5], rsq[5];
#pragma unroll
        for (int mb = 0; mb < 5; ++mb) { rsum[mb] = 0.f; rsq[mb] = 0.f; }
#pragma unroll 1
        for (int half = 0; half < 2; ++half) {
            f32x4 acc[5][4];
#pragma unroll
            for (int mb = 0; mb < 5; ++mb)
#pragma unroll
                for (int nb = 0; nb < 4; ++nb) acc[mb][nb] = (f32x4){0.f, 0.f, 0.f, 0.f};
            const bf16_t* wb = wpool + ((size_t)g * 256 + 128 * hh + 64 * half + fr) * 256 + 8 * fq;
#pragma unroll 1
            for (int kh = 0; kh < 2; ++kh) {
                bf16x8 b[4][4];
#pragma unroll
                for (int ks = 0; ks < 4; ++ks)
#pragma unroll
                    for (int nb = 0; nb < 4; ++nb) b[ks][nb] = *(const bf16x8*)(wb + (size_t)(16 * nb) * 256 + 32 * (4 * kh + ks));
                if (half == 0 && kh == 0) __syncthreads();
#pragma unroll
                for (int ks = 0; ks < 4; ++ks) {
                    const int chunk = 32 * g + 4 * (4 * kh + ks) + fq;
                    bf16x8 a[5];
#pragma unroll
                    for (int mb = 0; mb < 5; ++mb) { const int row = mb < 4 ? 16 * mb + fr : 64 + (fr & 7); a[mb] = *(const LAS bf16x8*)(lds + row * 2048 + ((chunk ^ (row & 15)) << 4)); }
#pragma unroll
                    for (int mb = 0; mb < 4; ++mb)
#pragma unroll
                        for (int nb = 0; nb < 4; ++nb) acc[mb][nb] = __builtin_amdgcn_mfma_f32_16x16x32_bf16(b[ks][nb], a[mb], acc[mb][nb], 0, 0, 0);
                    if (host) {
#pragma unroll
                        for (int nb = 0; nb < 4; ++nb) acc[4][nb] = __builtin_amdgcn_mfma_f32_16x16x32_bf16(b[ks][nb], a[4], acc[4][nb], 0, 0, 0); }
                }
            }
            const int c0 = 256 * g + 128 * hh + 64 * half + 4 * fq;
#pragma unroll
            for (int mb = 0; mb < 5; ++mb) {
                if (mb == 4 && (!host || fr >= 8)) continue;
                const int tok = mb < 4 ? tok0 + 16 * mb + fr : NTOK_P + 4 * seq0 + fr, R = row_of_tok(tok);
                const float* xr = (mb < 4 ? q->in[0] + (size_t)tok * D : q->in[1] + (size_t)(tok - NTOK_P) * D) + c0;
                f32x4 xv[4];
#pragma unroll
                for (int nb = 0; nb < 4; ++nb) xv[nb] = *(const f32x4*)(xr + 16 * nb);
#pragma unroll
                for (int nb = 0; nb < 4; ++nb) { const f32x4 v = xv[nb] * ALPHA + acc[mb][nb];
                    rsum[mb] += (v[0] + v[1]) + (v[2] + v[3]); rsq[mb] += (v[0] * v[0] + v[1] * v[1]) + (v[2] * v[2] + v[3] * v[3]);
                    u32x2 wv; wv.x = pk2(v[0], v[1]); wv.y = pk2(v[2], v[3]); *(u32x2*)(vbf + (size_t)R * D + c0 + 16 * nb) = wv; }
            }
        }
#pragma unroll
        for (int mb = 0; mb < 5; ++mb) {
            float sum = rsum[mb], sq = rsq[mb];
            sum += __shfl_xor(sum, 16); sum += __shfl_xor(sum, 32); sq += __shfl_xor(sq, 16); sq += __shfl_xor(sq, 32);
            if (fq == 0 && (mb < 4 || fr < 8)) { f32x2 t; t.x = sum; t.y = sq; T[(mb < 4 ? 16 * mb + fr : 64 + fr) * 8 + wave] = t; }
        }
        __syncthreads();
        if (tid < 4 * (host ? 72 : 64)) { const int row = tid >> 2, gg = tid & 3; const f32x2 a = T[row * 8 + 2 * gg], b = T[row * 8 + 2 * gg + 1];
            const float mt = (a.x + b.x) * (1.0f / 256.0f); f32x2 r; r.x = mt; r.y = (a.y + b.y) - 256.0f * mt * mt;
            const int tok = row < 64 ? tok0 + row : NTOK_P + 4 * seq0 + (row - 64);
            part[(size_t)row_of_tok(tok) * 4 + gg] = r; }
        __syncthreads();
    }
}

__device__ __forceinline__ void phase_fixup(int l) {
    const KA Params* q = kargs();
    const float* kc = (const float*)(q->ws + WS_KC_UP) + (size_t)l * 4 * FF2; bf16_t* act = (bf16_t*)(q->ws + WS_ACT);
    const float* Hf = (const float*)(q->ws + WS_HF); const float* Hl = (const float*)(q->ws + WS_HL);
    const int gt = blockIdx.x * 512 + tid_fresh(), NGT = gridDim.x * 512;
    for (int i = gt; i < 128 * (FF / 4); i += NGT) {
        const int q = i / (FF / 4), f = (i % (FF / 4)) * 4;
        if ((q & 15) == 0) continue;
        const int cg_ = 256 * (f >> 7) + (f & 127), cv_ = cg_ + 128;
        const float* hf = Hf + (size_t)q * 2 * FF2; const float* hl = Hl + (size_t)(q - 1) * 2 * FF2;
        const f32x4 k0g = *(const f32x4*)(kc + cg_), k1g = *(const f32x4*)(kc + FF2 + cg_), k2g = *(const f32x4*)(kc + 2 * FF2 + cg_), kbg = *(const f32x4*)(kc + 3 * FF2 + cg_);
        const f32x4 k0v = *(const f32x4*)(kc + cv_), k1v = *(const f32x4*)(kc + FF2 + cv_), k2v = *(const f32x4*)(kc + 2 * FF2 + cv_), kbv = *(const f32x4*)(kc + 3 * FF2 + cv_);
        const f32x4 g2 = *(const f32x4*)(hl + cg_), g1 = *(const f32x4*)(hl + FF2 + cg_), a0 = *(const f32x4*)(hf + cg_), a1 = *(const f32x4*)(hf + FF2 + cg_);
        const f32x4 v2 = *(const f32x4*)(hl + cv_), v1 = *(const f32x4*)(hl + FF2 + cv_), b0 = *(const f32x4*)(hf + cv_), b1 = *(const f32x4*)(hf + FF2 + cv_);
        const f32x4 zg0 = k2g * a0 + k1g * g1 + k0g * g2 + kbg, zv0 = k2v * b0 + k1v * v1 + k0v * v2 + kbv;
        const f32x4 zg1 = k2g * a1 + k1g * a0 + k0g * g1 + kbg, zv1 = k2v * b1 + k1v * b0 + k0v * v1 + kbv;
        const int R0 = (q >> 1) * 256 + 64 * (q & 1);
        u32x2 w0, w1; w0.x = pk2(silu_mul(zg0[0], zv0[0]), silu_mul(zg0[1], zv0[1])); w0.y = pk2(silu_mul(zg0[2], zv0[2]), silu_mul(zg0[3], zv0[3]));
        w1.x = pk2(silu_mul(zg1[0], zv1[0]), silu_mul(zg1[1], zv1[1])); w1.y = pk2(silu_mul(zg1[2], zv1[2]), silu_mul(zg1[3], zv1[3]));
        *(u32x2*)(act + (size_t)R0 * FF + f) = w0; *(u32x2*)(act + (size_t)(R0 + 16) * FF + f) = w1;
    }
}

__device__ __forceinline__ void phase_conv() {
    const KA Params* q = kargs();
    const bf16_t* ubuf = (const bf16_t*)(q->ws + WS_ACT); const bf16_t* bbuf = ubuf + (size_t)MROWS * D; bf16_t* obuf = (bf16_t*)q->out;
    const float* ck = q->in[10]; const float* ckb = q->in[11]; const float* st = q->in[3];
    const int gt = blockIdx.x * 512 + tid_fresh(), NGT = gridDim.x * 512;
    for (int i = gt; i < MROWS * (D / 8); i += NGT) {
        const int tok = i >> 7, ch = (i & 127) * 8;
        int t, seq = 0; const bool sample = tok >= NTOK_P;
        if (!sample) t = tok & (SEQ - 1); else { seq = (tok - NTOK_P) >> 2; t = tok & 3; }
        const int R = row_of_tok(tok);
        float u0[8], u1[8], u2[8], bb[8];
        { const u32x4 w = *(const u32x4*)(ubuf + (size_t)R * D + ch); const u32x4 wb = *(const u32x4*)(bbuf + (size_t)R * D + ch);
#pragma unroll
          for (int e = 0; e < 4; ++e) { u2[2 * e] = bf2f(w[e] & 0xffffu); u2[2 * e + 1] = bf2f(w[e] >> 16); bb[2 * e] = bf2f(wb[e] & 0xffffu); bb[2 * e + 1] = bf2f(wb[e] >> 16); } }
        if (t >= 1) { const u32x4 w = *(const u32x4*)(ubuf + (size_t)row_of_tok(tok - 1) * D + ch);
#pragma unroll
            for (int e = 0; e < 4; ++e) { u1[2 * e] = bf2f(w[e] & 0xffffu); u1[2 * e + 1] = bf2f(w[e] >> 16); } }
        else if (sample) { const f32x4 a = *(const f32x4*)(st + ((size_t)seq * 2 + 1) * D + ch), b = *(const f32x4*)(st + ((size_t)seq * 2 + 1) * D + ch + 4);
#pragma unroll
            for (int e = 0; e < 4; ++e) { u1[e] = a[e]; u1[4 + e] = b[e]; } }
        else {
#pragma unroll
            for (int e = 0; e < 8; ++e) u1[e] = 0.f; }
        if (t >= 2) { const u32x4 w = *(const u32x4*)(ubuf + (size_t)row_of_tok(tok - 2) * D + ch);
#pragma unroll
            for (int e = 0; e < 4; ++e) { u0[2 * e] = bf2f(w[e] & 0xffffu); u0[2 * e + 1] = bf2f(w[e] >> 16); } }
        else if (sample) { const f32x4 a = *(const f32x4*)(st + ((size_t)seq * 2 + t) * D + ch), b = *(const f32x4*)(st + ((size_t)seq * 2 + t) * D + ch + 4);
#pragma unroll
            for (int e = 0; e < 4; ++e) { u0[e] = a[e]; u0[4 + e] = b[e]; } }
        else {
#pragma unroll
            for (int e = 0; e < 8; ++e) u0[e] = 0.f; }
        float o[8];
#pragma unroll
        for (int e = 0; e < 8; ++e) o[e] = bb[e] * (ck[ch + e] * u0[e] + ck[D + ch + e] * u1[e] + ck[2 * D + ch + e] * u2[e] + ckb[ch + e]);
        u32x4 w; w.x = pk2(o[0], o[1]); w.y = pk2(o[2], o[3]); w.z = pk2(o[4], o[5]); w.w = pk2(o[6], o[7]);
        *(u32x4*)(obuf + (size_t)R * D + ch) = w;
    }
}

__device__ __forceinline__ void phase_final() {
    const KA Params* q = kargs();
    const f32x2* part = (const f32x2*)(q->ws + WS_PART); const float* g = q->in[17] + D; const float* b = q->in[18] + D;
    const int tid = tid_fresh(), lane = tid & 63, gw = blockIdx.x * 8 + (tid >> 6), NGW = gridDim.x * 8;
    f32x4 gv[4], bv[4];
#pragma unroll
    for (int j = 0; j < 4; ++j) { gv[j] = *(const f32x4*)(g + 256 * j + 4 * lane); bv[j] = *(const f32x4*)(b + 256 * j + 4 * lane); }
    for (int tok = gw; tok < MROWS; tok += NGW) {
        const f32x2 s = row_stats(part, row_of_tok(tok));
        float* yr = q->out + (size_t)tok * D + 4 * lane;
#pragma unroll
        for (int j = 0; j < 4; ++j) { const f32x4 v = *(const f32x4*)(yr + 256 * j); *(f32x4*)(yr + 256 * j) = ((v - s.x) * s.y) * gv[j] + bv[j]; }
    }
}

#define XB_TMO      128
#define XB_XCNT(j)  (256  + 64 * (j))
#define XB_XSUB(j)  (1280 + 64 * (j))
#define XB_XGEN(j)  (2304 + 64 * (j))
#define XB_TOP      3328
#define XB_TOPGEN   3392
#define XCD_BAR_WORDS 3456
#define XB_SPIN_CAP (1u << 18)

__device__ __forceinline__ unsigned xb_ld(unsigned* p)              { return __hip_atomic_load(p, __ATOMIC_RELAXED, __HIP_MEMORY_SCOPE_AGENT); }
__device__ __forceinline__ unsigned xb_add(unsigned* p, unsigned v) { return __hip_atomic_fetch_add(p, v, __ATOMIC_RELAXED, __HIP_MEMORY_SCOPE_AGENT); }
__device__ __forceinline__ unsigned xb_xcc_id() { return (unsigned)__builtin_amdgcn_s_getreg((3 << 11) | 20) & 0xFu; }
#define XB_SPIN(cond, bar) do { unsigned _sp = 0; while (cond) { __builtin_amdgcn_s_sleep(1); \
    if ((++_sp & 255u) == 0u) { if (xb_ld(&(bar)[XB_TMO])) break; if (_sp > XB_SPIN_CAP) { atomicAdd(&(bar)[XB_TMO], 1u); break; } } } } while (0)

struct XcdBarrier {
    unsigned* bar; unsigned x;
    volatile LAS unsigned* st;
};

__device__ __forceinline__ XcdBarrier xcd_barrier_post(unsigned* bar, volatile LAS unsigned* st) {
    XcdBarrier b; b.bar = bar; b.x = xb_xcc_id(); b.st = st;
    if (threadIdx.x == 0) (void)xb_add(&bar[XB_XCNT(b.x)], 1u);
    return b;
}
__device__ __forceinline__ void xcd_barrier_complete(unsigned* bar, unsigned x, unsigned& nloc, unsigned& nx) {
    const unsigned G = gridDim.x * gridDim.y * gridDim.z;
    unsigned sum, cnt, mine, sp = 0u;
    for (;;) {
        sum = 0u; cnt = 0u; mine = 0u;
#pragma unroll
        for (unsigned j = 0; j < 16; ++j) { const unsigned c = xb_ld(&bar[XB_XCNT(j)]); sum += c; cnt += (c > 0u) ? 1u : 0u; mine = (j == x) ? c : mine; }
        if (sum == G) break;
        __builtin_amdgcn_s_sleep(1);
        if ((++sp & 255u) == 0u) { if (xb_ld(&bar[XB_TMO])) break; if (sp > XB_SPIN_CAP) { atomicAdd(&bar[XB_TMO], 1u); break; } }
    }
    nloc = mine > 0u ? mine : 1u; nx = cnt > 0u ? cnt : 1u;
}

__device__ __forceinline__ void xcd_barrier(const XcdBarrier& b) {
    asm volatile("s_waitcnt vmcnt(0)" ::: "memory");
    __syncthreads();
    if (threadIdx.x == 0) {
        unsigned* bar = b.bar;
        __builtin_amdgcn_s_waitcnt(0);
        unsigned nloc = b.st[0], nx = b.st[1];
        if (nloc == 0u) { xcd_barrier_complete(bar, b.x, nloc, nx); b.st[0] = nloc; b.st[1] = nx; }
        const unsigned old = xb_add(&bar[XB_XSUB(b.x)], 1u);
        const unsigned gen = old / nloc;
        if (old + 1u == (gen + 1u) * nloc) {
            __builtin_amdgcn_fence(__ATOMIC_RELEASE, "agent");
            asm volatile("s_waitcnt vmcnt(0)" ::: "memory");
            const unsigned og = xb_add(&bar[XB_TOP], 1u);
            const unsigned tg = og / nx;
            if (og + 1u == (tg + 1u) * nx) xb_add(&bar[XB_TOPGEN], 1u);
            else XB_SPIN(xb_ld(&bar[XB_TOPGEN]) == tg, bar);
            __builtin_amdgcn_fence(__ATOMIC_ACQUIRE, "agent");
            xb_add(&bar[XB_XGEN(b.x)], 1u);
            asm volatile("s_waitcnt vmcnt(0)" ::: "memory");
        } else {
            XB_SPIN(xb_ld(&bar[XB_XGEN(b.x)]) == gen, bar);
            __builtin_amdgcn_fence(__ATOMIC_ACQUIRE, "agent");
            asm volatile("s_waitcnt vmcnt(0)" ::: "memory");
        }
    }
    __syncthreads();
}


__global__ void __launch_bounds__(512, 2) fwd_megakernel(Params p) {
    extern __shared__ __attribute__((aligned(16))) unsigned char lds_raw[];
    LAS unsigned char* lds = (LAS unsigned char*)lds_raw;
    cg::grid_group grid = cg::this_grid();
    const int G = gridDim.x, cid = blockIdx.x;
    if (threadIdx.x < 2) ((LAS unsigned*)(lds + BARST_OFF))[threadIdx.x] = 0u;
    __syncthreads();
    const XcdBarrier bar = xcd_barrier_post((unsigned*)(kargs()->ws + WS_BAR), (volatile LAS unsigned*)(lds + BARST_OFF));
#define WSP(off) (kargs()->ws + (off))
#define H1P ((const bf16_t*)WSP(WS_H1))
#define H2P ((const bf16_t*)kargs()->out)
#if DIAG & 1
    for (int rep = 0; rep < ((REP & 1) ? 2 : 1); ++rep) phase0(lds);
#endif
    grid.sync();
#if DIAG & 2
    for (int rep = 0; rep < ((REP & 2) ? 2 : 1); ++rep) phase1(lds);
#endif
    xcd_barrier(bar);
#if DIAG & 32
    for (int rep = 0; rep < ((REP & 32) ? 2 : 1); ++rep) { pg8::Gemm g{H1P, (const bf16_t*)WSP(WS_WUP), D}; pg8::StaticOrder S; S.init(NPANEL, 22, G, cid); EpiUp E{0}; pg8::gemm_phase(lds, g, S, E); }
#endif
    xcd_barrier(bar);
#if DIAG & 64
    for (int rep = 0; rep < ((REP & 64) ? 2 : 1); ++rep) phase_fixup(0);
#endif
    xcd_barrier(bar);
#if DIAG & 128
    { pg8::Gemm g{(const bf16_t*)WSP(WS_ACT), (const bf16_t*)WSP(WS_WDN), FF}; pg8::StaticOrder S; S.init(NPANEL, 4, G, cid);
      EpiRes<false> E{0, 1, 5, 0}; pg8::gemm_phase(lds, g, S, E); }
#endif
    xcd_barrier(bar);
#if DIAG & 4
    for (int rep = 0; rep < ((REP & 4) ? 2 : 1); ++rep) { pg8::Gemm g{H1P, (const bf16_t*)WSP(WS_WIN), D}; pg8::StaticOrder S; S.init(NPANEL, 12, G, cid); EpiIn E{0}; pg8::gemm_phase(lds, g, S, E); }
#endif
    xcd_barrier(bar);
#if DIAG & 8
    for (int rep = 0; rep < ((REP & 8) ? 2 : 1); ++rep) phase_conv();
#endif
    xcd_barrier(bar);
#if DIAG & 16
    { pg8::Gemm g{H2P, (const bf16_t*)WSP(WS_WOUT), D}; pg8::StaticOrder S; S.init(NPANEL, 4, G, cid);
      EpiRes<false> E{1, 2, 17, 0}; pg8::gemm_phase(lds, g, S, E); }
#endif
    xcd_barrier(bar);
#if DIAG & 32
    for (int rep = 0; rep < ((REP & 32) ? 2 : 1); ++rep) { pg8::Gemm g{H1P, (const bf16_t*)WSP(WS_WUP) + (size_t)FF2 * D, D}; pg8::StaticOrder S; S.init(NPANEL, 22, G, cid); EpiUp E{1}; pg8::gemm_phase(lds, g, S, E); }
#endif
    xcd_barrier(bar);
#if DIAG & 64
    for (int rep = 0; rep < ((REP & 64) ? 2 : 1); ++rep) phase_fixup(1);
#endif
    xcd_barrier(bar);
#if DIAG & 256
    { pg8::Gemm g{(const bf16_t*)WSP(WS_ACT), (const bf16_t*)WSP(WS_WDN) + (size_t)D * FF, FF}; pg8::StaticOrder S; S.init(NPANEL, 4, G, cid);
      EpiRes<true> E{2, 0, 5, D}; pg8::gemm_phase(lds, g, S, E); }
#endif
    xcd_barrier(bar);
#if DIAG & 512
    phase_final();
#endif
}

extern "C" void kernel_launch(void* const* d_in, const int* in_sizes, int n_in, void* d_out, int out_size, void* d_ws, size_t ws_size, hipStream_t stream) {
    static int grid_blocks = 0;
    if (grid_blocks == 0) {
        if (n_in != 19 || out_size != (int)O_END || ws_size < WS_END) { fprintf(stderr, "kernel_launch: unexpected shapes (n_in %d out %d ws %zu)\n", n_in, out_size, ws_size); grid_blocks = -1; return; }
        int dev = 0, cus = 0, per_cu = 0;
        hipGetDevice(&dev);
        hipDeviceGetAttribute(&cus, hipDeviceAttributeMultiprocessorCount, dev);
        if (hipFuncSetAttribute((const void*)fwd_megakernel, hipFuncAttributeMaxDynamicSharedMemorySize, LDS_BYTES) != hipSuccess) { fprintf(stderr, "kernel_launch: hipFuncSetAttribute failed\n"); grid_blocks = -1; return; }
        hipOccupancyMaxActiveBlocksPerMultiprocessor(&per_cu, (const void*)fwd_megakernel, 512, LDS_BYTES);
        if (per_cu < 1) { fprintf(stderr, "kernel_launch: occupancy query reports %d blocks per CU\n", per_cu); grid_blocks = -1; return; }
        grid_blocks = cus;
    }
    if (grid_blocks < 0) return;
    if (hipMemsetAsync((char*)d_ws + WS_BAR, 0, 16384, stream) != hipSuccess) { fprintf(stderr, "kernel_launch: hipMemsetAsync failed\n"); return; }
    Params p{};
    for (int i = 0; i < 19; ++i) p.in[i] = (const float*)d_in[i];
    p.out = (float*)d_out; p.ws = (unsigned char*)d_ws;
    void* args[] = {&p};
    hipError_t e = hipLaunchCooperativeKernel((const void*)fwd_megakernel, dim3(grid_blocks), dim3(512), args, LDS_BYTES, stream);
    if (e != hipSuccess) fprintf(stderr, "cooperative launch failed: %s (grid %d)\n", hipGetErrorString(e), grid_blocks);
}
```

```cpp
#include <hip/hip_runtime.h>
#include <hip/hip_cooperative_groups.h>
#include <cstdio>
#include <cstdint>
namespace cg = cooperative_groups;
#ifndef REP
#define REP 0
#endif
#ifndef SEG
#define SEG 255
#endif
#ifndef DIAG
#define DIAG 1023
#endif

#define LAS __attribute__((address_space(3)))
typedef unsigned short bf16_t;
typedef short bf16x8 __attribute__((ext_vector_type(8)));
typedef float f32x4 __attribute__((ext_vector_type(4)));
typedef float f32x2 __attribute__((ext_vector_type(2)));
typedef unsigned u32x4 __attribute__((ext_vector_type(4)));
typedef unsigned u32x2 __attribute__((ext_vector_type(2)));

constexpr int D = 1024, FF = 2816, FF2 = 5632, SEQ = 2048, NB_P = 8, NB_S = 128, TS = 4;
constexpr int NTOK_P = NB_P * SEQ;
constexpr int NTOK_S = NB_S * TS;
constexpr int MROWS = NTOK_P + NTOK_S;
constexpr int NPANEL = MROWS / 256;
constexpr int NPANEL_P = NTOK_P / 256;
constexpr float ALPHA = 1.41421356237309515f;
constexpr float LN_EPS = 1e-5f;

constexpr size_t O_Y = 0;
constexpr size_t O_POOL_P = (size_t)MROWS * D;
constexpr size_t O_POOL_S = O_POOL_P + (size_t)NB_P * 15 * D;
constexpr size_t O_CONV_P = O_POOL_S + (size_t)NB_S * 15 * D;
constexpr size_t O_CONV_S = O_CONV_P + (size_t)NB_P * 2 * D;
constexpr size_t O_FFN_P = O_CONV_S + (size_t)NB_S * 2 * D;
constexpr size_t O_FFN_S = O_FFN_P + (size_t)2 * NB_P * 2 * FF2;
constexpr size_t O_END = O_FFN_S + (size_t)2 * NB_S * 2 * FF2;

constexpr size_t WS_WUP = 0;
constexpr size_t WS_WDN = WS_WUP + (size_t)2 * FF2 * D * 2;
constexpr size_t WS_WIN = WS_WDN + (size_t)2 * D * FF * 2;
constexpr size_t WS_WOUT = WS_WIN + (size_t)3 * D * D * 2;
constexpr size_t WS_WPOOL = WS_WOUT + (size_t)D * D * 2;
constexpr size_t WS_CSP_UP = WS_WPOOL + (size_t)4 * 256 * 256 * 2;
constexpr size_t WS_CBP_UP = WS_CSP_UP + (size_t)2 * 16 * FF2 * 4;
constexpr size_t WS_CSP_IN = WS_CBP_UP + (size_t)2 * 16 * FF2 * 4;
constexpr size_t WS_CBP_IN = WS_CSP_IN + (size_t)16 * 3072 * 4;
constexpr size_t WS_CS_UP = WS_CBP_IN + (size_t)16 * 3072 * 4;
constexpr size_t WS_CB_UP = WS_CS_UP + (size_t)2 * FF2 * 4;
constexpr size_t WS_KC_UP = WS_CB_UP + (size_t)2 * FF2 * 4;
constexpr size_t WS_CS_IN = WS_KC_UP + (size_t)2 * 4 * FF2 * 4;
constexpr size_t WS_CB_IN = WS_CS_IN + (size_t)3072 * 4;
constexpr size_t WS_PART = WS_CB_IN + (size_t)3072 * 4;
constexpr size_t PART_BYTES = (size_t)MROWS * 4 * 8;
constexpr size_t WS_HF = WS_PART + 3 * PART_BYTES;
constexpr size_t HALO_BYTES = (size_t)132 * 2 * FF2 * 4;
constexpr size_t WS_HL = WS_HF + HALO_BYTES;
constexpr size_t WS_H1 = WS_HL + HALO_BYTES;
constexpr size_t WS_ACT = WS_H1 + (size_t)MROWS * D * 2;
constexpr size_t WS_BAR = WS_ACT + (size_t)MROWS * FF * 2;
constexpr size_t WS_CNT = WS_BAR + 16384;
constexpr size_t CTL_BYTES = 32768;
constexpr size_t WS_SU = WS_BAR + CTL_BYTES;
constexpr size_t WS_SB = WS_SU + (size_t)NTOK_S * D * 2;
constexpr size_t WS_PBUF = WS_SB + (size_t)NTOK_S * D * 2;
constexpr size_t WS_END = WS_PBUF + (size_t)32 * 262144;
static_assert(WS_END <= (size_t)256 * 1024 * 1024, "workspace");
static_assert(WS_WDN % 256 == 0 && WS_WIN % 256 == 0 && WS_WOUT % 256 == 0 && WS_WPOOL % 256 == 0 && WS_PART % 256 == 0 && WS_HF % 256 == 0 && WS_H1 % 256 == 0 && WS_ACT % 256 == 0, "align");

constexpr int STAGE_BYTES = 131072;
constexpr int EPI_OFF = STAGE_BYTES;
constexpr int P1_T_OFF = 147456;
constexpr int BARST_OFF = 155648 - 64;
constexpr int LDS_BYTES = 155648;

struct Params {
    const float* in[19];
    float* out;
    unsigned char* ws;
};

__device__ __forceinline__ unsigned f2bf(float f) { unsigned u = __builtin_bit_cast(unsigned, f); return (u + 0x7fffu + ((u >> 16) & 1u)) >> 16; }
__device__ __forceinline__ float bf2f(unsigned b) { return __builtin_bit_cast(float, b << 16); }
__device__ __forceinline__ unsigned pk2(float lo, float hi) { return f2bf(lo) | (f2bf(hi) << 16); }
__device__ __forceinline__ float dpp_shr1(float v) {
    return __builtin_bit_cast(float, __builtin_amdgcn_update_dpp(0, __builtin_bit_cast(int, v), 0x111, 0xf, 0xf, true));
}
__device__ __forceinline__ float silu_mul(float g, float v) { return g * v * __builtin_amdgcn_rcpf(1.0f + __expf(-g)); }
__device__ __forceinline__ int tid_fresh() { int t = threadIdx.x; asm volatile("" : "+v"(t)); return t; }
__device__ __forceinline__ int row_of_tok(int tok) {
    const int pm = tok >> 8, tau = tok & 255;
    return pm * 256 + 128 * ((tau >> 2) & 1) + 64 * (tau >> 7) + 16 * (tau & 3) + ((tau >> 3) & 15);
}
__device__ __forceinline__ f32x2 row_stats(const f32x2* part, int R) {
    const f32x4 a = *(const f32x4*)(part + (size_t)R * 4), b = *(const f32x4*)(part + (size_t)R * 4 + 2);
    const float mean = ((a[0] + a[2]) + (b[0] + b[2])) * 0.25f;
    const float d0 = a[0] - mean, d1 = a[2] - mean, d2 = b[0] - mean, d3 = b[2] - mean;
    const float m2 = ((a[1] + a[3]) + (b[1] + b[3])) + 256.0f * ((d0 * d0 + d1 * d1) + (d2 * d2 + d3 * d3));
    f32x2 r; r.x = mean; r.y = __builtin_amdgcn_rsqf(m2 * (1.0f / 1024.0f) + LN_EPS); return r;
}
__device__ __forceinline__ void stats_to_lds(const f32x2* part, int pm, LAS f32x2* S) {
    int tx = threadIdx.x; asm volatile("" : "+v"(tx));
    if (tx < 256) { const f32x2 s = row_stats(part, pm * 256 + tx); f32x2 t; t.x = s.y; t.y = -s.x * s.y; S[tx] = t; }
    asm volatile("s_waitcnt lgkmcnt(0)" ::: "memory"); __builtin_amdgcn_s_barrier(); asm volatile("" ::: "memory");
}
#define KA __attribute__((address_space(4)))
__device__ __forceinline__ const KA Params* kargs() { const KA Params* p = (const KA Params*)__builtin_amdgcn_kernarg_segment_ptr(); asm volatile("" : "+s"(p)); return p; }

namespace pg8 {
constexpr int BM = 256, BK = 64, HALF = 128, HTB = HALF * BK * 2, NXCD = 8, WGM = 8;
__host__ __device__ __forceinline__ int lds_byte(int r, int c) { const int st = (r >> 4) * 2 + (c >> 5), rr = r & 15, cc = c & 31, ob = rr * 64 + cc * 2; return st * 1024 + (ob ^ (((ob >> 9) & 1) << 5)); }
__host__ __device__ __forceinline__ void stage_rc(int b, int& R, int& C) { const int st = b / 1024, sb = b % 1024, swz = sb ^ (((sb >> 9) & 1) << 5); R = (st >> 1) * 16 + swz / 64; C = (st & 1) * 32 + (swz % 64) / 2; }

struct Unit { int pm, pn; };
enum { K_UP0 = 0, K_UP1 = 1, K_DN0 = 2, K_DN1 = 3, K_IN = 4, K_OUT = 5, K_DNS0 = 6, K_DNS1 = 7 };
struct UnitD { int kind, pm, pn, ks, dep, want, sig; };
__device__ __forceinline__ void map_unit(int L, int nM, int nN, int& pm, int& pn) {
    const int nwg = nM * nN; int wgid = L; { const int q = nwg / NXCD, r = nwg % NXCD, xcd = wgid % NXCD, off = wgid / NXCD; wgid = (xcd < r ? xcd * (q + 1) : r * (q + 1) + (xcd - r) * q) + off; }
    const int nig = WGM * nN, gid = wgid / nig, fm = gid * WGM, gsz = (nM - fm) < WGM ? (nM - fm) : WGM;
    pm = fm + ((wgid % nig) % gsz); pn = (wgid % nig) / gsz;
}
}


template <int BJ> __device__ __forceinline__ void pin_half(f32x4 (&acc)[2][2][4][2]) {
#pragma unroll
    for (int ai = 0; ai < 2; ++ai)
        asm volatile("" : "+v"(acc[ai][BJ][0][0]), "+v"(acc[ai][BJ][0][1]), "+v"(acc[ai][BJ][1][0]), "+v"(acc[ai][BJ][1][1]), "+v"(acc[ai][BJ][2][0]), "+v"(acc[ai][BJ][2][1]), "+v"(acc[ai][BJ][3][0]), "+v"(acc[ai][BJ][3][1]) :: "memory");
}
template <int BJ, int N> __device__ __forceinline__ void pin_group(f32x4 (&acc)[2][2][4][2]) {
    asm volatile("" : "+v"(acc[0][BJ][0][N]), "+v"(acc[0][BJ][1][N]), "+v"(acc[0][BJ][2][N]), "+v"(acc[0][BJ][3][N]), "+v"(acc[1][BJ][0][N]), "+v"(acc[1][BJ][1][N]), "+v"(acc[1][BJ][2][N]), "+v"(acc[1][BJ][3][N]) :: "memory");
}
template <int N> __device__ __forceinline__ void pin_n(f32x4 (&acc)[2][2][4][2]) {
#pragma unroll
    for (int ai = 0; ai < 2; ++ai)
        asm volatile("" : "+v"(acc[ai][0][0][N]), "+v"(acc[ai][0][1][N]), "+v"(acc[ai][0][2][N]), "+v"(acc[ai][0][3][N]), "+v"(acc[ai][1][0][N]), "+v"(acc[ai][1][1][N]), "+v"(acc[ai][1][2][N]), "+v"(acc[ai][1][3][N]) :: "memory");
}
template <int BJ, int N, int J0, int LEN>
__device__ __forceinline__ void conv_chain(f32x4 (&acc)[2][2][4][2], const f32x4 k0, const f32x4 k1, const f32x4 k2, const f32x4 kb, const f32x4 p1, const f32x4 p2) {
#pragma unroll
    for (int i = LEN - 1; i >= 0; --i) {
        const int j = J0 + i;
        const f32x4 h0 = acc[j >> 2][BJ][j & 3][N];
        const f32x4 h1 = i >= 1 ? acc[(j - 1) >> 2][BJ][(j - 1) & 3][N] : p1;
        const f32x4 h2 = i >= 2 ? acc[(j - 2) >> 2][BJ][(j - 2) & 3][N] : (i == 1 ? p1 : p2);
        acc[j >> 2][BJ][j & 3][N] = k2 * h0 + k1 * h1 + k0 * h2 + kb;
    }
}
struct EpiUp {
    int l;
    template <int N>
    __device__ __forceinline__ void half(f32x4 (&acc)[2][2][4][2], int pm, int pn, int wr, int wc, int fr, int fq) const {
        asm volatile("" : "+v"(fr), "+v"(fq));
        const KA Params* q = kargs(); unsigned char* ws = q->ws;
        const bool sample = pm >= NPANEL_P;
        const int chunk = 2 * pm + wr;
        const int ucol = 256 * pn + 32 * wc + 16 * N;
        const int ufcol = 128 * pn + 32 * wc + 16 * N;
        const char* kcb = (const char*)((const float*)(ws + WS_KC_UP) + (size_t)l * 4 * FF2 + ucol);
        const unsigned lq = (unsigned)(16 * fq);
#define KC4(tap, vhalf) (*(const f32x4*)(kcb + lq + (unsigned)(((tap) * FF2 + (vhalf) * 128) * 4)))
        if (!sample) {
            f32x4 g2, g1;
#pragma unroll
            for (int e = 0; e < 4; ++e) { g2[e] = dpp_shr1(acc[1][0][2][N][e]); g1[e] = dpp_shr1(acc[1][0][3][N][e]); }
            if (fr == 0) {
                char* hf = (char*)((float*)(ws + WS_HF) + (size_t)chunk * 2 * FF2 + ucol) + lq;
                *(f32x4*)(hf) = acc[0][0][0][N]; *(f32x4*)(hf + FF2 * 4) = acc[0][0][1][N];
                *(f32x4*)(hf + 128 * 4) = acc[0][1][0][N]; *(f32x4*)(hf + (FF2 + 128) * 4) = acc[0][1][1][N];
            }
            if (fr == 15) {
                char* hl = (char*)((float*)(ws + WS_HL) + (size_t)chunk * 2 * FF2 + ucol) + lq;
                *(f32x4*)(hl) = acc[1][0][2][N]; *(f32x4*)(hl + FF2 * 4) = acc[1][0][3][N];
                *(f32x4*)(hl + 128 * 4) = acc[1][1][2][N]; *(f32x4*)(hl + (FF2 + 128) * 4) = acc[1][1][3][N];
                if ((pm & 7) == 7 && wr == 1) {
                    char* o = (char*)(q->out + O_FFN_P + ((size_t)l * NB_P + (pm >> 3)) * 2 * FF2 + ufcol) + lq;
                    *(f32x4*)(o) = acc[1][0][2][N]; *(f32x4*)(o + FF2 * 4) = acc[1][0][3][N];
                    *(f32x4*)(o + FF * 4) = acc[1][1][2][N]; *(f32x4*)(o + (FF2 + FF) * 4) = acc[1][1][3][N];
                }
            }
            pin_n<N>(acc);
            { const f32x4 k0 = KC4(0, 0), k1 = KC4(1, 0), k2 = KC4(2, 0), kb = KC4(3, 0); conv_chain<0, N, 0, 8>(acc, k0, k1, k2, kb, g1, g2); }
            pin_n<N>(acc);
            { f32x4 v2, v1;
#pragma unroll
              for (int e = 0; e < 4; ++e) { v2[e] = dpp_shr1(acc[1][1][2][N][e]); v1[e] = dpp_shr1(acc[1][1][3][N][e]); }
              const f32x4 k0 = KC4(0, 1), k1 = KC4(1, 1), k2 = KC4(2, 1), kb = KC4(3, 1); conv_chain<1, N, 0, 8>(acc, k0, k1, k2, kb, v1, v2); }
        } else {
            const int useq0 = 64 * (pm - NPANEL_P) + 32 * wr;
            const unsigned ls = (unsigned)(2 * fr * 2 * FF2 * 4) + lq;
            char* ob = (char*)(q->out + O_FFN_S + ((size_t)l * NB_S + useq0) * 2 * FF2 + ufcol);
#pragma unroll
            for (int ai = 0; ai < 2; ++ai) { char* o = ob + ls + (unsigned)(ai * 2 * FF2 * 4);
                *(f32x4*)(o) = acc[ai][0][2][N]; *(f32x4*)(o + FF2 * 4) = acc[ai][0][3][N];
                *(f32x4*)(o + FF * 4) = acc[ai][1][2][N]; *(f32x4*)(o + (FF2 + FF) * 4) = acc[ai][1][3][N]; }
            pin_n<N>(acc);
            const char* sb = (const char*)(q->in[4] + ((size_t)l * NB_S + useq0) * 2 * FF2 + ufcol);
            { const f32x4 k0 = KC4(0, 0), k1 = KC4(1, 0), k2 = KC4(2, 0), kb = KC4(3, 0);
              conv_chain<0, N, 0, 4>(acc, k0, k1, k2, kb, *(const f32x4*)(sb + ls + FF2 * 4), *(const f32x4*)(sb + ls));
              conv_chain<0, N, 4, 4>(acc, k0, k1, k2, kb, *(const f32x4*)(sb + ls + 3 * FF2 * 4), *(const f32x4*)(sb + ls + 2 * FF2 * 4)); }
            pin_n<N>(acc);
            { const f32x4 k0 = KC4(0, 1), k1 = KC4(1, 1), k2 = KC4(2, 1), kb = KC4(3, 1);
              conv_chain<1, N, 0, 4>(acc, k0, k1, k2, kb, *(const f32x4*)(sb + ls + (FF2 + FF) * 4), *(const f32x4*)(sb + ls + FF * 4));
              conv_chain<1, N, 4, 4>(acc, k0, k1, k2, kb, *(const f32x4*)(sb + ls + (3 * FF2 + FF) * 4), *(const f32x4*)(sb + ls + (2 * FF2 + FF) * 4)); }
        }
#undef KC4
        pin_n<N>(acc);
        char* ab = (char*)((bf16_t*)(ws + WS_ACT) + (size_t)(pm * 256 + 64 * wr) * FF + ufcol);
        const unsigned la = (unsigned)((fr * FF + 4 * fq) * 2);
#pragma unroll
        for (int j = 0; j < 8; ++j) {
            const f32x4 zg = acc[j >> 2][0][j & 3][N], zv = acc[j >> 2][1][j & 3][N];
            u32x2 w; w.x = pk2(silu_mul(zg[0], zv[0]), silu_mul(zg[1], zv[1])); w.y = pk2(silu_mul(zg[2], zv[2]), silu_mul(zg[3], zv[3]));
            *(u32x2*)(ab + la + (unsigned)((128 * (j >> 2) + 16 * (j & 3)) * FF * 2)) = w;
        }
        asm volatile("" ::: "memory");
    }
    __device__ __forceinline__ void operator()(f32x4 (&acc)[2][2][4][2], const pg8::Unit& u, int wr, int wc, int fr, int fq, LAS unsigned char* elds) const {
        const int pm = u.pm, pn = u.pn;
        LAS f32x2* S = (LAS f32x2*)(elds + 8192);
        { const KA Params* q = kargs(); unsigned char* ws = q->ws;
          stats_to_lds((const f32x2*)(ws + WS_PART) + (size_t)(l == 0 ? 0 : 2) * MROWS * 4, pm, S);
          const char* csb = (const char*)((const float*)(ws + WS_CS_UP) + l * FF2 + 256 * pn + 32 * wc); const char* cbb = (const char*)((const float*)(ws + WS_CB_UP) + l * FF2 + 256 * pn + 32 * wc);
          const unsigned lq = (unsigned)(16 * fq);
          f32x2 st[8];
#pragma unroll
          for (int j = 0; j < 8; ++j) st[j] = S[128 * (j >> 2) + 64 * wr + 16 * (j & 3) + fr];
#pragma unroll
          for (int bj = 0; bj < 2; ++bj)
#pragma unroll
              for (int n = 0; n < 2; ++n) { const f32x4 csv = *(const f32x4*)(csb + lq + (unsigned)((128 * bj + 16 * n) * 4)), cbv = *(const f32x4*)(cbb + lq + (unsigned)((128 * bj + 16 * n) * 4));
#pragma unroll
                  for (int j = 0; j < 8; ++j) acc[j >> 2][bj][j & 3][n] = acc[j >> 2][bj][j & 3][n] * st[j].x + (csv * st[j].y + cbv);
                  asm volatile("" ::: "memory"); }
        }
        pin_half<0>(acc); pin_half<1>(acc);
        half<0>(acc, pm, pn, wr, wc, fr, fq);
        half<1>(acc, pm, pn, wr, wc, fr, fq);
    }
};

template <bool FINAL> struct EpiRes {
    int pprev, pnew, gi, goff;
    template <int BJ>
    __device__ __forceinline__ void resid(f32x4 (&acc)[2][2][4][2], int pm, int pn, int wr, int wc, int fr, int fq, LAS f32x2* S) const {
        asm volatile("" : "+v"(fr), "+v"(fq));
        const KA Params* q = kargs();
        const int ucol = 256 * pn + 128 * BJ + 32 * wc;
        const char* vb = (const char*)((const bf16_t*)(q->ws + WS_H1) + (size_t)(pm * 256 + 64 * wr) * D + ucol);
        const unsigned lv = (unsigned)((fr * D + 4 * fq) * 2), lq = (unsigned)(16 * fq);
        const char* gb = (const char*)(q->in[gi] + goff + ucol); const char* bb = (const char*)(q->in[gi + 1] + goff + ucol);
        u32x2 vp[8][2];
#pragma unroll
        for (int j = 0; j < 8; ++j)
#pragma unroll
            for (int n = 0; n < 2; ++n) vp[j][n] = *(const u32x2*)(vb + lv + (unsigned)(((128 * (j >> 2) + 16 * (j & 3)) * D + 16 * n) * 2));
        f32x4 gv[2], bv[2];
#pragma unroll
        for (int n = 0; n < 2; ++n) { gv[n] = *(const f32x4*)(gb + lq + (unsigned)(64 * n)) * ALPHA; bv[n] = *(const f32x4*)(bb + lq + (unsigned)(64 * n)) * ALPHA; }
        const LAS f32x2* Sl = S + 64 * wr + fr;
#pragma unroll
        for (int j = 0; j < 8; ++j) { const f32x2 s = Sl[128 * (j >> 2) + 16 * (j & 3)];
#pragma unroll
            for (int n = 0; n < 2; ++n) { f32x4 v; v[0] = bf2f(vp[j][n].x & 0xffffu); v[1] = bf2f(vp[j][n].x >> 16); v[2] = bf2f(vp[j][n].y & 0xffffu); v[3] = bf2f(vp[j][n].y >> 16);
                acc[j >> 2][BJ][j & 3][n] = (v * s.x + s.y) * gv[n] + bv[n] + acc[j >> 2][BJ][j & 3][n]; } }
        pin_half<BJ>(acc);
    }
    __device__ __forceinline__ void operator()(f32x4 (&acc)[2][2][4][2], const pg8::Unit& u, int wr, int wc, int fr, int fq, LAS unsigned char* elds) const {
        const int pm = u.pm, pn = u.pn;
        LAS f32x2* P = (LAS f32x2*)elds;
        LAS f32x2* S = (LAS f32x2*)(elds + 8192);
        stats_to_lds((const f32x2*)(kargs()->ws + WS_PART) + (size_t)pprev * MROWS * 4, pm, S);
        resid<0>(acc, pm, pn, wr, wc, fr, fq, S);
        resid<1>(acc, pm, pn, wr, wc, fr, fq, S);
        asm volatile("" : "+v"(fr), "+v"(fq));
        const KA Params* q = kargs();
        char* ob; unsigned lo;
        if (FINAL) { ob = (char*)(q->out + O_Y + (size_t)(pm * 256 + 128 * wr) * D + 256 * pn + 32 * wc); lo = (unsigned)((8 * fr * D + 4 * fq) * 4); }
        else { ob = (char*)((bf16_t*)(q->ws + WS_H1) + (size_t)(pm * 256 + 64 * wr) * D + 256 * pn + 32 * wc); lo = (unsigned)((fr * D + 4 * fq) * 2); }
        LAS f32x2* Pl = P + (64 * wr + fr) * 4 + wc;
#pragma unroll
        for (int j = 0; j < 8; ++j) {
            const int ai = j >> 2, m = j & 3;
            float sum = 0.f;
#pragma unroll
            for (int bj = 0; bj < 2; ++bj)
#pragma unroll
                for (int n = 0; n < 2; ++n) { const f32x4 vn = acc[ai][bj][m][n]; sum += (vn[0] + vn[1]) + (vn[2] + vn[3]); }
            sum += __shfl_xor(sum, 16); sum += __shfl_xor(sum, 32);
            const float mw = sum * (1.0f / 64.0f); float qq = 0.f;
#pragma unroll
            for (int bj = 0; bj < 2; ++bj)
#pragma unroll
                for (int n = 0; n < 2; ++n) { const f32x4 d = acc[ai][bj][m][n] - mw; qq += (d[0] * d[0] + d[1] * d[1]) + (d[2] * d[2] + d[3] * d[3]); }
            qq += __shfl_xor(qq, 16); qq += __shfl_xor(qq, 32);
            if (fq == 0) { f32x2 t; t.x = mw; t.y = qq; Pl[(128 * ai + 16 * m) * 4] = t; }
#pragma unroll
            for (int bj = 0; bj < 2; ++bj)
#pragma unroll
                for (int n = 0; n < 2; ++n) { const f32x4 vn = acc[ai][bj][m][n];
                    if (FINAL) *(f32x4*)(ob + lo + (unsigned)(((4 * ai + m) * D + 128 * bj + 16 * n) * 4)) = vn;
                    else { u32x2 w; w.x = pk2(vn[0], vn[1]); w.y = pk2(vn[2], vn[3]); *(u32x2*)(ob + lo + (unsigned)(((128 * ai + 16 * m) * D + 128 * bj + 16 * n) * 2)) = w; } }
        }
        asm volatile("s_waitcnt lgkmcnt(0)" ::: "memory"); __builtin_amdgcn_s_barrier(); asm volatile("" ::: "memory");
        int rl = threadIdx.x; asm volatile("" : "+v"(rl));
        if (rl < 256) {
            const f32x2 a = P[rl * 4 + 0], b2 = P[rl * 4 + 1], c2 = P[rl * 4 + 2], d2 = P[rl * 4 + 3];
            const float mt = (a.x + b2.x + c2.x + d2.x) * 0.25f;
            const float da = a.x - mt, db = b2.x - mt, dc = c2.x - mt, dd = d2.x - mt;
            f32x2 r; r.x = mt; r.y = (a.y + b2.y) + (c2.y + d2.y) + 64.0f * ((da * da + db * db) + (dc * dc + dd * dd));
            char* pb = (char*)((f32x2*)(q->ws + WS_PART) + (size_t)pnew * MROWS * 4 + (size_t)pm * 256 * 4 + pn);
            *(f32x2*)(pb + (unsigned)(rl * 32)) = r;
        }
    }
};

struct EpiIn {
    int dummy;
    __device__ __forceinline__ void operator()(f32x4 (&acc)[2][2][4][2], const pg8::Unit& u, int wr, int wc, int fr, int fq, LAS unsigned char* elds) const {
        const int pm = u.pm, pn = u.pn; const bool sample = pm >= NPANEL_P;
        LAS f32x2* S = (LAS f32x2*)(elds + 8192);
        const KA Params* q = kargs(); unsigned char* ws = q->ws;
        stats_to_lds((const f32x2*)(ws + WS_PART) + (size_t)1 * MROWS * 4, pm, S);
        const unsigned lq = (unsigned)(16 * fq);
        { const char* csb = (const char*)((const float*)(ws + WS_CS_IN) + 256 * pn + 32 * wc); const char* cbb = (const char*)((const float*)(ws + WS_CB_IN) + 256 * pn + 32 * wc);
          f32x2 st[8];
#pragma unroll
          for (int j = 0; j < 8; ++j) st[j] = S[128 * (j >> 2) + 64 * wr + 16 * (j & 3) + fr];
#pragma unroll
          for (int bj = 0; bj < 2; ++bj)
#pragma unroll
              for (int n = 0; n < 2; ++n) { const f32x4 csv = *(const f32x4*)(csb + lq + (unsigned)((128 * bj + 16 * n) * 4)), cbv = *(const f32x4*)(cbb + lq + (unsigned)((128 * bj + 16 * n) * 4));
#pragma unroll
                  for (int j = 0; j < 8; ++j) acc[j >> 2][bj][j & 3][n] = acc[j >> 2][bj][j & 3][n] * st[j].x + (csv * st[j].y + cbv);
                  asm volatile("" ::: "memory"); } }
        pin_half<0>(acc); pin_half<1>(acc);
        asm volatile("" : "+v"(fr), "+v"(fq));
        const unsigned lr = (unsigned)((fr * D + 4 * fq) * 2);
        if (pn < 8) {
            char* ub = sample ? (char*)((bf16_t*)(ws + WS_SU) + (size_t)((pm - NPANEL_P) * 256 + 64 * wr) * D + 128 * pn + 32 * wc)
                              : (char*)((bf16_t*)(ws + WS_ACT) + (size_t)(pm * 256 + 64 * wr) * D + 128 * pn + 32 * wc);
#pragma unroll
            for (int n = 0; n < 2; ++n) {
#pragma unroll
                for (int j = 0; j < 8; ++j) { const int ai = j >> 2, m = j & 3; const f32x4 uu = acc[ai][0][m][n] * acc[ai][1][m][n];
                    u32x2 w; w.x = pk2(uu[0], uu[1]); w.y = pk2(uu[2], uu[3]); *(u32x2*)(ub + lr + (unsigned)(((128 * ai + 16 * m) * D + 16 * n) * 2)) = w;
                    if (sample) { if (m >= 2) { const int seq = 64 * (pm - NPANEL_P) + 32 * wr + 2 * fr + ai; *(f32x4*)(q->out + O_CONV_S + ((size_t)seq * 2 + (m - 2)) * D + 128 * pn + 32 * wc + 16 * n + 4 * fq) = uu; } }
                    else if ((pm & 7) == 7 && wr == 1 && fr == 15 && j >= 6) { *(f32x4*)(q->out + O_CONV_P + ((size_t)(pm >> 3) * 2 + (j - 6)) * D + 128 * pn + 32 * wc + 16 * n + 4 * fq) = uu; } } }
        } else {
            char* bb = sample ? (char*)((bf16_t*)(ws + WS_SB) + (size_t)((pm - NPANEL_P) * 256 + 64 * wr) * D + 256 * (pn - 8) + 32 * wc)
                              : (char*)((bf16_t*)(ws + WS_ACT) + (size_t)MROWS * D + (size_t)(pm * 256 + 64 * wr) * D + 256 * (pn - 8) + 32 * wc);
#pragma unroll
            for (int bj = 0; bj < 2; ++bj)
#pragma unroll
                for (int n = 0; n < 2; ++n) {
#pragma unroll
                    for (int j = 0; j < 8; ++j) { const int ai = j >> 2, m = j & 3; const f32x4 v = acc[ai][bj][m][n];
                        u32x2 w; w.x = pk2(v[0], v[1]); w.y = pk2(v[2], v[3]); *(u32x2*)(bb + lr + (unsigned)(((128 * ai + 16 * m) * D + 128 * bj + 16 * n) * 2)) = w; } }
        }
    }
};

struct EpiPartial {
    __device__ __forceinline__ void operator()(f32x4 (&acc)[2][2][4][2], const pg8::UnitD& u) const {
        const int tid = tid_fresh();
        char* pb = (char*)(kargs()->ws + WS_PBUF) + (size_t)((((u.pm - NPANEL_P) * 4 + u.pn) * 4 + u.ks) * 32) * 8192;
#pragma unroll
        for (int ai = 0; ai < 2; ++ai)
#pragma unroll
            for (int bj = 0; bj < 2; ++bj)
#pragma unroll
                for (int m = 0; m < 4; ++m)
#pragma unroll
                    for (int n = 0; n < 2; ++n) *(f32x4*)(pb + (unsigned)(((((ai * 2 + bj) * 4 + m) * 2 + n) * 512 + tid) * 16)) = acc[ai][bj][m][n];
    }
};
__device__ __forceinline__ unsigned* cnt_word(int idx) { return (unsigned*)(kargs()->ws + WS_CNT) + 64 * idx; }
__device__ __forceinline__ int C_UP(int l, int p) { return l * 16 + p; }
__device__ __forceinline__ int C_DNS(int l, int p, int pn) { return l * 16 + 2 + p * 4 + pn; }
__device__ __forceinline__ int C_FIN(int l, int p) { return l * 16 + 10 + p; }
__device__ __forceinline__ int C_OUT(int p) { return 32 + p; }
__device__ __forceinline__ void dep_wait(int idx, unsigned want) {
    int tid = tid_fresh();
    if (tid < 64) {
        unsigned* w = cnt_word(idx); unsigned sp = 0;
        while ((unsigned)__builtin_amdgcn_readfirstlane(__hip_atomic_load(w, __ATOMIC_RELAXED, __HIP_MEMORY_SCOPE_AGENT)) < want) { __builtin_amdgcn_s_sleep(2); if (++sp > (1u << 22)) break; }
        __builtin_amdgcn_fence(__ATOMIC_ACQUIRE, "agent");
        asm volatile("s_waitcnt vmcnt(0)" ::: "memory");
    }
    asm volatile("" ::: "memory"); __builtin_amdgcn_s_barrier(); asm volatile("" ::: "memory");
}
__device__ __forceinline__ void unit_signal(int idx) {
    asm volatile("s_waitcnt vmcnt(0)" ::: "memory"); __builtin_amdgcn_s_barrier(); asm volatile("" ::: "memory");
    if (tid_fresh() == 0) { __builtin_amdgcn_fence(__ATOMIC_RELEASE, "agent"); asm volatile("s_waitcnt vmcnt(0)" ::: "memory");
        __hip_atomic_fetch_add(cnt_word(idx), 1u, __ATOMIC_RELAXED, __HIP_MEMORY_SCOPE_AGENT); }
}

namespace pg8 {
__device__ __forceinline__ void unit_gemm(const UnitD& u, const char*& cA, const char*& cB, int& Kf, int& nt) {
    const KA Params* q = kargs(); unsigned char* ws = q->ws;
    switch (u.kind) {
    case K_UP0: case K_UP1: Kf = D; nt = 16; cA = (const char*)(ws + WS_H1) + (size_t)u.pm * 256 * D * 2; cB = (const char*)(ws + WS_WUP) + ((size_t)(u.kind - K_UP0) * FF2 + (size_t)u.pn * 256) * D * 2; break;
    case K_DN0: case K_DN1: Kf = FF; nt = 44; cA = (const char*)(ws + WS_ACT) + (size_t)u.pm * 256 * FF * 2; cB = (const char*)(ws + WS_WDN) + ((size_t)(u.kind - K_DN0) * D + (size_t)u.pn * 256) * FF * 2; break;
    case K_DNS0: case K_DNS1: { const int k0 = u.ks < 2 ? u.ks * 768 : 1536 + (u.ks - 2) * 640; Kf = FF; nt = u.ks < 2 ? 12 : 10;
        cA = (const char*)(ws + WS_ACT) + ((size_t)u.pm * 256 * FF + k0) * 2; cB = (const char*)(ws + WS_WDN) + (((size_t)(u.kind - K_DNS0) * D + (size_t)u.pn * 256) * FF + k0) * 2; break; }
    case K_IN: Kf = D; nt = 16; cA = (const char*)(ws + WS_H1) + (size_t)u.pm * 256 * D * 2; cB = (const char*)(ws + WS_WIN) + (size_t)u.pn * 256 * D * 2; break;
    default: Kf = D; nt = 16; cA = (const char*)q->out + (size_t)u.pm * 256 * D * 2; cB = (const char*)(ws + WS_WOUT) + (size_t)u.pn * 256 * D * 2; break;
    }
}
template <int KINDS, bool MIXK, class Sched>
__device__ __forceinline__ void gemm_stream(LAS unsigned char* lds, const Sched& S) {
    const int tid = tid_fresh(), wid = __builtin_amdgcn_readfirstlane(tid >> 6), lane = tid & 63, wr = wid >> 2, wc = wid & 3, fr = lane & 15, fq = lane >> 4;
    int Rs[2], Cs[2];
#pragma unroll
    for (int i = 0; i < 2; ++i) stage_rc(tid * 16 + i * 8192, Rs[i], Cs[i]);
    const size_t kstep = (size_t)(BK * 2);
    const unsigned ldsw = (unsigned)wid * 1024u;
    const int aoff = lds_byte(wr * 64 + fr, fq * 8), boff = lds_byte(wc * 32 + fr, fq * 8);
#define PG8_SA(b, h) (((b) * 2 + (h)) * HTB)
#define PG8_SB(b, h) ((4 + (b) * 2 + (h)) * HTB)
#define PG8_STAGE(bufoff, gbase, vo) do { _Pragma("unroll") for (int _i = 0; _i < 2; ++_i) \
        __builtin_amdgcn_global_load_lds((const unsigned*)((const char*)(gbase) + (vo)[_i]), (LAS unsigned*)(lds + (bufoff) + ldsw + _i * 8192), 16, 0, 0); } while (0)
#define PG8_LDA(dst, b, h) do { _Pragma("unroll") for (int m = 0; m < 4; ++m) _Pragma("unroll") for (int k = 0; k < 2; ++k) dst[m][k] = *(const LAS bf16x8*)(lds + PG8_SA(b, h) + aoff + m * 2048 + k * 1024); } while (0)
#define PG8_LDB(dst, b, h) do { _Pragma("unroll") for (int n = 0; n < 2; ++n) _Pragma("unroll") for (int k = 0; k < 2; ++k) dst[n][k] = *(const LAS bf16x8*)(lds + PG8_SB(b, h) + boff + n * 2048 + k * 1024); } while (0)
#define PG8_MMA(ai, bj, At, Bt) do { __builtin_amdgcn_s_setprio(1); _Pragma("unroll") for (int m = 0; m < 4; ++m) _Pragma("unroll") for (int n = 0; n < 2; ++n) _Pragma("unroll") for (int k = 0; k < 2; ++k) \
        acc[ai][bj][m][n] = __builtin_amdgcn_mfma_f32_16x16x32_bf16(Bt[n][k], At[m][k], acc[ai][bj][m][n], 0, 0, 0); __builtin_amdgcn_s_setprio(0); } while (0)
#define PG8_WAIT_V(n) asm volatile("s_waitcnt vmcnt(" #n ")" ::: "memory")
#define PG8_WAIT_L(n) asm volatile("s_waitcnt lgkmcnt(" #n ")" ::: "memory")
#define PG8_BAR __builtin_amdgcn_s_barrier()
#define PG8_SCHED __builtin_amdgcn_sched_barrier(0)
    UnitD cur, nxt; int ui = 0;
    if (!S.next(0, cur)) return;
    const char* cA; const char* cB; int KfC, ntC; unit_gemm(cur, cA, cB, KfC, ntC);
    unsigned voffC[2], voffN[2];
#pragma unroll
    for (int i = 0; i < 2; ++i) { voffC[i] = (unsigned)(Rs[i] * KfC + Cs[i]) * 2u; voffN[i] = voffC[i]; }
    size_t hstepC = (size_t)HALF * KfC * 2, hstepN = hstepC;
    f32x4 acc[2][2][4][2];
#pragma unroll
    for (int a = 0; a < 2; ++a)
#pragma unroll
        for (int b = 0; b < 2; ++b)
#pragma unroll
            for (int m = 0; m < 4; ++m)
#pragma unroll
                for (int n = 0; n < 2; ++n) acc[a][b][m][n] = (f32x4){0.f, 0.f, 0.f, 0.f};
    bf16x8 At[4][2], B0[2][2], B1[2][2];
    if (cur.dep >= 0) dep_wait(cur.dep, (unsigned)cur.want);
    PG8_STAGE(PG8_SB(0, 0), cB, voffC); PG8_STAGE(PG8_SB(0, 1), cB + hstepC, voffC); PG8_STAGE(PG8_SA(0, 0), cA, voffC); PG8_STAGE(PG8_SA(0, 1), cA + hstepC, voffC);
    if (wr == 1) PG8_BAR;
    PG8_WAIT_V(2); PG8_BAR;
    PG8_STAGE(PG8_SB(1, 0), cB + kstep, voffC); PG8_STAGE(PG8_SA(1, 0), cA + kstep, voffC); PG8_STAGE(PG8_SB(1, 1), cB + hstepC + kstep, voffC);
    PG8_WAIT_V(6); PG8_BAR;
    for (;;) {
        const bool has_next = S.next(ui + 1, nxt);
        const char* nA = cA; const char* nB = cB; int KfN = KfC, ntN = ntC;
        if (has_next) unit_gemm(nxt, nA, nB, KfN, ntN);
        if (MIXK) {
#pragma unroll
            for (int i = 0; i < 2; ++i) voffN[i] = (unsigned)(Rs[i] * KfN + Cs[i]) * 2u;
            hstepN = (size_t)HALF * KfN * 2; }
        for (int t = 0; t < ntC; t += 2) {
            const bool last = (t == ntC - 2);
            const char* a1 = cA + (size_t)(t + 1) * kstep;
            const char* a2 = last ? nA : cA + (size_t)(t + 2) * kstep; const char* b2 = last ? nB : cB + (size_t)(t + 2) * kstep;
            const char* a3 = a2 + kstep; const char* b3 = b2 + kstep;
            unsigned vo2[2]; size_t hs2 = hstepC;
#pragma unroll
            for (int i = 0; i < 2; ++i) vo2[i] = voffC[i];
            if (MIXK) { if (last) {
#pragma unroll
                for (int i = 0; i < 2; ++i) vo2[i] = voffN[i];
                hs2 = hstepN; } }
            if (last && has_next && nxt.dep >= 0) dep_wait(nxt.dep, (unsigned)nxt.want);
            PG8_LDB(B0, 0, 0); PG8_LDB(B1, 0, 1); PG8_SCHED; PG8_LDA(At, 0, 0); PG8_STAGE(PG8_SA(1, 1), a1 + hstepC, voffC);
            PG8_WAIT_V(8); PG8_WAIT_L(0); PG8_BAR; PG8_MMA(0, 0, At, B0); PG8_MMA(0, 1, At, B1); PG8_BAR; PG8_SCHED;
            PG8_LDA(At, 0, 1); PG8_STAGE(PG8_SB(0, 0), b2, vo2); PG8_STAGE(PG8_SB(0, 1), b2 + hs2, vo2); PG8_STAGE(PG8_SA(0, 0), a2, vo2);
            PG8_WAIT_V(8); PG8_WAIT_L(0); PG8_BAR; PG8_MMA(1, 0, At, B0); PG8_MMA(1, 1, At, B1); PG8_BAR; PG8_SCHED;
            PG8_LDB(B0, 1, 0); PG8_LDB(B1, 1, 1); PG8_SCHED; PG8_LDA(At, 1, 0); PG8_STAGE(PG8_SA(0, 1), a2 + hs2, vo2);
            PG8_WAIT_V(8); PG8_WAIT_L(0); PG8_BAR; PG8_MMA(0, 0, At, B0); PG8_MMA(0, 1, At, B1); PG8_BAR; PG8_SCHED;
            PG8_LDA(At, 1, 1); PG8_STAGE(PG8_SB(1, 0), b3, vo2); PG8_STAGE(PG8_SB(1, 1), b3 + hs2, vo2); PG8_STAGE(PG8_SA(1, 0), a3, vo2);
            PG8_WAIT_V(8); PG8_WAIT_L(0); PG8_BAR; PG8_MMA(1, 0, At, B0); PG8_MMA(1, 1, At, B1); PG8_BAR; PG8_SCHED;
        }
        if (wr == 0) PG8_BAR;
        { int fr_e = fr, fq_e = fq; asm volatile("" : "+v"(fr_e), "+v"(fq_e));
          const Unit uu{cur.pm, cur.pn}; LAS unsigned char* elds = lds + EPI_OFF;
          if ((KINDS & ((1 << K_UP0) | (1 << K_UP1))) && (cur.kind == K_UP0 || cur.kind == K_UP1)) { EpiUp E{cur.kind - K_UP0}; E(acc, uu, wr, wc, fr_e, fq_e, elds); }
          if ((KINDS & (1 << K_DN0)) && cur.kind == K_DN0) { EpiRes<false> E{0, 1, 5, 0}; E(acc, uu, wr, wc, fr_e, fq_e, elds); }
          if ((KINDS & (1 << K_DN1)) && cur.kind == K_DN1) { EpiRes<true> E{2, 0, 5, D}; E(acc, uu, wr, wc, fr_e, fq_e, elds); }
          if ((KINDS & (1 << K_IN)) && cur.kind == K_IN) { EpiIn E{0}; E(acc, uu, wr, wc, fr_e, fq_e, elds); }
          if ((KINDS & (1 << K_OUT)) && cur.kind == K_OUT) { EpiRes<false> E{1, 2, 17, 0}; E(acc, uu, wr, wc, fr_e, fq_e, elds); }
          if ((KINDS & ((1 << K_DNS0) | (1 << K_DNS1))) && (cur.kind == K_DNS0 || cur.kind == K_DNS1)) { EpiPartial E; E(acc, cur); }
          if (cur.sig >= 0) unit_signal(cur.sig); }
        if (!has_next) break;
#pragma unroll
        for (int a = 0; a < 2; ++a)
#pragma unroll
            for (int b = 0; b < 2; ++b)
#pragma unroll
                for (int m = 0; m < 4; ++m)
#pragma unroll
                    for (int n = 0; n < 2; ++n) acc[a][b][m][n] = (f32x4){0.f, 0.f, 0.f, 0.f};
        cur = nxt; cA = nA; cB = nB; KfC = KfN; ntC = ntN; ++ui;
        if (MIXK) {
#pragma unroll
            for (int i = 0; i < 2; ++i) voffC[i] = voffN[i];
            hstepC = hstepN; }
        if (wr == 1) PG8_BAR;
    }
    PG8_WAIT_V(0);
    PG8_BAR;
#undef PG8_SA
#undef PG8_SB
#undef PG8_STAGE
#undef PG8_LDA
#undef PG8_LDB
#undef PG8_MMA
#undef PG8_WAIT_V
#undef PG8_WAIT_L
#undef PG8_BAR
#undef PG8_SCHED
}
struct SchedSimple {
    int kind, nM, nN, G, c;
    __device__ __forceinline__ bool next(int i, UnitD& u) const {
        const long L = (long)i * G + c; if (L >= (long)nM * nN) return false;
        u.kind = kind; map_unit((int)L, nM, nN, u.pm, u.pn); u.ks = 0; u.dep = -1; u.want = 0; u.sig = -1; return true; }
};
struct SchedUp {
    int l, c, first, count, gpos; UnitD guest;
    __device__ __forceinline__ void init(int l_, int c_) {
        l = l_; c = c_; first = 0; count = 6; gpos = -1; guest.kind = 0; guest.pm = 0; guest.pn = 0; guest.ks = 0; guest.dep = -1; guest.want = 0; guest.sig = -1;
        const int lc = c - 128; if (lc < 0) return;
        if (l == 0) {
            if (lc < 44) { gpos = 0; guest.kind = K_UP0; guest.pm = NPANEL_P + lc / 22; guest.pn = lc % 22; guest.sig = C_UP(0, lc / 22); }
            else if (lc < 76) { const int ix = lc - 44, p = ix >> 4; gpos = 2; guest.kind = K_DNS0; guest.pm = NPANEL_P + p; guest.pn = (ix >> 2) & 3; guest.ks = ix & 3; guest.dep = C_UP(0, p); guest.want = 22; guest.sig = C_DNS(0, p, guest.pn); }
            else if (lc < 84) { }
            else if (lc < 108) { const int ix = lc - 84, p = ix / 12; gpos = 5; guest.kind = K_IN; guest.pm = NPANEL_P + p; guest.pn = ix % 12; guest.dep = C_FIN(0, p); guest.want = 4; }
        } else {
            if (lc < 8) { gpos = 0; guest.kind = K_OUT; guest.pm = NPANEL_P + (lc >> 2); guest.pn = lc & 3; guest.sig = C_OUT(lc >> 2); }
            else if (lc < 52) { const int ix = lc - 8, p = ix / 22; gpos = 2; guest.kind = K_UP1; guest.pm = NPANEL_P + p; guest.pn = ix % 22; guest.dep = C_OUT(p); guest.want = 4; guest.sig = C_UP(1, p); }
            else if (lc < 84) { const int ix = lc - 52, p = ix >> 4; gpos = 4; guest.kind = K_DNS1; guest.pm = NPANEL_P + p; guest.pn = (ix >> 2) & 3; guest.ks = ix & 3; guest.dep = C_UP(1, p); guest.want = 22; guest.sig = C_DNS(1, p, guest.pn); }
        }
    }
    __device__ __forceinline__ bool next(int i, UnitD& u) const {
        if (i >= count) return false;
        const int pos = first + i; int ip = pos;
        if (gpos >= 0) { if (pos == gpos) { u = guest; return true; } if (pos > gpos) ip = pos - 1; }
        const int L = ip * 256 + c; if (L >= NPANEL_P * 22) return false;
        u.kind = l == 0 ? K_UP0 : K_UP1; map_unit(L, NPANEL_P, 22, u.pm, u.pn); u.ks = 0; u.dep = -1; u.want = 0; u.sig = -1; return true; }
};
}

template <int L_> __device__ __forceinline__ void finisher(LAS unsigned char* lds, int p, int pn) {
    dep_wait(C_DNS(L_, p, pn), 4u);
    const int tid = tid_fresh(), wid = __builtin_amdgcn_readfirstlane(tid >> 6), lane = tid & 63, wr = wid >> 2, wc = wid & 3, fr = lane & 15, fq = lane >> 4;
    f32x4 acc[2][2][4][2];
    const char* pb = (const char*)(kargs()->ws + WS_PBUF) + (size_t)(((p * 4 + pn) * 4) * 32) * 8192;
#pragma unroll
    for (int ai = 0; ai < 2; ++ai)
#pragma unroll
        for (int bj = 0; bj < 2; ++bj)
#pragma unroll
            for (int m = 0; m < 4; m += 2) {
#pragma unroll
                for (int mm = 0; mm < 2; ++mm)
#pragma unroll
                    for (int n = 0; n < 2; ++n) { const unsigned o = (unsigned)(((((ai * 2 + bj) * 4 + m + mm) * 2 + n) * 512 + tid) * 16);
                        acc[ai][bj][m + mm][n] = (*(const f32x4*)(pb + o) + *(const f32x4*)(pb + o + 262144u)) + (*(const f32x4*)(pb + o + 2u * 262144u) + *(const f32x4*)(pb + o + 3u * 262144u)); }
                asm volatile("" : "+v"(acc[ai][bj][m][0]), "+v"(acc[ai][bj][m][1]), "+v"(acc[ai][bj][m + 1][0]), "+v"(acc[ai][bj][m + 1][1]) :: "memory"); }
    const pg8::Unit uu{NPANEL_P + p, pn};
    if (L_ == 0) { EpiRes<false> E{0, 1, 5, 0}; E(acc, uu, wr, wc, fr, fq, lds + EPI_OFF); unit_signal(C_FIN(0, p)); }
    else { EpiRes<true> E{2, 0, 5, D}; E(acc, uu, wr, wc, fr, fq, lds + EPI_OFF); }
    asm volatile("s_waitcnt vmcnt(0) lgkmcnt(0)" ::: "memory"); __syncthreads();
}

__device__ __forceinline__ void p0_item(const float* W, int K, int N, int kb, int nb, bf16_t* WT, int dest_row0, const float* rowscale, const float* colscale,
                                        float* csp, const float* bvec, float* cbp, int pstride, LAS float* scr, int lane) {
    const int k0 = 64 * kb, n0 = 32 * nb;
#pragma unroll 8
    for (int i = 0; i < 32; ++i) { const int kk = 2 * i + (lane >> 5); scr[kk * 33 + (lane & 31)] = W[(size_t)(k0 + kk) * N + n0 + (lane & 31)]; }
    asm volatile("s_waitcnt lgkmcnt(0)" ::: "memory");
    const int c = lane & 7;
    float rs[8], bb[8];
#pragma unroll
    for (int i = 0; i < 8; ++i) { rs[i] = rowscale ? rowscale[k0 + 8 * c + i] : 1.0f; bb[i] = bvec ? bvec[k0 + 8 * c + i] : 0.0f; }
#pragma unroll
    for (int j = 0; j < 4; ++j) { const int n = (lane >> 3) + 8 * j; const LAS float* s = scr + (8 * c) * 33 + n;
        const float sc = colscale ? colscale[n0 + n] : 1.0f;
        unsigned r[8]; float ps = 0.f, pb = 0.f;
#pragma unroll
        for (int i = 0; i < 8; ++i) { const float w = s[i * 33]; r[i] = f2bf(w * rs[i] * sc); ps += bf2f(r[i]); pb += w * bb[i]; }
        u32x4 o; o.x = r[0] | (r[1] << 16); o.y = r[2] | (r[3] << 16); o.z = r[4] | (r[5] << 16); o.w = r[6] | (r[7] << 16);
        *(u32x4*)(WT + (size_t)(dest_row0 + n) * K + k0 + 8 * c) = o;
        if (csp) {
            ps += __shfl_xor(ps, 1); ps += __shfl_xor(ps, 2); ps += __shfl_xor(ps, 4);
            pb += __shfl_xor(pb, 1); pb += __shfl_xor(pb, 2); pb += __shfl_xor(pb, 4);
            if (c == 0) { csp[(size_t)kb * pstride + dest_row0 + n] = ps; cbp[(size_t)kb * pstride + dest_row0 + n] = pb; }
        }
    }
    asm volatile("s_waitcnt lgkmcnt(0)" ::: "memory");
}
__device__ __forceinline__ int up_dest(int n) { return n < FF ? 256 * (n >> 7) + (n & 127) : 256 * ((n - FF) >> 7) + 128 + ((n - FF) & 127); }
__device__ __forceinline__ int in_dest(int n) { return n < D ? 2048 + n : (n < 2 * D ? 256 * ((n - D) >> 7) + ((n - D) & 127) : 256 * ((n - 2 * D) >> 7) + 128 + ((n - 2 * D) & 127)); }

__device__ __forceinline__ void phase0(LAS unsigned char* lds) {
    const KA Params* q = kargs();
    const int tid = tid_fresh(), lane = tid & 63, wave = tid >> 6;
    LAS float* scr = (LAS float*)(lds + wave * 8704);
    const int gw = blockIdx.x * 8 + wave, NGW = gridDim.x * 8;
    unsigned char* ws = q->ws;
    constexpr int I_UP = 16 * 176, I_IN = 16 * 96, I_OUT = 16 * 32, I_DN = 44 * 32, I_POOL = 4 * 8;
    constexpr int NITEMS = 2 * I_UP + I_IN + I_OUT + 2 * I_DN + 4 * I_POOL;
    for (int it = gw; it < NITEMS; it += NGW) {
        int r = it;
        if (r < 2 * I_UP) { const int l = r / I_UP; r -= l * I_UP; const int kb = r / 176, nb = r % 176;
            p0_item(q->in[13] + (size_t)l * D * FF2, D, FF2, kb, nb, (bf16_t*)(ws + WS_WUP) + (size_t)l * FF2 * D, up_dest(32 * nb), q->in[5] + l * D, nullptr,
                    (float*)(ws + WS_CSP_UP) + (size_t)l * 16 * FF2, q->in[6] + l * D, (float*)(ws + WS_CBP_UP) + (size_t)l * 16 * FF2, FF2, scr, lane); continue; }
        r -= 2 * I_UP;
        if (r < I_IN) { const int kb = r / 96, nb = r % 96;
            p0_item(q->in[9], D, 3 * D, kb, nb, (bf16_t*)(ws + WS_WIN), in_dest(32 * nb), q->in[17], nullptr, (float*)(ws + WS_CSP_IN), q->in[18], (float*)(ws + WS_CBP_IN), 3 * D, scr, lane); continue; }
        r -= I_IN;
        if (r < I_OUT) { const int kb = r / 32, nb = r % 32;
            p0_item(q->in[12], D, D, kb, nb, (bf16_t*)(ws + WS_WOUT), 32 * nb, nullptr, nullptr, nullptr, nullptr, nullptr, 0, scr, lane); continue; }
        r -= I_OUT;
        if (r < 2 * I_DN) { const int l = r / I_DN; r -= l * I_DN; const int kb = r / 32, nb = r % 32;
            p0_item(q->in[16] + (size_t)l * FF * D, FF, D, kb, nb, (bf16_t*)(ws + WS_WDN) + (size_t)l * D * FF, 32 * nb, nullptr, nullptr, nullptr, nullptr, nullptr, 0, scr, lane); continue; }
        r -= 2 * I_DN;
        { const int g = r / I_POOL; r -= g * I_POOL; const int kb = r / 8, nb = r % 8;
            p0_item(q->in[7] + (size_t)g * 256 * 256, 256, 256, kb, nb, (bf16_t*)(ws + WS_WPOOL) + (size_t)g * 256 * 256, 32 * nb, nullptr, q->in[8] + g * 256, nullptr, nullptr, nullptr, 0, scr, lane); }
    }
    const int gt = blockIdx.x * 512 + tid, NGT = gridDim.x * 512;
    for (int i = gt; i < 2 * FF2; i += NGT) { const int l = i / FF2, n = i % FF2, d = up_dest(n); float* kc = (float*)(ws + WS_KC_UP) + (size_t)l * 4 * FF2;
        kc[d] = q->in[14][(size_t)(l * 3 + 0) * FF2 + n]; kc[FF2 + d] = q->in[14][(size_t)(l * 3 + 1) * FF2 + n]; kc[2 * FF2 + d] = q->in[14][(size_t)(l * 3 + 2) * FF2 + n]; kc[3 * FF2 + d] = q->in[15][(size_t)l * FF2 + n]; }
    for (int i = gt; i < NB_P * 15 * (D / 4); i += NGT) { const int c4 = i % (D / 4), rr = (i / (D / 4)) % 15, b = i / (15 * (D / 4));
        ((f32x4*)(q->out + O_POOL_P))[i] = *(const f32x4*)(q->in[0] + ((size_t)b * SEQ + 2033 + rr) * D + c4 * 4); }
    for (int i = gt; i < NB_S * 15 * (D / 4); i += NGT) { const int c4 = i % (D / 4), rr = (i / (D / 4)) % 15, s = i / (15 * (D / 4));
        ((f32x4*)(q->out + O_POOL_S))[i] = rr < 11 ? *(const f32x4*)(q->in[2] + ((size_t)s * 15 + 4 + rr) * D + c4 * 4) : *(const f32x4*)(q->in[1] + ((size_t)s * TS + rr - 11) * D + c4 * 4); }
}

template <int W>
__device__ __forceinline__ void p1_window_prompt(const float* xseq, int tpos0, LAS unsigned char* lds, int row0, int cq) {
    f32x4 a[16 + W];
#pragma unroll
    for (int k = 0; k < 16 + W; ++k) { const int t = tpos0 - W + k, tc = t < 0 ? 0 : t; const f32x4 v = *(const f32x4*)(xseq + (size_t)tc * D); a[k] = t >= 0 ? v : (f32x4){0.f, 0.f, 0.f, 0.f}; }
    f32x4 s = {0.f, 0.f, 0.f, 0.f};
#pragma unroll
    for (int k = 0; k < W; ++k) s += a[k];
#pragma unroll
    for (int j = 0; j < 16; ++j) { s += a[W + j] - a[j]; const int t = tpos0 + j; const float inv = 1.0f / (float)(t + 1 < W ? t + 1 : W); const f32x4 d = s * inv - a[W + j];
        const int row = row0 + j; u32x2 w; w.x = pk2(d[0], d[1]); w.y = pk2(d[2], d[3]);
        *(LAS u32x2*)(lds + row * 2048 + ((((cq >> 1) ^ (row & 15))) << 4) + (cq & 1) * 8) = w; }
}
template <int W>
__device__ __forceinline__ void p1_window_sample(const float* hist, const float* xs, LAS unsigned char* lds, int row0, int cq) {
    f32x4 a[W + 4];
#pragma unroll
    for (int k = 0; k < W; ++k) { const int i = W - k; a[k] = i <= 15 ? *(const f32x4*)(hist + (size_t)(15 - i) * D) : (f32x4){0.f, 0.f, 0.f, 0.f}; }
#pragma unroll
    for (int t = 0; t < 4; ++t) a[W + t] = *(const f32x4*)(xs + (size_t)t * D);
    f32x4 s = {0.f, 0.f, 0.f, 0.f};
#pragma unroll
    for (int k = 0; k < W; ++k) s += a[k];
#pragma unroll
    for (int t = 0; t < 4; ++t) { s += a[W + t] - a[t]; const f32x4 d = s * (1.0f / (float)W) - a[W + t];
        const int row = row0 + t; u32x2 w; w.x = pk2(d[0], d[1]); w.y = pk2(d[2], d[3]);
        *(LAS u32x2*)(lds + row * 2048 + ((((cq >> 1) ^ (row & 15))) << 4) + (cq & 1) * 8) = w; }
}
__device__ __forceinline__ void phase1(LAS unsigned char* lds) {
    const KA Params* q = kargs();
    const int tid = tid_fresh(), lane = tid & 63, wave = __builtin_amdgcn_readfirstlane(tid >> 6), fr = lane & 15, fq = lane >> 4;
    unsigned char* ws = q->ws;
    { const int gt = blockIdx.x * 512 + tid, NGT = gridDim.x * 512;
      for (int i = gt; i < 2 * FF2 + 3 * D; i += NGT) {
          float s = 0.f, b = 0.f;
          if (i < 2 * FF2) { const int l = i / FF2, c = i % FF2; const float* sp = (const float*)(ws + WS_CSP_UP) + (size_t)l * 16 * FF2 + c; const float* bp = (const float*)(ws + WS_CBP_UP) + (size_t)l * 16 * FF2 + c;
              for (int k = 0; k < 16; ++k) { s += sp[(size_t)k * FF2]; b += bp[(size_t)k * FF2]; }
              ((float*)(ws + WS_CS_UP))[i] = s; ((float*)(ws + WS_CB_UP))[i] = b; }
          else { const int c = i - 2 * FF2; const float* sp = (const float*)(ws + WS_CSP_IN) + c; const float* bp = (const float*)(ws + WS_CBP_IN) + c;
              for (int k = 0; k < 16; ++k) { s += sp[(size_t)k * 3 * D]; b += bp[(size_t)k * 3 * D]; }
              ((float*)(ws + WS_CS_IN))[c] = s; ((float*)(ws + WS_CB_IN))[c] = b; } } }
    const bf16_t* wpool = (const bf16_t*)(ws + WS_WPOOL);
    bf16_t* vbf = (bf16_t*)(ws + WS_H1);
    f32x2* part = (f32x2*)(ws + WS_PART);
    LAS f32x2* T = (LAS f32x2*)(lds + P1_T_OFF);
    const int cq = tid & 255, th = __builtin_amdgcn_readfirstlane(tid >> 8), gw = (wave & 3);
    const int g = wave >> 1, hh = wave & 1;
    for (int tile = blockIdx.x; tile < NTOK_P / 64; tile += gridDim.x) {
        const int tok0 = tile * 64, t0 = tok0 & (SEQ - 1);
        const bool host = (tile & 3) == 0; const int seq0 = 2 * (tile >> 2);
        { const float* xseq = q->in[0] + (size_t)(tok0 - t0) * D + 4 * cq;
#pragma unroll 1
          for (int st = 0; st < 2; ++st) { const int r0 = 32 * th + 16 * st;
              if (gw == 0) p1_window_prompt<2>(xseq, t0 + r0, lds, r0, cq); else if (gw == 1) p1_window_prompt<4>(xseq, t0 + r0, lds, r0, cq);
              else if (gw == 2) p1_window_prompt<8>(xseq, t0 + r0, lds, r0, cq); else p1_window_prompt<16>(xseq, t0 + r0, lds, r0, cq); }
          if (host) { const float* hist = q->in[2] + (size_t)(seq0 + th) * 15 * D + 4 * cq; const float* xs = q->in[1] + (size_t)(seq0 + th) * TS * D + 4 * cq;
              if (gw == 0) p1_window_sample<2>(hist, xs, lds, 64 + 4 * th, cq); else if (gw == 1) p1_window_sample<4>(hist, xs, lds, 64 + 4 * th, cq);
              else if (gw == 2) p1_window_sample<8>(hist, xs, lds, 64 + 4 * th, cq); else p1_window_sample<16>(hist, xs, lds, 64 + 4 * th, cq); } }
        float rsum[5], rsq[5];
#pragma unroll
        for (int mb = 0; mb < 5; ++mb) { rsum[mb] = 0.f; rsq[mb] = 0.f; }
#pragma unroll 1
        for (int half = 0; half < 2; ++half) {
            f32x4 acc[5][4];
#pragma unroll
            for (int mb = 0; mb < 5; ++mb)
#pragma unroll
                for (int nb = 0; nb < 4; ++nb) acc[mb][nb] = (f32x4){0.f, 0.f, 0.f, 0.f};
            const bf16_t* wb = wpool + ((size_t)g * 256 + 128 * hh + 64 * half + fr) * 256 + 8 * fq;
#pragma unroll 1
            for (int kh = 0; kh < 2; ++kh) {
                bf16x8 b[4][4];
#pragma unroll
                for (int ks = 0; ks < 4; ++ks)
#pragma unroll
                    for (int nb = 0; nb < 4; ++nb) b[ks][nb] = *(const bf16x8*)(wb + (size_t)(16 * nb) * 256 + 32 * (4 * kh + ks));
                if (half == 0 && kh == 0) __syncthreads();
#pragma unroll
                for (int ks = 0; ks < 4; ++ks) {
                    const int chunk = 32 * g + 4 * (4 * kh + ks) + fq;
                    bf16x8 a[5];
#pragma unroll
                    for (int mb = 0; mb < 5; ++mb) { const int row = mb < 4 ? 16 * mb + fr : 64 + (fr & 7); a[mb] = *(const LAS bf16x8*)(lds + row * 2048 + ((chunk ^ (row & 15)) << 4)); }
#pragma unroll
                    for (int mb = 0; mb < 4; ++mb)
#pragma unroll
                        for (int nb = 0; nb < 4; ++nb) acc[mb][nb] = __builtin_amdgcn_mfma_f32_16x16x32_bf16(b[ks][nb], a[mb], acc[mb][nb], 0, 0, 0);
                    if (host) {
#pragma unroll
                        for (int nb = 0; nb < 4; ++nb) acc[4][nb] = __builtin_amdgcn_mfma_f32_16x16x32_bf16(b[ks][nb], a[4], acc[4][nb], 0, 0, 0); }
                }
            }
            const int c0 = 256 * g + 128 * hh + 64 * half + 4 * fq;
#pragma unroll
            for (int mb = 0; mb < 5; ++mb) {
                if (mb == 4 && (!host || fr >= 8)) continue;
                const int tok = mb < 4 ? tok0 + 16 * mb + fr : NTOK_P + 4 * seq0 + fr, R = row_of_tok(tok);
                const float* xr = (mb < 4 ? q->in[0] + (size_t)tok * D : q->in[1] + (size_t)(tok - NTOK_P) * D) + c0;
                f32x4 xv[4];
#pragma unroll
                for (int nb = 0; nb < 4; ++nb) xv[nb] = *(const f32x4*)(xr + 16 * nb);
#pragma unroll
                for (int nb = 0; nb < 4; ++nb) { const f32x4 v = xv[nb] * ALPHA + acc[mb][nb];
                    rsum[mb] += (v[0] + v[1]) + (v[2] + v[3]); rsq[mb] += (v[0] * v[0] + v[1] * v[1]) + (v[2] * v[2] + v[3] * v[3]);
                    u32x2 wv; wv.x = pk2(v[0], v[1]); wv.y = pk2(v[2], v[3]); *(u32x2*)(vbf + (size_t)R * D + c0 + 16 * nb) = wv; }
            }
        }
#pragma unroll
        for (int mb = 0; mb < 5; ++mb) {
            float sum = rsum[mb], sq = rsq[mb];
            sum += __shfl_xor(sum, 16); sum += __shfl_xor(sum, 32); sq += __shfl_xor(sq, 16); sq += __shfl_xor(sq, 32);
            if (fq == 0 && (mb < 4 || fr < 8)) { f32x2 t; t.x = sum; t.y = sq; T[(mb < 4 ? 16 * mb + fr : 64 + fr) * 8 + wave] = t; }
        }
        __syncthreads();
        if (tid < 4 * (host ? 72 : 64)) { const int row = tid >> 2, gg = tid & 3; const f32x2 a = T[row * 8 + 2 * gg], b = T[row * 8 + 2 * gg + 1];
            const float mt = (a.x + b.x) * (1.0f / 256.0f); f32x2 r; r.x = mt; r.y = (a.y + b.y) - 256.0f * mt * mt;
            const int tok = row < 64 ? tok0 + row : NTOK_P + 4 * seq0 + (row - 64);
            part[(size_t)row_of_tok(tok) * 4 + gg] = r; }
        __syncthreads();
    }
}

__device__ __forceinline__ void phase_fixup(int l) {
    const KA Params* q = kargs();
    const float* kc = (const float*)(q->ws + WS_KC_UP) + (size_t)l * 4 * FF2; bf16_t* act = (bf16_t*)(q->ws + WS_ACT);
    const float* Hf = (const float*)(q->ws + WS_HF); const float* Hl = (const float*)(q->ws + WS_HL);
    const int gt = blockIdx.x * 512 + tid_fresh(), NGT = gridDim.x * 512;
    for (int i = gt; i < 128 * (FF / 4); i += NGT) {
        const int q = i / (FF / 4), f = (i % (FF / 4)) * 4;
        if ((q & 15) == 0) continue;
        const int cg_ = 256 * (f >> 7) + (f & 127), cv_ = cg_ + 128;
        const float* hf = Hf + (size_t)q * 2 * FF2; const float* hl = Hl + (size_t)(q - 1) * 2 * FF2;
        const f32x4 k0g = *(const f32x4*)(kc + cg_), k1g = *(const f32x4*)(kc + FF2 + cg_), k2g = *(const f32x4*)(kc + 2 * FF2 + cg_), kbg = *(const f32x4*)(kc + 3 * FF2 + cg_);
        const f32x4 k0v = *(const f32x4*)(kc + cv_), k1v = *(const f32x4*)(kc + FF2 + cv_), k2v = *(const f32x4*)(kc + 2 * FF2 + cv_), kbv = *(const f32x4*)(kc + 3 * FF2 + cv_);
        const f32x4 g2 = *(const f32x4*)(hl + cg_), g1 = *(const f32x4*)(hl + FF2 + cg_), a0 = *(const f32x4*)(hf + cg_), a1 = *(const f32x4*)(hf + FF2 + cg_);
        const f32x4 v2 = *(const f32x4*)(hl + cv_), v1 = *(const f32x4*)(hl + FF2 + cv_), b0 = *(const f32x4*)(hf + cv_), b1 = *(const f32x4*)(hf + FF2 + cv_);
        const f32x4 zg0 = k2g * a0 + k1g * g1 + k0g * g2 + kbg, zv0 = k2v * b0 + k1v * v1 + k0v * v2 + kbv;
        const f32x4 zg1 = k2g * a1 + k1g * a0 + k0g * g1 + kbg, zv1 = k2v * b1 + k1v * b0 + k0v * v1 + kbv;
        const int R0 = (q >> 1) * 256 + 64 * (q & 1);
        u32x2 w0, w1; w0.x = pk2(silu_mul(zg0[0], zv0[0]), silu_mul(zg0[1], zv0[1])); w0.y = pk2(silu_mul(zg0[2], zv0[2]), silu_mul(zg0[3], zv0[3]));
        w1.x = pk2(silu_mul(zg1[0], zv1[0]), silu_mul(zg1[1], zv1[1])); w1.y = pk2(silu_mul(zg1[2], zv1[2]), silu_mul(zg1[3], zv1[3]));
        *(u32x2*)(act + (size_t)R0 * FF + f) = w0; *(u32x2*)(act + (size_t)(R0 + 16) * FF + f) = w1;
    }
}

__device__ __forceinline__ void phase_conv() {
    const KA Params* q = kargs();
    bf16_t* obuf = (bf16_t*)q->out;
    const float* ck = q->in[10]; const float* ckb = q->in[11]; const float* st = q->in[3];
    const int gt = blockIdx.x * 512 + tid_fresh(), NGT = gridDim.x * 512;
    for (int i = gt; i < MROWS * (D / 8); i += NGT) {
        const int tok = i >> 7, ch = (i & 127) * 8;
        int t, seq = 0; const bool sample = tok >= NTOK_P;
        if (!sample) t = tok & (SEQ - 1); else { seq = (tok - NTOK_P) >> 2; t = tok & 3; }
        const bf16_t* ubuf = sample ? (const bf16_t*)(q->ws + WS_SU) - (size_t)NTOK_P * D : (const bf16_t*)(q->ws + WS_ACT);
        const bf16_t* bbuf = sample ? (const bf16_t*)(q->ws + WS_SB) - (size_t)NTOK_P * D : (const bf16_t*)(q->ws + WS_ACT) + (size_t)MROWS * D;
        const int R = row_of_tok(tok);
        float u0[8], u1[8], u2[8], bb[8];
        { const u32x4 w = *(const u32x4*)(ubuf + (size_t)R * D + ch); const u32x4 wb = *(const u32x4*)(bbuf + (size_t)R * D + ch);
#pragma unroll
          for (int e = 0; e < 4; ++e) { u2[2 * e] = bf2f(w[e] & 0xffffu); u2[2 * e + 1] = bf2f(w[e] >> 16); bb[2 * e] = bf2f(wb[e] & 0xffffu); bb[2 * e + 1] = bf2f(wb[e] >> 16); } }
        if (t >= 1) { const u32x4 w = *(const u32x4*)(ubuf + (size_t)row_of_tok(tok - 1) * D + ch);
#pragma unroll
            for (int e = 0; e < 4; ++e) { u1[2 * e] = bf2f(w[e] & 0xffffu); u1[2 * e + 1] = bf2f(w[e] >> 16); } }
        else if (sample) { const f32x4 a = *(const f32x4*)(st + ((size_t)seq * 2 + 1) * D + ch), b = *(const f32x4*)(st + ((size_t)seq * 2 + 1) * D + ch + 4);
#pragma unroll
            for (int e = 0; e < 4; ++e) { u1[e] = a[e]; u1[4 + e] = b[e]; } }
        else {
#pragma unroll
            for (int e = 0; e < 8; ++e) u1[e] = 0.f; }
        if (t >= 2) { const u32x4 w = *(const u32x4*)(ubuf + (size_t)row_of_tok(tok - 2) * D + ch);
#pragma unroll
            for (int e = 0; e < 4; ++e) { u0[2 * e] = bf2f(w[e] & 0xffffu); u0[2 * e + 1] = bf2f(w[e] >> 16); } }
        else if (sample) { const f32x4 a = *(const f32x4*)(st + ((size_t)seq * 2 + t) * D + ch), b = *(const f32x4*)(st + ((size_t)seq * 2 + t) * D + ch + 4);
#pragma unroll
            for (int e = 0; e < 4; ++e) { u0[e] = a[e]; u0[4 + e] = b[e]; } }
        else {
#pragma unroll
            for (int e = 0; e < 8; ++e) u0[e] = 0.f; }
        float o[8];
#pragma unroll
        for (int e = 0; e < 8; ++e) o[e] = bb[e] * (ck[ch + e] * u0[e] + ck[D + ch + e] * u1[e] + ck[2 * D + ch + e] * u2[e] + ckb[ch + e]);
        u32x4 w; w.x = pk2(o[0], o[1]); w.y = pk2(o[2], o[3]); w.z = pk2(o[4], o[5]); w.w = pk2(o[6], o[7]);
        *(u32x4*)(obuf + (size_t)R * D + ch) = w;
    }
}

__device__ __forceinline__ void phase_final() {
    const KA Params* q = kargs();
    const f32x2* part = (const f32x2*)(q->ws + WS_PART); const float* g = q->in[17] + D; const float* b = q->in[18] + D;
    const int tid = tid_fresh(), lane = tid & 63, gw = blockIdx.x * 8 + (tid >> 6), NGW = gridDim.x * 8;
    f32x4 gv[4], bv[4];
#pragma unroll
    for (int j = 0; j < 4; ++j) { gv[j] = *(const f32x4*)(g + 256 * j + 4 * lane); bv[j] = *(const f32x4*)(b + 256 * j + 4 * lane); }
    for (int tok = gw; tok < MROWS; tok += NGW) {
        const f32x2 s = row_stats(part, row_of_tok(tok));
        float* yr = q->out + (size_t)tok * D + 4 * lane;
#pragma unroll
        for (int j = 0; j < 4; ++j) { const f32x4 v = *(const f32x4*)(yr + 256 * j); *(f32x4*)(yr + 256 * j) = ((v - s.x) * s.y) * gv[j] + bv[j]; }
    }
}

#define XB_TMO      128
#define XB_XCNT(j)  (256  + 64 * (j))
#define XB_XSUB(j)  (1280 + 64 * (j))
#define XB_XGEN(j)  (2304 + 64 * (j))
#define XB_TOP      3328
#define XB_TOPGEN   3392
#define XCD_BAR_WORDS 3456
#define XB_SPIN_CAP (1u << 18)

__device__ __forceinline__ unsigned xb_ld(unsigned* p)              { return __hip_atomic_load(p, __ATOMIC_RELAXED, __HIP_MEMORY_SCOPE_AGENT); }
__device__ __forceinline__ unsigned xb_add(unsigned* p, unsigned v) { return __hip_atomic_fetch_add(p, v, __ATOMIC_RELAXED, __HIP_MEMORY_SCOPE_AGENT); }
__device__ __forceinline__ unsigned xb_xcc_id() { return (unsigned)__builtin_amdgcn_s_getreg((3 << 11) | 20) & 0xFu; }
#define XB_SPIN(cond, bar) do { unsigned _sp = 0; while (cond) { __builtin_amdgcn_s_sleep(1); \
    if ((++_sp & 255u) == 0u) { if (xb_ld(&(bar)[XB_TMO])) break; if (_sp > XB_SPIN_CAP) { atomicAdd(&(bar)[XB_TMO], 1u); break; } } } } while (0)

struct XcdBarrier {
    unsigned* bar; unsigned x;
    volatile LAS unsigned* st;
};

__device__ __forceinline__ XcdBarrier xcd_barrier_post(unsigned* bar, volatile LAS unsigned* st) {
    XcdBarrier b; b.bar = bar; b.x = xb_xcc_id(); b.st = st;
    if (threadIdx.x == 0) (void)xb_add(&bar[XB_XCNT(b.x)], 1u);
    return b;
}
__device__ __forceinline__ void xcd_barrier_complete(unsigned* bar, unsigned x, unsigned& nloc, unsigned& nx) {
    const unsigned G = gridDim.x * gridDim.y * gridDim.z;
    unsigned sum, cnt, mine, sp = 0u;
    for (;;) {
        sum = 0u; cnt = 0u; mine = 0u;
#pragma unroll
        for (unsigned j = 0; j < 16; ++j) { const unsigned c = xb_ld(&bar[XB_XCNT(j)]); sum += c; cnt += (c > 0u) ? 1u : 0u; mine = (j == x) ? c : mine; }
        if (sum == G) break;
        __builtin_amdgcn_s_sleep(1);
        if ((++sp & 255u) == 0u) { if (xb_ld(&bar[XB_TMO])) break; if (sp > XB_SPIN_CAP) { atomicAdd(&bar[XB_TMO], 1u); break; } }
    }
    nloc = mine > 0u ? mine : 1u; nx = cnt > 0u ? cnt : 1u;
}

__device__ __forceinline__ void xcd_barrier(const XcdBarrier& b) {
    asm volatile("s_waitcnt vmcnt(0)" ::: "memory");
    __syncthreads();
    if (threadIdx.x == 0) {
        unsigned* bar = b.bar;
        __builtin_amdgcn_s_waitcnt(0);
        unsigned nloc = b.st[0], nx = b.st[1];
        if (nloc == 0u) { xcd_barrier_complete(bar, b.x, nloc, nx); b.st[0] = nloc; b.st[1] = nx; }
        const unsigned old = xb_add(&bar[XB_XSUB(b.x)], 1u);
        const unsigned gen = old / nloc;
        if (old + 1u == (gen + 1u) * nloc) {
            __builtin_amdgcn_fence(__ATOMIC_RELEASE, "agent");
            asm volatile("s_waitcnt vmcnt(0)" ::: "memory");
            const unsigned og = xb_add(&bar[XB_TOP], 1u);
            const unsigned tg = og / nx;
            if (og + 1u == (tg + 1u) * nx) xb_add(&bar[XB_TOPGEN], 1u);
            else XB_SPIN(xb_ld(&bar[XB_TOPGEN]) == tg, bar);
            __builtin_amdgcn_fence(__ATOMIC_ACQUIRE, "agent");
            xb_add(&bar[XB_XGEN(b.x)], 1u);
            asm volatile("s_waitcnt vmcnt(0)" ::: "memory");
        } else {
            XB_SPIN(xb_ld(&bar[XB_XGEN(b.x)]) == gen, bar);
            __builtin_amdgcn_fence(__ATOMIC_ACQUIRE, "agent");
            asm volatile("s_waitcnt vmcnt(0)" ::: "memory");
        }
    }
    __syncthreads();
}


__global__ void __launch_bounds__(512, 2) fwd_megakernel(Params p) {
    extern __shared__ __attribute__((aligned(16))) unsigned char lds_raw[];
    LAS unsigned char* lds = (LAS unsigned char*)lds_raw;
    cg::grid_group grid = cg::this_grid();
    const int G = gridDim.x, cid = blockIdx.x;
    if (threadIdx.x < 2) ((LAS unsigned*)(lds + BARST_OFF))[threadIdx.x] = 0u;
    __syncthreads();
    const XcdBarrier bar = xcd_barrier_post((unsigned*)(kargs()->ws + WS_BAR), (volatile LAS unsigned*)(lds + BARST_OFF));
    using namespace pg8;
    constexpr int M_UP = (1 << K_UP0) | (1 << K_UP1), M_DNS = (1 << K_DNS0) | (1 << K_DNS1);
#if DIAG & 1
    for (int rep = 0; rep < ((REP & 1) ? 2 : 1); ++rep) phase0(lds);
#endif
    grid.sync();
#if DIAG & 2
    for (int rep = 0; rep < ((REP & 2) ? 2 : 1); ++rep) phase1(lds);
#endif
    xcd_barrier(bar);
#if SEG & 1
    { SchedUp S; S.init(0, cid);
      const int lc = cid - 128;
      if (lc >= 76 && lc < 84) { S.first = 0; S.count = 4; gemm_stream<M_UP, false>(lds, S); finisher<0>(lds, (lc - 76) >> 2, (lc - 76) & 3); S.first = 4; S.count = 1; gemm_stream<M_UP, false>(lds, S); }
      else gemm_stream<M_UP | M_DNS | (1 << K_IN), true>(lds, S); }
#endif
    xcd_barrier(bar);
    phase_fixup(0);
    xcd_barrier(bar);
#if SEG & 2
    { SchedSimple S{K_DN0, NPANEL_P, 4, G, cid}; gemm_stream<(1 << K_DN0), false>(lds, S); }
#endif
    xcd_barrier(bar);
#if SEG & 4
    { SchedSimple S{K_IN, NPANEL_P, 12, G, cid}; gemm_stream<(1 << K_IN), false>(lds, S); }
#endif
    xcd_barrier(bar);
    phase_conv();
    xcd_barrier(bar);
#if SEG & 8
    { SchedSimple S{K_OUT, NPANEL_P, 4, G, cid}; gemm_stream<(1 << K_OUT), false>(lds, S); }
#endif
    xcd_barrier(bar);
#if SEG & 16
    { SchedUp S; S.init(1, cid);
      const int lc = cid - 128;
      gemm_stream<M_UP | M_DNS | (1 << K_OUT), true>(lds, S);
      if (lc >= 84 && lc < 92) finisher<1>(lds, (lc - 84) >> 2, (lc - 84) & 3); }
#endif
    xcd_barrier(bar);
    phase_fixup(1);
    xcd_barrier(bar);
#if SEG & 32
    { SchedSimple S{K_DN1, NPANEL_P, 4, G, cid}; gemm_stream<(1 << K_DN1), false>(lds, S); }
#endif
    xcd_barrier(bar);
    phase_final();
}

extern "C" void kernel_launch(void* const* d_in, const int* in_sizes, int n_in, void* d_out, int out_size, void* d_ws, size_t ws_size, hipStream_t stream) {
    static int grid_blocks = 0;
    if (grid_blocks == 0) {
        if (n_in != 19 || out_size != (int)O_END || ws_size < WS_END) { fprintf(stderr, "kernel_launch: unexpected shapes (n_in %d out %d ws %zu)\n", n_in, out_size, ws_size); grid_blocks = -1; return; }
        int dev = 0, cus = 0, per_cu = 0;
        hipGetDevice(&dev);
        hipDeviceGetAttribute(&cus, hipDeviceAttributeMultiprocessorCount, dev);
        if (hipFuncSetAttribute((const void*)fwd_megakernel, hipFuncAttributeMaxDynamicSharedMemorySize, LDS_BYTES) != hipSuccess) { fprintf(stderr, "kernel_launch: hipFuncSetAttribute failed\n"); grid_blocks = -1; return; }
        hipOccupancyMaxActiveBlocksPerMultiprocessor(&per_cu, (const void*)fwd_megakernel, 512, LDS_BYTES);
        if (per_cu < 1) { fprintf(stderr, "kernel_launch: occupancy query reports %d blocks per CU\n", per_cu); grid_blocks = -1; return; }
        if (cus != 256) { fprintf(stderr, "kernel_launch: the unit schedule is built for 256 CUs, this device has %d\n", cus); grid_blocks = -1; return; }
        grid_blocks = cus;
    }
    if (grid_blocks < 0) return;
    if (hipMemsetAsync((char*)d_ws + WS_BAR, 0, CTL_BYTES, stream) != hipSuccess) { fprintf(stderr, "kernel_launch: hipMemsetAsync failed\n"); return; }
    Params p{};
    for (int i = 0; i < 19; ++i) p.in[i] = (const float*)d_in[i];
    p.out = (float*)d_out; p.ws = (unsigned char*)d_ws;
    void* args[] = {&p};
    hipError_t e = hipLaunchCooperativeKernel((const void*)fwd_megakernel, dim3(grid_blocks), dim3(512), args, LDS_BYTES, stream);
    if (e != hipSuccess) fprintf(stderr, "cooperative launch failed: %s (grid %d)\n", hipGetErrorString(e), grid_blocks);
}
```

```cpp
#include <hip/hip_runtime.h>
#include <hip/hip_cooperative_groups.h>
#include <cstdio>
#include <cstdint>
namespace cg = cooperative_groups;
#ifndef REP
#define REP 0
#endif
#ifndef SEG
#define SEG 255
#endif
#ifndef DIAG
#define DIAG 1023
#endif

#define LAS __attribute__((address_space(3)))
typedef unsigned short bf16_t;
typedef short bf16x8 __attribute__((ext_vector_type(8)));
typedef float f32x4 __attribute__((ext_vector_type(4)));
typedef float f32x2 __attribute__((ext_vector_type(2)));
typedef unsigned u32x4 __attribute__((ext_vector_type(4)));
typedef unsigned u32x2 __attribute__((ext_vector_type(2)));

constexpr int D = 1024, FF = 2816, FF2 = 5632, SEQ = 2048, NB_P = 8, NB_S = 128, TS = 4;
constexpr int NTOK_P = NB_P * SEQ;
constexpr int NTOK_S = NB_S * TS;
constexpr int MROWS = NTOK_P + NTOK_S;
constexpr int NPANEL = MROWS / 256;
constexpr int NPANEL_P = NTOK_P / 256;
constexpr float ALPHA = 1.41421356237309515f;
constexpr float LN_EPS = 1e-5f;

constexpr size_t O_Y = 0;
constexpr size_t O_POOL_P = (size_t)MROWS * D;
constexpr size_t O_POOL_S = O_POOL_P + (size_t)NB_P * 15 * D;
constexpr size_t O_CONV_P = O_POOL_S + (size_t)NB_S * 15 * D;
constexpr size_t O_CONV_S = O_CONV_P + (size_t)NB_P * 2 * D;
constexpr size_t O_FFN_P = O_CONV_S + (size_t)NB_S * 2 * D;
constexpr size_t O_FFN_S = O_FFN_P + (size_t)2 * NB_P * 2 * FF2;
constexpr size_t O_END = O_FFN_S + (size_t)2 * NB_S * 2 * FF2;

constexpr size_t WS_WUP = 0;
constexpr size_t WS_WDN = WS_WUP + (size_t)2 * FF2 * D * 2;
constexpr size_t WS_WIN = WS_WDN + (size_t)2 * D * FF * 2;
constexpr size_t WS_WOUT = WS_WIN + (size_t)3 * D * D * 2;
constexpr size_t WS_WPOOL = WS_WOUT + (size_t)D * D * 2;
constexpr size_t WS_CSP_UP = WS_WPOOL + (size_t)4 * 256 * 256 * 2;
constexpr size_t WS_CBP_UP = WS_CSP_UP + (size_t)2 * 16 * FF2 * 4;
constexpr size_t WS_CSP_IN = WS_CBP_UP + (size_t)2 * 16 * FF2 * 4;
constexpr size_t WS_CBP_IN = WS_CSP_IN + (size_t)16 * 3072 * 4;
constexpr size_t WS_CS_UP = WS_CBP_IN + (size_t)16 * 3072 * 4;
constexpr size_t WS_CB_UP = WS_CS_UP + (size_t)2 * FF2 * 4;
constexpr size_t WS_KC_UP = WS_CB_UP + (size_t)2 * FF2 * 4;
constexpr size_t WS_CS_IN = WS_KC_UP + (size_t)2 * 4 * FF2 * 4;
constexpr size_t WS_CB_IN = WS_CS_IN + (size_t)3072 * 4;
constexpr size_t WS_PART = WS_CB_IN + (size_t)3072 * 4;
constexpr size_t PART_BYTES = (size_t)MROWS * 4 * 8;
constexpr size_t WS_HF = WS_PART + 3 * PART_BYTES;
constexpr size_t HALO_BYTES = (size_t)132 * 2 * FF2 * 4;
constexpr size_t WS_HL = WS_HF + HALO_BYTES;
constexpr size_t WS_H1 = WS_HL + HALO_BYTES;
constexpr size_t WS_ACT = WS_H1 + (size_t)MROWS * D * 2;
constexpr size_t WS_BAR = WS_ACT + (size_t)MROWS * FF * 2;
constexpr size_t WS_CNT = WS_BAR + 16384;
constexpr size_t CTL_BYTES = 32768;
constexpr size_t WS_SU = WS_BAR + CTL_BYTES;
constexpr size_t WS_SB = WS_SU + (size_t)NTOK_S * D * 2;
constexpr size_t WS_PBUF = WS_SB + (size_t)NTOK_S * D * 2;
constexpr size_t WS_END = WS_PBUF + (size_t)32 * 262144;
static_assert(WS_END <= (size_t)256 * 1024 * 1024, "workspace");
static_assert(WS_WDN % 256 == 0 && WS_WIN % 256 == 0 && WS_WOUT % 256 == 0 && WS_WPOOL % 256 == 0 && WS_PART % 256 == 0 && WS_HF % 256 == 0 && WS_H1 % 256 == 0 && WS_ACT % 256 == 0, "align");

constexpr int STAGE_BYTES = 131072;
constexpr int EPI_OFF = STAGE_BYTES;
constexpr int EPI_S = 8192, EPI_CST = 10240, EPI_PART = 16384;
constexpr int P1_T_OFF = 147456;
constexpr int BARST_OFF = 155648;
constexpr int LDS_BYTES = 159744;

struct Params {
    const float* in[19];
    float* out;
    unsigned char* ws;
};

__device__ __forceinline__ unsigned f2bf(float f) { unsigned u = __builtin_bit_cast(unsigned, f); return (u + 0x7fffu + ((u >> 16) & 1u)) >> 16; }
__device__ __forceinline__ float bf2f(unsigned b) { return __builtin_bit_cast(float, b << 16); }
typedef __bf16 bf16v2 __attribute__((ext_vector_type(2)));
__device__ __forceinline__ unsigned pk2(float lo, float hi) { const f32x2 v = {lo, hi}; return __builtin_bit_cast(unsigned, __builtin_convertvector(v, bf16v2)); }
__device__ __forceinline__ float dpp_shr1(float v) {
    return __builtin_bit_cast(float, __builtin_amdgcn_update_dpp(0, __builtin_bit_cast(int, v), 0x111, 0xf, 0xf, true));
}
__device__ __forceinline__ float silu_mul(float g, float v) { return g * v * __builtin_amdgcn_rcpf(1.0f + __expf(-g)); }
__device__ __forceinline__ int tid_fresh() { int t = threadIdx.x; asm volatile("" : "+v"(t)); return t; }
__device__ __forceinline__ int row_of_tok(int tok) {
    const int pm = tok >> 8, tau = tok & 255;
    return pm * 256 + 128 * ((tau >> 2) & 1) + 64 * (tau >> 7) + 16 * (tau & 3) + ((tau >> 3) & 15);
}
__device__ __forceinline__ f32x2 row_stats(const f32x2* part, int R) {
    const f32x4 a = *(const f32x4*)(part + (size_t)R * 4), b = *(const f32x4*)(part + (size_t)R * 4 + 2);
    const float mean = ((a[0] + a[2]) + (b[0] + b[2])) * 0.25f;
    const float d0 = a[0] - mean, d1 = a[2] - mean, d2 = b[0] - mean, d3 = b[2] - mean;
    const float m2 = ((a[1] + a[3]) + (b[1] + b[3])) + 256.0f * ((d0 * d0 + d1 * d1) + (d2 * d2 + d3 * d3));
    f32x2 r; r.x = mean; r.y = __builtin_amdgcn_rsqf(m2 * (1.0f / 1024.0f) + LN_EPS); return r;
}
__device__ __forceinline__ void stats_from_lds(LAS unsigned char* elds) {
    int tx = threadIdx.x; asm volatile("" : "+v"(tx));
    if (tx < 256) { const f32x4 a = *(const LAS f32x4*)(elds + EPI_PART + tx * 32), b = *(const LAS f32x4*)(elds + EPI_PART + tx * 32 + 16);
        const float mean = ((a[0] + a[2]) + (b[0] + b[2])) * 0.25f;
        const float d0 = a[0] - mean, d1 = a[2] - mean, d2 = b[0] - mean, d3 = b[2] - mean;
        const float m2 = ((a[1] + a[3]) + (b[1] + b[3])) + 256.0f * ((d0 * d0 + d1 * d1) + (d2 * d2 + d3 * d3));
        const float rstd = __builtin_amdgcn_rsqf(m2 * (1.0f / 1024.0f) + LN_EPS);
        f32x2 t; t.x = rstd; t.y = -mean * rstd; ((LAS f32x2*)(elds + EPI_S))[tx] = t; }
    asm volatile("s_waitcnt lgkmcnt(0)" ::: "memory"); __builtin_amdgcn_s_barrier(); asm volatile("" ::: "memory");
}
#define KA __attribute__((address_space(4)))
__device__ __forceinline__ const KA Params* kargs() { const KA Params* p = (const KA Params*)__builtin_amdgcn_kernarg_segment_ptr(); asm volatile("" : "+s"(p)); return p; }

namespace pg8 {
constexpr int BM = 256, BK = 64, HALF = 128, HTB = HALF * BK * 2, NXCD = 8, WGM = 8;
__host__ __device__ __forceinline__ int lds_byte(int r, int c) { const int st = (r >> 4) * 2 + (c >> 5), rr = r & 15, cc = c & 31, ob = rr * 64 + cc * 2; return st * 1024 + (ob ^ (((ob >> 9) & 1) << 5)); }
__host__ __device__ __forceinline__ void stage_rc(int b, int& R, int& C) { const int st = b / 1024, sb = b % 1024, swz = sb ^ (((sb >> 9) & 1) << 5); R = (st >> 1) * 16 + swz / 64; C = (st & 1) * 32 + (swz % 64) / 2; }

struct Unit { int pm, pn; };
enum { K_UP0 = 0, K_UP1 = 1, K_DN0 = 2, K_DN1 = 3, K_IN = 4, K_OUT = 5, K_DNS0 = 6, K_DNS1 = 7 };
struct UnitD { int kind, pm, pn, ks, dep, want, sig; };
__device__ __forceinline__ void map_unit(int L, int nM, int nN, int& pm, int& pn) {
    const int nwg = nM * nN; int wgid = L; { const int q = nwg / NXCD, r = nwg % NXCD, xcd = wgid % NXCD, off = wgid / NXCD; wgid = (xcd < r ? xcd * (q + 1) : r * (q + 1) + (xcd - r) * q) + off; }
    const int nig = WGM * nN, gid = wgid / nig, fm = gid * WGM, gsz = (nM - fm) < WGM ? (nM - fm) : WGM;
    pm = fm + ((wgid % nig) % gsz); pn = (wgid % nig) / gsz;
}
}


template <int BJ> __device__ __forceinline__ void pin_half(f32x4 (&acc)[2][2][4][2]) {
#pragma unroll
    for (int ai = 0; ai < 2; ++ai)
        asm volatile("" : "+v"(acc[ai][BJ][0][0]), "+v"(acc[ai][BJ][0][1]), "+v"(acc[ai][BJ][1][0]), "+v"(acc[ai][BJ][1][1]), "+v"(acc[ai][BJ][2][0]), "+v"(acc[ai][BJ][2][1]), "+v"(acc[ai][BJ][3][0]), "+v"(acc[ai][BJ][3][1]) :: "memory");
}
template <int BJ, int N> __device__ __forceinline__ void pin_group(f32x4 (&acc)[2][2][4][2]) {
    asm volatile("" : "+v"(acc[0][BJ][0][N]), "+v"(acc[0][BJ][1][N]), "+v"(acc[0][BJ][2][N]), "+v"(acc[0][BJ][3][N]), "+v"(acc[1][BJ][0][N]), "+v"(acc[1][BJ][1][N]), "+v"(acc[1][BJ][2][N]), "+v"(acc[1][BJ][3][N]) :: "memory");
}
template <int N> __device__ __forceinline__ void pin_n(f32x4 (&acc)[2][2][4][2]) {
#pragma unroll
    for (int ai = 0; ai < 2; ++ai)
        asm volatile("" : "+v"(acc[ai][0][0][N]), "+v"(acc[ai][0][1][N]), "+v"(acc[ai][0][2][N]), "+v"(acc[ai][0][3][N]), "+v"(acc[ai][1][0][N]), "+v"(acc[ai][1][1][N]), "+v"(acc[ai][1][2][N]), "+v"(acc[ai][1][3][N]) :: "memory");
}
template <int BJ, int N, int J0, int LEN>
__device__ __forceinline__ void conv_chain(f32x4 (&acc)[2][2][4][2], const f32x4 k0, const f32x4 k1, const f32x4 k2, const f32x4 kb, const f32x4 p1, const f32x4 p2) {
#pragma unroll
    for (int i = LEN - 1; i >= 0; --i) {
        const int j = J0 + i;
        const f32x4 h0 = acc[j >> 2][BJ][j & 3][N];
        const f32x4 h1 = i >= 1 ? acc[(j - 1) >> 2][BJ][(j - 1) & 3][N] : p1;
        const f32x4 h2 = i >= 2 ? acc[(j - 2) >> 2][BJ][(j - 2) & 3][N] : (i == 1 ? p1 : p2);
        acc[j >> 2][BJ][j & 3][N] = k2 * h0 + k1 * h1 + k0 * h2 + kb;
    }
}
struct EpiUp {
    int l;
    template <int N>
    __device__ __forceinline__ void half(f32x4 (&acc)[2][2][4][2], int pm, int pn, int wr, int wc, int fr, int fq, LAS unsigned char* elds) const {
        asm volatile("" : "+v"(fr), "+v"(fq));
        const KA Params* q = kargs(); unsigned char* ws = q->ws;
        const bool sample = pm >= NPANEL_P;
        const int chunk = 2 * pm + wr;
        const int ucol = 256 * pn + 32 * wc + 16 * N;
        const int ufcol = 128 * pn + 32 * wc + 16 * N;
        const unsigned lq = (unsigned)(16 * fq);
        const LAS unsigned char* kcl = elds + EPI_CST + 2048 + (32 * wc + 16 * N) * 4 + lq;
#define KC4(tap, vhalf) (*(const LAS f32x4*)(kcl + ((tap) * 256 + (vhalf) * 128) * 4))
        if (!sample) {
            f32x4 g2, g1;
#pragma unroll
            for (int e = 0; e < 4; ++e) { g2[e] = dpp_shr1(acc[1][0][2][N][e]); g1[e] = dpp_shr1(acc[1][0][3][N][e]); }
            if (fr == 0) {
                char* hf = (char*)((float*)(ws + WS_HF) + (size_t)chunk * 2 * FF2 + ucol) + lq;
                *(f32x4*)(hf) = acc[0][0][0][N]; *(f32x4*)(hf + FF2 * 4) = acc[0][0][1][N];
                *(f32x4*)(hf + 128 * 4) = acc[0][1][0][N]; *(f32x4*)(hf + (FF2 + 128) * 4) = acc[0][1][1][N];
            }
            if (fr == 15) {
                char* hl = (char*)((float*)(ws + WS_HL) + (size_t)chunk * 2 * FF2 + ucol) + lq;
                *(f32x4*)(hl) = acc[1][0][2][N]; *(f32x4*)(hl + FF2 * 4) = acc[1][0][3][N];
                *(f32x4*)(hl + 128 * 4) = acc[1][1][2][N]; *(f32x4*)(hl + (FF2 + 128) * 4) = acc[1][1][3][N];
                if ((pm & 7) == 7 && wr == 1) {
                    char* o = (char*)(q->out + O_FFN_P + ((size_t)l * NB_P + (pm >> 3)) * 2 * FF2 + ufcol) + lq;
                    *(f32x4*)(o) = acc[1][0][2][N]; *(f32x4*)(o + FF2 * 4) = acc[1][0][3][N];
                    *(f32x4*)(o + FF * 4) = acc[1][1][2][N]; *(f32x4*)(o + (FF2 + FF) * 4) = acc[1][1][3][N];
                }
            }
            pin_n<N>(acc);
            { const f32x4 k0 = KC4(0, 0), k1 = KC4(1, 0), k2 = KC4(2, 0), kb = KC4(3, 0); conv_chain<0, N, 0, 8>(acc, k0, k1, k2, kb, g1, g2); }
            pin_n<N>(acc);
            { f32x4 v2, v1;
#pragma unroll
              for (int e = 0; e < 4; ++e) { v2[e] = dpp_shr1(acc[1][1][2][N][e]); v1[e] = dpp_shr1(acc[1][1][3][N][e]); }
              const f32x4 k0 = KC4(0, 1), k1 = KC4(1, 1), k2 = KC4(2, 1), kb = KC4(3, 1); conv_chain<1, N, 0, 8>(acc, k0, k1, k2, kb, v1, v2); }
        } else {
            const int useq0 = 64 * (pm - NPANEL_P) + 32 * wr;
            const unsigned ls = (unsigned)(2 * fr * 2 * FF2 * 4) + lq;
            char* ob = (char*)(q->out + O_FFN_S + ((size_t)l * NB_S + useq0) * 2 * FF2 + ufcol);
#pragma unroll
            for (int ai = 0; ai < 2; ++ai) { char* o = ob + ls + (unsigned)(ai * 2 * FF2 * 4);
                *(f32x4*)(o) = acc[ai][0][2][N]; *(f32x4*)(o + FF2 * 4) = acc[ai][0][3][N];
                *(f32x4*)(o + FF * 4) = acc[ai][1][2][N]; *(f32x4*)(o + (FF2 + FF) * 4) = acc[ai][1][3][N]; }
            pin_n<N>(acc);
            const char* sb = (const char*)(q->in[4] + ((size_t)l * NB_S + useq0) * 2 * FF2 + ufcol);
            { const f32x4 k0 = KC4(0, 0), k1 = KC4(1, 0), k2 = KC4(2, 0), kb = KC4(3, 0);
              conv_chain<0, N, 0, 4>(acc, k0, k1, k2, kb, *(const f32x4*)(sb + ls + FF2 * 4), *(const f32x4*)(sb + ls));
              conv_chain<0, N, 4, 4>(acc, k0, k1, k2, kb, *(const f32x4*)(sb + ls + 3 * FF2 * 4), *(const f32x4*)(sb + ls + 2 * FF2 * 4)); }
            pin_n<N>(acc);
            { const f32x4 k0 = KC4(0, 1), k1 = KC4(1, 1), k2 = KC4(2, 1), kb = KC4(3, 1);
              conv_chain<1, N, 0, 4>(acc, k0, k1, k2, kb, *(const f32x4*)(sb + ls + (FF2 + FF) * 4), *(const f32x4*)(sb + ls + FF * 4));
              conv_chain<1, N, 4, 4>(acc, k0, k1, k2, kb, *(const f32x4*)(sb + ls + (3 * FF2 + FF) * 4), *(const f32x4*)(sb + ls + (2 * FF2 + FF) * 4)); }
        }
#undef KC4
        pin_n<N>(acc);
        char* ab = (char*)((bf16_t*)(ws + WS_ACT) + (size_t)(pm * 256 + 64 * wr) * FF + ufcol);
        const unsigned la = (unsigned)((fr * FF + 4 * fq) * 2);
#pragma unroll
        for (int j = 0; j < 8; ++j) {
            const f32x4 zg = acc[j >> 2][0][j & 3][N], zv = acc[j >> 2][1][j & 3][N];
            u32x2 w; w.x = pk2(silu_mul(zg[0], zv[0]), silu_mul(zg[1], zv[1])); w.y = pk2(silu_mul(zg[2], zv[2]), silu_mul(zg[3], zv[3]));
            *(u32x2*)(ab + la + (unsigned)((128 * (j >> 2) + 16 * (j & 3)) * FF * 2)) = w;
        }
        asm volatile("" ::: "memory");
    }
    __device__ __forceinline__ void operator()(f32x4 (&acc)[2][2][4][2], const pg8::Unit& u, int wr, int wc, int fr, int fq, LAS unsigned char* elds) const {
        const int pm = u.pm, pn = u.pn;
        LAS f32x2* S = (LAS f32x2*)(elds + EPI_S);
        { stats_from_lds(elds);
          const LAS unsigned char* csl = elds + EPI_CST + (32 * wc) * 4 + 16 * fq;
          f32x2 st[8];
#pragma unroll
          for (int j = 0; j < 8; ++j) st[j] = S[128 * (j >> 2) + 64 * wr + 16 * (j & 3) + fr];
#pragma unroll
          for (int bj = 0; bj < 2; ++bj)
#pragma unroll
              for (int n = 0; n < 2; ++n) { const f32x4 csv = *(const LAS f32x4*)(csl + (128 * bj + 16 * n) * 4), cbv = *(const LAS f32x4*)(csl + 1024 + (128 * bj + 16 * n) * 4);
#pragma unroll
                  for (int j = 0; j < 8; ++j) acc[j >> 2][bj][j & 3][n] = acc[j >> 2][bj][j & 3][n] * st[j].x + (csv * st[j].y + cbv); }
        }
        pin_half<0>(acc); pin_half<1>(acc);
        half<0>(acc, pm, pn, wr, wc, fr, fq, elds);
        half<1>(acc, pm, pn, wr, wc, fr, fq, elds);
    }
};

template <bool FINAL> struct EpiRes {
    int pprev, pnew, gi, goff;
    template <int BJ>
    __device__ __forceinline__ void resid(f32x4 (&acc)[2][2][4][2], int pm, int pn, int wr, int wc, int fr, int fq, LAS f32x2* S, const LAS unsigned char* cst) const {
        asm volatile("" : "+v"(fr), "+v"(fq));
        const KA Params* q = kargs();
        const int ucol = 256 * pn + 128 * BJ + 32 * wc;
        const char* vb = (const char*)((const bf16_t*)(q->ws + WS_H1) + (size_t)(pm * 256 + 64 * wr) * D + ucol);
        const unsigned lv = (unsigned)((fr * D + 4 * fq) * 2), lq = (unsigned)(16 * fq);
        u32x2 vp[8][2];
#pragma unroll
        for (int j = 0; j < 8; ++j)
#pragma unroll
            for (int n = 0; n < 2; ++n) vp[j][n] = *(const u32x2*)(vb + lv + (unsigned)(((128 * (j >> 2) + 16 * (j & 3)) * D + 16 * n) * 2));
        f32x4 gv[2], bv[2];
#pragma unroll
        for (int n = 0; n < 2; ++n) { gv[n] = *(const LAS f32x4*)(cst + (128 * BJ + 32 * wc + 16 * n) * 4 + lq) * ALPHA; bv[n] = *(const LAS f32x4*)(cst + 1024 + (128 * BJ + 32 * wc + 16 * n) * 4 + lq) * ALPHA; }
        const LAS f32x2* Sl = S + 64 * wr + fr;
#pragma unroll
        for (int j = 0; j < 8; ++j) { const f32x2 s = Sl[128 * (j >> 2) + 16 * (j & 3)];
#pragma unroll
            for (int n = 0; n < 2; ++n) { f32x4 v; v[0] = bf2f(vp[j][n].x & 0xffffu); v[1] = bf2f(vp[j][n].x >> 16); v[2] = bf2f(vp[j][n].y & 0xffffu); v[3] = bf2f(vp[j][n].y >> 16);
                acc[j >> 2][BJ][j & 3][n] = (v * s.x + s.y) * gv[n] + bv[n] + acc[j >> 2][BJ][j & 3][n]; } }
        pin_half<BJ>(acc);
    }
    __device__ __forceinline__ void operator()(f32x4 (&acc)[2][2][4][2], const pg8::Unit& u, int wr, int wc, int fr, int fq, LAS unsigned char* elds) const {
        const int pm = u.pm, pn = u.pn;
        LAS f32x2* P = (LAS f32x2*)elds;
        LAS f32x2* S = (LAS f32x2*)(elds + EPI_S);
        stats_from_lds(elds);
        resid<0>(acc, pm, pn, wr, wc, fr, fq, S, elds + EPI_CST);
        resid<1>(acc, pm, pn, wr, wc, fr, fq, S, elds + EPI_CST);
        asm volatile("" : "+v"(fr), "+v"(fq));
        const KA Params* q = kargs();
        char* ob; unsigned lo;
        if (FINAL) { ob = (char*)(q->out + O_Y + (size_t)(pm * 256 + 128 * wr) * D + 256 * pn + 32 * wc); lo = (unsigned)((8 * fr * D + 4 * fq) * 4); }
        else { ob = (char*)((bf16_t*)(q->ws + WS_H1) + (size_t)(pm * 256 + 64 * wr) * D + 256 * pn + 32 * wc); lo = (unsigned)((fr * D + 4 * fq) * 2); }
        LAS f32x2* Pl = P + (64 * wr + fr) * 4 + wc;
#pragma unroll
        for (int j = 0; j < 8; ++j) {
            const int ai = j >> 2, m = j & 3;
            float sum = 0.f;
#pragma unroll
            for (int bj = 0; bj < 2; ++bj)
#pragma unroll
                for (int n = 0; n < 2; ++n) { const f32x4 vn = acc[ai][bj][m][n]; sum += (vn[0] + vn[1]) + (vn[2] + vn[3]); }
            sum += __shfl_xor(sum, 16); sum += __shfl_xor(sum, 32);
            const float mw = sum * (1.0f / 64.0f); float qq = 0.f;
#pragma unroll
            for (int bj = 0; bj < 2; ++bj)
#pragma unroll
                for (int n = 0; n < 2; ++n) { const f32x4 d = acc[ai][bj][m][n] - mw; qq += (d[0] * d[0] + d[1] * d[1]) + (d[2] * d[2] + d[3] * d[3]); }
            qq += __shfl_xor(qq, 16); qq += __shfl_xor(qq, 32);
            if (fq == 0) { f32x2 t; t.x = mw; t.y = qq; Pl[(128 * ai + 16 * m) * 4] = t; }
#pragma unroll
            for (int bj = 0; bj < 2; ++bj)
#pragma unroll
                for (int n = 0; n < 2; ++n) { const f32x4 vn = acc[ai][bj][m][n];
                    if (FINAL) *(f32x4*)(ob + lo + (unsigned)(((4 * ai + m) * D + 128 * bj + 16 * n) * 4)) = vn;
                    else { u32x2 w; w.x = pk2(vn[0], vn[1]); w.y = pk2(vn[2], vn[3]); *(u32x2*)(ob + lo + (unsigned)(((128 * ai + 16 * m) * D + 128 * bj + 16 * n) * 2)) = w; } }
        }
        asm volatile("s_waitcnt lgkmcnt(0)" ::: "memory"); __builtin_amdgcn_s_barrier(); asm volatile("" ::: "memory");
        int rl = threadIdx.x; asm volatile("" : "+v"(rl));
        if (rl < 256) {
            const f32x2 a = P[rl * 4 + 0], b2 = P[rl * 4 + 1], c2 = P[rl * 4 + 2], d2 = P[rl * 4 + 3];
            const float mt = (a.x + b2.x + c2.x + d2.x) * 0.25f;
            const float da = a.x - mt, db = b2.x - mt, dc = c2.x - mt, dd = d2.x - mt;
            f32x2 r; r.x = mt; r.y = (a.y + b2.y) + (c2.y + d2.y) + 64.0f * ((da * da + db * db) + (dc * dc + dd * dd));
            char* pb = (char*)((f32x2*)(q->ws + WS_PART) + (size_t)pnew * MROWS * 4 + (size_t)pm * 256 * 4 + pn);
            *(f32x2*)(pb + (unsigned)(rl * 32)) = r;
        }
    }
};

struct EpiIn {
    int dummy;
    __device__ __forceinline__ void operator()(f32x4 (&acc)[2][2][4][2], const pg8::Unit& u, int wr, int wc, int fr, int fq, LAS unsigned char* elds) const {
        const int pm = u.pm, pn = u.pn; const bool sample = pm >= NPANEL_P;
        LAS f32x2* S = (LAS f32x2*)(elds + EPI_S);
        const KA Params* q = kargs(); unsigned char* ws = q->ws;
        stats_from_lds(elds);
        { const LAS unsigned char* csl = elds + EPI_CST + (32 * wc) * 4 + 16 * fq;
          f32x2 st[8];
#pragma unroll
          for (int j = 0; j < 8; ++j) st[j] = S[128 * (j >> 2) + 64 * wr + 16 * (j & 3) + fr];
#pragma unroll
          for (int bj = 0; bj < 2; ++bj)
#pragma unroll
              for (int n = 0; n < 2; ++n) { const f32x4 csv = *(const LAS f32x4*)(csl + (128 * bj + 16 * n) * 4), cbv = *(const LAS f32x4*)(csl + 1024 + (128 * bj + 16 * n) * 4);
#pragma unroll
                  for (int j = 0; j < 8; ++j) acc[j >> 2][bj][j & 3][n] = acc[j >> 2][bj][j & 3][n] * st[j].x + (csv * st[j].y + cbv); } }
        pin_half<0>(acc); pin_half<1>(acc);
        asm volatile("" : "+v"(fr), "+v"(fq));
        const unsigned lr = (unsigned)((fr * D + 4 * fq) * 2);
        if (pn < 8) {
            char* ub = sample ? (char*)((bf16_t*)(ws + WS_SU) + (size_t)((pm - NPANEL_P) * 256 + 64 * wr) * D + 128 * pn + 32 * wc)
                              : (char*)((bf16_t*)(ws + WS_ACT) + (size_t)(pm * 256 + 64 * wr) * D + 128 * pn + 32 * wc);
#pragma unroll
            for (int n = 0; n < 2; ++n) {
#pragma unroll
                for (int j = 0; j < 8; ++j) { const int ai = j >> 2, m = j & 3; const f32x4 uu = acc[ai][0][m][n] * acc[ai][1][m][n];
                    u32x2 w; w.x = pk2(uu[0], uu[1]); w.y = pk2(uu[2], uu[3]); *(u32x2*)(ub + lr + (unsigned)(((128 * ai + 16 * m) * D + 16 * n) * 2)) = w;
                    if (sample) { if (m >= 2) { const int seq = 64 * (pm - NPANEL_P) + 32 * wr + 2 * fr + ai; *(f32x4*)(q->out + O_CONV_S + ((size_t)seq * 2 + (m - 2)) * D + 128 * pn + 32 * wc + 16 * n + 4 * fq) = uu; } }
                    else if ((pm & 7) == 7 && wr == 1 && fr == 15 && j >= 6) { *(f32x4*)(q->out + O_CONV_P + ((size_t)(pm >> 3) * 2 + (j - 6)) * D + 128 * pn + 32 * wc + 16 * n + 4 * fq) = uu; } } }
        } else {
            char* bb = sample ? (char*)((bf16_t*)(ws + WS_SB) + (size_t)((pm - NPANEL_P) * 256 + 64 * wr) * D + 256 * (pn - 8) + 32 * wc)
                              : (char*)((bf16_t*)(ws + WS_ACT) + (size_t)MROWS * D + (size_t)(pm * 256 + 64 * wr) * D + 256 * (pn - 8) + 32 * wc);
#pragma unroll
            for (int bj = 0; bj < 2; ++bj)
#pragma unroll
                for (int n = 0; n < 2; ++n) {
#pragma unroll
                    for (int j = 0; j < 8; ++j) { const int ai = j >> 2, m = j & 3; const f32x4 v = acc[ai][bj][m][n];
                        u32x2 w; w.x = pk2(v[0], v[1]); w.y = pk2(v[2], v[3]); *(u32x2*)(bb + lr + (unsigned)(((128 * ai + 16 * m) * D + 128 * bj + 16 * n) * 2)) = w; } }
        }
    }
};

struct EpiPartial {
    __device__ __forceinline__ void operator()(f32x4 (&acc)[2][2][4][2], const pg8::UnitD& u) const {
        const int tid = tid_fresh();
        char* pb = (char*)(kargs()->ws + WS_PBUF) + (size_t)((((u.pm - NPANEL_P) * 4 + u.pn) * 4 + u.ks) * 32) * 8192;
#pragma unroll
        for (int ai = 0; ai < 2; ++ai)
#pragma unroll
            for (int bj = 0; bj < 2; ++bj)
#pragma unroll
                for (int m = 0; m < 4; ++m)
#pragma unroll
                    for (int n = 0; n < 2; ++n) *(f32x4*)(pb + (unsigned)(((((ai * 2 + bj) * 4 + m) * 2 + n) * 512 + tid) * 16)) = acc[ai][bj][m][n];
    }
};
__device__ __forceinline__ unsigned* cnt_word(int idx) { return (unsigned*)(kargs()->ws + WS_CNT) + 64 * idx; }
__device__ __forceinline__ int C_UP(int l, int p) { return l * 16 + p; }
__device__ __forceinline__ int C_DNS(int l, int p, int pn) { return l * 16 + 2 + p * 4 + pn; }
__device__ __forceinline__ int C_FIN(int l, int p) { return l * 16 + 10 + p; }
__device__ __forceinline__ int C_OUT(int p) { return 32 + p; }
__device__ __forceinline__ void dep_wait(int idx, unsigned want) {
    int tid = tid_fresh();
    if (tid < 64) {
        unsigned* w = cnt_word(idx); unsigned sp = 0;
        while ((unsigned)__builtin_amdgcn_readfirstlane(__hip_atomic_load(w, __ATOMIC_RELAXED, __HIP_MEMORY_SCOPE_AGENT)) < want) { __builtin_amdgcn_s_sleep(2); if (++sp > (1u << 22)) break; }
        __builtin_amdgcn_fence(__ATOMIC_ACQUIRE, "agent");
        asm volatile("s_waitcnt vmcnt(0)" ::: "memory");
    }
    asm volatile("" ::: "memory"); __builtin_amdgcn_s_barrier(); asm volatile("" ::: "memory");
}
__device__ __forceinline__ void unit_signal(int idx) {
    asm volatile("s_waitcnt vmcnt(0)" ::: "memory"); __builtin_amdgcn_s_barrier(); asm volatile("" ::: "memory");
    if (tid_fresh() == 0) { __builtin_amdgcn_fence(__ATOMIC_RELEASE, "agent"); asm volatile("s_waitcnt vmcnt(0)" ::: "memory");
        __hip_atomic_fetch_add(cnt_word(idx), 1u, __ATOMIC_RELAXED, __HIP_MEMORY_SCOPE_AGENT); }
}

__device__ __forceinline__ void epi_prefetch(int kind, int pm, int pn, LAS unsigned char* elds, int wid, int lane) {
    if (kind == pg8::K_DNS0 || kind == pg8::K_DNS1) return;
    const KA Params* q = kargs(); unsigned char* ws = q->ws;
    const int bank = (kind == pg8::K_UP0 || kind == pg8::K_DN0) ? 0 : ((kind == pg8::K_UP1 || kind == pg8::K_DN1) ? 2 : 1);
    const char* pp = (const char*)(ws + WS_PART) + ((size_t)bank * MROWS * 4 + (size_t)pm * 256 * 4) * 8 + wid * 1024 + lane * 16;
    __builtin_amdgcn_global_load_lds((const unsigned*)pp, (LAS unsigned*)(elds + EPI_PART + wid * 1024), 16, 0, 0);
    const float* cp = nullptr;
    if (kind == pg8::K_UP0 || kind == pg8::K_UP1) { const int l = kind - pg8::K_UP0;
        if (wid < 2) cp = (const float*)(ws + (wid == 0 ? WS_CS_UP : WS_CB_UP)) + l * FF2 + 256 * pn;
        else if (wid < 6) cp = (const float*)(ws + WS_KC_UP) + ((size_t)l * 4 + (wid - 2)) * FF2 + 256 * pn; }
    else if (kind == pg8::K_IN) { if (wid < 2) cp = (const float*)(ws + (wid == 0 ? WS_CS_IN : WS_CB_IN)) + 256 * pn; }
    else { if (wid < 2) { const int gi = kind == pg8::K_OUT ? 17 : 5, goff = kind == pg8::K_DN1 ? D : 0; cp = q->in[gi + wid] + goff + 256 * pn; } }
    if (cp) __builtin_amdgcn_global_load_lds((const unsigned*)((const char*)cp + lane * 16), (LAS unsigned*)(elds + EPI_CST + wid * 1024), 16, 0, 0);
}

namespace pg8 {
__device__ __forceinline__ void unit_gemm(const UnitD& u, const char*& cA, const char*& cB, int& Kf, int& nt) {
    const KA Params* q = kargs(); unsigned char* ws = q->ws;
    switch (u.kind) {
    case K_UP0: case K_UP1: Kf = D; nt = 16; cA = (const char*)(ws + WS_H1) + (size_t)u.pm * 256 * D * 2; cB = (const char*)(ws + WS_WUP) + ((size_t)(u.kind - K_UP0) * FF2 + (size_t)u.pn * 256) * D * 2; break;
    case K_DN0: case K_DN1: Kf = FF; nt = 44; cA = (const char*)(ws + WS_ACT) + (size_t)u.pm * 256 * FF * 2; cB = (const char*)(ws + WS_WDN) + ((size_t)(u.kind - K_DN0) * D + (size_t)u.pn * 256) * FF * 2; break;
    case K_DNS0: case K_DNS1: { const int k0 = u.ks < 2 ? u.ks * 768 : 1536 + (u.ks - 2) * 640; Kf = FF; nt = u.ks < 2 ? 12 : 10;
        cA = (const char*)(ws + WS_ACT) + ((size_t)u.pm * 256 * FF + k0) * 2; cB = (const char*)(ws + WS_WDN) + (((size_t)(u.kind - K_DNS0) * D + (size_t)u.pn * 256) * FF + k0) * 2; break; }
    case K_IN: Kf = D; nt = 16; cA = (const char*)(ws + WS_H1) + (size_t)u.pm * 256 * D * 2; cB = (const char*)(ws + WS_WIN) + (size_t)u.pn * 256 * D * 2; break;
    default: Kf = D; nt = 16; cA = (const char*)q->out + (size_t)u.pm * 256 * D * 2; cB = (const char*)(ws + WS_WOUT) + (size_t)u.pn * 256 * D * 2; break;
    }
}
template <int KINDS, bool MIXK, class Sched>
__device__ __forceinline__ void gemm_stream(LAS unsigned char* lds, const Sched& S) {
    const int tid = tid_fresh(), wid = __builtin_amdgcn_readfirstlane(tid >> 6), lane = tid & 63, wr = wid >> 2, wc = wid & 3, fr = lane & 15, fq = lane >> 4;
    int Rs[2], Cs[2];
#pragma unroll
    for (int i = 0; i < 2; ++i) stage_rc(tid * 16 + i * 8192, Rs[i], Cs[i]);
    const size_t kstep = (size_t)(BK * 2);
    const unsigned ldsw = (unsigned)wid * 1024u;
    const int aoff = lds_byte(wr * 64 + fr, fq * 8), boff = lds_byte(wc * 32 + fr, fq * 8);
#define PG8_SA(b, h) (((b) * 2 + (h)) * HTB)
#define PG8_SB(b, h) ((4 + (b) * 2 + (h)) * HTB)
#define PG8_STAGE(bufoff, gbase, vo) do { _Pragma("unroll") for (int _i = 0; _i < 2; ++_i) \
        __builtin_amdgcn_global_load_lds((const unsigned*)((const char*)(gbase) + (vo)[_i]), (LAS unsigned*)(lds + (bufoff) + ldsw + _i * 8192), 16, 0, 0); } while (0)
#define PG8_LDA(dst, b, h) do { _Pragma("unroll") for (int m = 0; m < 4; ++m) _Pragma("unroll") for (int k = 0; k < 2; ++k) dst[m][k] = *(const LAS bf16x8*)(lds + PG8_SA(b, h) + aoff + m * 2048 + k * 1024); } while (0)
#define PG8_LDB(dst, b, h) do { _Pragma("unroll") for (int n = 0; n < 2; ++n) _Pragma("unroll") for (int k = 0; k < 2; ++k) dst[n][k] = *(const LAS bf16x8*)(lds + PG8_SB(b, h) + boff + n * 2048 + k * 1024); } while (0)
#define PG8_MMA(ai, bj, At, Bt) do { __builtin_amdgcn_s_setprio(1); _Pragma("unroll") for (int m = 0; m < 4; ++m) _Pragma("unroll") for (int n = 0; n < 2; ++n) _Pragma("unroll") for (int k = 0; k < 2; ++k) \
        acc[ai][bj][m][n] = __builtin_amdgcn_mfma_f32_16x16x32_bf16(Bt[n][k], At[m][k], acc[ai][bj][m][n], 0, 0, 0); __builtin_amdgcn_s_setprio(0); } while (0)
#define PG8_WAIT_V(n) asm volatile("s_waitcnt vmcnt(" #n ")" ::: "memory")
#define PG8_WAIT_L(n) asm volatile("s_waitcnt lgkmcnt(" #n ")" ::: "memory")
#define PG8_BAR __builtin_amdgcn_s_barrier()
#define PG8_SCHED __builtin_amdgcn_sched_barrier(0)
    UnitD cur, nxt; int ui = 0;
    if (!S.next(0, cur)) return;
    const char* cA; const char* cB; int KfC, ntC; unit_gemm(cur, cA, cB, KfC, ntC);
    unsigned voffC[2], voffN[2];
#pragma unroll
    for (int i = 0; i < 2; ++i) { voffC[i] = (unsigned)(Rs[i] * KfC + Cs[i]) * 2u; voffN[i] = voffC[i]; }
    size_t hstepC = (size_t)HALF * KfC * 2, hstepN = hstepC;
    f32x4 acc[2][2][4][2];
#pragma unroll
    for (int a = 0; a < 2; ++a)
#pragma unroll
        for (int b = 0; b < 2; ++b)
#pragma unroll
            for (int m = 0; m < 4; ++m)
#pragma unroll
                for (int n = 0; n < 2; ++n) acc[a][b][m][n] = (f32x4){0.f, 0.f, 0.f, 0.f};
    bf16x8 At[4][2], B0[2][2], B1[2][2];
    if (cur.dep >= 0) dep_wait(cur.dep, (unsigned)cur.want);
    PG8_STAGE(PG8_SB(0, 0), cB, voffC); PG8_STAGE(PG8_SB(0, 1), cB + hstepC, voffC); PG8_STAGE(PG8_SA(0, 0), cA, voffC); PG8_STAGE(PG8_SA(0, 1), cA + hstepC, voffC);
    if (wr == 1) PG8_BAR;
    PG8_WAIT_V(2); PG8_BAR;
    PG8_STAGE(PG8_SB(1, 0), cB + kstep, voffC); PG8_STAGE(PG8_SA(1, 0), cA + kstep, voffC); PG8_STAGE(PG8_SB(1, 1), cB + hstepC + kstep, voffC);
    PG8_WAIT_V(6); PG8_BAR;
    for (;;) {
        const bool has_next = S.next(ui + 1, nxt);
        const char* nA = cA; const char* nB = cB; int KfN = KfC, ntN = ntC;
        if (has_next) unit_gemm(nxt, nA, nB, KfN, ntN);
        if (MIXK) {
#pragma unroll
            for (int i = 0; i < 2; ++i) voffN[i] = (unsigned)(Rs[i] * KfN + Cs[i]) * 2u;
            hstepN = (size_t)HALF * KfN * 2; }
        for (int t = 0; t < ntC; t += 2) {
            const bool last = (t == ntC - 2);
            const char* a1 = cA + (size_t)(t + 1) * kstep;
            const char* a2 = last ? nA : cA + (size_t)(t + 2) * kstep; const char* b2 = last ? nB : cB + (size_t)(t + 2) * kstep;
            const char* a3 = a2 + kstep; const char* b3 = b2 + kstep;
            unsigned vo2[2]; size_t hs2 = hstepC;
#pragma unroll
            for (int i = 0; i < 2; ++i) vo2[i] = voffC[i];
            if (MIXK) { if (last) {
#pragma unroll
                for (int i = 0; i < 2; ++i) vo2[i] = voffN[i];
                hs2 = hstepN; } }
            if (last && has_next && nxt.dep >= 0) dep_wait(nxt.dep, (unsigned)nxt.want);
            if (t == 2) epi_prefetch(cur.kind, cur.pm, cur.pn, lds + EPI_OFF, wid, lane);
            PG8_LDB(B0, 0, 0); PG8_LDB(B1, 0, 1); PG8_SCHED; PG8_LDA(At, 0, 0); PG8_STAGE(PG8_SA(1, 1), a1 + hstepC, voffC);
            PG8_WAIT_V(8); PG8_WAIT_L(0); PG8_BAR; PG8_MMA(0, 0, At, B0); PG8_MMA(0, 1, At, B1); PG8_BAR; PG8_SCHED;
            PG8_LDA(At, 0, 1); PG8_STAGE(PG8_SB(0, 0), b2, vo2); PG8_STAGE(PG8_SB(0, 1), b2 + hs2, vo2); PG8_STAGE(PG8_SA(0, 0), a2, vo2);
            PG8_WAIT_V(8); PG8_WAIT_L(0); PG8_BAR; PG8_MMA(1, 0, At, B0); PG8_MMA(1, 1, At, B1); PG8_BAR; PG8_SCHED;
            PG8_LDB(B0, 1, 0); PG8_LDB(B1, 1, 1); PG8_SCHED; PG8_LDA(At, 1, 0); PG8_STAGE(PG8_SA(0, 1), a2 + hs2, vo2);
            PG8_WAIT_V(8); PG8_WAIT_L(0); PG8_BAR; PG8_MMA(0, 0, At, B0); PG8_MMA(0, 1, At, B1); PG8_BAR; PG8_SCHED;
            PG8_LDA(At, 1, 1); PG8_STAGE(PG8_SB(1, 0), b3, vo2); PG8_STAGE(PG8_SB(1, 1), b3 + hs2, vo2); PG8_STAGE(PG8_SA(1, 0), a3, vo2);
            PG8_WAIT_V(8); PG8_WAIT_L(0); PG8_BAR; PG8_MMA(1, 0, At, B0); PG8_MMA(1, 1, At, B1); PG8_BAR; PG8_SCHED;
        }
        if (wr == 0) PG8_BAR;
        { int fr_e = fr, fq_e = fq; asm volatile("" : "+v"(fr_e), "+v"(fq_e));
          const Unit uu{cur.pm, cur.pn}; LAS unsigned char* elds = lds + EPI_OFF;
          if ((KINDS & ((1 << K_UP0) | (1 << K_UP1))) && (cur.kind == K_UP0 || cur.kind == K_UP1)) { EpiUp E{cur.kind - K_UP0}; E(acc, uu, wr, wc, fr_e, fq_e, elds); }
          if ((KINDS & (1 << K_DN0)) && cur.kind == K_DN0) { EpiRes<false> E{0, 1, 5, 0}; E(acc, uu, wr, wc, fr_e, fq_e, elds); }
          if ((KINDS & (1 << K_DN1)) && cur.kind == K_DN1) { EpiRes<true> E{2, 0, 5, D}; E(acc, uu, wr, wc, fr_e, fq_e, elds); }
          if ((KINDS & (1 << K_IN)) && cur.kind == K_IN) { EpiIn E{0}; E(acc, uu, wr, wc, fr_e, fq_e, elds); }
          if ((KINDS & (1 << K_OUT)) && cur.kind == K_OUT) { EpiRes<false> E{1, 2, 17, 0}; E(acc, uu, wr, wc, fr_e, fq_e, elds); }
          if ((KINDS & ((1 << K_DNS0) | (1 << K_DNS1))) && (cur.kind == K_DNS0 || cur.kind == K_DNS1)) { EpiPartial E; E(acc, cur); }
          if (cur.sig >= 0) unit_signal(cur.sig); }
        if (!has_next) break;
#pragma unroll
        for (int a = 0; a < 2; ++a)
#pragma unroll
            for (int b = 0; b < 2; ++b)
#pragma unroll
                for (int m = 0; m < 4; ++m)
#pragma unroll
                    for (int n = 0; n < 2; ++n) acc[a][b][m][n] = (f32x4){0.f, 0.f, 0.f, 0.f};
        cur = nxt; cA = nA; cB = nB; KfC = KfN; ntC = ntN; ++ui;
        if (MIXK) {
#pragma unroll
            for (int i = 0; i < 2; ++i) voffC[i] = voffN[i];
            hstepC = hstepN; }
        if (wr == 1) PG8_BAR;
    }
    PG8_WAIT_V(0);
    PG8_BAR;
#undef PG8_SA
#undef PG8_SB
#undef PG8_STAGE
#undef PG8_LDA
#undef PG8_LDB
#undef PG8_MMA
#undef PG8_WAIT_V
#undef PG8_WAIT_L
#undef PG8_BAR
#undef PG8_SCHED
}
struct SchedSimple {
    int kind, nM, nN, G, c;
    __device__ __forceinline__ bool next(int i, UnitD& u) const {
        const long L = (long)i * G + c; if (L >= (long)nM * nN) return false;
        u.kind = kind; map_unit((int)L, nM, nN, u.pm, u.pn); u.ks = 0; u.dep = -1; u.want = 0; u.sig = -1; return true; }
};
struct SchedUp {
    int l, c, first, count, gpos; UnitD guest;
    __device__ __forceinline__ void init(int l_, int c_) {
        l = l_; c = c_; first = 0; count = 6; gpos = -1; guest.kind = 0; guest.pm = 0; guest.pn = 0; guest.ks = 0; guest.dep = -1; guest.want = 0; guest.sig = -1;
        const int lc = c - 128; if (lc < 0) return;
        if (l == 0) {
            if (lc < 44) { gpos = 0; guest.kind = K_UP0; guest.pm = NPANEL_P + lc / 22; guest.pn = lc % 22; guest.sig = C_UP(0, lc / 22); }
            else if (lc < 76) { const int ix = lc - 44, p = ix >> 4; gpos = 2; guest.kind = K_DNS0; guest.pm = NPANEL_P + p; guest.pn = (ix >> 2) & 3; guest.ks = ix & 3; guest.dep = C_UP(0, p); guest.want = 22; guest.sig = C_DNS(0, p, guest.pn); }
            else if (lc < 84) { }
            else if (lc < 108) { const int ix = lc - 84, p = ix / 12; gpos = 5; guest.kind = K_IN; guest.pm = NPANEL_P + p; guest.pn = ix % 12; guest.dep = C_FIN(0, p); guest.want = 4; }
        } else {
            if (lc < 8) { gpos = 0; guest.kind = K_OUT; guest.pm = NPANEL_P + (lc >> 2); guest.pn = lc & 3; guest.sig = C_OUT(lc >> 2); }
            else if (lc < 52) { const int ix = lc - 8, p = ix / 22; gpos = 2; guest.kind = K_UP1; guest.pm = NPANEL_P + p; guest.pn = ix % 22; guest.dep = C_OUT(p); guest.want = 4; guest.sig = C_UP(1, p); }
            else if (lc < 84) { const int ix = lc - 52, p = ix >> 4; gpos = 4; guest.kind = K_DNS1; guest.pm = NPANEL_P + p; guest.pn = (ix >> 2) & 3; guest.ks = ix & 3; guest.dep = C_UP(1, p); guest.want = 22; guest.sig = C_DNS(1, p, guest.pn); }
        }
    }
    __device__ __forceinline__ bool next(int i, UnitD& u) const {
        if (i >= count) return false;
        const int pos = first + i; int ip = pos;
        if (gpos >= 0) { if (pos == gpos) { u = guest; return true; } if (pos > gpos) ip = pos - 1; }
        const int L = ip * 256 + c; if (L >= NPANEL_P * 22) return false;
        u.kind = l == 0 ? K_UP0 : K_UP1; map_unit(L, NPANEL_P, 22, u.pm, u.pn); u.ks = 0; u.dep = -1; u.want = 0; u.sig = -1; return true; }
};
}

template <int L_> __device__ __forceinline__ void finisher(LAS unsigned char* lds, int p, int pn) {
    dep_wait(C_DNS(L_, p, pn), 4u);
    const int tid = tid_fresh(), wid = __builtin_amdgcn_readfirstlane(tid >> 6), lane = tid & 63, wr = wid >> 2, wc = wid & 3, fr = lane & 15, fq = lane >> 4;
    f32x4 acc[2][2][4][2];
    const char* pb = (const char*)(kargs()->ws + WS_PBUF) + (size_t)(((p * 4 + pn) * 4) * 32) * 8192;
#pragma unroll
    for (int ai = 0; ai < 2; ++ai)
#pragma unroll
        for (int bj = 0; bj < 2; ++bj)
#pragma unroll
            for (int m = 0; m < 4; m += 2) {
#pragma unroll
                for (int mm = 0; mm < 2; ++mm)
#pragma unroll
                    for (int n = 0; n < 2; ++n) { const unsigned o = (unsigned)(((((ai * 2 + bj) * 4 + m + mm) * 2 + n) * 512 + tid) * 16);
                        acc[ai][bj][m + mm][n] = (*(const f32x4*)(pb + o) + *(const f32x4*)(pb + o + 262144u)) + (*(const f32x4*)(pb + o + 2u * 262144u) + *(const f32x4*)(pb + o + 3u * 262144u)); }
                asm volatile("" : "+v"(acc[ai][bj][m][0]), "+v"(acc[ai][bj][m][1]), "+v"(acc[ai][bj][m + 1][0]), "+v"(acc[ai][bj][m + 1][1]) :: "memory"); }
    epi_prefetch(L_ == 0 ? pg8::K_DN0 : pg8::K_DN1, NPANEL_P + p, pn, lds + EPI_OFF, wid, lane);
    asm volatile("s_waitcnt vmcnt(0)" ::: "memory"); __syncthreads();
    const pg8::Unit uu{NPANEL_P + p, pn};
    if (L_ == 0) { EpiRes<false> E{0, 1, 5, 0}; E(acc, uu, wr, wc, fr, fq, lds + EPI_OFF); unit_signal(C_FIN(0, p)); }
    else { EpiRes<true> E{2, 0, 5, D}; E(acc, uu, wr, wc, fr, fq, lds + EPI_OFF); }
    asm volatile("s_waitcnt vmcnt(0) lgkmcnt(0)" ::: "memory"); __syncthreads();
}

__device__ __forceinline__ void p0_item(const float* W, int K, int N, int kb, int nb, bf16_t* WT, int dest_row0, const float* rowscale, const float* colscale,
                                        float* csp, const float* bvec, float* cbp, int pstride, LAS float* scr, int lane) {
    const int k0 = 64 * kb, n0 = 32 * nb;
#pragma unroll 8
    for (int i = 0; i < 32; ++i) { const int kk = 2 * i + (lane >> 5); scr[kk * 33 + (lane & 31)] = W[(size_t)(k0 + kk) * N + n0 + (lane & 31)]; }
    asm volatile("s_waitcnt lgkmcnt(0)" ::: "memory");
    const int c = lane & 7;
    float rs[8], bb[8];
#pragma unroll
    for (int i = 0; i < 8; ++i) { rs[i] = rowscale ? rowscale[k0 + 8 * c + i] : 1.0f; bb[i] = bvec ? bvec[k0 + 8 * c + i] : 0.0f; }
#pragma unroll
    for (int j = 0; j < 4; ++j) { const int n = (lane >> 3) + 8 * j; const LAS float* s = scr + (8 * c) * 33 + n;
        const float sc = colscale ? colscale[n0 + n] : 1.0f;
        unsigned r[8]; float ps = 0.f, pb = 0.f;
#pragma unroll
        for (int i = 0; i < 8; ++i) { const float w = s[i * 33]; r[i] = f2bf(w * rs[i] * sc); ps += bf2f(r[i]); pb += w * bb[i]; }
        u32x4 o; o.x = r[0] | (r[1] << 16); o.y = r[2] | (r[3] << 16); o.z = r[4] | (r[5] << 16); o.w = r[6] | (r[7] << 16);
        *(u32x4*)(WT + (size_t)(dest_row0 + n) * K + k0 + 8 * c) = o;
        if (csp) {
            ps += __shfl_xor(ps, 1); ps += __shfl_xor(ps, 2); ps += __shfl_xor(ps, 4);
            pb += __shfl_xor(pb, 1); pb += __shfl_xor(pb, 2); pb += __shfl_xor(pb, 4);
            if (c == 0) { csp[(size_t)kb * pstride + dest_row0 + n] = ps; cbp[(size_t)kb * pstride + dest_row0 + n] = pb; }
        }
    }
    asm volatile("s_waitcnt lgkmcnt(0)" ::: "memory");
}
__device__ __forceinline__ int up_dest(int n) { return n < FF ? 256 * (n >> 7) + (n & 127) : 256 * ((n - FF) >> 7) + 128 + ((n - FF) & 127); }
__device__ __forceinline__ int in_dest(int n) { return n < D ? 2048 + n : (n < 2 * D ? 256 * ((n - D) >> 7) + ((n - D) & 127) : 256 * ((n - 2 * D) >> 7) + 128 + ((n - 2 * D) & 127)); }

__device__ __forceinline__ void phase0(LAS unsigned char* lds) {
    const KA Params* q = kargs();
    const int tid = tid_fresh(), lane = tid & 63, wave = tid >> 6;
    LAS float* scr = (LAS float*)(lds + wave * 8704);
    const int gw = blockIdx.x * 8 + wave, NGW = gridDim.x * 8;
    unsigned char* ws = q->ws;
    constexpr int I_UP = 16 * 176, I_IN = 16 * 96, I_OUT = 16 * 32, I_DN = 44 * 32, I_POOL = 4 * 8;
    constexpr int NITEMS = 2 * I_UP + I_IN + I_OUT + 2 * I_DN + 4 * I_POOL;
    for (int it = gw; it < NITEMS; it += NGW) {
        int r = it;
        if (r < 2 * I_UP) { const int l = r / I_UP; r -= l * I_UP; const int kb = r / 176, nb = r % 176;
            p0_item(q->in[13] + (size_t)l * D * FF2, D, FF2, kb, nb, (bf16_t*)(ws + WS_WUP) + (size_t)l * FF2 * D, up_dest(32 * nb), q->in[5] + l * D, nullptr,
                    (float*)(ws + WS_CSP_UP) + (size_t)l * 16 * FF2, q->in[6] + l * D, (float*)(ws + WS_CBP_UP) + (size_t)l * 16 * FF2, FF2, scr, lane); continue; }
        r -= 2 * I_UP;
        if (r < I_IN) { const int kb = r / 96, nb = r % 96;
            p0_item(q->in[9], D, 3 * D, kb, nb, (bf16_t*)(ws + WS_WIN), in_dest(32 * nb), q->in[17], nullptr, (float*)(ws + WS_CSP_IN), q->in[18], (float*)(ws + WS_CBP_IN), 3 * D, scr, lane); continue; }
        r -= I_IN;
        if (r < I_OUT) { const int kb = r / 32, nb = r % 32;
            p0_item(q->in[12], D, D, kb, nb, (bf16_t*)(ws + WS_WOUT), 32 * nb, nullptr, nullptr, nullptr, nullptr, nullptr, 0, scr, lane); continue; }
        r -= I_OUT;
        if (r < 2 * I_DN) { const int l = r / I_DN; r -= l * I_DN; const int kb = r / 32, nb = r % 32;
            p0_item(q->in[16] + (size_t)l * FF * D, FF, D, kb, nb, (bf16_t*)(ws + WS_WDN) + (size_t)l * D * FF, 32 * nb, nullptr, nullptr, nullptr, nullptr, nullptr, 0, scr, lane); continue; }
        r -= 2 * I_DN;
        { const int g = r / I_POOL; r -= g * I_POOL; const int kb = r / 8, nb = r % 8;
            p0_item(q->in[7] + (size_t)g * 256 * 256, 256, 256, kb, nb, (bf16_t*)(ws + WS_WPOOL) + (size_t)g * 256 * 256, 32 * nb, nullptr, q->in[8] + g * 256, nullptr, nullptr, nullptr, 0, scr, lane); }
    }
    const int gt = blockIdx.x * 512 + tid, NGT = gridDim.x * 512;
    for (int i = gt; i < 2 * FF2; i += NGT) { const int l = i / FF2, n = i % FF2, d = up_dest(n); float* kc = (float*)(ws + WS_KC_UP) + (size_t)l * 4 * FF2;
        kc[d] = q->in[14][(size_t)(l * 3 + 0) * FF2 + n]; kc[FF2 + d] = q->in[14][(size_t)(l * 3 + 1) * FF2 + n]; kc[2 * FF2 + d] = q->in[14][(size_t)(l * 3 + 2) * FF2 + n]; kc[3 * FF2 + d] = q->in[15][(size_t)l * FF2 + n]; }
    for (int i = gt; i < NB_P * 15 * (D / 4); i += NGT) { const int c4 = i % (D / 4), rr = (i / (D / 4)) % 15, b = i / (15 * (D / 4));
        ((f32x4*)(q->out + O_POOL_P))[i] = *(const f32x4*)(q->in[0] + ((size_t)b * SEQ + 2033 + rr) * D + c4 * 4); }
    for (int i = gt; i < NB_S * 15 * (D / 4); i += NGT) { const int c4 = i % (D / 4), rr = (i / (D / 4)) % 15, s = i / (15 * (D / 4));
        ((f32x4*)(q->out + O_POOL_S))[i] = rr < 11 ? *(const f32x4*)(q->in[2] + ((size_t)s * 15 + 4 + rr) * D + c4 * 4) : *(const f32x4*)(q->in[1] + ((size_t)s * TS + rr - 11) * D + c4 * 4); }
}

template <int W>
__device__ __forceinline__ void p1_window_prompt(const float* xseq, int tpos0, LAS unsigned char* lds, int row0, int cq) {
    f32x4 a[16 + W];
#pragma unroll
    for (int k = 0; k < 16 + W; ++k) { const int t = tpos0 - W + k, tc = t < 0 ? 0 : t; const f32x4 v = *(const f32x4*)(xseq + (size_t)tc * D); a[k] = t >= 0 ? v : (f32x4){0.f, 0.f, 0.f, 0.f}; }
    f32x4 s = {0.f, 0.f, 0.f, 0.f};
#pragma unroll
    for (int k = 0; k < W; ++k) s += a[k];
#pragma unroll
    for (int j = 0; j < 16; ++j) { s += a[W + j] - a[j]; const int t = tpos0 + j; const float inv = 1.0f / (float)(t + 1 < W ? t + 1 : W); const f32x4 d = s * inv - a[W + j];
        const int row = row0 + j; u32x2 w; w.x = pk2(d[0], d[1]); w.y = pk2(d[2], d[3]);
        *(LAS u32x2*)(lds + row * 2048 + ((((cq >> 1) ^ (row & 15))) << 4) + (cq & 1) * 8) = w; }
}
template <int W>
__device__ __forceinline__ void p1_window_sample(const float* hist, const float* xs, LAS unsigned char* lds, int row0, int cq) {
    f32x4 a[W + 4];
#pragma unroll
    for (int k = 0; k < W; ++k) { const int i = W - k; a[k] = i <= 15 ? *(const f32x4*)(hist + (size_t)(15 - i) * D) : (f32x4){0.f, 0.f, 0.f, 0.f}; }
#pragma unroll
    for (int t = 0; t < 4; ++t) a[W + t] = *(const f32x4*)(xs + (size_t)t * D);
    f32x4 s = {0.f, 0.f, 0.f, 0.f};
#pragma unroll
    for (int k = 0; k < W; ++k) s += a[k];
#pragma unroll
    for (int t = 0; t < 4; ++t) { s += a[W + t] - a[t]; const f32x4 d = s * (1.0f / (float)W) - a[W + t];
        const int row = row0 + t; u32x2 w; w.x = pk2(d[0], d[1]); w.y = pk2(d[2], d[3]);
        *(LAS u32x2*)(lds + row * 2048 + ((((cq >> 1) ^ (row & 15))) << 4) + (cq & 1) * 8) = w; }
}
__device__ __forceinline__ void phase1(LAS unsigned char* lds) {
    const KA Params* q = kargs();
    const int tid = tid_fresh(), lane = tid & 63, wave = __builtin_amdgcn_readfirstlane(tid >> 6), fr = lane & 15, fq = lane >> 4;
    unsigned char* ws = q->ws;
    { const int gt = blockIdx.x * 512 + tid, NGT = gridDim.x * 512;
      for (int i = gt; i < 2 * FF2 + 3 * D; i += NGT) {
          float s = 0.f, b = 0.f;
          if (i < 2 * FF2) { const int l = i / FF2, c = i % FF2; const float* sp = (const float*)(ws + WS_CSP_UP) + (size_t)l * 16 * FF2 + c; const float* bp = (const float*)(ws + WS_CBP_UP) + (size_t)l * 16 * FF2 + c;
              for (int k = 0; k < 16; ++k) { s += sp[(size_t)k * FF2]; b += bp[(size_t)k * FF2]; }
              ((float*)(ws + WS_CS_UP))[i] = s; ((float*)(ws + WS_CB_UP))[i] = b; }
          else { const int c = i - 2 * FF2; const float* sp = (const float*)(ws + WS_CSP_IN) + c; const float* bp = (const float*)(ws + WS_CBP_IN) + c;
              for (int k = 0; k < 16; ++k) { s += sp[(size_t)k * 3 * D]; b += bp[(size_t)k * 3 * D]; }
              ((float*)(ws + WS_CS_IN))[c] = s; ((float*)(ws + WS_CB_IN))[c] = b; } } }
    const bf16_t* wpool = (const bf16_t*)(ws + WS_WPOOL);
    bf16_t* vbf = (bf16_t*)(ws + WS_H1);
    f32x2* part = (f32x2*)(ws + WS_PART);
    LAS f32x2* T = (LAS f32x2*)(lds + P1_T_OFF);
    const int cq = tid & 255, th = __builtin_amdgcn_readfirstlane(tid >> 8), gw = (wave & 3);
    const int g = wave >> 1, hh = wave & 1;
    for (int tile = blockIdx.x; tile < NTOK_P / 64; tile += gridDim.x) {
        const int tok0 = tile * 64, t0 = tok0 & (SEQ - 1);
        const bool host = (tile & 3) == 0; const int seq0 = 2 * (tile >> 2);
        { const float* xseq = q->in[0] + (size_t)(tok0 - t0) * D + 4 * cq;
#pragma unroll 1
          for (int st = 0; st < 2; ++st) { const int r0 = 32 * th + 16 * st;
              if (gw == 0) p1_window_prompt<2>(xseq, t0 + r0, lds, r0, cq); else if (gw == 1) p1_window_prompt<4>(xseq, t0 + r0, lds, r0, cq);
              else if (gw == 2) p1_window_prompt<8>(xseq, t0 + r0, lds, r0, cq); else p1_window_prompt<16>(xseq, t0 + r0, lds, r0, cq); }
          if (host) { const float* hist = q->in[2] + (size_t)(seq0 + th) * 15 * D + 4 * cq; const float* xs = q->in[1] + (size_t)(seq0 + th) * TS * D + 4 * cq;
              if (gw == 0) p1_window_sample<2>(hist, xs, lds, 64 + 4 * th, cq); else if (gw == 1) p1_window_sample<4>(hist, xs, lds, 64 + 4 * th, cq);
              else if (gw == 2) p1_window_sample<8>(hist, xs, lds, 64 + 4 * th, cq); else p1_window_sample<16>(hist, xs, lds, 64 + 4 * th, cq); } }
        float rsum[5], rsq[5];
#pragma unroll
        for (int mb = 0; mb < 5; ++mb) { rsum[mb] = 0.f; rsq[mb] = 0.f; }
#pragma unroll 1
        for (int half = 0; half < 2; ++half) {
            f32x4 acc[5][4];
#pragma unroll
            for (int mb = 0; mb < 5; ++mb)
#pragma unroll
                for (int nb = 0; nb < 4; ++nb) acc[mb][nb] = (f32x4){0.f, 0.f, 0.f, 0.f};
            const bf16_t* wb = wpool + ((size_t)g * 256 + 128 * hh + 64 * half + fr) * 256 + 8 * fq;
#pragma unroll 1
            for (int kh = 0; kh < 2; ++kh) {
                bf16x8 b[4][4];
#pragma unroll
                for (int ks = 0; ks < 4; ++ks)
#pragma unroll
                    for (int nb = 0; nb < 4; ++nb) b[ks][nb] = *(const bf16x8*)(wb + (size_t)(16 * nb) * 256 + 32 * (4 * kh + ks));
                if (half == 0 && kh == 0) __syncthreads();
#pragma unroll
                for (int ks = 0; ks < 4; ++ks) {
                    const int chunk = 32 * g + 4 * (4 * kh + ks) + fq;
                    bf16x8 a[5];
#pragma unroll
                    for (int mb = 0; mb < 5; ++mb) { const int row = mb < 4 ? 16 * mb + fr : 64 + (fr & 7); a[mb] = *(const LAS bf16x8*)(lds + row * 2048 + ((chunk ^ (row & 15)) << 4)); }
#pragma unroll
                    for (int mb = 0; mb < 4; ++mb)
#pragma unroll
                        for (int nb = 0; nb < 4; ++nb) acc[mb][nb] = __builtin_amdgcn_mfma_f32_16x16x32_bf16(b[ks][nb], a[mb], acc[mb][nb], 0, 0, 0);
                    if (host) {
#pragma unroll
                        for (int nb = 0; nb < 4; ++nb) acc[4][nb] = __builtin_amdgcn_mfma_f32_16x16x32_bf16(b[ks][nb], a[4], acc[4][nb], 0, 0, 0); }
                }
            }
            const int c0 = 256 * g + 128 * hh + 64 * half + 4 * fq;
#pragma unroll
            for (int mb = 0; mb < 5; ++mb) {
                if (mb == 4 && (!host || fr >= 8)) continue;
                const int tok = mb < 4 ? tok0 + 16 * mb + fr : NTOK_P + 4 * seq0 + fr, R = row_of_tok(tok);
                const float* xr = (mb < 4 ? q->in[0] + (size_t)tok * D : q->in[1] + (size_t)(tok - NTOK_P) * D) + c0;
                f32x4 xv[4];
#pragma unroll
                for (int nb = 0; nb < 4; ++nb) xv[nb] = *(const f32x4*)(xr + 16 * nb);
#pragma unroll
                for (int nb = 0; nb < 4; ++nb) { const f32x4 v = xv[nb] * ALPHA + acc[mb][nb];
                    rsum[mb] += (v[0] + v[1]) + (v[2] + v[3]); rsq[mb] += (v[0] * v[0] + v[1] * v[1]) + (v[2] * v[2] + v[3] * v[3]);
                    u32x2 wv; wv.x = pk2(v[0], v[1]); wv.y = pk2(v[2], v[3]); *(u32x2*)(vbf + (size_t)R * D + c0 + 16 * nb) = wv; }
            }
        }
#pragma unroll
        for (int mb = 0; mb < 5; ++mb) {
            float sum = rsum[mb], sq = rsq[mb];
            sum += __shfl_xor(sum, 16); sum += __shfl_xor(sum, 32); sq += __shfl_xor(sq, 16); sq += __shfl_xor(sq, 32);
            if (fq == 0 && (mb < 4 || fr < 8)) { f32x2 t; t.x = sum; t.y = sq; T[(mb < 4 ? 16 * mb + fr : 64 + fr) * 8 + wave] = t; }
        }
        __syncthreads();
        if (tid < 4 * (host ? 72 : 64)) { const int row = tid >> 2, gg = tid & 3; const f32x2 a = T[row * 8 + 2 * gg], b = T[row * 8 + 2 * gg + 1];
            const float mt = (a.x + b.x) * (1.0f / 256.0f); f32x2 r; r.x = mt; r.y = (a.y + b.y) - 256.0f * mt * mt;
            const int tok = row < 64 ? tok0 + row : NTOK_P + 4 * seq0 + (row - 64);
            part[(size_t)row_of_tok(tok) * 4 + gg] = r; }
        __syncthreads();
    }
}

__device__ __forceinline__ void phase_fixup(int l) {
    const KA Params* q = kargs();
    const float* kc = (const float*)(q->ws + WS_KC_UP) + (size_t)l * 4 * FF2; bf16_t* act = (bf16_t*)(q->ws + WS_ACT);
    const float* Hf = (const float*)(q->ws + WS_HF); const float* Hl = (const float*)(q->ws + WS_HL);
    const int gt = blockIdx.x * 512 + tid_fresh(), NGT = gridDim.x * 512;
    for (int i = gt; i < 128 * (FF / 4); i += NGT) {
        const int q = i / (FF / 4), f = (i % (FF / 4)) * 4;
        if ((q & 15) == 0) continue;
        const int cg_ = 256 * (f >> 7) + (f & 127), cv_ = cg_ + 128;
        const float* hf = Hf + (size_t)q * 2 * FF2; const float* hl = Hl + (size_t)(q - 1) * 2 * FF2;
        const f32x4 k0g = *(const f32x4*)(kc + cg_), k1g = *(const f32x4*)(kc + FF2 + cg_), k2g = *(const f32x4*)(kc + 2 * FF2 + cg_), kbg = *(const f32x4*)(kc + 3 * FF2 + cg_);
        const f32x4 k0v = *(const f32x4*)(kc + cv_), k1v = *(const f32x4*)(kc + FF2 + cv_), k2v = *(const f32x4*)(kc + 2 * FF2 + cv_), kbv = *(const f32x4*)(kc + 3 * FF2 + cv_);
        const f32x4 g2 = *(const f32x4*)(hl + cg_), g1 = *(const f32x4*)(hl + FF2 + cg_), a0 = *(const f32x4*)(hf + cg_), a1 = *(const f32x4*)(hf + FF2 + cg_);
        const f32x4 v2 = *(const f32x4*)(hl + cv_), v1 = *(const f32x4*)(hl + FF2 + cv_), b0 = *(const f32x4*)(hf + cv_), b1 = *(const f32x4*)(hf + FF2 + cv_);
        const f32x4 zg0 = k2g * a0 + k1g * g1 + k0g * g2 + kbg, zv0 = k2v * b0 + k1v * v1 + k0v * v2 + kbv;
        const f32x4 zg1 = k2g * a1 + k1g * a0 + k0g * g1 + kbg, zv1 = k2v * b1 + k1v * b0 + k0v * v1 + kbv;
        const int R0 = (q >> 1) * 256 + 64 * (q & 1);
        u32x2 w0, w1; w0.x = pk2(silu_mul(zg0[0], zv0[0]), silu_mul(zg0[1], zv0[1])); w0.y = pk2(silu_mul(zg0[2], zv0[2]), silu_mul(zg0[3], zv0[3]));
        w1.x = pk2(silu_mul(zg1[0], zv1[0]), silu_mul(zg1[1], zv1[1])); w1.y = pk2(silu_mul(zg1[2], zv1[2]), silu_mul(zg1[3], zv1[3]));
        *(u32x2*)(act + (size_t)R0 * FF + f) = w0; *(u32x2*)(act + (size_t)(R0 + 16) * FF + f) = w1;
    }
}

__device__ __forceinline__ void phase_conv() {
    const KA Params* q = kargs();
    bf16_t* obuf = (bf16_t*)q->out;
    const float* ck = q->in[10]; const float* ckb = q->in[11]; const float* st = q->in[3];
    const int gt = blockIdx.x * 512 + tid_fresh(), NGT = gridDim.x * 512;
    for (int i = gt; i < MROWS * (D / 8); i += NGT) {
        const int tok = i >> 7, ch = (i & 127) * 8;
        int t, seq = 0; const bool sample = tok >= NTOK_P;
        if (!sample) t = tok & (SEQ - 1); else { seq = (tok - NTOK_P) >> 2; t = tok & 3; }
        const bf16_t* ubuf = sample ? (const bf16_t*)(q->ws + WS_SU) - (size_t)NTOK_P * D : (const bf16_t*)(q->ws + WS_ACT);
        const bf16_t* bbuf = sample ? (const bf16_t*)(q->ws + WS_SB) - (size_t)NTOK_P * D : (const bf16_t*)(q->ws + WS_ACT) + (size_t)MROWS * D;
        const int R = row_of_tok(tok);
        float u0[8], u1[8], u2[8], bb[8];
        { const u32x4 w = *(const u32x4*)(ubuf + (size_t)R * D + ch); const u32x4 wb = *(const u32x4*)(bbuf + (size_t)R * D + ch);
#pragma unroll
          for (int e = 0; e < 4; ++e) { u2[2 * e] = bf2f(w[e] & 0xffffu); u2[2 * e + 1] = bf2f(w[e] >> 16); bb[2 * e] = bf2f(wb[e] & 0xffffu); bb[2 * e + 1] = bf2f(wb[e] >> 16); } }
        if (t >= 1) { const u32x4 w = *(const u32x4*)(ubuf + (size_t)row_of_tok(tok - 1) * D + ch);
#pragma unroll
            for (int e = 0; e < 4; ++e) { u1[2 * e] = bf2f(w[e] & 0xffffu); u1[2 * e + 1] = bf2f(w[e] >> 16); } }
        else if (sample) { const f32x4 a = *(const f32x4*)(st + ((size_t)seq * 2 + 1) * D + ch), b = *(const f32x4*)(st + ((size_t)seq * 2 + 1) * D + ch + 4);
#pragma unroll
            for (int e = 0; e < 4; ++e) { u1[e] = a[e]; u1[4 + e] = b[e]; } }
        else {
#pragma unroll
            for (int e = 0; e < 8; ++e) u1[e] = 0.f; }
        if (t >= 2) { const u32x4 w = *(const u32x4*)(ubuf + (size_t)row_of_tok(tok - 2) * D + ch);
#pragma unroll
            for (int e = 0; e < 4; ++e) { u0[2 * e] = bf2f(w[e] & 0xffffu); u0[2 * e + 1] = bf2f(w[e] >> 16); } }
        else if (sample) { const f32x4 a = *(const f32x4*)(st + ((size_t)seq * 2 + t) * D + ch), b = *(const f32x4*)(st + ((size_t)seq * 2 + t) * D + ch + 4);
#pragma unroll
            for (int e = 0; e < 4; ++e) { u0[e] = a[e]; u0[4 + e] = b[e]; } }
        else {
#pragma unroll
            for (int e = 0; e < 8; ++e) u0[e] = 0.f; }
        float o[8];
#pragma unroll
        for (int e = 0; e < 8; ++e) o[e] = bb[e] * (ck[ch + e] * u0[e] + ck[D + ch + e] * u1[e] + ck[2 * D + ch + e] * u2[e] + ckb[ch + e]);
        u32x4 w; w.x = pk2(o[0], o[1]); w.y = pk2(o[2], o[3]); w.z = pk2(o[4], o[5]); w.w = pk2(o[6], o[7]);
        *(u32x4*)(obuf + (size_t)R * D + ch) = w;
    }
}

__device__ __forceinline__ void phase_final() {
    const KA Params* q = kargs();
    const f32x2* part = (const f32x2*)(q->ws + WS_PART); const float* g = q->in[17] + D; const float* b = q->in[18] + D;
    const int tid = tid_fresh(), lane = tid & 63, gw = blockIdx.x * 8 + (tid >> 6), NGW = gridDim.x * 8;
    f32x4 gv[4], bv[4];
#pragma unroll
    for (int j = 0; j < 4; ++j) { gv[j] = *(const f32x4*)(g + 256 * j + 4 * lane); bv[j] = *(const f32x4*)(b + 256 * j + 4 * lane); }
    for (int tok = gw; tok < MROWS; tok += NGW) {
        const f32x2 s = row_stats(part, row_of_tok(tok));
        float* yr = q->out + (size_t)tok * D + 4 * lane;
#pragma unroll
        for (int j = 0; j < 4; ++j) { const f32x4 v = *(const f32x4*)(yr + 256 * j); *(f32x4*)(yr + 256 * j) = ((v - s.x) * s.y) * gv[j] + bv[j]; }
    }
}

#define XB_TMO      128
#define XB_XCNT(j)  (256  + 64 * (j))
#define XB_XSUB(j)  (1280 + 64 * (j))
#define XB_XGEN(j)  (2304 + 64 * (j))
#define XB_TOP      3328
#define XB_TOPGEN   3392
#define XCD_BAR_WORDS 3456
#define XB_SPIN_CAP (1u << 18)

__device__ __forceinline__ unsigned xb_ld(unsigned* p)              { return __hip_atomic_load(p, __ATOMIC_RELAXED, __HIP_MEMORY_SCOPE_AGENT); }
__device__ __forceinline__ unsigned xb_add(unsigned* p, unsigned v) { return __hip_atomic_fetch_add(p, v, __ATOMIC_RELAXED, __HIP_MEMORY_SCOPE_AGENT); }
__device__ __forceinline__ unsigned xb_xcc_id() { return (unsigned)__builtin_amdgcn_s_getreg((3 << 11) | 20) & 0xFu; }
#define XB_SPIN(cond, bar) do { unsigned _sp = 0; while (cond) { __builtin_amdgcn_s_sleep(1); \
    if ((++_sp & 255u) == 0u) { if (xb_ld(&(bar)[XB_TMO])) break; if (_sp > XB_SPIN_CAP) { atomicAdd(&(bar)[XB_TMO], 1u); break; } } } } while (0)

struct XcdBarrier {
    unsigned* bar; unsigned x;
    volatile LAS unsigned* st;
};

__device__ __forceinline__ XcdBarrier xcd_barrier_post(unsigned* bar, volatile LAS unsigned* st) {
    XcdBarrier b; b.bar = bar; b.x = xb_xcc_id(); b.st = st;
    if (threadIdx.x == 0) (void)xb_add(&bar[XB_XCNT(b.x)], 1u);
    return b;
}
__device__ __forceinline__ void xcd_barrier_complete(unsigned* bar, unsigned x, unsigned& nloc, unsigned& nx) {
    const unsigned G = gridDim.x * gridDim.y * gridDim.z;
    unsigned sum, cnt, mine, sp = 0u;
    for (;;) {
        sum = 0u; cnt = 0u; mine = 0u;
#pragma unroll
        for (unsigned j = 0; j < 16; ++j) { const unsigned c = xb_ld(&bar[XB_XCNT(j)]); sum += c; cnt += (c > 0u) ? 1u : 0u; mine = (j == x) ? c : mine; }
        if (sum == G) break;
        __builtin_amdgcn_s_sleep(1);
        if ((++sp & 255u) == 0u) { if (xb_ld(&bar[XB_TMO])) break; if (sp > XB_SPIN_CAP) { atomicAdd(&bar[XB_TMO], 1u); break; } }
    }
    nloc = mine > 0u ? mine : 1u; nx = cnt > 0u ? cnt : 1u;
}

__device__ __forceinline__ void xcd_barrier(const XcdBarrier& b) {
    asm volatile("s_waitcnt vmcnt(0)" ::: "memory");
    __syncthreads();
    if (threadIdx.x == 0) {
        unsigned* bar = b.bar;
        __builtin_amdgcn_s_waitcnt(0);
        unsigned nloc = b.st[0], nx = b.st[1];
        if (nloc == 0u) { xcd_barrier_complete(bar, b.x, nloc, nx); b.st[0] = nloc; b.st[1] = nx; }
        const unsigned old = xb_add(&bar[XB_XSUB(b.x)], 1u);
        const unsigned gen = old / nloc;
        if (old + 1u == (gen + 1u) * nloc) {
            __builtin_amdgcn_fence(__ATOMIC_RELEASE, "agent");
            asm volatile("s_waitcnt vmcnt(0)" ::: "memory");
            const unsigned og = xb_add(&bar[XB_TOP], 1u);
            const unsigned tg = og / nx;
            if (og + 1u == (tg + 1u) * nx) xb_add(&bar[XB_TOPGEN], 1u);
            else XB_SPIN(xb_ld(&bar[XB_TOPGEN]) == tg, bar);
            __builtin_amdgcn_fence(__ATOMIC_ACQUIRE, "agent");
            xb_add(&bar[XB_XGEN(b.x)], 1u);
            asm volatile("s_waitcnt vmcnt(0)" ::: "memory");
        } else {
            XB_SPIN(xb_ld(&bar[XB_XGEN(b.x)]) == gen, bar);
            __builtin_amdgcn_fence(__ATOMIC_ACQUIRE, "agent");
            asm volatile("s_waitcnt vmcnt(0)" ::: "memory");
        }
    }
    __syncthreads();
}


__global__ void __launch_bounds__(512, 2) fwd_megakernel(Params p) {
    extern __shared__ __attribute__((aligned(16))) unsigned char lds_raw[];
    LAS unsigned char* lds = (LAS unsigned char*)lds_raw;
    cg::grid_group grid = cg::this_grid();
    const int G = gridDim.x, cid = blockIdx.x;
    if (threadIdx.x < 2) ((LAS unsigned*)(lds + BARST_OFF))[threadIdx.x] = 0u;
    __syncthreads();
    const XcdBarrier bar = xcd_barrier_post((unsigned*)(kargs()->ws + WS_BAR), (volatile LAS unsigned*)(lds + BARST_OFF));
    using namespace pg8;
    constexpr int M_UP = (1 << K_UP0) | (1 << K_UP1), M_DNS = (1 << K_DNS0) | (1 << K_DNS1);
#if DIAG & 1
    for (int rep = 0; rep < ((REP & 1) ? 2 : 1); ++rep) phase0(lds);
#endif
    grid.sync();
#if DIAG & 2
    for (int rep = 0; rep < ((REP & 2) ? 2 : 1); ++rep) phase1(lds);
#endif
    xcd_barrier(bar);
#if SEG & 1
    { SchedUp S; S.init(0, cid);
      const int lc = cid - 128;
      if (lc >= 76 && lc < 84) { S.first = 0; S.count = 4; gemm_stream<M_UP, false>(lds, S); finisher<0>(lds, (lc - 76) >> 2, (lc - 76) & 3); S.first = 4; S.count = 1; gemm_stream<M_UP, false>(lds, S); }
      else gemm_stream<M_UP | M_DNS | (1 << K_IN), true>(lds, S); }
#endif
    xcd_barrier(bar);
    phase_fixup(0);
    xcd_barrier(bar);
#if SEG & 2
    { SchedSimple S{K_DN0, NPANEL_P, 4, G, cid}; gemm_stream<(1 << K_DN0), false>(lds, S); }
#endif
    xcd_barrier(bar);
#if SEG & 4
    { SchedSimple S{K_IN, NPANEL_P, 12, G, cid}; gemm_stream<(1 << K_IN), false>(lds, S); }
#endif
    xcd_barrier(bar);
    phase_conv();
    xcd_barrier(bar);
#if SEG & 8
    { SchedSimple S{K_OUT, NPANEL_P, 4, G, cid}; gemm_stream<(1 << K_OUT), false>(lds, S); }
#endif
    xcd_barrier(bar);
#if SEG & 16
    { SchedUp S; S.init(1, cid);
      const int lc = cid - 128;
      gemm_stream<M_UP | M_DNS | (1 << K_OUT), true>(lds, S);
      if (lc >= 84 && lc < 92) finisher<1>(lds, (lc - 84) >> 2, (lc - 84) & 3); }
#endif
    xcd_barrier(bar);
    phase_fixup(1);
    xcd_barrier(bar);
#if SEG & 32
    { SchedSimple S{K_DN1, NPANEL_P, 4, G, cid}; gemm_stream<(1 << K_DN1), false>(lds, S); }
#endif
    xcd_barrier(bar);
    phase_final();
}

extern "C" void kernel_launch(void* const* d_in, const int* in_sizes, int n_in, void* d_out, int out_size, void* d_ws, size_t ws_size, hipStream_t stream) {
    static int grid_blocks = 0;
    if (grid_blocks == 0) {
        if (n_in != 19 || out_size != (int)O_END || ws_size < WS_END) { fprintf(stderr, "kernel_launch: unexpected shapes (n_in %d out %d ws %zu)\n", n_in, out_size, ws_size); grid_blocks = -1; return; }
        int dev = 0, cus = 0, per_cu = 0;
        hipGetDevice(&dev);
        hipDeviceGetAttribute(&cus, hipDeviceAttributeMultiprocessorCount, dev);
        if (hipFuncSetAttribute((const void*)fwd_megakernel, hipFuncAttributeMaxDynamicSharedMemorySize, LDS_BYTES) != hipSuccess) { fprintf(stderr, "kernel_launch: hipFuncSetAttribute failed\n"); grid_blocks = -1; return; }
        hipOccupancyMaxActiveBlocksPerMultiprocessor(&per_cu, (const void*)fwd_megakernel, 512, LDS_BYTES);
        if (per_cu < 1) { fprintf(stderr, "kernel_launch: occupancy query reports %d blocks per CU\n", per_cu); grid_blocks = -1; return; }
        if (cus != 256) { fprintf(stderr, "kernel_launch: the unit schedule is built for 256 CUs, this device has %d\n", cus); grid_blocks = -1; return; }
        grid_blocks = cus;
    }
    if (grid_blocks < 0) return;
    if (hipMemsetAsync((char*)d_ws + WS_BAR, 0, CTL_BYTES, stream) != hipSuccess) { fprintf(stderr, "kernel_launch: hipMemsetAsync failed\n"); return; }
    Params p{};
    for (int i = 0; i < 19; ++i) p.in[i] = (const float*)d_in[i];
    p.out = (float*)d_out; p.ws = (unsigned char*)d_ws;
    void* args[] = {&p};
    hipError_t e = hipLaunchCooperativeKernel((const void*)fwd_megakernel, dim3(grid_blocks), dim3(512), args, LDS_BYTES, stream);
    if (e != hipSuccess) fprintf(stderr, "cooperative launch failed: %s (grid %d)\n", hipGetErrorString(e), grid_blocks);
}
```

```cpp
#include <hip/hip_runtime.h>
#include <hip/hip_cooperative_groups.h>
#include <cstdio>
#include <cstdint>
namespace cg = cooperative_groups;
#ifndef REP
#define REP 0
#endif
#ifndef SEG
#define SEG 255
#endif
#ifndef DIAG
#define DIAG 1023
#endif

#define LAS __attribute__((address_space(3)))
typedef unsigned short bf16_t;
typedef short bf16x8 __attribute__((ext_vector_type(8)));
typedef float f32x4 __attribute__((ext_vector_type(4)));
typedef float f32x2 __attribute__((ext_vector_type(2)));
typedef unsigned u32x4 __attribute__((ext_vector_type(4)));
typedef unsigned u32x2 __attribute__((ext_vector_type(2)));

constexpr int D = 1024, FF = 2816, FF2 = 5632, SEQ = 2048, NB_P = 8, NB_S = 128, TS = 4;
constexpr int NTOK_P = NB_P * SEQ;
constexpr int NTOK_S = NB_S * TS;
constexpr int MROWS = NTOK_P + NTOK_S;
constexpr int NPANEL = MROWS / 256;
constexpr int NPANEL_P = NTOK_P / 256;
constexpr float ALPHA = 1.41421356237309515f;
constexpr float LN_EPS = 1e-5f;

constexpr size_t O_Y = 0;
constexpr size_t O_POOL_P = (size_t)MROWS * D;
constexpr size_t O_POOL_S = O_POOL_P + (size_t)NB_P * 15 * D;
constexpr size_t O_CONV_P = O_POOL_S + (size_t)NB_S * 15 * D;
constexpr size_t O_CONV_S = O_CONV_P + (size_t)NB_P * 2 * D;
constexpr size_t O_FFN_P = O_CONV_S + (size_t)NB_S * 2 * D;
constexpr size_t O_FFN_S = O_FFN_P + (size_t)2 * NB_P * 2 * FF2;
constexpr size_t O_END = O_FFN_S + (size_t)2 * NB_S * 2 * FF2;

constexpr size_t WS_WUP = 0;
constexpr size_t WS_WDN = WS_WUP + (size_t)2 * FF2 * D * 2;
constexpr size_t WS_WIN = WS_WDN + (size_t)2 * D * FF * 2;
constexpr size_t WS_WOUT = WS_WIN + (size_t)3 * D * D * 2;
constexpr size_t WS_WPOOL = WS_WOUT + (size_t)D * D * 2;
constexpr size_t WS_CSP_UP = WS_WPOOL + (size_t)4 * 256 * 256 * 2;
constexpr size_t WS_CBP_UP = WS_CSP_UP + (size_t)2 * 16 * FF2 * 4;
constexpr size_t WS_CSP_IN = WS_CBP_UP + (size_t)2 * 16 * FF2 * 4;
constexpr size_t WS_CBP_IN = WS_CSP_IN + (size_t)16 * 3072 * 4;
constexpr size_t WS_CS_UP = WS_CBP_IN + (size_t)16 * 3072 * 4;
constexpr size_t WS_CB_UP = WS_CS_UP + (size_t)2 * FF2 * 4;
constexpr size_t WS_KC_UP = WS_CB_UP + (size_t)2 * FF2 * 4;
constexpr size_t WS_CS_IN = WS_KC_UP + (size_t)2 * 4 * FF2 * 4;
constexpr size_t WS_CB_IN = WS_CS_IN + (size_t)3072 * 4;
constexpr size_t WS_PART = WS_CB_IN + (size_t)3072 * 4;
constexpr size_t PART_BYTES = (size_t)MROWS * 4 * 8;
constexpr size_t WS_HF = WS_PART + 3 * PART_BYTES;
constexpr size_t HALO_BYTES = (size_t)132 * 2 * FF2 * 4;
constexpr size_t WS_HL = WS_HF + HALO_BYTES;
constexpr size_t WS_H1 = WS_HL + HALO_BYTES;
constexpr size_t WS_ACT = WS_H1 + (size_t)MROWS * D * 2;
constexpr size_t WS_BAR = WS_ACT + (size_t)MROWS * FF * 2;
constexpr size_t WS_CNT = WS_BAR + 16384;
constexpr size_t CTL_BYTES = 32768;
constexpr size_t WS_SU = WS_BAR + CTL_BYTES;
constexpr size_t WS_SB = WS_SU + (size_t)NTOK_S * D * 2;
constexpr size_t WS_PBUF = WS_SB + (size_t)NTOK_S * D * 2;
constexpr size_t WS_END = WS_PBUF + (size_t)32 * 262144;
static_assert(WS_END <= (size_t)256 * 1024 * 1024, "workspace");
static_assert(WS_WDN % 256 == 0 && WS_WIN % 256 == 0 && WS_WOUT % 256 == 0 && WS_WPOOL % 256 == 0 && WS_PART % 256 == 0 && WS_HF % 256 == 0 && WS_H1 % 256 == 0 && WS_ACT % 256 == 0, "align");

constexpr int STAGE_BYTES = 131072;
constexpr int EPI_OFF = STAGE_BYTES;
constexpr int EPI_S = 8192, EPI_CST = 10240, EPI_PART = 16384;
constexpr int P1_T_OFF = 147456;
constexpr int BARST_OFF = 155648;
constexpr int LDS_BYTES = 159744;

struct Params {
    const float* in[19];
    float* out;
    unsigned char* ws;
};

__device__ __forceinline__ unsigned f2bf(float f) { unsigned u = __builtin_bit_cast(unsigned, f); return (u + 0x7fffu + ((u >> 16) & 1u)) >> 16; }
__device__ __forceinline__ float bf2f(unsigned b) { return __builtin_bit_cast(float, b << 16); }
typedef __bf16 bf16v2 __attribute__((ext_vector_type(2)));
__device__ __forceinline__ unsigned pk2(float lo, float hi) { const f32x2 v = {lo, hi}; return __builtin_bit_cast(unsigned, __builtin_convertvector(v, bf16v2)); }
__device__ __forceinline__ float dpp_shr1(float v) {
    return __builtin_bit_cast(float, __builtin_amdgcn_update_dpp(0, __builtin_bit_cast(int, v), 0x111, 0xf, 0xf, true));
}
__device__ __forceinline__ float silu_mul(float g, float v) { return g * v * __builtin_amdgcn_rcpf(1.0f + __expf(-g)); }
__device__ __forceinline__ int tid_fresh() { int t = threadIdx.x; asm volatile("" : "+v"(t)); return t; }
__device__ __forceinline__ int row_of_tok(int tok) {
    const int pm = tok >> 8, tau = tok & 255;
    return pm * 256 + 128 * ((tau >> 2) & 1) + 64 * (tau >> 7) + 16 * (tau & 3) + ((tau >> 3) & 15);
}
__device__ __forceinline__ f32x2 row_stats(const f32x2* part, int R) {
    const f32x4 a = *(const f32x4*)(part + (size_t)R * 4), b = *(const f32x4*)(part + (size_t)R * 4 + 2);
    const float mean = ((a[0] + a[2]) + (b[0] + b[2])) * 0.25f;
    const float d0 = a[0] - mean, d1 = a[2] - mean, d2 = b[0] - mean, d3 = b[2] - mean;
    const float m2 = ((a[1] + a[3]) + (b[1] + b[3])) + 256.0f * ((d0 * d0 + d1 * d1) + (d2 * d2 + d3 * d3));
    f32x2 r; r.x = mean; r.y = __builtin_amdgcn_rsqf(m2 * (1.0f / 1024.0f) + LN_EPS); return r;
}
__device__ __forceinline__ void stats_from_lds(LAS unsigned char* elds) {
    int tx = threadIdx.x; asm volatile("" : "+v"(tx));
    if (tx < 256) { const f32x4 a = *(const LAS f32x4*)(elds + EPI_PART + tx * 32), b = *(const LAS f32x4*)(elds + EPI_PART + tx * 32 + 16);
        const float mean = ((a[0] + a[2]) + (b[0] + b[2])) * 0.25f;
        const float d0 = a[0] - mean, d1 = a[2] - mean, d2 = b[0] - mean, d3 = b[2] - mean;
        const float m2 = ((a[1] + a[3]) + (b[1] + b[3])) + 256.0f * ((d0 * d0 + d1 * d1) + (d2 * d2 + d3 * d3));
        const float rstd = __builtin_amdgcn_rsqf(m2 * (1.0f / 1024.0f) + LN_EPS);
        f32x2 t; t.x = rstd; t.y = -mean * rstd; ((LAS f32x2*)(elds + EPI_S))[tx] = t; }
    asm volatile("s_waitcnt lgkmcnt(0)" ::: "memory"); __builtin_amdgcn_s_barrier(); asm volatile("" ::: "memory");
}
#define KA __attribute__((address_space(4)))
__device__ __forceinline__ const KA Params* kargs() { const KA Params* p = (const KA Params*)__builtin_amdgcn_kernarg_segment_ptr(); asm volatile("" : "+s"(p)); return p; }

namespace pg8 {
constexpr int BM = 256, BK = 64, HALF = 128, HTB = HALF * BK * 2, NXCD = 8, WGM = 8;
__host__ __device__ __forceinline__ int lds_byte(int r, int c) { const int st = (r >> 4) * 2 + (c >> 5), rr = r & 15, cc = c & 31, ob = rr * 64 + cc * 2; return st * 1024 + (ob ^ (((ob >> 9) & 1) << 5)); }
__host__ __device__ __forceinline__ void stage_rc(int b, int& R, int& C) { const int st = b / 1024, sb = b % 1024, swz = sb ^ (((sb >> 9) & 1) << 5); R = (st >> 1) * 16 + swz / 64; C = (st & 1) * 32 + (swz % 64) / 2; }

struct Unit { int pm, pn; };
enum { K_UP0 = 0, K_UP1 = 1, K_DN0 = 2, K_DN1 = 3, K_IN = 4, K_OUT = 5, K_DNS0 = 6, K_DNS1 = 7 };
struct UnitD { int kind, pm, pn, ks, dep, want, sig; };
__device__ __forceinline__ void map_unit(int L, int nM, int nN, int& pm, int& pn) {
    const int nwg = nM * nN; int wgid = L; { const int q = nwg / NXCD, r = nwg % NXCD, xcd = wgid % NXCD, off = wgid / NXCD; wgid = (xcd < r ? xcd * (q + 1) : r * (q + 1) + (xcd - r) * q) + off; }
    const int nig = WGM * nN, gid = wgid / nig, fm = gid * WGM, gsz = (nM - fm) < WGM ? (nM - fm) : WGM;
    pm = fm + ((wgid % nig) % gsz); pn = (wgid % nig) / gsz;
}
}


template <int BJ> __device__ __forceinline__ void pin_half(f32x4 (&acc)[2][2][4][2]) {
#pragma unroll
    for (int ai = 0; ai < 2; ++ai)
        asm volatile("" : "+v"(acc[ai][BJ][0][0]), "+v"(acc[ai][BJ][0][1]), "+v"(acc[ai][BJ][1][0]), "+v"(acc[ai][BJ][1][1]), "+v"(acc[ai][BJ][2][0]), "+v"(acc[ai][BJ][2][1]), "+v"(acc[ai][BJ][3][0]), "+v"(acc[ai][BJ][3][1]) :: "memory");
}
template <int BJ, int N> __device__ __forceinline__ void pin_group(f32x4 (&acc)[2][2][4][2]) {
    asm volatile("" : "+v"(acc[0][BJ][0][N]), "+v"(acc[0][BJ][1][N]), "+v"(acc[0][BJ][2][N]), "+v"(acc[0][BJ][3][N]), "+v"(acc[1][BJ][0][N]), "+v"(acc[1][BJ][1][N]), "+v"(acc[1][BJ][2][N]), "+v"(acc[1][BJ][3][N]) :: "memory");
}
template <int N> __device__ __forceinline__ void pin_n(f32x4 (&acc)[2][2][4][2]) {
#pragma unroll
    for (int ai = 0; ai < 2; ++ai)
        asm volatile("" : "+v"(acc[ai][0][0][N]), "+v"(acc[ai][0][1][N]), "+v"(acc[ai][0][2][N]), "+v"(acc[ai][0][3][N]), "+v"(acc[ai][1][0][N]), "+v"(acc[ai][1][1][N]), "+v"(acc[ai][1][2][N]), "+v"(acc[ai][1][3][N]) :: "memory");
}
template <int BJ, int N, int J0, int LEN>
__device__ __forceinline__ void conv_chain(f32x4 (&acc)[2][2][4][2], const f32x4 k0, const f32x4 k1, const f32x4 k2, const f32x4 kb, const f32x4 p1, const f32x4 p2) {
#pragma unroll
    for (int i = LEN - 1; i >= 0; --i) {
        const int j = J0 + i;
        const f32x4 h0 = acc[j >> 2][BJ][j & 3][N];
        const f32x4 h1 = i >= 1 ? acc[(j - 1) >> 2][BJ][(j - 1) & 3][N] : p1;
        const f32x4 h2 = i >= 2 ? acc[(j - 2) >> 2][BJ][(j - 2) & 3][N] : (i == 1 ? p1 : p2);
        acc[j >> 2][BJ][j & 3][N] = k2 * h0 + k1 * h1 + k0 * h2 + kb;
    }
}
struct EpiUp {
    int l;
    template <int N>
    __device__ __forceinline__ void half(f32x4 (&acc)[2][2][4][2], int pm, int pn, int wr, int wc, int fr, int fq, LAS unsigned char* elds) const {
        asm volatile("" : "+v"(fr), "+v"(fq));
        const KA Params* q = kargs(); unsigned char* ws = q->ws;
        const bool sample = pm >= NPANEL_P;
        const int chunk = 2 * pm + wr;
        const int ucol = 256 * pn + 32 * wc + 16 * N;
        const int ufcol = 128 * pn + 32 * wc + 16 * N;
        const unsigned lq = (unsigned)(16 * fq);
        const LAS unsigned char* kcl = elds + EPI_CST + 2048 + (32 * wc + 16 * N) * 4 + lq;
#define KC4(tap, vhalf) (*(const LAS f32x4*)(kcl + ((tap) * 256 + (vhalf) * 128) * 4))
        if (!sample) {
            f32x4 g2, g1;
#pragma unroll
            for (int e = 0; e < 4; ++e) { g2[e] = dpp_shr1(acc[1][0][2][N][e]); g1[e] = dpp_shr1(acc[1][0][3][N][e]); }
            if (fr == 0) {
                char* hf = (char*)((float*)(ws + WS_HF) + (size_t)chunk * 2 * FF2 + ucol) + lq;
                *(f32x4*)(hf) = acc[0][0][0][N]; *(f32x4*)(hf + FF2 * 4) = acc[0][0][1][N];
                *(f32x4*)(hf + 128 * 4) = acc[0][1][0][N]; *(f32x4*)(hf + (FF2 + 128) * 4) = acc[0][1][1][N];
            }
            if (fr == 15) {
                char* hl = (char*)((float*)(ws + WS_HL) + (size_t)chunk * 2 * FF2 + ucol) + lq;
                *(f32x4*)(hl) = acc[1][0][2][N]; *(f32x4*)(hl + FF2 * 4) = acc[1][0][3][N];
                *(f32x4*)(hl + 128 * 4) = acc[1][1][2][N]; *(f32x4*)(hl + (FF2 + 128) * 4) = acc[1][1][3][N];
                if ((pm & 7) == 7 && wr == 1) {
                    char* o = (char*)(q->out + O_FFN_P + ((size_t)l * NB_P + (pm >> 3)) * 2 * FF2 + ufcol) + lq;
                    *(f32x4*)(o) = acc[1][0][2][N]; *(f32x4*)(o + FF2 * 4) = acc[1][0][3][N];
                    *(f32x4*)(o + FF * 4) = acc[1][1][2][N]; *(f32x4*)(o + (FF2 + FF) * 4) = acc[1][1][3][N];
                }
            }
            pin_n<N>(acc);
            { const f32x4 k0 = KC4(0, 0), k1 = KC4(1, 0), k2 = KC4(2, 0), kb = KC4(3, 0); conv_chain<0, N, 0, 8>(acc, k0, k1, k2, kb, g1, g2); }
            pin_n<N>(acc);
            { f32x4 v2, v1;
#pragma unroll
              for (int e = 0; e < 4; ++e) { v2[e] = dpp_shr1(acc[1][1][2][N][e]); v1[e] = dpp_shr1(acc[1][1][3][N][e]); }
              const f32x4 k0 = KC4(0, 1), k1 = KC4(1, 1), k2 = KC4(2, 1), kb = KC4(3, 1); conv_chain<1, N, 0, 8>(acc, k0, k1, k2, kb, v1, v2); }
        } else {
            const int useq0 = 64 * (pm - NPANEL_P) + 32 * wr;
            const unsigned ls = (unsigned)(2 * fr * 2 * FF2 * 4) + lq;
            char* ob = (char*)(q->out + O_FFN_S + ((size_t)l * NB_S + useq0) * 2 * FF2 + ufcol);
#pragma unroll
            for (int ai = 0; ai < 2; ++ai) { char* o = ob + ls + (unsigned)(ai * 2 * FF2 * 4);
                *(f32x4*)(o) = acc[ai][0][2][N]; *(f32x4*)(o + FF2 * 4) = acc[ai][0][3][N];
                *(f32x4*)(o + FF * 4) = acc[ai][1][2][N]; *(f32x4*)(o + (FF2 + FF) * 4) = acc[ai][1][3][N]; }
            pin_n<N>(acc);
            const char* sb = (const char*)(q->in[4] + ((size_t)l * NB_S + useq0) * 2 * FF2 + ufcol);
            { const f32x4 k0 = KC4(0, 0), k1 = KC4(1, 0), k2 = KC4(2, 0), kb = KC4(3, 0);
              conv_chain<0, N, 0, 4>(acc, k0, k1, k2, kb, *(const f32x4*)(sb + ls + FF2 * 4), *(const f32x4*)(sb + ls));
              conv_chain<0, N, 4, 4>(acc, k0, k1, k2, kb, *(const f32x4*)(sb + ls + 3 * FF2 * 4), *(const f32x4*)(sb + ls + 2 * FF2 * 4)); }
            pin_n<N>(acc);
            { const f32x4 k0 = KC4(0, 1), k1 = KC4(1, 1), k2 = KC4(2, 1), kb = KC4(3, 1);
              conv_chain<1, N, 0, 4>(acc, k0, k1, k2, kb, *(const f32x4*)(sb + ls + (FF2 + FF) * 4), *(const f32x4*)(sb + ls + FF * 4));
              conv_chain<1, N, 4, 4>(acc, k0, k1, k2, kb, *(const f32x4*)(sb + ls + (3 * FF2 + FF) * 4), *(const f32x4*)(sb + ls + (2 * FF2 + FF) * 4)); }
        }
#undef KC4
        pin_n<N>(acc);
        char* ab = (char*)((bf16_t*)(ws + WS_ACT) + (size_t)(pm * 256 + 64 * wr) * FF + ufcol);
        const unsigned la = (unsigned)((fr * FF + 4 * fq) * 2);
#pragma unroll
        for (int j = 0; j < 8; ++j) {
            const f32x4 zg = acc[j >> 2][0][j & 3][N], zv = acc[j >> 2][1][j & 3][N];
            u32x2 w; w.x = pk2(silu_mul(zg[0], zv[0]), silu_mul(zg[1], zv[1])); w.y = pk2(silu_mul(zg[2], zv[2]), silu_mul(zg[3], zv[3]));
            *(u32x2*)(ab + la + (unsigned)((128 * (j >> 2) + 16 * (j & 3)) * FF * 2)) = w;
        }
        asm volatile("" ::: "memory");
    }
    __device__ __forceinline__ void operator()(f32x4 (&acc)[2][2][4][2], const pg8::Unit& u, int wr, int wc, int fr, int fq, LAS unsigned char* elds) const {
        const int pm = u.pm, pn = u.pn;
        LAS f32x2* S = (LAS f32x2*)(elds + EPI_S);
        { stats_from_lds(elds);
          const LAS unsigned char* csl = elds + EPI_CST + (32 * wc) * 4 + 16 * fq;
          f32x2 st[8];
#pragma unroll
          for (int j = 0; j < 8; ++j) st[j] = S[128 * (j >> 2) + 64 * wr + 16 * (j & 3) + fr];
#pragma unroll
          for (int bj = 0; bj < 2; ++bj)
#pragma unroll
              for (int n = 0; n < 2; ++n) { const f32x4 csv = *(const LAS f32x4*)(csl + (128 * bj + 16 * n) * 4), cbv = *(const LAS f32x4*)(csl + 1024 + (128 * bj + 16 * n) * 4);
#pragma unroll
                  for (int j = 0; j < 8; ++j) acc[j >> 2][bj][j & 3][n] = acc[j >> 2][bj][j & 3][n] * st[j].x + (csv * st[j].y + cbv); }
        }
        pin_half<0>(acc); pin_half<1>(acc);
        half<0>(acc, pm, pn, wr, wc, fr, fq, elds);
        half<1>(acc, pm, pn, wr, wc, fr, fq, elds);
    }
};

template <bool FINAL> struct EpiRes {
    int pprev, pnew, gi, goff;
    template <int BJ>
    __device__ __forceinline__ void resid(f32x4 (&acc)[2][2][4][2], int pm, int pn, int wr, int wc, int fr, int fq, LAS f32x2* S, const LAS unsigned char* cst) const {
        asm volatile("" : "+v"(fr), "+v"(fq));
        const KA Params* q = kargs();
        const int ucol = 256 * pn + 128 * BJ + 32 * wc;
        const char* vb = (const char*)((const bf16_t*)(q->ws + WS_H1) + (size_t)(pm * 256 + 64 * wr) * D + ucol);
        const unsigned lv = (unsigned)((fr * D + 4 * fq) * 2), lq = (unsigned)(16 * fq);
        u32x2 vp[8][2];
#pragma unroll
        for (int j = 0; j < 8; ++j)
#pragma unroll
            for (int n = 0; n < 2; ++n) vp[j][n] = *(const u32x2*)(vb + lv + (unsigned)(((128 * (j >> 2) + 16 * (j & 3)) * D + 16 * n) * 2));
        f32x4 gv[2], bv[2];
#pragma unroll
        for (int n = 0; n < 2; ++n) { gv[n] = *(const LAS f32x4*)(cst + (128 * BJ + 32 * wc + 16 * n) * 4 + lq) * ALPHA; bv[n] = *(const LAS f32x4*)(cst + 1024 + (128 * BJ + 32 * wc + 16 * n) * 4 + lq) * ALPHA; }
        const LAS f32x2* Sl = S + 64 * wr + fr;
#pragma unroll
        for (int j = 0; j < 8; ++j) { const f32x2 s = Sl[128 * (j >> 2) + 16 * (j & 3)];
#pragma unroll
            for (int n = 0; n < 2; ++n) { f32x4 v; v[0] = bf2f(vp[j][n].x & 0xffffu); v[1] = bf2f(vp[j][n].x >> 16); v[2] = bf2f(vp[j][n].y & 0xffffu); v[3] = bf2f(vp[j][n].y >> 16);
                acc[j >> 2][BJ][j & 3][n] = (v * s.x + s.y) * gv[n] + bv[n] + acc[j >> 2][BJ][j & 3][n]; } }
        pin_half<BJ>(acc);
    }
    __device__ __forceinline__ void operator()(f32x4 (&acc)[2][2][4][2], const pg8::Unit& u, int wr, int wc, int fr, int fq, LAS unsigned char* elds) const {
        const int pm = u.pm, pn = u.pn;
        LAS f32x2* P = (LAS f32x2*)elds;
        LAS f32x2* S = (LAS f32x2*)(elds + EPI_S);
        stats_from_lds(elds);
        resid<0>(acc, pm, pn, wr, wc, fr, fq, S, elds + EPI_CST);
        resid<1>(acc, pm, pn, wr, wc, fr, fq, S, elds + EPI_CST);
        asm volatile("" : "+v"(fr), "+v"(fq));
        const KA Params* q = kargs();
        char* ob; unsigned lo;
        if (FINAL) { ob = (char*)(q->out + O_Y + (size_t)(pm * 256 + 128 * wr) * D + 256 * pn + 32 * wc); lo = (unsigned)((8 * fr * D + 4 * fq) * 4); }
        else { ob = (char*)((bf16_t*)(q->ws + WS_H1) + (size_t)(pm * 256 + 64 * wr) * D + 256 * pn + 32 * wc); lo = (unsigned)((fr * D + 4 * fq) * 2); }
        LAS f32x2* Pl = P + (64 * wr + fr) * 4 + wc;
#pragma unroll
        for (int j = 0; j < 8; ++j) {
            const int ai = j >> 2, m = j & 3;
            float sum = 0.f;
#pragma unroll
            for (int bj = 0; bj < 2; ++bj)
#pragma unroll
                for (int n = 0; n < 2; ++n) { const f32x4 vn = acc[ai][bj][m][n]; sum += (vn[0] + vn[1]) + (vn[2] + vn[3]); }
            sum += __shfl_xor(sum, 16); sum += __shfl_xor(sum, 32);
            const float mw = sum * (1.0f / 64.0f); float qq = 0.f;
#pragma unroll
            for (int bj = 0; bj < 2; ++bj)
#pragma unroll
                for (int n = 0; n < 2; ++n) { const f32x4 d = acc[ai][bj][m][n] - mw; qq += (d[0] * d[0] + d[1] * d[1]) + (d[2] * d[2] + d[3] * d[3]); }
            qq += __shfl_xor(qq, 16); qq += __shfl_xor(qq, 32);
            if (fq == 0) { f32x2 t; t.x = mw; t.y = qq; Pl[(128 * ai + 16 * m) * 4] = t; }
#pragma unroll
            for (int bj = 0; bj < 2; ++bj)
#pragma unroll
                for (int n = 0; n < 2; ++n) { const f32x4 vn = acc[ai][bj][m][n];
                    if (FINAL) *(f32x4*)(ob + lo + (unsigned)(((4 * ai + m) * D + 128 * bj + 16 * n) * 4)) = vn;
                    else { u32x2 w; w.x = pk2(vn[0], vn[1]); w.y = pk2(vn[2], vn[3]); *(u32x2*)(ob + lo + (unsigned)(((128 * ai + 16 * m) * D + 128 * bj + 16 * n) * 2)) = w; } }
        }
        asm volatile("s_waitcnt lgkmcnt(0)" ::: "memory"); __builtin_amdgcn_s_barrier(); asm volatile("" ::: "memory");
        int rl = threadIdx.x; asm volatile("" : "+v"(rl));
        if (rl < 256) {
            const f32x2 a = P[rl * 4 + 0], b2 = P[rl * 4 + 1], c2 = P[rl * 4 + 2], d2 = P[rl * 4 + 3];
            const float mt = (a.x + b2.x + c2.x + d2.x) * 0.25f;
            const float da = a.x - mt, db = b2.x - mt, dc = c2.x - mt, dd = d2.x - mt;
            f32x2 r; r.x = mt; r.y = (a.y + b2.y) + (c2.y + d2.y) + 64.0f * ((da * da + db * db) + (dc * dc + dd * dd));
            char* pb = (char*)((f32x2*)(q->ws + WS_PART) + (size_t)pnew * MROWS * 4 + (size_t)pm * 256 * 4 + pn);
            *(f32x2*)(pb + (unsigned)(rl * 32)) = r;
        }
    }
};

struct EpiIn {
    int dummy;
    __device__ __forceinline__ void operator()(f32x4 (&acc)[2][2][4][2], const pg8::Unit& u, int wr, int wc, int fr, int fq, LAS unsigned char* elds) const {
        const int pm = u.pm, pn = u.pn; const bool sample = pm >= NPANEL_P;
        LAS f32x2* S = (LAS f32x2*)(elds + EPI_S);
        const KA Params* q = kargs(); unsigned char* ws = q->ws;
        stats_from_lds(elds);
        { const LAS unsigned char* csl = elds + EPI_CST + (32 * wc) * 4 + 16 * fq;
          f32x2 st[8];
#pragma unroll
          for (int j = 0; j < 8; ++j) st[j] = S[128 * (j >> 2) + 64 * wr + 16 * (j & 3) + fr];
#pragma unroll
          for (int bj = 0; bj < 2; ++bj)
#pragma unroll
              for (int n = 0; n < 2; ++n) { const f32x4 csv = *(const LAS f32x4*)(csl + (128 * bj + 16 * n) * 4), cbv = *(const LAS f32x4*)(csl + 1024 + (128 * bj + 16 * n) * 4);
#pragma unroll
                  for (int j = 0; j < 8; ++j) acc[j >> 2][bj][j & 3][n] = acc[j >> 2][bj][j & 3][n] * st[j].x + (csv * st[j].y + cbv); } }
        pin_half<0>(acc); pin_half<1>(acc);
        asm volatile("" : "+v"(fr), "+v"(fq));
        const unsigned lr = (unsigned)((fr * D + 4 * fq) * 2);
        if (pn < 8) {
            char* ub = sample ? (char*)((bf16_t*)(ws + WS_SU) + (size_t)((pm - NPANEL_P) * 256 + 64 * wr) * D + 128 * pn + 32 * wc)
                              : (char*)((bf16_t*)(ws + WS_ACT) + (size_t)(pm * 256 + 64 * wr) * D + 128 * pn + 32 * wc);
#pragma unroll
            for (int n = 0; n < 2; ++n) {
#pragma unroll
                for (int j = 0; j < 8; ++j) { const int ai = j >> 2, m = j & 3; const f32x4 uu = acc[ai][0][m][n] * acc[ai][1][m][n];
                    u32x2 w; w.x = pk2(uu[0], uu[1]); w.y = pk2(uu[2], uu[3]); *(u32x2*)(ub + lr + (unsigned)(((128 * ai + 16 * m) * D + 16 * n) * 2)) = w;
                    if (sample) { if (m >= 2) { const int seq = 64 * (pm - NPANEL_P) + 32 * wr + 2 * fr + ai; *(f32x4*)(q->out + O_CONV_S + ((size_t)seq * 2 + (m - 2)) * D + 128 * pn + 32 * wc + 16 * n + 4 * fq) = uu; } }
                    else if ((pm & 7) == 7 && wr == 1 && fr == 15 && j >= 6) { *(f32x4*)(q->out + O_CONV_P + ((size_t)(pm >> 3) * 2 + (j - 6)) * D + 128 * pn + 32 * wc + 16 * n + 4 * fq) = uu; } } }
        } else {
            char* bb = sample ? (char*)((bf16_t*)(ws + WS_SB) + (size_t)((pm - NPANEL_P) * 256 + 64 * wr) * D + 256 * (pn - 8) + 32 * wc)
                              : (char*)((bf16_t*)(ws + WS_ACT) + (size_t)MROWS * D + (size_t)(pm * 256 + 64 * wr) * D + 256 * (pn - 8) + 32 * wc);
#pragma unroll
            for (int bj = 0; bj < 2; ++bj)
#pragma unroll
                for (int n = 0; n < 2; ++n) {
#pragma unroll
                    for (int j = 0; j < 8; ++j) { const int ai = j >> 2, m = j & 3; const f32x4 v = acc[ai][bj][m][n];
                        u32x2 w; w.x = pk2(v[0], v[1]); w.y = pk2(v[2], v[3]); *(u32x2*)(bb + lr + (unsigned)(((128 * ai + 16 * m) * D + 128 * bj + 16 * n) * 2)) = w; } }
        }
    }
};

struct EpiPartial {
    __device__ __forceinline__ void operator()(f32x4 (&acc)[2][2][4][2], const pg8::UnitD& u) const {
        const int tid = tid_fresh();
        char* pb = (char*)(kargs()->ws + WS_PBUF) + (size_t)((((u.pm - NPANEL_P) * 4 + u.pn) * 4 + u.ks) * 32) * 8192;
#pragma unroll
        for (int ai = 0; ai < 2; ++ai)
#pragma unroll
            for (int bj = 0; bj < 2; ++bj)
#pragma unroll
                for (int m = 0; m < 4; ++m)
#pragma unroll
                    for (int n = 0; n < 2; ++n) *(f32x4*)(pb + (unsigned)(((((ai * 2 + bj) * 4 + m) * 2 + n) * 512 + tid) * 16)) = acc[ai][bj][m][n];
    }
};
__device__ __forceinline__ unsigned* cnt_word(int idx) { return (unsigned*)(kargs()->ws + WS_CNT) + 64 * idx; }
__device__ __forceinline__ int C_UP(int l, int p) { return l * 16 + p; }
__device__ __forceinline__ int C_DNS(int l, int p, int pn) { return l * 16 + 2 + p * 4 + pn; }
__device__ __forceinline__ int C_FIN(int l, int p) { return l * 16 + 10 + p; }
__device__ __forceinline__ int C_OUT(int p) { return 32 + p; }
__device__ __forceinline__ void dep_wait(int idx, unsigned want) {
    int tid = tid_fresh();
    if (tid < 64) {
        unsigned* w = cnt_word(idx); unsigned sp = 0;
        while ((unsigned)__builtin_amdgcn_readfirstlane(__hip_atomic_load(w, __ATOMIC_RELAXED, __HIP_MEMORY_SCOPE_AGENT)) < want) { __builtin_amdgcn_s_sleep(2); if (++sp > (1u << 22)) break; }
        __builtin_amdgcn_fence(__ATOMIC_ACQUIRE, "agent");
        asm volatile("s_waitcnt vmcnt(0)" ::: "memory");
    }
    asm volatile("" ::: "memory"); __builtin_amdgcn_s_barrier(); asm volatile("" ::: "memory");
}
__device__ __forceinline__ void unit_signal(int idx) {
    asm volatile("s_waitcnt vmcnt(0)" ::: "memory"); __builtin_amdgcn_s_barrier(); asm volatile("" ::: "memory");
    if (tid_fresh() == 0) { __builtin_amdgcn_fence(__ATOMIC_RELEASE, "agent"); asm volatile("s_waitcnt vmcnt(0)" ::: "memory");
        __hip_atomic_fetch_add(cnt_word(idx), 1u, __ATOMIC_RELAXED, __HIP_MEMORY_SCOPE_AGENT); }
}

__device__ __forceinline__ void epi_prefetch(int kind, int pm, int pn, LAS unsigned char* elds, int wid, int lane) {
    if (kind == pg8::K_DNS0 || kind == pg8::K_DNS1) return;
    const KA Params* q = kargs(); unsigned char* ws = q->ws;
    const int bank = (kind == pg8::K_UP0 || kind == pg8::K_DN0) ? 0 : ((kind == pg8::K_UP1 || kind == pg8::K_DN1) ? 2 : 1);
    const char* pp = (const char*)(ws + WS_PART) + ((size_t)bank * MROWS * 4 + (size_t)pm * 256 * 4) * 8 + wid * 1024 + lane * 16;
    __builtin_amdgcn_global_load_lds((const unsigned*)pp, (LAS unsigned*)(elds + EPI_PART + wid * 1024), 16, 0, 0);
    const float* cp = nullptr;
    if (kind == pg8::K_UP0 || kind == pg8::K_UP1) { const int l = kind - pg8::K_UP0;
        if (wid < 2) cp = (const float*)(ws + (wid == 0 ? WS_CS_UP : WS_CB_UP)) + l * FF2 + 256 * pn;
        else if (wid < 6) cp = (const float*)(ws + WS_KC_UP) + ((size_t)l * 4 + (wid - 2)) * FF2 + 256 * pn; }
    else if (kind == pg8::K_IN) { if (wid < 2) cp = (const float*)(ws + (wid == 0 ? WS_CS_IN : WS_CB_IN)) + 256 * pn; }
    else { if (wid < 2) { const int gi = kind == pg8::K_OUT ? 17 : 5, goff = kind == pg8::K_DN1 ? D : 0; cp = q->in[gi + wid] + goff + 256 * pn; } }
    if (cp) __builtin_amdgcn_global_load_lds((const unsigned*)((const char*)cp + lane * 16), (LAS unsigned*)(elds + EPI_CST + wid * 1024), 16, 0, 0);
}

namespace pg8 {
__device__ __forceinline__ void unit_gemm(const UnitD& u, const char*& cA, const char*& cB, int& Kf, int& nt) {
    const KA Params* q = kargs(); unsigned char* ws = q->ws;
    switch (u.kind) {
    case K_UP0: case K_UP1: Kf = D; nt = 16; cA = (const char*)(ws + WS_H1) + (size_t)u.pm * 256 * D * 2; cB = (const char*)(ws + WS_WUP) + ((size_t)(u.kind - K_UP0) * FF2 + (size_t)u.pn * 256) * D * 2; break;
    case K_DN0: case K_DN1: Kf = FF; nt = 44; cA = (const char*)(ws + WS_ACT) + (size_t)u.pm * 256 * FF * 2; cB = (const char*)(ws + WS_WDN) + ((size_t)(u.kind - K_DN0) * D + (size_t)u.pn * 256) * FF * 2; break;
    case K_DNS0: case K_DNS1: { const int k0 = u.ks < 2 ? u.ks * 768 : 1536 + (u.ks - 2) * 640; Kf = FF; nt = u.ks < 2 ? 12 : 10;
        cA = (const char*)(ws + WS_ACT) + ((size_t)u.pm * 256 * FF + k0) * 2; cB = (const char*)(ws + WS_WDN) + (((size_t)(u.kind - K_DNS0) * D + (size_t)u.pn * 256) * FF + k0) * 2; break; }
    case K_IN: Kf = D; nt = 16; cA = (const char*)(ws + WS_H1) + (size_t)u.pm * 256 * D * 2; cB = (const char*)(ws + WS_WIN) + (size_t)u.pn * 256 * D * 2; break;
    default: Kf = D; nt = 16; cA = (const char*)q->out + (size_t)u.pm * 256 * D * 2; cB = (const char*)(ws + WS_WOUT) + (size_t)u.pn * 256 * D * 2; break;
    }
}
template <int KINDS, bool MIXK, class Sched>
__device__ __forceinline__ void gemm_stream(LAS unsigned char* lds, const Sched& S) {
    const int tid = tid_fresh(), wid = __builtin_amdgcn_readfirstlane(tid >> 6), lane = tid & 63, wr = wid >> 2, wc = wid & 3, fr = lane & 15, fq = lane >> 4;
    int Rs[2], Cs[2];
#pragma unroll
    for (int i = 0; i < 2; ++i) stage_rc(tid * 16 + i * 8192, Rs[i], Cs[i]);
    const size_t kstep = (size_t)(BK * 2);
    const unsigned ldsw = (unsigned)wid * 1024u;
    const int aoff = lds_byte(wr * 64 + fr, fq * 8), boff = lds_byte(wc * 32 + fr, fq * 8);
#define PG8_SA(b, h) (((b) * 2 + (h)) * HTB)
#define PG8_SB(b, h) ((4 + (b) * 2 + (h)) * HTB)
#define PG8_STAGE(bufoff, gbase, vo) do { _Pragma("unroll") for (int _i = 0; _i < 2; ++_i) \
        __builtin_amdgcn_global_load_lds((const unsigned*)((const char*)(gbase) + (vo)[_i]), (LAS unsigned*)(lds + (bufoff) + ldsw + _i * 8192), 16, 0, 0); } while (0)
#define PG8_LDA(dst, b, h) do { _Pragma("unroll") for (int m = 0; m < 4; ++m) _Pragma("unroll") for (int k = 0; k < 2; ++k) dst[m][k] = *(const LAS bf16x8*)(lds + PG8_SA(b, h) + aoff + m * 2048 + k * 1024); } while (0)
#define PG8_LDB(dst, b, h) do { _Pragma("unroll") for (int n = 0; n < 2; ++n) _Pragma("unroll") for (int k = 0; k < 2; ++k) dst[n][k] = *(const LAS bf16x8*)(lds + PG8_SB(b, h) + boff + n * 2048 + k * 1024); } while (0)
#define PG8_MMA(ai, bj, At, Bt) do { __builtin_amdgcn_s_setprio(1); _Pragma("unroll") for (int m = 0; m < 4; ++m) _Pragma("unroll") for (int n = 0; n < 2; ++n) _Pragma("unroll") for (int k = 0; k < 2; ++k) \
        acc[ai][bj][m][n] = __builtin_amdgcn_mfma_f32_16x16x32_bf16(Bt[n][k], At[m][k], acc[ai][bj][m][n], 0, 0, 0); __builtin_amdgcn_s_setprio(0); } while (0)
#define PG8_WAIT_V(n) asm volatile("s_waitcnt vmcnt(" #n ")" ::: "memory")
#define PG8_WAIT_L(n) asm volatile("s_waitcnt lgkmcnt(" #n ")" ::: "memory")
#define PG8_BAR __builtin_amdgcn_s_barrier()
#define PG8_SCHED __builtin_amdgcn_sched_barrier(0)
    UnitD cur, nxt; int ui = 0;
    if (!S.next(0, cur)) return;
    const char* cA; const char* cB; int KfC, ntC; unit_gemm(cur, cA, cB, KfC, ntC);
    unsigned voffC[2], voffN[2];
#pragma unroll
    for (int i = 0; i < 2; ++i) { voffC[i] = (unsigned)(Rs[i] * KfC + Cs[i]) * 2u; voffN[i] = voffC[i]; }
    size_t hstepC = (size_t)HALF * KfC * 2, hstepN = hstepC;
    f32x4 acc[2][2][4][2];
#pragma unroll
    for (int a = 0; a < 2; ++a)
#pragma unroll
        for (int b = 0; b < 2; ++b)
#pragma unroll
            for (int m = 0; m < 4; ++m)
#pragma unroll
                for (int n = 0; n < 2; ++n) acc[a][b][m][n] = (f32x4){0.f, 0.f, 0.f, 0.f};
    bf16x8 At[4][2], B0[2][2], B1[2][2];
    if (cur.dep >= 0) dep_wait(cur.dep, (unsigned)cur.want);
    PG8_STAGE(PG8_SB(0, 0), cB, voffC); PG8_STAGE(PG8_SB(0, 1), cB + hstepC, voffC); PG8_STAGE(PG8_SA(0, 0), cA, voffC); PG8_STAGE(PG8_SA(0, 1), cA + hstepC, voffC);
    if (wr == 1) PG8_BAR;
    PG8_WAIT_V(2); PG8_BAR;
    PG8_STAGE(PG8_SB(1, 0), cB + kstep, voffC); PG8_STAGE(PG8_SA(1, 0), cA + kstep, voffC); PG8_STAGE(PG8_SB(1, 1), cB + hstepC + kstep, voffC);
    PG8_WAIT_V(6); PG8_BAR;
    for (;;) {
        const bool has_next = S.next(ui + 1, nxt);
        const char* nA = cA; const char* nB = cB; int KfN = KfC, ntN = ntC;
        if (has_next) unit_gemm(nxt, nA, nB, KfN, ntN);
        if (MIXK) {
#pragma unroll
            for (int i = 0; i < 2; ++i) voffN[i] = (unsigned)(Rs[i] * KfN + Cs[i]) * 2u;
            hstepN = (size_t)HALF * KfN * 2; }
        for (int t = 0; t < ntC; t += 2) {
            const bool last = (t == ntC - 2);
            const char* a1 = cA + (size_t)(t + 1) * kstep;
            const char* a2 = last ? nA : cA + (size_t)(t + 2) * kstep; const char* b2 = last ? nB : cB + (size_t)(t + 2) * kstep;
            const char* a3 = a2 + kstep; const char* b3 = b2 + kstep;
            unsigned vo2[2]; size_t hs2 = hstepC;
#pragma unroll
            for (int i = 0; i < 2; ++i) vo2[i] = voffC[i];
            if (MIXK) { if (last) {
#pragma unroll
                for (int i = 0; i < 2; ++i) vo2[i] = voffN[i];
                hs2 = hstepN; } }
            if (last && has_next && nxt.dep >= 0) dep_wait(nxt.dep, (unsigned)nxt.want);
            if (t == 2) epi_prefetch(cur.kind, cur.pm, cur.pn, lds + EPI_OFF, wid, lane);
            PG8_LDB(B0, 0, 0); PG8_LDB(B1, 0, 1); PG8_SCHED; PG8_LDA(At, 0, 0); PG8_STAGE(PG8_SA(1, 1), a1 + hstepC, voffC);
            PG8_WAIT_V(8); PG8_WAIT_L(0); PG8_BAR; PG8_MMA(0, 0, At, B0); PG8_MMA(0, 1, At, B1); PG8_BAR; PG8_SCHED;
            PG8_LDA(At, 0, 1); PG8_STAGE(PG8_SB(0, 0), b2, vo2); PG8_STAGE(PG8_SB(0, 1), b2 + hs2, vo2); PG8_STAGE(PG8_SA(0, 0), a2, vo2);
            PG8_WAIT_V(8); PG8_WAIT_L(0); PG8_BAR; PG8_MMA(1, 0, At, B0); PG8_MMA(1, 1, At, B1); PG8_BAR; PG8_SCHED;
            PG8_LDB(B0, 1, 0); PG8_LDB(B1, 1, 1); PG8_SCHED; PG8_LDA(At, 1, 0); PG8_STAGE(PG8_SA(0, 1), a2 + hs2, vo2);
            PG8_WAIT_V(8); PG8_WAIT_L(0); PG8_BAR; PG8_MMA(0, 0, At, B0); PG8_MMA(0, 1, At, B1); PG8_BAR; PG8_SCHED;
            PG8_LDA(At, 1, 1); PG8_STAGE(PG8_SB(1, 0), b3, vo2); PG8_STAGE(PG8_SB(1, 1), b3 + hs2, vo2); PG8_STAGE(PG8_SA(1, 0), a3, vo2);
            PG8_WAIT_V(8); PG8_WAIT_L(0); PG8_BAR; PG8_MMA(1, 0, At, B0); PG8_MMA(1, 1, At, B1); PG8_BAR; PG8_SCHED;
        }
        if (wr == 0) PG8_BAR;
        { int fr_e = fr, fq_e = fq; asm volatile("" : "+v"(fr_e), "+v"(fq_e));
          const Unit uu{cur.pm, cur.pn}; LAS unsigned char* elds = lds + EPI_OFF;
          if ((KINDS & ((1 << K_UP0) | (1 << K_UP1))) && (cur.kind == K_UP0 || cur.kind == K_UP1)) { EpiUp E{cur.kind - K_UP0}; E(acc, uu, wr, wc, fr_e, fq_e, elds); }
          if ((KINDS & (1 << K_DN0)) && cur.kind == K_DN0) { EpiRes<false> E{0, 1, 5, 0}; E(acc, uu, wr, wc, fr_e, fq_e, elds); }
          if ((KINDS & (1 << K_DN1)) && cur.kind == K_DN1) { EpiRes<true> E{2, 0, 5, D}; E(acc, uu, wr, wc, fr_e, fq_e, elds); }
          if ((KINDS & (1 << K_IN)) && cur.kind == K_IN) { EpiIn E{0}; E(acc, uu, wr, wc, fr_e, fq_e, elds); }
          if ((KINDS & (1 << K_OUT)) && cur.kind == K_OUT) { EpiRes<false> E{1, 2, 17, 0}; E(acc, uu, wr, wc, fr_e, fq_e, elds); }
          if ((KINDS & ((1 << K_DNS0) | (1 << K_DNS1))) && (cur.kind == K_DNS0 || cur.kind == K_DNS1)) { EpiPartial E; E(acc, cur); }
          if (cur.sig >= 0) unit_signal(cur.sig); }
        if (!has_next) break;
#pragma unroll
        for (int a = 0; a < 2; ++a)
#pragma unroll
            for (int b = 0; b < 2; ++b)
#pragma unroll
                for (int m = 0; m < 4; ++m)
#pragma unroll
                    for (int n = 0; n < 2; ++n) acc[a][b][m][n] = (f32x4){0.f, 0.f, 0.f, 0.f};
        cur = nxt; cA = nA; cB = nB; KfC = KfN; ntC = ntN; ++ui;
        if (MIXK) {
#pragma unroll
            for (int i = 0; i < 2; ++i) voffC[i] = voffN[i];
            hstepC = hstepN; }
        if (wr == 1) PG8_BAR;
    }
    PG8_WAIT_V(0);
    PG8_BAR;
#undef PG8_SA
#undef PG8_SB
#undef PG8_STAGE
#undef PG8_LDA
#undef PG8_LDB
#undef PG8_MMA
#undef PG8_WAIT_V
#undef PG8_WAIT_L
#undef PG8_BAR
#undef PG8_SCHED
}
struct SchedSimple {
    int kind, nM, nN, G, c;
    __device__ __forceinline__ bool next(int i, UnitD& u) const {
        const long L = (long)i * G + c; if (L >= (long)nM * nN) return false;
        u.kind = kind; map_unit((int)L, nM, nN, u.pm, u.pn); u.ks = 0; u.dep = -1; u.want = 0; u.sig = -1; return true; }
};
struct SchedUp {
    int l, c, first, count, gpos; UnitD guest;
    __device__ __forceinline__ void init(int l_, int c_) {
        l = l_; c = c_; first = 0; count = 6; gpos = -1; guest.kind = 0; guest.pm = 0; guest.pn = 0; guest.ks = 0; guest.dep = -1; guest.want = 0; guest.sig = -1;
        const int lc = c - 128; if (lc < 0) return;
        if (l == 0) {
            if (lc < 44) { gpos = 0; guest.kind = K_UP0; guest.pm = NPANEL_P + lc / 22; guest.pn = lc % 22; guest.sig = C_UP(0, lc / 22); }
            else if (lc < 76) { const int ix = lc - 44, p = ix >> 4; gpos = 2; guest.kind = K_DNS0; guest.pm = NPANEL_P + p; guest.pn = (ix >> 2) & 3; guest.ks = ix & 3; guest.dep = C_UP(0, p); guest.want = 22; guest.sig = C_DNS(0, p, guest.pn); }
            else if (lc < 84) { }
            else if (lc < 108) { const int ix = lc - 84, p = ix / 12; gpos = 5; guest.kind = K_IN; guest.pm = NPANEL_P + p; guest.pn = ix % 12; guest.dep = C_FIN(0, p); guest.want = 4; }
        } else {
            if (lc < 8) { gpos = 0; guest.kind = K_OUT; guest.pm = NPANEL_P + (lc >> 2); guest.pn = lc & 3; guest.sig = C_OUT(lc >> 2); }
            else if (lc < 52) { const int ix = lc - 8, p = ix / 22; gpos = 2; guest.kind = K_UP1; guest.pm = NPANEL_P + p; guest.pn = ix % 22; guest.dep = C_OUT(p); guest.want = 4; guest.sig = C_UP(1, p); }
            else if (lc < 84) { const int ix = lc - 52, p = ix >> 4; gpos = 4; guest.kind = K_DNS1; guest.pm = NPANEL_P + p; guest.pn = (ix >> 2) & 3; guest.ks = ix & 3; guest.dep = C_UP(1, p); guest.want = 22; guest.sig = C_DNS(1, p, guest.pn); }
        }
    }
    __device__ __forceinline__ bool next(int i, UnitD& u) const {
        if (i >= count) return false;
        const int pos = first + i; int ip = pos;
        if (gpos >= 0) { if (pos == gpos) { u = guest; return true; } if (pos > gpos) ip = pos - 1; }
        const int L = ip * 256 + c; if (L >= NPANEL_P * 22) return false;
        u.kind = l == 0 ? K_UP0 : K_UP1; map_unit(L, NPANEL_P, 22, u.pm, u.pn); u.ks = 0; u.dep = -1; u.want = 0; u.sig = -1; return true; }
};
}

template <int L_> __device__ __forceinline__ void finisher(LAS unsigned char* lds, int p, int pn) {
    dep_wait(C_DNS(L_, p, pn), 4u);
    const int tid = tid_fresh(), wid = __builtin_amdgcn_readfirstlane(tid >> 6), lane = tid & 63, wr = wid >> 2, wc = wid & 3, fr = lane & 15, fq = lane >> 4;
    f32x4 acc[2][2][4][2];
    const char* pb = (const char*)(kargs()->ws + WS_PBUF) + (size_t)(((p * 4 + pn) * 4) * 32) * 8192;
#pragma unroll
    for (int ai = 0; ai < 2; ++ai)
#pragma unroll
        for (int bj = 0; bj < 2; ++bj)
#pragma unroll
            for (int m = 0; m < 4; m += 2) {
#pragma unroll
                for (int mm = 0; mm < 2; ++mm)
#pragma unroll
                    for (int n = 0; n < 2; ++n) { const unsigned o = (unsigned)(((((ai * 2 + bj) * 4 + m + mm) * 2 + n) * 512 + tid) * 16);
                        acc[ai][bj][m + mm][n] = (*(const f32x4*)(pb + o) + *(const f32x4*)(pb + o + 262144u)) + (*(const f32x4*)(pb + o + 2u * 262144u) + *(const f32x4*)(pb + o + 3u * 262144u)); }
                asm volatile("" : "+v"(acc[ai][bj][m][0]), "+v"(acc[ai][bj][m][1]), "+v"(acc[ai][bj][m + 1][0]), "+v"(acc[ai][bj][m + 1][1]) :: "memory"); }
    epi_prefetch(L_ == 0 ? pg8::K_DN0 : pg8::K_DN1, NPANEL_P + p, pn, lds + EPI_OFF, wid, lane);
    asm volatile("s_waitcnt vmcnt(0)" ::: "memory"); __syncthreads();
    const pg8::Unit uu{NPANEL_P + p, pn};
    if (L_ == 0) { EpiRes<false> E{0, 1, 5, 0}; E(acc, uu, wr, wc, fr, fq, lds + EPI_OFF); unit_signal(C_FIN(0, p)); }
    else { EpiRes<true> E{2, 0, 5, D}; E(acc, uu, wr, wc, fr, fq, lds + EPI_OFF); }
    asm volatile("s_waitcnt vmcnt(0) lgkmcnt(0)" ::: "memory"); __syncthreads();
}

__device__ __forceinline__ void p0_item(const float* W, int K, int N, int kb, int nb, bf16_t* WT, int dest_row0, const float* rowscale, const float* colscale,
                                        float* csp, const float* bvec, float* cbp, int pstride, LAS float* scr, int lane) {
    const int k0 = 64 * kb, n0 = 32 * nb;
#pragma unroll 8
    for (int i = 0; i < 32; ++i) { const int kk = 2 * i + (lane >> 5); scr[kk * 33 + (lane & 31)] = W[(size_t)(k0 + kk) * N + n0 + (lane & 31)]; }
    asm volatile("s_waitcnt lgkmcnt(0)" ::: "memory");
    const int c = lane & 7;
    float rs[8], bb[8];
#pragma unroll
    for (int i = 0; i < 8; ++i) { rs[i] = rowscale ? rowscale[k0 + 8 * c + i] : 1.0f; bb[i] = bvec ? bvec[k0 + 8 * c + i] : 0.0f; }
#pragma unroll
    for (int j = 0; j < 4; ++j) { const int n = (lane >> 3) + 8 * j; const LAS float* s = scr + (8 * c) * 33 + n;
        const float sc = colscale ? colscale[n0 + n] : 1.0f;
        unsigned r[8]; float ps = 0.f, pb = 0.f;
#pragma unroll
        for (int i = 0; i < 8; ++i) { const float w = s[i * 33]; r[i] = f2bf(w * rs[i] * sc); ps += bf2f(r[i]); pb += w * bb[i]; }
        u32x4 o; o.x = r[0] | (r[1] << 16); o.y = r[2] | (r[3] << 16); o.z = r[4] | (r[5] << 16); o.w = r[6] | (r[7] << 16);
        *(u32x4*)(WT + (size_t)(dest_row0 + n) * K + k0 + 8 * c) = o;
        if (csp) {
            ps += __shfl_xor(ps, 1); ps += __shfl_xor(ps, 2); ps += __shfl_xor(ps, 4);
            pb += __shfl_xor(pb, 1); pb += __shfl_xor(pb, 2); pb += __shfl_xor(pb, 4);
            if (c == 0) { csp[(size_t)kb * pstride + dest_row0 + n] = ps; cbp[(size_t)kb * pstride + dest_row0 + n] = pb; }
        }
    }
    asm volatile("s_waitcnt lgkmcnt(0)" ::: "memory");
}
__device__ __forceinline__ int up_dest(int n) { return n < FF ? 256 * (n >> 7) + (n & 127) : 256 * ((n - FF) >> 7) + 128 + ((n - FF) & 127); }
__device__ __forceinline__ int in_dest(int n) { return n < D ? 2048 + n : (n < 2 * D ? 256 * ((n - D) >> 7) + ((n - D) & 127) : 256 * ((n - 2 * D) >> 7) + 128 + ((n - 2 * D) & 127)); }

__device__ __forceinline__ void phase0(LAS unsigned char* lds) {
    const KA Params* q = kargs();
    const int tid = tid_fresh(), lane = tid & 63, wave = tid >> 6;
    LAS float* scr = (LAS float*)(lds + wave * 8704);
    const int gw = blockIdx.x * 8 + wave, NGW = gridDim.x * 8;
    unsigned char* ws = q->ws;
    constexpr int I_UP = 16 * 176, I_IN = 16 * 96, I_OUT = 16 * 32, I_DN = 44 * 32, I_POOL = 4 * 8;
    constexpr int NITEMS = 2 * I_UP + I_IN + I_OUT + 2 * I_DN + 4 * I_POOL;
    for (int it = gw; it < NITEMS; it += NGW) {
        int r = it;
        if (r < 2 * I_UP) { const int l = r / I_UP; r -= l * I_UP; const int kb = r / 176, nb = r % 176;
            p0_item(q->in[13] + (size_t)l * D * FF2, D, FF2, kb, nb, (bf16_t*)(ws + WS_WUP) + (size_t)l * FF2 * D, up_dest(32 * nb), q->in[5] + l * D, nullptr,
                    (float*)(ws + WS_CSP_UP) + (size_t)l * 16 * FF2, q->in[6] + l * D, (float*)(ws + WS_CBP_UP) + (size_t)l * 16 * FF2, FF2, scr, lane); continue; }
        r -= 2 * I_UP;
        if (r < I_IN) { const int kb = r / 96, nb = r % 96;
            p0_item(q->in[9], D, 3 * D, kb, nb, (bf16_t*)(ws + WS_WIN), in_dest(32 * nb), q->in[17], nullptr, (float*)(ws + WS_CSP_IN), q->in[18], (float*)(ws + WS_CBP_IN), 3 * D, scr, lane); continue; }
        r -= I_IN;
        if (r < I_OUT) { const int kb = r / 32, nb = r % 32;
            p0_item(q->in[12], D, D, kb, nb, (bf16_t*)(ws + WS_WOUT), 32 * nb, nullptr, nullptr, nullptr, nullptr, nullptr, 0, scr, lane); continue; }
        r -= I_OUT;
        if (r < 2 * I_DN) { const int l = r / I_DN; r -= l * I_DN; const int kb = r / 32, nb = r % 32;
            p0_item(q->in[16] + (size_t)l * FF * D, FF, D, kb, nb, (bf16_t*)(ws + WS_WDN) + (size_t)l * D * FF, 32 * nb, nullptr, nullptr, nullptr, nullptr, nullptr, 0, scr, lane); continue; }
        r -= 2 * I_DN;
        { const int g = r / I_POOL; r -= g * I_POOL; const int kb = r / 8, nb = r % 8;
            p0_item(q->in[7] + (size_t)g * 256 * 256, 256, 256, kb, nb, (bf16_t*)(ws + WS_WPOOL) + (size_t)g * 256 * 256, 32 * nb, nullptr, q->in[8] + g * 256, nullptr, nullptr, nullptr, 0, scr, lane); }
    }
    const int gt = blockIdx.x * 512 + tid, NGT = gridDim.x * 512;
    for (int i = gt; i < 2 * FF2; i += NGT) { const int l = i / FF2, n = i % FF2, d = up_dest(n); float* kc = (float*)(ws + WS_KC_UP) + (size_t)l * 4 * FF2;
        kc[d] = q->in[14][(size_t)(l * 3 + 0) * FF2 + n]; kc[FF2 + d] = q->in[14][(size_t)(l * 3 + 1) * FF2 + n]; kc[2 * FF2 + d] = q->in[14][(size_t)(l * 3 + 2) * FF2 + n]; kc[3 * FF2 + d] = q->in[15][(size_t)l * FF2 + n]; }
    for (int i = gt; i < NB_P * 15 * (D / 4); i += NGT) { const int c4 = i % (D / 4), rr = (i / (D / 4)) % 15, b = i / (15 * (D / 4));
        ((f32x4*)(q->out + O_POOL_P))[i] = *(const f32x4*)(q->in[0] + ((size_t)b * SEQ + 2033 + rr) * D + c4 * 4); }
    for (int i = gt; i < NB_S * 15 * (D / 4); i += NGT) { const int c4 = i % (D / 4), rr = (i / (D / 4)) % 15, s = i / (15 * (D / 4));
        ((f32x4*)(q->out + O_POOL_S))[i] = rr < 11 ? *(const f32x4*)(q->in[2] + ((size_t)s * 15 + 4 + rr) * D + c4 * 4) : *(const f32x4*)(q->in[1] + ((size_t)s * TS + rr - 11) * D + c4 * 4); }
}

template <int W>
__device__ __forceinline__ void p1_window_prompt(const float* xseq, int tpos0, LAS unsigned char* lds, int row0, int cq) {
    f32x4 a[16 + W];
#pragma unroll
    for (int k = 0; k < 16 + W; ++k) { const int t = tpos0 - W + k, tc = t < 0 ? 0 : t; const f32x4 v = *(const f32x4*)(xseq + (size_t)tc * D); a[k] = t >= 0 ? v : (f32x4){0.f, 0.f, 0.f, 0.f}; }
    f32x4 s = {0.f, 0.f, 0.f, 0.f};
#pragma unroll
    for (int k = 0; k < W; ++k) s += a[k];
#pragma unroll
    for (int j = 0; j < 16; ++j) { s += a[W + j] - a[j]; const int t = tpos0 + j; const float inv = 1.0f / (float)(t + 1 < W ? t + 1 : W); const f32x4 d = s * inv - a[W + j];
        const int row = row0 + j; u32x2 w; w.x = pk2(d[0], d[1]); w.y = pk2(d[2], d[3]);
        *(LAS u32x2*)(lds + row * 2048 + ((((cq >> 1) ^ (row & 15))) << 4) + (cq & 1) * 8) = w; }
}
template <int W>
__device__ __forceinline__ void p1_window_sample(const float* hist, const float* xs, LAS unsigned char* lds, int row0, int cq) {
    f32x4 a[W + 4];
#pragma unroll
    for (int k = 0; k < W; ++k) { const int i = W - k; a[k] = i <= 15 ? *(const f32x4*)(hist + (size_t)(15 - i) * D) : (f32x4){0.f, 0.f, 0.f, 0.f}; }
#pragma unroll
    for (int t = 0; t < 4; ++t) a[W + t] = *(const f32x4*)(xs + (size_t)t * D);
    f32x4 s = {0.f, 0.f, 0.f, 0.f};
#pragma unroll
    for (int k = 0; k < W; ++k) s += a[k];
#pragma unroll
    for (int t = 0; t < 4; ++t) { s += a[W + t] - a[t]; const f32x4 d = s * (1.0f / (float)W) - a[W + t];
        const int row = row0 + t; u32x2 w; w.x = pk2(d[0], d[1]); w.y = pk2(d[2], d[3]);
        *(LAS u32x2*)(lds + row * 2048 + ((((cq >> 1) ^ (row & 15))) << 4) + (cq & 1) * 8) = w; }
}
__device__ __forceinline__ void phase1(LAS unsigned char* lds) {
    const KA Params* q = kargs();
    const int tid = tid_fresh(), lane = tid & 63, wave = __builtin_amdgcn_readfirstlane(tid >> 6), fr = lane & 15, fq = lane >> 4;
    unsigned char* ws = q->ws;
    { const int gt = blockIdx.x * 512 + tid, NGT = gridDim.x * 512;
      for (int i = gt; i < 2 * FF2 + 3 * D; i += NGT) {
          float s = 0.f, b = 0.f;
          if (i < 2 * FF2) { const int l = i / FF2, c = i % FF2; const float* sp = (const float*)(ws + WS_CSP_UP) + (size_t)l * 16 * FF2 + c; const float* bp = (const float*)(ws + WS_CBP_UP) + (size_t)l * 16 * FF2 + c;
              for (int k = 0; k < 16; ++k) { s += sp[(size_t)k * FF2]; b += bp[(size_t)k * FF2]; }
              ((float*)(ws + WS_CS_UP))[i] = s; ((float*)(ws + WS_CB_UP))[i] = b; }
          else { const int c = i - 2 * FF2; const float* sp = (const float*)(ws + WS_CSP_IN) + c; const float* bp = (const float*)(ws + WS_CBP_IN) + c;
              for (int k = 0; k < 16; ++k) { s += sp[(size_t)k * 3 * D]; b += bp[(size_t)k * 3 * D]; }
              ((float*)(ws + WS_CS_IN))[c] = s; ((float*)(ws + WS_CB_IN))[c] = b; } } }
    const bf16_t* wpool = (const bf16_t*)(ws + WS_WPOOL);
    bf16_t* vbf = (bf16_t*)(ws + WS_H1);
    f32x2* part = (f32x2*)(ws + WS_PART);
    LAS f32x2* T = (LAS f32x2*)(lds + P1_T_OFF);
    const int cq = tid & 255, th = __builtin_amdgcn_readfirstlane(tid >> 8), gw = (wave & 3);
    const int g = wave >> 1, hh = wave & 1;
    for (int tile = blockIdx.x; tile < NTOK_P / 64; tile += gridDim.x) {
        const int tok0 = tile * 64, t0 = tok0 & (SEQ - 1);
        const bool host = (tile & 3) == 0; const int seq0 = 2 * (tile >> 2);
        { const float* xseq = q->in[0] + (size_t)(tok0 - t0) * D + 4 * cq;
#pragma unroll 1
          for (int st = 0; st < 2; ++st) { const int r0 = 32 * th + 16 * st;
              if (gw == 0) p1_window_prompt<2>(xseq, t0 + r0, lds, r0, cq); else if (gw == 1) p1_window_prompt<4>(xseq, t0 + r0, lds, r0, cq);
              else if (gw == 2) p1_window_prompt<8>(xseq, t0 + r0, lds, r0, cq); else p1_window_prompt<16>(xseq, t0 + r0, lds, r0, cq); }
          if (host) { const float* hist = q->in[2] + (size_t)(seq0 + th) * 15 * D + 4 * cq; const float* xs = q->in[1] + (size_t)(seq0 + th) * TS * D + 4 * cq;
              if (gw == 0) p1_window_sample<2>(hist, xs, lds, 64 + 4 * th, cq); else if (gw == 1) p1_window_sample<4>(hist, xs, lds, 64 + 4 * th, cq);
              else if (gw == 2) p1_window_sample<8>(hist, xs, lds, 64 + 4 * th, cq); else p1_window_sample<16>(hist, xs, lds, 64 + 4 * th, cq); } }
        float rsum[5], rsq[5];
#pragma unroll
        for (int mb = 0; mb < 5; ++mb) { rsum[mb] = 0.f; rsq[mb] = 0.f; }
#pragma unroll 1
        for (int half = 0; half < 2; ++half) {
            f32x4 acc[5][4];
#pragma unroll
            for (int mb = 0; mb < 5; ++mb)
#pragma unroll
                for (int nb = 0; nb < 4; ++nb) acc[mb][nb] = (f32x4){0.f, 0.f, 0.f, 0.f};
            const bf16_t* wb = wpool + ((size_t)g * 256 + 128 * hh + 64 * half + fr) * 256 + 8 * fq;
#pragma unroll 1
            for (int kh = 0; kh < 2; ++kh) {
                bf16x8 b[4][4];
#pragma unroll
                for (int ks = 0; ks < 4; ++ks)
#pragma unroll
                    for (int nb = 0; nb < 4; ++nb) b[ks][nb] = *(const bf16x8*)(wb + (size_t)(16 * nb) * 256 + 32 * (4 * kh + ks));
                if (half == 0 && kh == 0) __syncthreads();
#pragma unroll
                for (int ks = 0; ks < 4; ++ks) {
                    const int chunk = 32 * g + 4 * (4 * kh + ks) + fq;
                    bf16x8 a[5];
#pragma unroll
                    for (int mb = 0; mb < 5; ++mb) { const int row = mb < 4 ? 16 * mb + fr : 64 + (fr & 7); a[mb] = *(const LAS bf16x8*)(lds + row * 2048 + ((chunk ^ (row & 15)) << 4)); }
#pragma unroll
                    for (int mb = 0; mb < 4; ++mb)
#pragma unroll
                        for (int nb = 0; nb < 4; ++nb) acc[mb][nb] = __builtin_amdgcn_mfma_f32_16x16x32_bf16(b[ks][nb], a[mb], acc[mb][nb], 0, 0, 0);
                    if (host) {
#pragma unroll
                        for (int nb = 0; nb < 4; ++nb) acc[4][nb] = __builtin_amdgcn_mfma_f32_16x16x32_bf16(b[ks][nb], a[4], acc[4][nb], 0, 0, 0); }
                }
            }
            const int c0 = 256 * g + 128 * hh + 64 * half + 4 * fq;
#pragma unroll
            for (int mb = 0; mb < 5; ++mb) {
                if (mb == 4 && (!host || fr >= 8)) continue;
                const int tok = mb < 4 ? tok0 + 16 * mb + fr : NTOK_P + 4 * seq0 + fr, R = row_of_tok(tok);
                const float* xr = (mb < 4 ? q->in[0] + (size_t)tok * D : q->in[1] + (size_t)(tok - NTOK_P) * D) + c0;
                f32x4 xv[4];
#pragma unroll
                for (int nb = 0; nb < 4; ++nb) xv[nb] = *(const f32x4*)(xr + 16 * nb);
#pragma unroll
                for (int nb = 0; nb < 4; ++nb) { const f32x4 v = xv[nb] * ALPHA + acc[mb][nb];
                    rsum[mb] += (v[0] + v[1]) + (v[2] + v[3]); rsq[mb] += (v[0] * v[0] + v[1] * v[1]) + (v[2] * v[2] + v[3] * v[3]);
                    u32x2 wv; wv.x = pk2(v[0], v[1]); wv.y = pk2(v[2], v[3]); *(u32x2*)(vbf + (size_t)R * D + c0 + 16 * nb) = wv; }
            }
        }
#pragma unroll
        for (int mb = 0; mb < 5; ++mb) {
            float sum = rsum[mb], sq = rsq[mb];
            sum += __shfl_xor(sum, 16); sum += __shfl_xor(sum, 32); sq += __shfl_xor(sq, 16); sq += __shfl_xor(sq, 32);
            if (fq == 0 && (mb < 4 || fr < 8)) { f32x2 t; t.x = sum; t.y = sq; T[(mb < 4 ? 16 * mb + fr : 64 + fr) * 8 + wave] = t; }
        }
        __syncthreads();
        if (tid < 4 * (host ? 72 : 64)) { const int row = tid >> 2, gg = tid & 3; const f32x2 a = T[row * 8 + 2 * gg], b = T[row * 8 + 2 * gg + 1];
            const float mt = (a.x + b.x) * (1.0f / 256.0f); f32x2 r; r.x = mt; r.y = (a.y + b.y) - 256.0f * mt * mt;
            const int tok = row < 64 ? tok0 + row : NTOK_P + 4 * seq0 + (row - 64);
            part[(size_t)row_of_tok(tok) * 4 + gg] = r; }
        __syncthreads();
    }
}

__device__ __forceinline__ void phase_fixup(int l) {
    const KA Params* q = kargs();
    const float* kc = (const float*)(q->ws + WS_KC_UP) + (size_t)l * 4 * FF2; bf16_t* act = (bf16_t*)(q->ws + WS_ACT);
    const float* Hf = (const float*)(q->ws + WS_HF); const float* Hl = (const float*)(q->ws + WS_HL);
    const int gt = blockIdx.x * 512 + tid_fresh(), NGT = gridDim.x * 512;
    for (int i = gt; i < 128 * (FF / 4); i += NGT) {
        const int q = i / (FF / 4), f = (i % (FF / 4)) * 4;
        if ((q & 15) == 0) continue;
        const int cg_ = 256 * (f >> 7) + (f & 127), cv_ = cg_ + 128;
        const float* hf = Hf + (size_t)q * 2 * FF2; const float* hl = Hl + (size_t)(q - 1) * 2 * FF2;
        const f32x4 k0g = *(const f32x4*)(kc + cg_), k1g = *(const f32x4*)(kc + FF2 + cg_), k2g = *(const f32x4*)(kc + 2 * FF2 + cg_), kbg = *(const f32x4*)(kc + 3 * FF2 + cg_);
        const f32x4 k0v = *(const f32x4*)(kc + cv_), k1v = *(const f32x4*)(kc + FF2 + cv_), k2v = *(const f32x4*)(kc + 2 * FF2 + cv_), kbv = *(const f32x4*)(kc + 3 * FF2 + cv_);
        const f32x4 g2 = *(const f32x4*)(hl + cg_), g1 = *(const f32x4*)(hl + FF2 + cg_), a0 = *(const f32x4*)(hf + cg_), a1 = *(const f32x4*)(hf + FF2 + cg_);
        const f32x4 v2 = *(const f32x4*)(hl + cv_), v1 = *(const f32x4*)(hl + FF2 + cv_), b0 = *(const f32x4*)(hf + cv_), b1 = *(const f32x4*)(hf + FF2 + cv_);
        const f32x4 zg0 = k2g * a0 + k1g * g1 + k0g * g2 + kbg, zv0 = k2v * b0 + k1v * v1 + k0v * v2 + kbv;
        const f32x4 zg1 = k2g * a1 + k1g * a0 + k0g * g1 + kbg, zv1 = k2v * b1 + k1v * b0 + k0v * v1 + kbv;
        const int R0 = (q >> 1) * 256 + 64 * (q & 1);
        u32x2 w0, w1; w0.x = pk2(silu_mul(zg0[0], zv0[0]), silu_mul(zg0[1], zv0[1])); w0.y = pk2(silu_mul(zg0[2], zv0[2]), silu_mul(zg0[3], zv0[3]));
        w1.x = pk2(silu_mul(zg1[0], zv1[0]), silu_mul(zg1[1], zv1[1])); w1.y = pk2(silu_mul(zg1[2], zv1[2]), silu_mul(zg1[3], zv1[3]));
        *(u32x2*)(act + (size_t)R0 * FF + f) = w0; *(u32x2*)(act + (size_t)(R0 + 16) * FF + f) = w1;
    }
}

__device__ __forceinline__ void phase_conv() {
    const KA Params* q = kargs();
    bf16_t* obuf = (bf16_t*)q->out;
    const float* ck = q->in[10]; const float* ckb = q->in[11]; const float* st = q->in[3];
    const int gt = blockIdx.x * 512 + tid_fresh(), NGT = gridDim.x * 512;
    for (int i = gt; i < MROWS * (D / 8); i += NGT) {
        const int tok = i >> 7, ch = (i & 127) * 8;
        int t, seq = 0; const bool sample = tok >= NTOK_P;
        if (!sample) t = tok & (SEQ - 1); else { seq = (tok - NTOK_P) >> 2; t = tok & 3; }
        const bf16_t* ubuf = sample ? (const bf16_t*)(q->ws + WS_SU) - (size_t)NTOK_P * D : (const bf16_t*)(q->ws + WS_ACT);
        const bf16_t* bbuf = sample ? (const bf16_t*)(q->ws + WS_SB) - (size_t)NTOK_P * D : (const bf16_t*)(q->ws + WS_ACT) + (size_t)MROWS * D;
        const int R = row_of_tok(tok);
        float u0[8], u1[8], u2[8], bb[8];
        { const u32x4 w = *(const u32x4*)(ubuf + (size_t)R * D + ch); const u32x4 wb = *(const u32x4*)(bbuf + (size_t)R * D + ch);
#pragma unroll
          for (int e = 0; e < 4; ++e) { u2[2 * e] = bf2f(w[e] & 0xffffu); u2[2 * e + 1] = bf2f(w[e] >> 16); bb[2 * e] = bf2f(wb[e] & 0xffffu); bb[2 * e + 1] = bf2f(wb[e] >> 16); } }
        if (t >= 1) { const u32x4 w = *(const u32x4*)(ubuf + (size_t)row_of_tok(tok - 1) * D + ch);
#pragma unroll
            for (int e = 0; e < 4; ++e) { u1[2 * e] = bf2f(w[e] & 0xffffu); u1[2 * e + 1] = bf2f(w[e] >> 16); } }
        else if (sample) { const f32x4 a = *(const f32x4*)(st + ((size_t)seq * 2 + 1) * D + ch), b = *(const f32x4*)(st + ((size_t)seq * 2 + 1) * D + ch + 4);
#pragma unroll
            for (int e = 0; e < 4; ++e) { u1[e] = a[e]; u1[4 + e] = b[e]; } }
        else {
#pragma unroll
            for (int e = 0; e < 8; ++e) u1[e] = 0.f; }
        if (t >= 2) { const u32x4 w = *(const u32x4*)(ubuf + (size_t)row_of_tok(tok - 2) * D + ch);
#pragma unroll
            for (int e = 0; e < 4; ++e) { u0[2 * e] = bf2f(w[e] & 0xffffu); u0[2 * e + 1] = bf2f(w[e] >> 16); } }
        else if (sample) { const f32x4 a = *(const f32x4*)(st + ((size_t)seq * 2 + t) * D + ch), b = *(const f32x4*)(st + ((size_t)seq * 2 + t) * D + ch + 4);
#pragma unroll
            for (int e = 0; e < 4; ++e) { u0[e] = a[e]; u0[4 + e] = b[e]; } }
        else {
#pragma unroll
            for (int e = 0; e < 8; ++e) u0[e] = 0.f; }
        float o[8];
#pragma unroll
        for (int e = 0; e < 8; ++e) o[e] = bb[e] * (ck[ch + e] * u0[e] + ck[D + ch + e] * u1[e] + ck[2 * D + ch + e] * u2[e] + ckb[ch + e]);
        u32x4 w; w.x = pk2(o[0], o[1]); w.y = pk2(o[2], o[3]); w.z = pk2(o[4], o[5]); w.w = pk2(o[6], o[7]);
        *(u32x4*)(obuf + (size_t)R * D + ch) = w;
    }
}

__device__ __forceinline__ void phase_final() {
    const KA Params* q = kargs();
    const f32x2* part = (const f32x2*)(q->ws + WS_PART); const float* g = q->in[17] + D; const float* b = q->in[18] + D;
    const int tid = tid_fresh(), lane = tid & 63, gw = blockIdx.x * 8 + (tid >> 6), NGW = gridDim.x * 8;
    f32x4 gv[4], bv[4];
#pragma unroll
    for (int j = 0; j < 4; ++j) { gv[j] = *(const f32x4*)(g + 256 * j + 4 * lane); bv[j] = *(const f32x4*)(b + 256 * j + 4 * lane); }
    for (int tok = gw; tok < MROWS; tok += NGW) {
        const f32x2 s = row_stats(part, row_of_tok(tok));
        float* yr = q->out + (size_t)tok * D + 4 * lane;
#pragma unroll
        for (int j = 0; j < 4; ++j) { const f32x4 v = *(const f32x4*)(yr + 256 * j); *(f32x4*)(yr + 256 * j) = ((v - s.x) * s.y) * gv[j] + bv[j]; }
    }
}

#define XB_TMO      128
#define XB_XCNT(j)  (256  + 64 * (j))
#define XB_XSUB(j)  (1280 + 64 * (j))
#define XB_XGEN(j)  (2304 + 64 * (j))
#define XB_TOP      3328
#define XB_TOPGEN   3392
#define XCD_BAR_WORDS 3456
#define XB_SPIN_CAP (1u << 18)

__device__ __forceinline__ unsigned xb_ld(unsigned* p)              { return __hip_atomic_load(p, __ATOMIC_RELAXED, __HIP_MEMORY_SCOPE_AGENT); }
__device__ __forceinline__ unsigned xb_add(unsigned* p, unsigned v) { return __hip_atomic_fetch_add(p, v, __ATOMIC_RELAXED, __HIP_MEMORY_SCOPE_AGENT); }
__device__ __forceinline__ unsigned xb_xcc_id() { return (unsigned)__builtin_amdgcn_s_getreg((3 << 11) | 20) & 0xFu; }
#define XB_SPIN(cond, bar) do { unsigned _sp = 0; while (cond) { __builtin_amdgcn_s_sleep(1); \
    if ((++_sp & 255u) == 0u) { if (xb_ld(&(bar)[XB_TMO])) break; if (_sp > XB_SPIN_CAP) { atomicAdd(&(bar)[XB_TMO], 1u); break; } } } } while (0)

struct XcdBarrier {
    unsigned* bar; unsigned x;
    volatile LAS unsigned* st;
};

__device__ __forceinline__ XcdBarrier xcd_barrier_post(unsigned* bar, volatile LAS unsigned* st) {
    XcdBarrier b; b.bar = bar; b.x = xb_xcc_id(); b.st = st;
    if (threadIdx.x == 0) (void)xb_add(&bar[XB_XCNT(b.x)], 1u);
    return b;
}
__device__ __forceinline__ void xcd_barrier_complete(unsigned* bar, unsigned x, unsigned& nloc, unsigned& nx) {
    const unsigned G = gridDim.x * gridDim.y * gridDim.z;
    unsigned sum, cnt, mine, sp = 0u;
    for (;;) {
        sum = 0u; cnt = 0u; mine = 0u;
#pragma unroll
        for (unsigned j = 0; j < 16; ++j) { const unsigned c = xb_ld(&bar[XB_XCNT(j)]); sum += c; cnt += (c > 0u) ? 1u : 0u; mine = (j == x) ? c : mine; }
        if (sum == G) break;
        __builtin_amdgcn_s_sleep(1);
        if ((++sp & 255u) == 0u) { if (xb_ld(&bar[XB_TMO])) break; if (sp > XB_SPIN_CAP) { atomicAdd(&bar[XB_TMO], 1u); break; } }
    }
    nloc = mine > 0u ? mine : 1u; nx = cnt > 0u ? cnt : 1u;
}

__device__ __forceinline__ void xcd_barrier(const XcdBarrier& b) {
    asm volatile("s_waitcnt vmcnt(0)" ::: "memory");
    __syncthreads();
    if (threadIdx.x == 0) {
        unsigned* bar = b.bar;
        __builtin_amdgcn_s_waitcnt(0);
        unsigned nloc = b.st[0], nx = b.st[1];
        if (nloc == 0u) { xcd_barrier_complete(bar, b.x, nloc, nx); b.st[0] = nloc; b.st[1] = nx; }
        const unsigned old = xb_add(&bar[XB_XSUB(b.x)], 1u);
        const unsigned gen = old / nloc;
        if (old + 1u == (gen + 1u) * nloc) {
            __builtin_amdgcn_fence(__ATOMIC_RELEASE, "agent");
            asm volatile("s_waitcnt vmcnt(0)" ::: "memory");
            const unsigned og = xb_add(&bar[XB_TOP], 1u);
            const unsigned tg = og / nx;
            if (og + 1u == (tg + 1u) * nx) xb_add(&bar[XB_TOPGEN], 1u);
            else XB_SPIN(xb_ld(&bar[XB_TOPGEN]) == tg, bar);
            __builtin_amdgcn_fence(__ATOMIC_ACQUIRE, "agent");
            xb_add(&bar[XB_XGEN(b.x)], 1u);
            asm volatile("s_waitcnt vmcnt(0)" ::: "memory");
        } else {
            XB_SPIN(xb_ld(&bar[XB_XGEN(b.x)]) == gen, bar);
            __builtin_amdgcn_fence(__ATOMIC_ACQUIRE, "agent");
            asm volatile("s_waitcnt vmcnt(0)" ::: "memory");
        }
    }
    __syncthreads();
}


__global__ void __launch_bounds__(512, 2) fwd_megakernel(Params p) {
    extern __shared__ __attribute__((aligned(16))) unsigned char lds_raw[];
    LAS unsigned char* lds = (LAS unsigned char*)lds_raw;
    const int G = gridDim.x, cid = blockIdx.x;
    if (threadIdx.x < 2) ((LAS unsigned*)(lds + BARST_OFF))[threadIdx.x] = 0u;
    __syncthreads();
    const XcdBarrier bar = xcd_barrier_post((unsigned*)(kargs()->ws + WS_BAR), (volatile LAS unsigned*)(lds + BARST_OFF));
    using namespace pg8;
    constexpr int M_UP = (1 << K_UP0) | (1 << K_UP1), M_DNS = (1 << K_DNS0) | (1 << K_DNS1);
#if DIAG & 1
    for (int rep = 0; rep < ((REP & 1) ? 2 : 1); ++rep) phase0(lds);
#endif
    xcd_barrier(bar);
#if DIAG & 2
    for (int rep = 0; rep < ((REP & 2) ? 2 : 1); ++rep) phase1(lds);
#endif
    xcd_barrier(bar);
#if SEG & 1
    { SchedUp S; S.init(0, cid);
      const int lc = cid - 128;
      if (lc >= 76 && lc < 84) { S.first = 0; S.count = 4; gemm_stream<M_UP, false>(lds, S); finisher<0>(lds, (lc - 76) >> 2, (lc - 76) & 3); S.first = 4; S.count = 1; gemm_stream<M_UP, false>(lds, S); }
      else gemm_stream<M_UP | M_DNS | (1 << K_IN), true>(lds, S); }
#endif
    xcd_barrier(bar);
    phase_fixup(0);
    xcd_barrier(bar);
#if SEG & 2
    { SchedSimple S{K_DN0, NPANEL_P, 4, G, cid}; gemm_stream<(1 << K_DN0), false>(lds, S); }
#endif
    xcd_barrier(bar);
#if SEG & 4
    { SchedSimple S{K_IN, NPANEL_P, 12, G, cid}; gemm_stream<(1 << K_IN), false>(lds, S); }
#endif
    xcd_barrier(bar);
    phase_conv();
    xcd_barrier(bar);
#if SEG & 8
    { SchedSimple S{K_OUT, NPANEL_P, 4, G, cid}; gemm_stream<(1 << K_OUT), false>(lds, S); }
#endif
    xcd_barrier(bar);
#if SEG & 16
    { SchedUp S; S.init(1, cid);
      const int lc = cid - 128;
      gemm_stream<M_UP | M_DNS | (1 << K_OUT), true>(lds, S);
      if (lc >= 84 && lc < 92) finisher<1>(lds, (lc - 84) >> 2, (lc - 84) & 3); }
#endif
    xcd_barrier(bar);
    phase_fixup(1);
    xcd_barrier(bar);
#if SEG & 32
    { SchedSimple S{K_DN1, NPANEL_P, 4, G, cid}; gemm_stream<(1 << K_DN1), false>(lds, S); }
#endif
    xcd_barrier(bar);
    phase_final();
}

extern "C" void kernel_launch(void* const* d_in, const int* in_sizes, int n_in, void* d_out, int out_size, void* d_ws, size_t ws_size, hipStream_t stream) {
    static int grid_blocks = 0;
    if (grid_blocks == 0) {
        if (n_in != 19 || out_size != (int)O_END || ws_size < WS_END) { fprintf(stderr, "kernel_launch: unexpected shapes (n_in %d out %d ws %zu)\n", n_in, out_size, ws_size); grid_blocks = -1; return; }
        int dev = 0, cus = 0, per_cu = 0;
        hipGetDevice(&dev);
        hipDeviceGetAttribute(&cus, hipDeviceAttributeMultiprocessorCount, dev);
        if (hipFuncSetAttribute((const void*)fwd_megakernel, hipFuncAttributeMaxDynamicSharedMemorySize, LDS_BYTES) != hipSuccess) { fprintf(stderr, "kernel_launch: hipFuncSetAttribute failed\n"); grid_blocks = -1; return; }
        hipOccupancyMaxActiveBlocksPerMultiprocessor(&per_cu, (const void*)fwd_megakernel, 512, LDS_BYTES);
        if (per_cu < 1) { fprintf(stderr, "kernel_launch: occupancy query reports %d blocks per CU\n", per_cu); grid_blocks = -1; return; }
        if (cus != 256) { fprintf(stderr, "kernel_launch: the unit schedule is built for 256 CUs, this device has %d\n", cus); grid_blocks = -1; return; }
        grid_blocks = cus;
    }
    if (grid_blocks < 0) return;
    if (hipMemsetAsync((char*)d_ws + WS_BAR, 0, CTL_BYTES, stream) != hipSuccess) { fprintf(stderr, "kernel_launch: hipMemsetAsync failed\n"); return; }
    Params p{};
    for (int i = 0; i < 19; ++i) p.in[i] = (const float*)d_in[i];
    p.out = (float*)d_out; p.ws = (unsigned char*)d_ws;
    void* args[] = {&p};
    hipError_t e = hipLaunchCooperativeKernel((const void*)fwd_megakernel, dim3(grid_blocks), dim3(512), args, LDS_BYTES, stream);
    if (e != hipSuccess) fprintf(stderr, "cooperative launch failed: %s (grid %d)\n", hipGetErrorString(e), grid_blocks);
}
```

```cpp
#include <hip/hip_runtime.h>
#include <hip/hip_cooperative_groups.h>
#include <cstdio>
#include <cstdint>
namespace cg = cooperative_groups;
#ifndef REP
#define REP 0
#endif
#ifndef SEG
#define SEG 255
#endif
#ifndef DIAG
#define DIAG 1023
#endif

#define LAS __attribute__((address_space(3)))
typedef unsigned short bf16_t;
typedef short bf16x8 __attribute__((ext_vector_type(8)));
typedef float f32x4 __attribute__((ext_vector_type(4)));
typedef float f32x2 __attribute__((ext_vector_type(2)));
typedef unsigned u32x4 __attribute__((ext_vector_type(4)));
typedef unsigned u32x2 __attribute__((ext_vector_type(2)));

constexpr int D = 1024, FF = 2816, FF2 = 5632, SEQ = 2048, NB_P = 8, NB_S = 128, TS = 4;
constexpr int NTOK_P = NB_P * SEQ;
constexpr int NTOK_S = NB_S * TS;
constexpr int MROWS = NTOK_P + NTOK_S;
constexpr int NPANEL = MROWS / 256;
constexpr int NPANEL_P = NTOK_P / 256;
constexpr float ALPHA = 1.41421356237309515f;
constexpr float LN_EPS = 1e-5f;

constexpr size_t O_Y = 0;
constexpr size_t O_POOL_P = (size_t)MROWS * D;
constexpr size_t O_POOL_S = O_POOL_P + (size_t)NB_P * 15 * D;
constexpr size_t O_CONV_P = O_POOL_S + (size_t)NB_S * 15 * D;
constexpr size_t O_CONV_S = O_CONV_P + (size_t)NB_P * 2 * D;
constexpr size_t O_FFN_P = O_CONV_S + (size_t)NB_S * 2 * D;
constexpr size_t O_FFN_S = O_FFN_P + (size_t)2 * NB_P * 2 * FF2;
constexpr size_t O_END = O_FFN_S + (size_t)2 * NB_S * 2 * FF2;

constexpr size_t WS_WUP = 0;
constexpr size_t WS_WDN = WS_WUP + (size_t)2 * FF2 * D * 2;
constexpr size_t WS_WIN = WS_WDN + (size_t)2 * D * FF * 2;
constexpr size_t WS_WOUT = WS_WIN + (size_t)3 * D * D * 2;
constexpr size_t WS_WPOOL = WS_WOUT + (size_t)D * D * 2;
constexpr size_t WS_CSP_UP = WS_WPOOL + (size_t)4 * 256 * 256 * 2;
constexpr size_t WS_CBP_UP = WS_CSP_UP + (size_t)2 * 16 * FF2 * 4;
constexpr size_t WS_CSP_IN = WS_CBP_UP + (size_t)2 * 16 * FF2 * 4;
constexpr size_t WS_CBP_IN = WS_CSP_IN + (size_t)16 * 3072 * 4;
constexpr size_t WS_CS_UP = WS_CBP_IN + (size_t)16 * 3072 * 4;
constexpr size_t WS_CB_UP = WS_CS_UP + (size_t)2 * FF2 * 4;
constexpr size_t WS_KC_UP = WS_CB_UP + (size_t)2 * FF2 * 4;
constexpr size_t WS_CS_IN = WS_KC_UP + (size_t)2 * 4 * FF2 * 4;
constexpr size_t WS_CB_IN = WS_CS_IN + (size_t)3072 * 4;
constexpr size_t WS_PART = WS_CB_IN + (size_t)3072 * 4;
constexpr size_t PART_BYTES = (size_t)MROWS * 4 * 8;
constexpr size_t WS_HF = WS_PART + 3 * PART_BYTES;
constexpr size_t HALO_BYTES = (size_t)132 * 2 * FF2 * 4;
constexpr size_t WS_HL = WS_HF + HALO_BYTES;
constexpr size_t WS_H1 = WS_HL + HALO_BYTES;
constexpr size_t WS_ACT = WS_H1 + (size_t)MROWS * D * 2;
constexpr size_t WS_BAR = WS_ACT + (size_t)MROWS * FF * 2;
constexpr size_t WS_CNT = WS_BAR + 16384;
constexpr size_t CTL_BYTES = 16384 + 32768;
constexpr size_t WS_SU = WS_BAR + CTL_BYTES;
constexpr size_t WS_SB = WS_SU + (size_t)NTOK_S * D * 2;
constexpr size_t WS_PBUF = WS_SB + (size_t)NTOK_S * D * 2;
constexpr size_t WS_END = WS_PBUF + (size_t)32 * 262144;
static_assert(WS_END <= (size_t)256 * 1024 * 1024, "workspace");
static_assert(WS_WDN % 256 == 0 && WS_WIN % 256 == 0 && WS_WOUT % 256 == 0 && WS_WPOOL % 256 == 0 && WS_PART % 256 == 0 && WS_HF % 256 == 0 && WS_H1 % 256 == 0 && WS_ACT % 256 == 0, "align");

constexpr int STAGE_BYTES = 131072;
constexpr int EPI_OFF = STAGE_BYTES;
constexpr int EPI_S = 8192, EPI_CST = 10240, EPI_PART = 16384;
constexpr int P1_T_OFF = 147456;
constexpr int BARST_OFF = 155648;
constexpr int LDS_BYTES = 159744;

struct Params {
    const float* in[19];
    float* out;
    unsigned char* ws;
};

__device__ __forceinline__ unsigned f2bf(float f) { unsigned u = __builtin_bit_cast(unsigned, f); return (u + 0x7fffu + ((u >> 16) & 1u)) >> 16; }
__device__ __forceinline__ float bf2f(unsigned b) { return __builtin_bit_cast(float, b << 16); }
typedef __bf16 bf16v2 __attribute__((ext_vector_type(2)));
__device__ __forceinline__ unsigned pk2(float lo, float hi) { const f32x2 v = {lo, hi}; return __builtin_bit_cast(unsigned, __builtin_convertvector(v, bf16v2)); }
__device__ __forceinline__ float dpp_shr1(float v) {
    return __builtin_bit_cast(float, __builtin_amdgcn_update_dpp(0, __builtin_bit_cast(int, v), 0x111, 0xf, 0xf, true));
}
__device__ __forceinline__ float silu_mul(float g, float v) { return g * v * __builtin_amdgcn_rcpf(1.0f + __expf(-g)); }
__device__ __forceinline__ int tid_fresh() { int t = threadIdx.x; asm volatile("" : "+v"(t)); return t; }
__device__ __forceinline__ int row_of_tok(int tok) {
    const int pm = tok >> 8, tau = tok & 255;
    return pm * 256 + 128 * ((tau >> 2) & 1) + 64 * (tau >> 7) + 16 * (tau & 3) + ((tau >> 3) & 15);
}
__device__ __forceinline__ f32x2 row_stats(const f32x2* part, int R) {
    const f32x4 a = *(const f32x4*)(part + (size_t)R * 4), b = *(const f32x4*)(part + (size_t)R * 4 + 2);
    const float mean = ((a[0] + a[2]) + (b[0] + b[2])) * 0.25f;
    const float d0 = a[0] - mean, d1 = a[2] - mean, d2 = b[0] - mean, d3 = b[2] - mean;
    const float m2 = ((a[1] + a[3]) + (b[1] + b[3])) + 256.0f * ((d0 * d0 + d1 * d1) + (d2 * d2 + d3 * d3));
    f32x2 r; r.x = mean; r.y = __builtin_amdgcn_rsqf(m2 * (1.0f / 1024.0f) + LN_EPS); return r;
}
__device__ __forceinline__ void stats_from_lds(LAS unsigned char* elds) {
    int tx = threadIdx.x; asm volatile("" : "+v"(tx));
    if (tx < 256) { const f32x4 a = *(const LAS f32x4*)(elds + EPI_PART + tx * 32), b = *(const LAS f32x4*)(elds + EPI_PART + tx * 32 + 16);
        const float mean = ((a[0] + a[2]) + (b[0] + b[2])) * 0.25f;
        const float d0 = a[0] - mean, d1 = a[2] - mean, d2 = b[0] - mean, d3 = b[2] - mean;
        const float m2 = ((a[1] + a[3]) + (b[1] + b[3])) + 256.0f * ((d0 * d0 + d1 * d1) + (d2 * d2 + d3 * d3));
        const float rstd = __builtin_amdgcn_rsqf(m2 * (1.0f / 1024.0f) + LN_EPS);
        f32x2 t; t.x = rstd; t.y = -mean * rstd; ((LAS f32x2*)(elds + EPI_S))[tx] = t; }
    asm volatile("s_waitcnt lgkmcnt(0)" ::: "memory"); __builtin_amdgcn_s_barrier(); asm volatile("" ::: "memory");
}
#define KA __attribute__((address_space(4)))
__device__ __forceinline__ const KA Params* kargs() { const KA Params* p = (const KA Params*)__builtin_amdgcn_kernarg_segment_ptr(); asm volatile("" : "+s"(p)); return p; }

__device__ __forceinline__ unsigned* cnt_word(int idx) { return (unsigned*)(kargs()->ws + WS_CNT) + 64 * idx; }
namespace pg8 {
constexpr int BM = 256, BK = 64, HALF = 128, HTB = HALF * BK * 2, NXCD = 8, WGM = 8;
__host__ __device__ __forceinline__ int lds_byte(int r, int c) { const int st = (r >> 4) * 2 + (c >> 5), rr = r & 15, cc = c & 31, ob = rr * 64 + cc * 2; return st * 1024 + (ob ^ (((ob >> 9) & 1) << 5)); }
__host__ __device__ __forceinline__ void stage_rc(int b, int& R, int& C) { const int st = b / 1024, sb = b % 1024, swz = sb ^ (((sb >> 9) & 1) << 5); R = (st >> 1) * 16 + swz / 64; C = (st & 1) * 32 + (swz % 64) / 2; }

struct Unit { int pm, pn; };
enum { K_UP0 = 0, K_UP1 = 1, K_DN0 = 2, K_DN1 = 3, K_IN = 4, K_OUT = 5, K_DNS0 = 6, K_DNS1 = 7 };
struct UnitD { int kind, pm, pn, ks, dep, want, sig; };
__device__ __forceinline__ void map_unit(int L, int nM, int nN, int& pm, int& pn) {
    const int nwg = nM * nN; int wgid = L; { const int q = nwg / NXCD, r = nwg % NXCD, xcd = wgid % NXCD, off = wgid / NXCD; wgid = (xcd < r ? xcd * (q + 1) : r * (q + 1) + (xcd - r) * q) + off; }
    const int nig = WGM * nN, gid = wgid / nig, fm = gid * WGM, gsz = (nM - fm) < WGM ? (nM - fm) : WGM;
    pm = fm + ((wgid % nig) % gsz); pn = (wgid % nig) / gsz;
}
}


template <int BJ> __device__ __forceinline__ void pin_half(f32x4 (&acc)[2][2][4][2]) {
#pragma unroll
    for (int ai = 0; ai < 2; ++ai)
        asm volatile("" : "+v"(acc[ai][BJ][0][0]), "+v"(acc[ai][BJ][0][1]), "+v"(acc[ai][BJ][1][0]), "+v"(acc[ai][BJ][1][1]), "+v"(acc[ai][BJ][2][0]), "+v"(acc[ai][BJ][2][1]), "+v"(acc[ai][BJ][3][0]), "+v"(acc[ai][BJ][3][1]) :: "memory");
}
template <int BJ, int N> __device__ __forceinline__ void pin_group(f32x4 (&acc)[2][2][4][2]) {
    asm volatile("" : "+v"(acc[0][BJ][0][N]), "+v"(acc[0][BJ][1][N]), "+v"(acc[0][BJ][2][N]), "+v"(acc[0][BJ][3][N]), "+v"(acc[1][BJ][0][N]), "+v"(acc[1][BJ][1][N]), "+v"(acc[1][BJ][2][N]), "+v"(acc[1][BJ][3][N]) :: "memory");
}
template <int N> __device__ __forceinline__ void pin_n(f32x4 (&acc)[2][2][4][2]) {
#pragma unroll
    for (int ai = 0; ai < 2; ++ai)
        asm volatile("" : "+v"(acc[ai][0][0][N]), "+v"(acc[ai][0][1][N]), "+v"(acc[ai][0][2][N]), "+v"(acc[ai][0][3][N]), "+v"(acc[ai][1][0][N]), "+v"(acc[ai][1][1][N]), "+v"(acc[ai][1][2][N]), "+v"(acc[ai][1][3][N]) :: "memory");
}
template <int BJ, int N, int J0, int LEN>
__device__ __forceinline__ void conv_chain(f32x4 (&acc)[2][2][4][2], const f32x4 k0, const f32x4 k1, const f32x4 k2, const f32x4 kb, const f32x4 p1, const f32x4 p2) {
#pragma unroll
    for (int i = LEN - 1; i >= 0; --i) {
        const int j = J0 + i;
        const f32x4 h0 = acc[j >> 2][BJ][j & 3][N];
        const f32x4 h1 = i >= 1 ? acc[(j - 1) >> 2][BJ][(j - 1) & 3][N] : p1;
        const f32x4 h2 = i >= 2 ? acc[(j - 2) >> 2][BJ][(j - 2) & 3][N] : (i == 1 ? p1 : p2);
        acc[j >> 2][BJ][j & 3][N] = k2 * h0 + k1 * h1 + k0 * h2 + kb;
    }
}
struct EpiUp {
    int l;
    template <int N>
    __device__ __forceinline__ void half(f32x4 (&acc)[2][2][4][2], int pm, int pn, int wr, int wc, int fr, int fq, LAS unsigned char* elds) const {
        asm volatile("" : "+v"(fr), "+v"(fq));
        const KA Params* q = kargs(); unsigned char* ws = q->ws;
        const bool sample = pm >= NPANEL_P;
        const int chunk = 2 * pm + wr;
        const int ucol = 256 * pn + 32 * wc + 16 * N;
        const int ufcol = 128 * pn + 32 * wc + 16 * N;
        const unsigned lq = (unsigned)(16 * fq);
        const LAS unsigned char* kcl = elds + EPI_CST + 2048 + (32 * wc + 16 * N) * 4 + lq;
#define KC4(tap, vhalf) (*(const LAS f32x4*)(kcl + ((tap) * 256 + (vhalf) * 128) * 4))
        if (!sample) {
            f32x4 g2, g1;
#pragma unroll
            for (int e = 0; e < 4; ++e) { g2[e] = dpp_shr1(acc[1][0][2][N][e]); g1[e] = dpp_shr1(acc[1][0][3][N][e]); }
            if (fr == 0) {
                char* hf = (char*)((float*)(ws + WS_HF) + (size_t)chunk * 2 * FF2 + ucol) + lq;
                *(f32x4*)(hf) = acc[0][0][0][N]; *(f32x4*)(hf + FF2 * 4) = acc[0][0][1][N];
                *(f32x4*)(hf + 128 * 4) = acc[0][1][0][N]; *(f32x4*)(hf + (FF2 + 128) * 4) = acc[0][1][1][N];
            }
            if (fr == 15) {
                char* hl = (char*)((float*)(ws + WS_HL) + (size_t)chunk * 2 * FF2 + ucol) + lq;
                *(f32x4*)(hl) = acc[1][0][2][N]; *(f32x4*)(hl + FF2 * 4) = acc[1][0][3][N];
                *(f32x4*)(hl + 128 * 4) = acc[1][1][2][N]; *(f32x4*)(hl + (FF2 + 128) * 4) = acc[1][1][3][N];
                if ((pm & 7) == 7 && wr == 1) {
                    char* o = (char*)(q->out + O_FFN_P + ((size_t)l * NB_P + (pm >> 3)) * 2 * FF2 + ufcol) + lq;
                    *(f32x4*)(o) = acc[1][0][2][N]; *(f32x4*)(o + FF2 * 4) = acc[1][0][3][N];
                    *(f32x4*)(o + FF * 4) = acc[1][1][2][N]; *(f32x4*)(o + (FF2 + FF) * 4) = acc[1][1][3][N];
                }
            }
            pin_n<N>(acc);
            { const f32x4 k0 = KC4(0, 0), k1 = KC4(1, 0), k2 = KC4(2, 0), kb = KC4(3, 0); conv_chain<0, N, 0, 8>(acc, k0, k1, k2, kb, g1, g2); }
            pin_n<N>(acc);
            { f32x4 v2, v1;
#pragma unroll
              for (int e = 0; e < 4; ++e) { v2[e] = dpp_shr1(acc[1][1][2][N][e]); v1[e] = dpp_shr1(acc[1][1][3][N][e]); }
              const f32x4 k0 = KC4(0, 1), k1 = KC4(1, 1), k2 = KC4(2, 1), kb = KC4(3, 1); conv_chain<1, N, 0, 8>(acc, k0, k1, k2, kb, v1, v2); }
        } else {
            const int useq0 = 64 * (pm - NPANEL_P) + 32 * wr;
            const unsigned ls = (unsigned)(2 * fr * 2 * FF2 * 4) + lq;
            char* ob = (char*)(q->out + O_FFN_S + ((size_t)l * NB_S + useq0) * 2 * FF2 + ufcol);
#pragma unroll
            for (int ai = 0; ai < 2; ++ai) { char* o = ob + ls + (unsigned)(ai * 2 * FF2 * 4);
                *(f32x4*)(o) = acc[ai][0][2][N]; *(f32x4*)(o + FF2 * 4) = acc[ai][0][3][N];
                *(f32x4*)(o + FF * 4) = acc[ai][1][2][N]; *(f32x4*)(o + (FF2 + FF) * 4) = acc[ai][1][3][N]; }
            pin_n<N>(acc);
            const char* sb = (const char*)(q->in[4] + ((size_t)l * NB_S + useq0) * 2 * FF2 + ufcol);
            { const f32x4 k0 = KC4(0, 0), k1 = KC4(1, 0), k2 = KC4(2, 0), kb = KC4(3, 0);
              conv_chain<0, N, 0, 4>(acc, k0, k1, k2, kb, *(const f32x4*)(sb + ls + FF2 * 4), *(const f32x4*)(sb + ls));
              conv_chain<0, N, 4, 4>(acc, k0, k1, k2, kb, *(const f32x4*)(sb + ls + 3 * FF2 * 4), *(const f32x4*)(sb + ls + 2 * FF2 * 4)); }
            pin_n<N>(acc);
            { const f32x4 k0 = KC4(0, 1), k1 = KC4(1, 1), k2 = KC4(2, 1), kb = KC4(3, 1);
              conv_chain<1, N, 0, 4>(acc, k0, k1, k2, kb, *(const f32x4*)(sb + ls + (FF2 + FF) * 4), *(const f32x4*)(sb + ls + FF * 4));
              conv_chain<1, N, 4, 4>(acc, k0, k1, k2, kb, *(const f32x4*)(sb + ls + (3 * FF2 + FF) * 4), *(const f32x4*)(sb + ls + (2 * FF2 + FF) * 4)); }
        }
#undef KC4
        pin_n<N>(acc);
        char* ab = (char*)((bf16_t*)(ws + WS_ACT) + (size_t)(pm * 256 + 64 * wr) * FF + ufcol);
        const unsigned la = (unsigned)((fr * FF + 4 * fq) * 2);
#pragma unroll
        for (int j = 0; j < 8; ++j) {
            const f32x4 zg = acc[j >> 2][0][j & 3][N], zv = acc[j >> 2][1][j & 3][N];
            u32x2 w; w.x = pk2(silu_mul(zg[0], zv[0]), silu_mul(zg[1], zv[1])); w.y = pk2(silu_mul(zg[2], zv[2]), silu_mul(zg[3], zv[3]));
            *(u32x2*)(ab + la + (unsigned)((128 * (j >> 2) + 16 * (j & 3)) * FF * 2)) = w;
        }
        asm volatile("" ::: "memory");
    }
    __device__ __forceinline__ void operator()(f32x4 (&acc)[2][2][4][2], const pg8::Unit& u, int wr, int wc, int fr, int fq, LAS unsigned char* elds) const {
        const int pm = u.pm, pn = u.pn;
        LAS f32x2* S = (LAS f32x2*)(elds + EPI_S);
        { stats_from_lds(elds);
          const LAS unsigned char* csl = elds + EPI_CST + (32 * wc) * 4 + 16 * fq;
          f32x2 st[8];
#pragma unroll
          for (int j = 0; j < 8; ++j) st[j] = S[128 * (j >> 2) + 64 * wr + 16 * (j & 3) + fr];
#pragma unroll
          for (int bj = 0; bj < 2; ++bj)
#pragma unroll
              for (int n = 0; n < 2; ++n) { const f32x4 csv = *(const LAS f32x4*)(csl + (128 * bj + 16 * n) * 4), cbv = *(const LAS f32x4*)(csl + 1024 + (128 * bj + 16 * n) * 4);
#pragma unroll
                  for (int j = 0; j < 8; ++j) acc[j >> 2][bj][j & 3][n] = acc[j >> 2][bj][j & 3][n] * st[j].x + (csv * st[j].y + cbv); }
        }
        pin_half<0>(acc); pin_half<1>(acc);
        half<0>(acc, pm, pn, wr, wc, fr, fq, elds);
        half<1>(acc, pm, pn, wr, wc, fr, fq, elds);
    }
};

template <bool FINAL> struct EpiRes {
    int pprev, pnew, gi, goff;
    template <int BJ>
    __device__ __forceinline__ void resid(f32x4 (&acc)[2][2][4][2], int pm, int pn, int wr, int wc, int fr, int fq, LAS f32x2* S, const LAS unsigned char* cst) const {
        asm volatile("" : "+v"(fr), "+v"(fq));
        const KA Params* q = kargs();
        const int ucol = 256 * pn + 128 * BJ + 32 * wc;
        const char* vb = (const char*)((const bf16_t*)(q->ws + WS_H1) + (size_t)(pm * 256 + 64 * wr) * D + ucol);
        const unsigned lv = (unsigned)((fr * D + 4 * fq) * 2), lq = (unsigned)(16 * fq);
        u32x2 vp[8][2];
#pragma unroll
        for (int j = 0; j < 8; ++j)
#pragma unroll
            for (int n = 0; n < 2; ++n) vp[j][n] = *(const u32x2*)(vb + lv + (unsigned)(((128 * (j >> 2) + 16 * (j & 3)) * D + 16 * n) * 2));
        f32x4 gv[2], bv[2];
#pragma unroll
        for (int n = 0; n < 2; ++n) { gv[n] = *(const LAS f32x4*)(cst + (128 * BJ + 32 * wc + 16 * n) * 4 + lq) * ALPHA; bv[n] = *(const LAS f32x4*)(cst + 1024 + (128 * BJ + 32 * wc + 16 * n) * 4 + lq) * ALPHA; }
        const LAS f32x2* Sl = S + 64 * wr + fr;
#pragma unroll
        for (int j = 0; j < 8; ++j) { const f32x2 s = Sl[128 * (j >> 2) + 16 * (j & 3)];
#pragma unroll
            for (int n = 0; n < 2; ++n) { f32x4 v; v[0] = bf2f(vp[j][n].x & 0xffffu); v[1] = bf2f(vp[j][n].x >> 16); v[2] = bf2f(vp[j][n].y & 0xffffu); v[3] = bf2f(vp[j][n].y >> 16);
                acc[j >> 2][BJ][j & 3][n] = (v * s.x + s.y) * gv[n] + bv[n] + acc[j >> 2][BJ][j & 3][n]; } }
        pin_half<BJ>(acc);
    }
    __device__ __forceinline__ void operator()(f32x4 (&acc)[2][2][4][2], const pg8::Unit& u, int wr, int wc, int fr, int fq, LAS unsigned char* elds) const {
        const int pm = u.pm, pn = u.pn;
        LAS f32x2* P = (LAS f32x2*)elds;
        LAS f32x2* S = (LAS f32x2*)(elds + EPI_S);
        stats_from_lds(elds);
        resid<0>(acc, pm, pn, wr, wc, fr, fq, S, elds + EPI_CST);
        resid<1>(acc, pm, pn, wr, wc, fr, fq, S, elds + EPI_CST);
        asm volatile("" : "+v"(fr), "+v"(fq));
        const KA Params* q = kargs();
        char* ob = (char*)((bf16_t*)(q->ws + WS_H1) + (size_t)(pm * 256 + 64 * wr) * D + 256 * pn + 32 * wc); const unsigned lo = (unsigned)((fr * D + 4 * fq) * 2);
        LAS f32x2* Pl = P + (64 * wr + fr) * 4 + wc;
#pragma unroll
        for (int j = 0; j < 8; ++j) {
            const int ai = j >> 2, m = j & 3;
            float sum = 0.f;
#pragma unroll
            for (int bj = 0; bj < 2; ++bj)
#pragma unroll
                for (int n = 0; n < 2; ++n) { const f32x4 vn = acc[ai][bj][m][n]; sum += (vn[0] + vn[1]) + (vn[2] + vn[3]); }
            sum += __shfl_xor(sum, 16); sum += __shfl_xor(sum, 32);
            const float mw = sum * (1.0f / 64.0f); float qq = 0.f;
#pragma unroll
            for (int bj = 0; bj < 2; ++bj)
#pragma unroll
                for (int n = 0; n < 2; ++n) { const f32x4 d = acc[ai][bj][m][n] - mw; qq += (d[0] * d[0] + d[1] * d[1]) + (d[2] * d[2] + d[3] * d[3]); }
            qq += __shfl_xor(qq, 16); qq += __shfl_xor(qq, 32);
            if (fq == 0) { f32x2 t; t.x = mw; t.y = qq; Pl[(128 * ai + 16 * m) * 4] = t; }
            if (!FINAL) {
#pragma unroll
                for (int bj = 0; bj < 2; ++bj)
#pragma unroll
                    for (int n = 0; n < 2; ++n) { const f32x4 vn = acc[ai][bj][m][n];
                        u32x2 w; w.x = pk2(vn[0], vn[1]); w.y = pk2(vn[2], vn[3]); *(u32x2*)(ob + lo + (unsigned)(((128 * ai + 16 * m) * D + 128 * bj + 16 * n) * 2)) = w; } }
        }
        asm volatile("s_waitcnt lgkmcnt(0)" ::: "memory"); __builtin_amdgcn_s_barrier(); asm volatile("" ::: "memory");
        int rl = threadIdx.x; asm volatile("" : "+v"(rl));
        unsigned long long* slots = (unsigned long long*)(q->ws + WS_PART) + (size_t)pnew * MROWS * 4 + (size_t)pm * 256 * 4;
        if (rl < 256) {
            const f32x2 a = P[rl * 4 + 0], b2 = P[rl * 4 + 1], c2 = P[rl * 4 + 2], d2 = P[rl * 4 + 3];
            const float mt = (a.x + b2.x + c2.x + d2.x) * 0.25f;
            const float da = a.x - mt, db = b2.x - mt, dc = c2.x - mt, dd = d2.x - mt;
            const float m2 = (a.y + b2.y) + (c2.y + d2.y) + 64.0f * ((da * da + db * db) + (dc * dc + dd * dd));
            if (!FINAL) { f32x2 r; r.x = mt; r.y = m2; *(f32x2*)((char*)slots + (unsigned)(rl * 32 + pn * 8)) = r; }
            else __hip_atomic_store(slots + rl * 4 + pn, ((unsigned long long)__builtin_bit_cast(unsigned, m2) << 32) | __builtin_bit_cast(unsigned, mt), __ATOMIC_RELAXED, __HIP_MEMORY_SCOPE_AGENT);
        }
        if (FINAL) {
            unsigned* xc = cnt_word(40 + pm);
            if (rl < 256) { asm volatile("s_waitcnt vmcnt(0)" ::: "memory"); if ((rl & 63) == 0) __hip_atomic_fetch_add(xc, 1u, __ATOMIC_RELAXED, __HIP_MEMORY_SCOPE_AGENT); }
            if (rl < 64) { unsigned sp = 0;
                while ((unsigned)__builtin_amdgcn_readfirstlane(__hip_atomic_load(xc, __ATOMIC_RELAXED, __HIP_MEMORY_SCOPE_AGENT)) < 16u) { __builtin_amdgcn_s_sleep(2); if (++sp > (1u << 22)) break; }
                __builtin_amdgcn_fence(__ATOMIC_ACQUIRE, "agent"); asm volatile("s_waitcnt vmcnt(0)" ::: "memory"); }
            asm volatile("" ::: "memory"); __builtin_amdgcn_s_barrier(); asm volatile("" ::: "memory");
            if (rl < 256) { float mt[4], m2[4]; float ms = 0.f;
#pragma unroll
                for (int t = 0; t < 4; ++t) { const unsigned long long w = __hip_atomic_load(slots + rl * 4 + t, __ATOMIC_RELAXED, __HIP_MEMORY_SCOPE_AGENT); mt[t] = __builtin_bit_cast(float, (unsigned)w); m2[t] = __builtin_bit_cast(float, (unsigned)(w >> 32)); ms += mt[t]; }
                const float mean = ms * 0.25f; float qv = 0.f;
#pragma unroll
                for (int t = 0; t < 4; ++t) { const float dm = mt[t] - mean; qv += m2[t] + 256.0f * dm * dm; }
                const float rstd = __builtin_amdgcn_rsqf(qv * (1.0f / 1024.0f) + LN_EPS);
                f32x2 t2; t2.x = rstd; t2.y = -mean * rstd; S[rl] = t2; }
            asm volatile("s_waitcnt lgkmcnt(0)" ::: "memory"); __builtin_amdgcn_s_barrier(); asm volatile("" ::: "memory");
            asm volatile("" : "+v"(fr), "+v"(fq));
            char* yb = (char*)(q->out + O_Y + (size_t)(pm * 256 + 128 * wr) * D + 256 * pn + 32 * wc); const unsigned ly = (unsigned)((8 * fr * D + 4 * fq) * 4);
            const LAS unsigned char* cst = elds + EPI_CST + 2048 + (32 * wc) * 4 + 16 * fq;
            const LAS f32x2* Sl = S + 64 * wr + fr;
#pragma unroll
            for (int bj = 0; bj < 2; ++bj)
#pragma unroll
                for (int n = 0; n < 2; ++n) { const f32x4 g2 = *(const LAS f32x4*)(cst + (128 * bj + 16 * n) * 4), b2 = *(const LAS f32x4*)(cst + 1024 + (128 * bj + 16 * n) * 4);
#pragma unroll
                    for (int j = 0; j < 8; ++j) { const f32x2 s = Sl[128 * (j >> 2) + 16 * (j & 3)];
                        *(f32x4*)(yb + ly + (unsigned)((j * D + 128 * bj + 16 * n) * 4)) = (acc[j >> 2][bj][j & 3][n] * s.x + s.y) * g2 + b2; } }
        }
    }
};

struct EpiIn {
    int dummy;
    __device__ __forceinline__ void operator()(f32x4 (&acc)[2][2][4][2], const pg8::Unit& u, int wr, int wc, int fr, int fq, LAS unsigned char* elds) const {
        const int pm = u.pm, pn = u.pn; const bool sample = pm >= NPANEL_P;
        LAS f32x2* S = (LAS f32x2*)(elds + EPI_S);
        const KA Params* q = kargs(); unsigned char* ws = q->ws;
        stats_from_lds(elds);
        { const LAS unsigned char* csl = elds + EPI_CST + (32 * wc) * 4 + 16 * fq;
          f32x2 st[8];
#pragma unroll
          for (int j = 0; j < 8; ++j) st[j] = S[128 * (j >> 2) + 64 * wr + 16 * (j & 3) + fr];
#pragma unroll
          for (int bj = 0; bj < 2; ++bj)
#pragma unroll
              for (int n = 0; n < 2; ++n) { const f32x4 csv = *(const LAS f32x4*)(csl + (128 * bj + 16 * n) * 4), cbv = *(const LAS f32x4*)(csl + 1024 + (128 * bj + 16 * n) * 4);
#pragma unroll
                  for (int j = 0; j < 8; ++j) acc[j >> 2][bj][j & 3][n] = acc[j >> 2][bj][j & 3][n] * st[j].x + (csv * st[j].y + cbv); } }
        pin_half<0>(acc); pin_half<1>(acc);
        asm volatile("" : "+v"(fr), "+v"(fq));
        const unsigned lr = (unsigned)((fr * D + 4 * fq) * 2);
        if (pn < 8) {
            char* ub = sample ? (char*)((bf16_t*)(ws + WS_SU) + (size_t)((pm - NPANEL_P) * 256 + 64 * wr) * D + 128 * pn + 32 * wc)
                              : (char*)((bf16_t*)(ws + WS_ACT) + (size_t)(pm * 256 + 64 * wr) * D + 128 * pn + 32 * wc);
#pragma unroll
            for (int n = 0; n < 2; ++n) {
#pragma unroll
                for (int j = 0; j < 8; ++j) { const int ai = j >> 2, m = j & 3; const f32x4 uu = acc[ai][0][m][n] * acc[ai][1][m][n];
                    u32x2 w; w.x = pk2(uu[0], uu[1]); w.y = pk2(uu[2], uu[3]); *(u32x2*)(ub + lr + (unsigned)(((128 * ai + 16 * m) * D + 16 * n) * 2)) = w;
                    if (sample) { if (m >= 2) { const int seq = 64 * (pm - NPANEL_P) + 32 * wr + 2 * fr + ai; *(f32x4*)(q->out + O_CONV_S + ((size_t)seq * 2 + (m - 2)) * D + 128 * pn + 32 * wc + 16 * n + 4 * fq) = uu; } }
                    else if ((pm & 7) == 7 && wr == 1 && fr == 15 && j >= 6) { *(f32x4*)(q->out + O_CONV_P + ((size_t)(pm >> 3) * 2 + (j - 6)) * D + 128 * pn + 32 * wc + 16 * n + 4 * fq) = uu; } } }
        } else {
            char* bb = sample ? (char*)((bf16_t*)(ws + WS_SB) + (size_t)((pm - NPANEL_P) * 256 + 64 * wr) * D + 256 * (pn - 8) + 32 * wc)
                              : (char*)((bf16_t*)(ws + WS_ACT) + (size_t)MROWS * D + (size_t)(pm * 256 + 64 * wr) * D + 256 * (pn - 8) + 32 * wc);
#pragma unroll
            for (int bj = 0; bj < 2; ++bj)
#pragma unroll
                for (int n = 0; n < 2; ++n) {
#pragma unroll
                    for (int j = 0; j < 8; ++j) { const int ai = j >> 2, m = j & 3; const f32x4 v = acc[ai][bj][m][n];
                        u32x2 w; w.x = pk2(v[0], v[1]); w.y = pk2(v[2], v[3]); *(u32x2*)(bb + lr + (unsigned)(((128 * ai + 16 * m) * D + 128 * bj + 16 * n) * 2)) = w; } }
        }
    }
};

struct EpiPartial {
    __device__ __forceinline__ void operator()(f32x4 (&acc)[2][2][4][2], const pg8::UnitD& u) const {
        const int tid = tid_fresh();
        char* pb = (char*)(kargs()->ws + WS_PBUF) + (size_t)((((u.pm - NPANEL_P) * 4 + u.pn) * 4 + u.ks) * 32) * 8192;
#pragma unroll
        for (int ai = 0; ai < 2; ++ai)
#pragma unroll
            for (int bj = 0; bj < 2; ++bj)
#pragma unroll
                for (int m = 0; m < 4; ++m)
#pragma unroll
                    for (int n = 0; n < 2; ++n) *(f32x4*)(pb + (unsigned)(((((ai * 2 + bj) * 4 + m) * 2 + n) * 512 + tid) * 16)) = acc[ai][bj][m][n];
    }
};
__device__ __forceinline__ int C_UP(int l, int p) { return l * 16 + p; }
__device__ __forceinline__ int C_DNS(int l, int p, int pn) { return l * 16 + 2 + p * 4 + pn; }
__device__ __forceinline__ int C_FIN(int l, int p) { return l * 16 + 10 + p; }
__device__ __forceinline__ int C_OUT(int p) { return 32 + p; }
__device__ __forceinline__ void dep_wait(int idx, unsigned want) {
    int tid = tid_fresh();
    if (tid < 64) {
        unsigned* w = cnt_word(idx); unsigned sp = 0;
        while ((unsigned)__builtin_amdgcn_readfirstlane(__hip_atomic_load(w, __ATOMIC_RELAXED, __HIP_MEMORY_SCOPE_AGENT)) < want) { __builtin_amdgcn_s_sleep(2); if (++sp > (1u << 22)) break; }
        __builtin_amdgcn_fence(__ATOMIC_ACQUIRE, "agent");
        asm volatile("s_waitcnt vmcnt(0)" ::: "memory");
    }
    asm volatile("" ::: "memory"); __builtin_amdgcn_s_barrier(); asm volatile("" ::: "memory");
}
__device__ __forceinline__ void unit_signal(int idx) {
    asm volatile("s_waitcnt vmcnt(0)" ::: "memory"); __builtin_amdgcn_s_barrier(); asm volatile("" ::: "memory");
    if (tid_fresh() == 0) { __builtin_amdgcn_fence(__ATOMIC_RELEASE, "agent"); asm volatile("s_waitcnt vmcnt(0)" ::: "memory");
        __hip_atomic_fetch_add(cnt_word(idx), 1u, __ATOMIC_RELAXED, __HIP_MEMORY_SCOPE_AGENT); }
}

__device__ __forceinline__ void epi_prefetch(int kind, int pm, int pn, LAS unsigned char* elds, int wid, int lane) {
    if (kind == pg8::K_DNS0 || kind == pg8::K_DNS1) return;
    const KA Params* q = kargs(); unsigned char* ws = q->ws;
    const int bank = (kind == pg8::K_UP0 || kind == pg8::K_DN0) ? 0 : ((kind == pg8::K_UP1 || kind == pg8::K_DN1) ? 2 : 1);
    const char* pp = (const char*)(ws + WS_PART) + ((size_t)bank * MROWS * 4 + (size_t)pm * 256 * 4) * 8 + wid * 1024 + lane * 16;
    __builtin_amdgcn_global_load_lds((const unsigned*)pp, (LAS unsigned*)(elds + EPI_PART + wid * 1024), 16, 0, 0);
    const float* cp = nullptr;
    if (kind == pg8::K_UP0 || kind == pg8::K_UP1) { const int l = kind - pg8::K_UP0;
        if (wid < 2) cp = (const float*)(ws + (wid == 0 ? WS_CS_UP : WS_CB_UP)) + l * FF2 + 256 * pn;
        else if (wid < 6) cp = (const float*)(ws + WS_KC_UP) + ((size_t)l * 4 + (wid - 2)) * FF2 + 256 * pn; }
    else if (kind == pg8::K_IN) { if (wid < 2) cp = (const float*)(ws + (wid == 0 ? WS_CS_IN : WS_CB_IN)) + 256 * pn; }
    else { if (wid < 2) { const int gi = kind == pg8::K_OUT ? 17 : 5, goff = kind == pg8::K_DN1 ? D : 0; cp = q->in[gi + wid] + goff + 256 * pn; }
           else if (wid < 4 && kind == pg8::K_DN1) cp = q->in[17 + (wid - 2)] + D + 256 * pn; }
    if (cp) __builtin_amdgcn_global_load_lds((const unsigned*)((const char*)cp + lane * 16), (LAS unsigned*)(elds + EPI_CST + wid * 1024), 16, 0, 0);
}

namespace pg8 {
__device__ __forceinline__ void unit_gemm(const UnitD& u, const char*& cA, const char*& cB, int& Kf, int& nt) {
    const KA Params* q = kargs(); unsigned char* ws = q->ws;
    switch (u.kind) {
    case K_UP0: case K_UP1: Kf = D; nt = 16; cA = (const char*)(ws + WS_H1) + (size_t)u.pm * 256 * D * 2; cB = (const char*)(ws + WS_WUP) + ((size_t)(u.kind - K_UP0) * FF2 + (size_t)u.pn * 256) * D * 2; break;
    case K_DN0: case K_DN1: Kf = FF; nt = 44; cA = (const char*)(ws + WS_ACT) + (size_t)u.pm * 256 * FF * 2; cB = (const char*)(ws + WS_WDN) + ((size_t)(u.kind - K_DN0) * D + (size_t)u.pn * 256) * FF * 2; break;
    case K_DNS0: case K_DNS1: { const int k0 = u.ks < 2 ? u.ks * 768 : 1536 + (u.ks - 2) * 640; Kf = FF; nt = u.ks < 2 ? 12 : 10;
        cA = (const char*)(ws + WS_ACT) + ((size_t)u.pm * 256 * FF + k0) * 2; cB = (const char*)(ws + WS_WDN) + (((size_t)(u.kind - K_DNS0) * D + (size_t)u.pn * 256) * FF + k0) * 2; break; }
    case K_IN: Kf = D; nt = 16; cA = (const char*)(ws + WS_H1) + (size_t)u.pm * 256 * D * 2; cB = (const char*)(ws + WS_WIN) + (size_t)u.pn * 256 * D * 2; break;
    default: Kf = D; nt = 16; cA = (const char*)q->out + (size_t)u.pm * 256 * D * 2; cB = (const char*)(ws + WS_WOUT) + (size_t)u.pn * 256 * D * 2; break;
    }
}
template <int KINDS, bool MIXK, class Sched>
__device__ __forceinline__ void gemm_stream(LAS unsigned char* lds, const Sched& S) {
    const int tid = tid_fresh(), wid = __builtin_amdgcn_readfirstlane(tid >> 6), lane = tid & 63, wr = wid >> 2, wc = wid & 3, fr = lane & 15, fq = lane >> 4;
    int Rs[2], Cs[2];
#pragma unroll
    for (int i = 0; i < 2; ++i) stage_rc(tid * 16 + i * 8192, Rs[i], Cs[i]);
    const size_t kstep = (size_t)(BK * 2);
    const unsigned ldsw = (unsigned)wid * 1024u;
    const int aoff = lds_byte(wr * 64 + fr, fq * 8), boff = lds_byte(wc * 32 + fr, fq * 8);
#define PG8_SA(b, h) (((b) * 2 + (h)) * HTB)
#define PG8_SB(b, h) ((4 + (b) * 2 + (h)) * HTB)
#define PG8_STAGE(bufoff, gbase, vo) do { _Pragma("unroll") for (int _i = 0; _i < 2; ++_i) \
        __builtin_amdgcn_global_load_lds((const unsigned*)((const char*)(gbase) + (vo)[_i]), (LAS unsigned*)(lds + (bufoff) + ldsw + _i * 8192), 16, 0, 0); } while (0)
#define PG8_LDA(dst, b, h) do { _Pragma("unroll") for (int m = 0; m < 4; ++m) _Pragma("unroll") for (int k = 0; k < 2; ++k) dst[m][k] = *(const LAS bf16x8*)(lds + PG8_SA(b, h) + aoff + m * 2048 + k * 1024); } while (0)
#define PG8_LDB(dst, b, h) do { _Pragma("unroll") for (int n = 0; n < 2; ++n) _Pragma("unroll") for (int k = 0; k < 2; ++k) dst[n][k] = *(const LAS bf16x8*)(lds + PG8_SB(b, h) + boff + n * 2048 + k * 1024); } while (0)
#define PG8_MMA(ai, bj, At, Bt) do { __builtin_amdgcn_s_setprio(1); _Pragma("unroll") for (int m = 0; m < 4; ++m) _Pragma("unroll") for (int n = 0; n < 2; ++n) _Pragma("unroll") for (int k = 0; k < 2; ++k) \
        acc[ai][bj][m][n] = __builtin_amdgcn_mfma_f32_16x16x32_bf16(Bt[n][k], At[m][k], acc[ai][bj][m][n], 0, 0, 0); __builtin_amdgcn_s_setprio(0); } while (0)
#define PG8_WAIT_V(n) asm volatile("s_waitcnt vmcnt(" #n ")" ::: "memory")
#define PG8_WAIT_L(n) asm volatile("s_waitcnt lgkmcnt(" #n ")" ::: "memory")
#define PG8_BAR __builtin_amdgcn_s_barrier()
#define PG8_SCHED __builtin_amdgcn_sched_barrier(0)
    UnitD cur, nxt; int ui = 0;
    if (!S.next(0, cur)) return;
    const char* cA; const char* cB; int KfC, ntC; unit_gemm(cur, cA, cB, KfC, ntC);
    unsigned voffC[2], voffN[2];
#pragma unroll
    for (int i = 0; i < 2; ++i) { voffC[i] = (unsigned)(Rs[i] * KfC + Cs[i]) * 2u; voffN[i] = voffC[i]; }
    size_t hstepC = (size_t)HALF * KfC * 2, hstepN = hstepC;
    f32x4 acc[2][2][4][2];
#pragma unroll
    for (int a = 0; a < 2; ++a)
#pragma unroll
        for (int b = 0; b < 2; ++b)
#pragma unroll
            for (int m = 0; m < 4; ++m)
#pragma unroll
                for (int n = 0; n < 2; ++n) acc[a][b][m][n] = (f32x4){0.f, 0.f, 0.f, 0.f};
    bf16x8 At[4][2], B0[2][2], B1[2][2];
    if (cur.dep >= 0) dep_wait(cur.dep, (unsigned)cur.want);
    PG8_STAGE(PG8_SB(0, 0), cB, voffC); PG8_STAGE(PG8_SB(0, 1), cB + hstepC, voffC); PG8_STAGE(PG8_SA(0, 0), cA, voffC); PG8_STAGE(PG8_SA(0, 1), cA + hstepC, voffC);
    if (wr == 1) PG8_BAR;
    PG8_WAIT_V(2); PG8_BAR;
    PG8_STAGE(PG8_SB(1, 0), cB + kstep, voffC); PG8_STAGE(PG8_SA(1, 0), cA + kstep, voffC); PG8_STAGE(PG8_SB(1, 1), cB + hstepC + kstep, voffC);
    PG8_WAIT_V(6); PG8_BAR;
    for (;;) {
        const bool has_next = S.next(ui + 1, nxt);
        const char* nA = cA; const char* nB = cB; int KfN = KfC, ntN = ntC;
        if (has_next) unit_gemm(nxt, nA, nB, KfN, ntN);
        if (MIXK) {
#pragma unroll
            for (int i = 0; i < 2; ++i) voffN[i] = (unsigned)(Rs[i] * KfN + Cs[i]) * 2u;
            hstepN = (size_t)HALF * KfN * 2; }
        for (int t = 0; t < ntC; t += 2) {
            const bool last = (t == ntC - 2);
            const char* a1 = cA + (size_t)(t + 1) * kstep;
            const char* a2 = last ? nA : cA + (size_t)(t + 2) * kstep; const char* b2 = last ? nB : cB + (size_t)(t + 2) * kstep;
            const char* a3 = a2 + kstep; const char* b3 = b2 + kstep;
            unsigned vo2[2]; size_t hs2 = hstepC;
#pragma unroll
            for (int i = 0; i < 2; ++i) vo2[i] = voffC[i];
            if (MIXK) { if (last) {
#pragma unroll
                for (int i = 0; i < 2; ++i) vo2[i] = voffN[i];
                hs2 = hstepN; } }
            if (last && has_next && nxt.dep >= 0) dep_wait(nxt.dep, (unsigned)nxt.want);
            if (t == 2) epi_prefetch(cur.kind, cur.pm, cur.pn, lds + EPI_OFF, wid, lane);
            PG8_LDB(B0, 0, 0); PG8_LDB(B1, 0, 1); PG8_SCHED; PG8_LDA(At, 0, 0); PG8_STAGE(PG8_SA(1, 1), a1 + hstepC, voffC);
            PG8_WAIT_V(8); PG8_WAIT_L(0); PG8_BAR; PG8_MMA(0, 0, At, B0); PG8_MMA(0, 1, At, B1); PG8_BAR; PG8_SCHED;
            PG8_LDA(At, 0, 1); PG8_STAGE(PG8_SB(0, 0), b2, vo2); PG8_STAGE(PG8_SB(0, 1), b2 + hs2, vo2); PG8_STAGE(PG8_SA(0, 0), a2, vo2);
            PG8_WAIT_V(8); PG8_WAIT_L(0); PG8_BAR; PG8_MMA(1, 0, At, B0); PG8_MMA(1, 1, At, B1); PG8_BAR; PG8_SCHED;
            PG8_LDB(B0, 1, 0); PG8_LDB(B1, 1, 1); PG8_SCHED; PG8_LDA(At, 1, 0); PG8_STAGE(PG8_SA(0, 1), a2 + hs2, vo2);
            PG8_WAIT_V(8); PG8_WAIT_L(0); PG8_BAR; PG8_MMA(0, 0, At, B0); PG8_MMA(0, 1, At, B1); PG8_BAR; PG8_SCHED;
            PG8_LDA(At, 1, 1); PG8_STAGE(PG8_SB(1, 0), b3, vo2); PG8_STAGE(PG8_SB(1, 1), b3 + hs2, vo2); PG8_STAGE(PG8_SA(1, 0), a3, vo2);
            PG8_WAIT_V(8); PG8_WAIT_L(0); PG8_BAR; PG8_MMA(1, 0, At, B0); PG8_MMA(1, 1, At, B1); PG8_BAR; PG8_SCHED;
        }
        if (wr == 0) PG8_BAR;
        { int fr_e = fr, fq_e = fq; asm volatile("" : "+v"(fr_e), "+v"(fq_e));
          const Unit uu{cur.pm, cur.pn}; LAS unsigned char* elds = lds + EPI_OFF;
          if ((KINDS & ((1 << K_UP0) | (1 << K_UP1))) && (cur.kind == K_UP0 || cur.kind == K_UP1)) { EpiUp E{cur.kind - K_UP0}; E(acc, uu, wr, wc, fr_e, fq_e, elds); }
          if ((KINDS & (1 << K_DN0)) && cur.kind == K_DN0) { EpiRes<false> E{0, 1, 5, 0}; E(acc, uu, wr, wc, fr_e, fq_e, elds); }
          if ((KINDS & (1 << K_DN1)) && cur.kind == K_DN1) { EpiRes<true> E{2, 0, 5, D}; E(acc, uu, wr, wc, fr_e, fq_e, elds); }
          if ((KINDS & (1 << K_IN)) && cur.kind == K_IN) { EpiIn E{0}; E(acc, uu, wr, wc, fr_e, fq_e, elds); }
          if ((KINDS & (1 << K_OUT)) && cur.kind == K_OUT) { EpiRes<false> E{1, 2, 17, 0}; E(acc, uu, wr, wc, fr_e, fq_e, elds); }
          if ((KINDS & ((1 << K_DNS0) | (1 << K_DNS1))) && (cur.kind == K_DNS0 || cur.kind == K_DNS1)) { EpiPartial E; E(acc, cur); }
          if (cur.sig >= 0) unit_signal(cur.sig); }
        if (!has_next) break;
#pragma unroll
        for (int a = 0; a < 2; ++a)
#pragma unroll
            for (int b = 0; b < 2; ++b)
#pragma unroll
                for (int m = 0; m < 4; ++m)
#pragma unroll
                    for (int n = 0; n < 2; ++n) acc[a][b][m][n] = (f32x4){0.f, 0.f, 0.f, 0.f};
        cur = nxt; cA = nA; cB = nB; KfC = KfN; ntC = ntN; ++ui;
        if (MIXK) {
#pragma unroll
            for (int i = 0; i < 2; ++i) voffC[i] = voffN[i];
            hstepC = hstepN; }
        if (wr == 1) PG8_BAR;
    }
    PG8_WAIT_V(0);
    PG8_BAR;
#undef PG8_SA
#undef PG8_SB
#undef PG8_STAGE
#undef PG8_LDA
#undef PG8_LDB
#undef PG8_MMA
#undef PG8_WAIT_V
#undef PG8_WAIT_L
#undef PG8_BAR
#undef PG8_SCHED
}
struct SchedSimple {
    int kind, nM, nN, G, c;
    __device__ __forceinline__ bool next(int i, UnitD& u) const {
        const long L = (long)i * G + c; if (L >= (long)nM * nN) return false;
        u.kind = kind; map_unit((int)L, nM, nN, u.pm, u.pn); u.ks = 0; u.dep = -1; u.want = 0; u.sig = -1; return true; }
};
struct SchedUp {
    int l, c, first, count, gpos; UnitD guest;
    __device__ __forceinline__ void init(int l_, int c_) {
        l = l_; c = c_; first = 0; count = 6; gpos = -1; guest.kind = 0; guest.pm = 0; guest.pn = 0; guest.ks = 0; guest.dep = -1; guest.want = 0; guest.sig = -1;
        const int lc = c - 128; if (lc < 0) return;
        if (l == 0) {
            if (lc < 44) { gpos = 0; guest.kind = K_UP0; guest.pm = NPANEL_P + lc / 22; guest.pn = lc % 22; guest.sig = C_UP(0, lc / 22); }
            else if (lc < 76) { const int ix = lc - 44, p = ix >> 4; gpos = 2; guest.kind = K_DNS0; guest.pm = NPANEL_P + p; guest.pn = (ix >> 2) & 3; guest.ks = ix & 3; guest.dep = C_UP(0, p); guest.want = 22; guest.sig = C_DNS(0, p, guest.pn); }
            else if (lc < 84) { }
            else if (lc < 108) { const int ix = lc - 84, p = ix / 12; gpos = 5; guest.kind = K_IN; guest.pm = NPANEL_P + p; guest.pn = ix % 12; guest.dep = C_FIN(0, p); guest.want = 4; }
        } else {
            if (lc < 8) { gpos = 0; guest.kind = K_OUT; guest.pm = NPANEL_P + (lc >> 2); guest.pn = lc & 3; guest.sig = C_OUT(lc >> 2); }
            else if (lc < 52) { const int ix = lc - 8, p = ix / 22; gpos = 2; guest.kind = K_UP1; guest.pm = NPANEL_P + p; guest.pn = ix % 22; guest.dep = C_OUT(p); guest.want = 4; guest.sig = C_UP(1, p); }
            else if (lc < 84) { const int ix = lc - 52, p = ix >> 4; gpos = 4; guest.kind = K_DNS1; guest.pm = NPANEL_P + p; guest.pn = (ix >> 2) & 3; guest.ks = ix & 3; guest.dep = C_UP(1, p); guest.want = 22; guest.sig = C_DNS(1, p, guest.pn); }
        }
    }
    __device__ __forceinline__ bool next(int i, UnitD& u) const {
        if (i >= count) return false;
        const int pos = first + i; int ip = pos;
        if (gpos >= 0) { if (pos == gpos) { u = guest; return true; } if (pos > gpos) ip = pos - 1; }
        const int L = ip * 256 + c; if (L >= NPANEL_P * 22) return false;
        u.kind = l == 0 ? K_UP0 : K_UP1; map_unit(L, NPANEL_P, 22, u.pm, u.pn); u.ks = 0; u.dep = -1; u.want = 0; u.sig = -1; return true; }
};
}

template <int L_> __device__ __forceinline__ void finisher(LAS unsigned char* lds, int p, int pn) {
    dep_wait(C_DNS(L_, p, pn), 4u);
    const int tid = tid_fresh(), wid = __builtin_amdgcn_readfirstlane(tid >> 6), lane = tid & 63, wr = wid >> 2, wc = wid & 3, fr = lane & 15, fq = lane >> 4;
    f32x4 acc[2][2][4][2];
    const char* pb = (const char*)(kargs()->ws + WS_PBUF) + (size_t)(((p * 4 + pn) * 4) * 32) * 8192;
#pragma unroll
    for (int ai = 0; ai < 2; ++ai)
#pragma unroll
        for (int bj = 0; bj < 2; ++bj)
#pragma unroll
            for (int m = 0; m < 4; m += 2) {
#pragma unroll
                for (int mm = 0; mm < 2; ++mm)
#pragma unroll
                    for (int n = 0; n < 2; ++n) { const unsigned o = (unsigned)(((((ai * 2 + bj) * 4 + m + mm) * 2 + n) * 512 + tid) * 16);
                        acc[ai][bj][m + mm][n] = (*(const f32x4*)(pb + o) + *(const f32x4*)(pb + o + 262144u)) + (*(const f32x4*)(pb + o + 2u * 262144u) + *(const f32x4*)(pb + o + 3u * 262144u)); }
                asm volatile("" : "+v"(acc[ai][bj][m][0]), "+v"(acc[ai][bj][m][1]), "+v"(acc[ai][bj][m + 1][0]), "+v"(acc[ai][bj][m + 1][1]) :: "memory"); }
    epi_prefetch(L_ == 0 ? pg8::K_DN0 : pg8::K_DN1, NPANEL_P + p, pn, lds + EPI_OFF, wid, lane);
    asm volatile("s_waitcnt vmcnt(0)" ::: "memory"); __syncthreads();
    const pg8::Unit uu{NPANEL_P + p, pn};
    if (L_ == 0) { EpiRes<false> E{0, 1, 5, 0}; E(acc, uu, wr, wc, fr, fq, lds + EPI_OFF); unit_signal(C_FIN(0, p)); }
    else { EpiRes<true> E{2, 0, 5, D}; E(acc, uu, wr, wc, fr, fq, lds + EPI_OFF); }
    asm volatile("s_waitcnt vmcnt(0) lgkmcnt(0)" ::: "memory"); __syncthreads();
}

__device__ __forceinline__ void p0_item(const float* W, int K, int N, int kb, int nb, bf16_t* WT, int dest_row0, const float* rowscale, const float* colscale,
                                        float* csp, const float* bvec, float* cbp, int pstride, LAS float* scr, int lane) {
    const int k0 = 64 * kb, n0 = 32 * nb;
#pragma unroll 8
    for (int i = 0; i < 32; ++i) { const int kk = 2 * i + (lane >> 5); scr[kk * 33 + (lane & 31)] = W[(size_t)(k0 + kk) * N + n0 + (lane & 31)]; }
    asm volatile("s_waitcnt lgkmcnt(0)" ::: "memory");
    const int c = lane & 7;
    float rs[8], bb[8];
#pragma unroll
    for (int i = 0; i < 8; ++i) { rs[i] = rowscale ? rowscale[k0 + 8 * c + i] : 1.0f; bb[i] = bvec ? bvec[k0 + 8 * c + i] : 0.0f; }
#pragma unroll
    for (int j = 0; j < 4; ++j) { const int n = (lane >> 3) + 8 * j; const LAS float* s = scr + (8 * c) * 33 + n;
        const float sc = colscale ? colscale[n0 + n] : 1.0f;
        unsigned r[8]; float ps = 0.f, pb = 0.f;
#pragma unroll
        for (int i = 0; i < 8; ++i) { const float w = s[i * 33]; r[i] = f2bf(w * rs[i] * sc); ps += bf2f(r[i]); pb += w * bb[i]; }
        u32x4 o; o.x = r[0] | (r[1] << 16); o.y = r[2] | (r[3] << 16); o.z = r[4] | (r[5] << 16); o.w = r[6] | (r[7] << 16);
        *(u32x4*)(WT + (size_t)(dest_row0 + n) * K + k0 + 8 * c) = o;
        if (csp) {
            ps += __shfl_xor(ps, 1); ps += __shfl_xor(ps, 2); ps += __shfl_xor(ps, 4);
            pb += __shfl_xor(pb, 1); pb += __shfl_xor(pb, 2); pb += __shfl_xor(pb, 4);
            if (c == 0) { csp[(size_t)kb * pstride + dest_row0 + n] = ps; cbp[(size_t)kb * pstride + dest_row0 + n] = pb; }
        }
    }
    asm volatile("s_waitcnt lgkmcnt(0)" ::: "memory");
}
__device__ __forceinline__ int up_dest(int n) { return n < FF ? 256 * (n >> 7) + (n & 127) : 256 * ((n - FF) >> 7) + 128 + ((n - FF) & 127); }
__device__ __forceinline__ int in_dest(int n) { return n < D ? 2048 + n : (n < 2 * D ? 256 * ((n - D) >> 7) + ((n - D) & 127) : 256 * ((n - 2 * D) >> 7) + 128 + ((n - 2 * D) & 127)); }

__device__ __forceinline__ void phase0(LAS unsigned char* lds) {
    const KA Params* q = kargs();
    const int tid = tid_fresh(), lane = tid & 63, wave = tid >> 6;
    LAS float* scr = (LAS float*)(lds + wave * 8704);
    const int gw = blockIdx.x * 8 + wave, NGW = gridDim.x * 8;
    unsigned char* ws = q->ws;
    constexpr int I_UP = 16 * 176, I_IN = 16 * 96, I_OUT = 16 * 32, I_DN = 44 * 32, I_POOL = 4 * 8;
    constexpr int NITEMS = 2 * I_UP + I_IN + I_OUT + 2 * I_DN + 4 * I_POOL;
    for (int it = gw; it < NITEMS; it += NGW) {
        int r = it;
        if (r < 2 * I_UP) { const int l = r / I_UP; r -= l * I_UP; const int kb = r / 176, nb = r % 176;
            p0_item(q->in[13] + (size_t)l * D * FF2, D, FF2, kb, nb, (bf16_t*)(ws + WS_WUP) + (size_t)l * FF2 * D, up_dest(32 * nb), q->in[5] + l * D, nullptr,
                    (float*)(ws + WS_CSP_UP) + (size_t)l * 16 * FF2, q->in[6] + l * D, (float*)(ws + WS_CBP_UP) + (size_t)l * 16 * FF2, FF2, scr, lane); continue; }
        r -= 2 * I_UP;
        if (r < I_IN) { const int kb = r / 96, nb = r % 96;
            p0_item(q->in[9], D, 3 * D, kb, nb, (bf16_t*)(ws + WS_WIN), in_dest(32 * nb), q->in[17], nullptr, (float*)(ws + WS_CSP_IN), q->in[18], (float*)(ws + WS_CBP_IN), 3 * D, scr, lane); continue; }
        r -= I_IN;
        if (r < I_OUT) { const int kb = r / 32, nb = r % 32;
            p0_item(q->in[12], D, D, kb, nb, (bf16_t*)(ws + WS_WOUT), 32 * nb, nullptr, nullptr, nullptr, nullptr, nullptr, 0, scr, lane); continue; }
        r -= I_OUT;
        if (r < 2 * I_DN) { const int l = r / I_DN; r -= l * I_DN; const int kb = r / 32, nb = r % 32;
            p0_item(q->in[16] + (size_t)l * FF * D, FF, D, kb, nb, (bf16_t*)(ws + WS_WDN) + (size_t)l * D * FF, 32 * nb, nullptr, nullptr, nullptr, nullptr, nullptr, 0, scr, lane); continue; }
        r -= 2 * I_DN;
        { const int g = r / I_POOL; r -= g * I_POOL; const int kb = r / 8, nb = r % 8;
            p0_item(q->in[7] + (size_t)g * 256 * 256, 256, 256, kb, nb, (bf16_t*)(ws + WS_WPOOL) + (size_t)g * 256 * 256, 32 * nb, nullptr, q->in[8] + g * 256, nullptr, nullptr, nullptr, 0, scr, lane); }
    }
    const int gt = blockIdx.x * 512 + tid, NGT = gridDim.x * 512;
    for (int i = gt; i < 2 * FF2; i += NGT) { const int l = i / FF2, n = i % FF2, d = up_dest(n); float* kc = (float*)(ws + WS_KC_UP) + (size_t)l * 4 * FF2;
        kc[d] = q->in[14][(size_t)(l * 3 + 0) * FF2 + n]; kc[FF2 + d] = q->in[14][(size_t)(l * 3 + 1) * FF2 + n]; kc[2 * FF2 + d] = q->in[14][(size_t)(l * 3 + 2) * FF2 + n]; kc[3 * FF2 + d] = q->in[15][(size_t)l * FF2 + n]; }
    for (int i = gt; i < NB_P * 15 * (D / 4); i += NGT) { const int c4 = i % (D / 4), rr = (i / (D / 4)) % 15, b = i / (15 * (D / 4));
        ((f32x4*)(q->out + O_POOL_P))[i] = *(const f32x4*)(q->in[0] + ((size_t)b * SEQ + 2033 + rr) * D + c4 * 4); }
    for (int i = gt; i < NB_S * 15 * (D / 4); i += NGT) { const int c4 = i % (D / 4), rr = (i / (D / 4)) % 15, s = i / (15 * (D / 4));
        ((f32x4*)(q->out + O_POOL_S))[i] = rr < 11 ? *(const f32x4*)(q->in[2] + ((size_t)s * 15 + 4 + rr) * D + c4 * 4) : *(const f32x4*)(q->in[1] + ((size_t)s * TS + rr - 11) * D + c4 * 4); }
}

template <int W>
__device__ __forceinline__ void p1_window_prompt(const float* xseq, int tpos0, LAS unsigned char* lds, int row0, int cq) {
    f32x4 a[16 + W];
#pragma unroll
    for (int k = 0; k < 16 + W; ++k) { const int t = tpos0 - W + k, tc = t < 0 ? 0 : t; const f32x4 v = *(const f32x4*)(xseq + (size_t)tc * D); a[k] = t >= 0 ? v : (f32x4){0.f, 0.f, 0.f, 0.f}; }
    f32x4 s = {0.f, 0.f, 0.f, 0.f};
#pragma unroll
    for (int k = 0; k < W; ++k) s += a[k];
#pragma unroll
    for (int j = 0; j < 16; ++j) { s += a[W + j] - a[j]; const int t = tpos0 + j; const float inv = 1.0f / (float)(t + 1 < W ? t + 1 : W); const f32x4 d = s * inv - a[W + j];
        const int row = row0 + j; u32x2 w; w.x = pk2(d[0], d[1]); w.y = pk2(d[2], d[3]);
        *(LAS u32x2*)(lds + row * 2048 + ((((cq >> 1) ^ (row & 15))) << 4) + (cq & 1) * 8) = w; }
}
template <int W>
__device__ __forceinline__ void p1_window_sample(const float* hist, const float* xs, LAS unsigned char* lds, int row0, int cq) {
    f32x4 a[W + 4];
#pragma unroll
    for (int k = 0; k < W; ++k) { const int i = W - k; a[k] = i <= 15 ? *(const f32x4*)(hist + (size_t)(15 - i) * D) : (f32x4){0.f, 0.f, 0.f, 0.f}; }
#pragma unroll
    for (int t = 0; t < 4; ++t) a[W + t] = *(const f32x4*)(xs + (size_t)t * D);
    f32x4 s = {0.f, 0.f, 0.f, 0.f};
#pragma unroll
    for (int k = 0; k < W; ++k) s += a[k];
#pragma unroll
    for (int t = 0; t < 4; ++t) { s += a[W + t] - a[t]; const f32x4 d = s * (1.0f / (float)W) - a[W + t];
        const int row = row0 + t; u32x2 w; w.x = pk2(d[0], d[1]); w.y = pk2(d[2], d[3]);
        *(LAS u32x2*)(lds + row * 2048 + ((((cq >> 1) ^ (row & 15))) << 4) + (cq & 1) * 8) = w; }
}
__device__ __forceinline__ void phase1(LAS unsigned char* lds) {
    const KA Params* q = kargs();
    const int tid = tid_fresh(), lane = tid & 63, wave = __builtin_amdgcn_readfirstlane(tid >> 6), fr = lane & 15, fq = lane >> 4;
    unsigned char* ws = q->ws;
    { const int gt = blockIdx.x * 512 + tid, NGT = gridDim.x * 512;
      for (int i = gt; i < 2 * FF2 + 3 * D; i += NGT) {
          float s = 0.f, b = 0.f;
          if (i < 2 * FF2) { const int l = i / FF2, c = i % FF2; const float* sp = (const float*)(ws + WS_CSP_UP) + (size_t)l * 16 * FF2 + c; const float* bp = (const float*)(ws + WS_CBP_UP) + (size_t)l * 16 * FF2 + c;
              for (int k = 0; k < 16; ++k) { s += sp[(size_t)k * FF2]; b += bp[(size_t)k * FF2]; }
              ((float*)(ws + WS_CS_UP))[i] = s; ((float*)(ws + WS_CB_UP))[i] = b; }
          else { const int c = i - 2 * FF2; const float* sp = (const float*)(ws + WS_CSP_IN) + c; const float* bp = (const float*)(ws + WS_CBP_IN) + c;
              for (int k = 0; k < 16; ++k) { s += sp[(size_t)k * 3 * D]; b += bp[(size_t)k * 3 * D]; }
              ((float*)(ws + WS_CS_IN))[c] = s; ((float*)(ws + WS_CB_IN))[c] = b; } } }
    const bf16_t* wpool = (const bf16_t*)(ws + WS_WPOOL);
    bf16_t* vbf = (bf16_t*)(ws + WS_H1);
    f32x2* part = (f32x2*)(ws + WS_PART);
    LAS f32x2* T = (LAS f32x2*)(lds + P1_T_OFF);
    const int cq = tid & 255, th = __builtin_amdgcn_readfirstlane(tid >> 8), gw = (wave & 3);
    const int g = wave >> 1, hh = wave & 1;
    for (int tile = blockIdx.x; tile < NTOK_P / 64; tile += gridDim.x) {
        const int tok0 = tile * 64, t0 = tok0 & (SEQ - 1);
        const bool host = (tile & 3) == 0; const int seq0 = 2 * (tile >> 2);
        { const float* xseq = q->in[0] + (size_t)(tok0 - t0) * D + 4 * cq;
#pragma unroll 1
          for (int st = 0; st < 2; ++st) { const int r0 = 32 * th + 16 * st;
              if (gw == 0) p1_window_prompt<2>(xseq, t0 + r0, lds, r0, cq); else if (gw == 1) p1_window_prompt<4>(xseq, t0 + r0, lds, r0, cq);
              else if (gw == 2) p1_window_prompt<8>(xseq, t0 + r0, lds, r0, cq); else p1_window_prompt<16>(xseq, t0 + r0, lds, r0, cq); }
          if (host) { const float* hist = q->in[2] + (size_t)(seq0 + th) * 15 * D + 4 * cq; const float* xs = q->in[1] + (size_t)(seq0 + th) * TS * D + 4 * cq;
              if (gw == 0) p1_window_sample<2>(hist, xs, lds, 64 + 4 * th, cq); else if (gw == 1) p1_window_sample<4>(hist, xs, lds, 64 + 4 * th, cq);
              else if (gw == 2) p1_window_sample<8>(hist, xs, lds, 64 + 4 * th, cq); else p1_window_sample<16>(hist, xs, lds, 64 + 4 * th, cq); } }
        float rsum[5], rsq[5];
#pragma unroll
        for (int mb = 0; mb < 5; ++mb) { rsum[mb] = 0.f; rsq[mb] = 0.f; }
#pragma unroll 1
        for (int half = 0; half < 2; ++half) {
            f32x4 acc[5][4];
#pragma unroll
            for (int mb = 0; mb < 5; ++mb)
#pragma unroll
                for (int nb = 0; nb < 4; ++nb) acc[mb][nb] = (f32x4){0.f, 0.f, 0.f, 0.f};
            const bf16_t* wb = wpool + ((size_t)g * 256 + 128 * hh + 64 * half + fr) * 256 + 8 * fq;
#pragma unroll 1
            for (int kh = 0; kh < 2; ++kh) {
                bf16x8 b[4][4];
#pragma unroll
                for (int ks = 0; ks < 4; ++ks)
#pragma unroll
                    for (int nb = 0; nb < 4; ++nb) b[ks][nb] = *(const bf16x8*)(wb + (size_t)(16 * nb) * 256 + 32 * (4 * kh + ks));
                if (half == 0 && kh == 0) __syncthreads();
#pragma unroll
                for (int ks = 0; ks < 4; ++ks) {
                    const int chunk = 32 * g + 4 * (4 * kh + ks) + fq;
                    bf16x8 a[5];
#pragma unroll
                    for (int mb = 0; mb < 5; ++mb) { const int row = mb < 4 ? 16 * mb + fr : 64 + (fr & 7); a[mb] = *(const LAS bf16x8*)(lds + row * 2048 + ((chunk ^ (row & 15)) << 4)); }
#pragma unroll
                    for (int mb = 0; mb < 4; ++mb)
#pragma unroll
                        for (int nb = 0; nb < 4; ++nb) acc[mb][nb] = __builtin_amdgcn_mfma_f32_16x16x32_bf16(b[ks][nb], a[mb], acc[mb][nb], 0, 0, 0);
                    if (host) {
#pragma unroll
                        for (int nb = 0; nb < 4; ++nb) acc[4][nb] = __builtin_amdgcn_mfma_f32_16x16x32_bf16(b[ks][nb], a[4], acc[4][nb], 0, 0, 0); }
                }
            }
            const int c0 = 256 * g + 128 * hh + 64 * half + 4 * fq;
#pragma unroll
            for (int mb = 0; mb < 5; ++mb) {
                if (mb == 4 && (!host || fr >= 8)) continue;
                const int tok = mb < 4 ? tok0 + 16 * mb + fr : NTOK_P + 4 * seq0 + fr, R = row_of_tok(tok);
                const float* xr = (mb < 4 ? q->in[0] + (size_t)tok * D : q->in[1] + (size_t)(tok - NTOK_P) * D) + c0;
                f32x4 xv[4];
#pragma unroll
                for (int nb = 0; nb < 4; ++nb) xv[nb] = *(const f32x4*)(xr + 16 * nb);
#pragma unroll
                for (int nb = 0; nb < 4; ++nb) { const f32x4 v = xv[nb] * ALPHA + acc[mb][nb];
                    rsum[mb] += (v[0] + v[1]) + (v[2] + v[3]); rsq[mb] += (v[0] * v[0] + v[1] * v[1]) + (v[2] * v[2] + v[3] * v[3]);
                    u32x2 wv; wv.x = pk2(v[0], v[1]); wv.y = pk2(v[2], v[3]); *(u32x2*)(vbf + (size_t)R * D + c0 + 16 * nb) = wv; }
            }
        }
#pragma unroll
        for (int mb = 0; mb < 5; ++mb) {
            float sum = rsum[mb], sq = rsq[mb];
            sum += __shfl_xor(sum, 16); sum += __shfl_xor(sum, 32); sq += __shfl_xor(sq, 16); sq += __shfl_xor(sq, 32);
            if (fq == 0 && (mb < 4 || fr < 8)) { f32x2 t; t.x = sum; t.y = sq; T[(mb < 4 ? 16 * mb + fr : 64 + fr) * 8 + wave] = t; }
        }
        __syncthreads();
        if (tid < 4 * (host ? 72 : 64)) { const int row = tid >> 2, gg = tid & 3; const f32x2 a = T[row * 8 + 2 * gg], b = T[row * 8 + 2 * gg + 1];
            const float mt = (a.x + b.x) * (1.0f / 256.0f); f32x2 r; r.x = mt; r.y = (a.y + b.y) - 256.0f * mt * mt;
            const int tok = row < 64 ? tok0 + row : NTOK_P + 4 * seq0 + (row - 64);
            part[(size_t)row_of_tok(tok) * 4 + gg] = r; }
        __syncthreads();
    }
}

__device__ __forceinline__ void phase_fixup(int l) {
    const KA Params* q = kargs();
    const float* kc = (const float*)(q->ws + WS_KC_UP) + (size_t)l * 4 * FF2; bf16_t* act = (bf16_t*)(q->ws + WS_ACT);
    const float* Hf = (const float*)(q->ws + WS_HF); const float* Hl = (const float*)(q->ws + WS_HL);
    const int gt = blockIdx.x * 512 + tid_fresh(), NGT = gridDim.x * 512;
    for (int i = gt; i < 128 * (FF / 4); i += NGT) {
        const int q = i / (FF / 4), f = (i % (FF / 4)) * 4;
        if ((q & 15) == 0) continue;
        const int cg_ = 256 * (f >> 7) + (f & 127), cv_ = cg_ + 128;
        const float* hf = Hf + (size_t)q * 2 * FF2; const float* hl = Hl + (size_t)(q - 1) * 2 * FF2;
        const f32x4 k0g = *(const f32x4*)(kc + cg_), k1g = *(const f32x4*)(kc + FF2 + cg_), k2g = *(const f32x4*)(kc + 2 * FF2 + cg_), kbg = *(const f32x4*)(kc + 3 * FF2 + cg_);
        const f32x4 k0v = *(const f32x4*)(kc + cv_), k1v = *(const f32x4*)(kc + FF2 + cv_), k2v = *(const f32x4*)(kc + 2 * FF2 + cv_), kbv = *(const f32x4*)(kc + 3 * FF2 + cv_);
        const f32x4 g2 = *(const f32x4*)(hl + cg_), g1 = *(const f32x4*)(hl + FF2 + cg_), a0 = *(const f32x4*)(hf + cg_), a1 = *(const f32x4*)(hf + FF2 + cg_);
        const f32x4 v2 = *(const f32x4*)(hl + cv_), v1 = *(const f32x4*)(hl + FF2 + cv_), b0 = *(const f32x4*)(hf + cv_), b1 = *(const f32x4*)(hf + FF2 + cv_);
        const f32x4 zg0 = k2g * a0 + k1g * g1 + k0g * g2 + kbg, zv0 = k2v * b0 + k1v * v1 + k0v * v2 + kbv;
        const f32x4 zg1 = k2g * a1 + k1g * a0 + k0g * g1 + kbg, zv1 = k2v * b1 + k1v * b0 + k0v * v1 + kbv;
        const int R0 = (q >> 1) * 256 + 64 * (q & 1);
        u32x2 w0, w1; w0.x = pk2(silu_mul(zg0[0], zv0[0]), silu_mul(zg0[1], zv0[1])); w0.y = pk2(silu_mul(zg0[2], zv0[2]), silu_mul(zg0[3], zv0[3]));
        w1.x = pk2(silu_mul(zg1[0], zv1[0]), silu_mul(zg1[1], zv1[1])); w1.y = pk2(silu_mul(zg1[2], zv1[2]), silu_mul(zg1[3], zv1[3]));
        *(u32x2*)(act + (size_t)R0 * FF + f) = w0; *(u32x2*)(act + (size_t)(R0 + 16) * FF + f) = w1;
    }
}

__device__ __forceinline__ void phase_conv() {
    const KA Params* q = kargs();
    bf16_t* obuf = (bf16_t*)q->out;
    const float* ck = q->in[10]; const float* ckb = q->in[11]; const float* st = q->in[3];
    const int gt = blockIdx.x * 512 + tid_fresh(), NGT = gridDim.x * 512;
    for (int i = gt; i < MROWS * (D / 8); i += NGT) {
        const int tok = i >> 7, ch = (i & 127) * 8;
        int t, seq = 0; const bool sample = tok >= NTOK_P;
        if (!sample) t = tok & (SEQ - 1); else { seq = (tok - NTOK_P) >> 2; t = tok & 3; }
        const bf16_t* ubuf = sample ? (const bf16_t*)(q->ws + WS_SU) - (size_t)NTOK_P * D : (const bf16_t*)(q->ws + WS_ACT);
        const bf16_t* bbuf = sample ? (const bf16_t*)(q->ws + WS_SB) - (size_t)NTOK_P * D : (const bf16_t*)(q->ws + WS_ACT) + (size_t)MROWS * D;
        const int R = row_of_tok(tok);
        float u0[8], u1[8], u2[8], bb[8];
        { const u32x4 w = *(const u32x4*)(ubuf + (size_t)R * D + ch); const u32x4 wb = *(const u32x4*)(bbuf + (size_t)R * D + ch);
#pragma unroll
          for (int e = 0; e < 4; ++e) { u2[2 * e] = bf2f(w[e] & 0xffffu); u2[2 * e + 1] = bf2f(w[e] >> 16); bb[2 * e] = bf2f(wb[e] & 0xffffu); bb[2 * e + 1] = bf2f(wb[e] >> 16); } }
        if (t >= 1) { const u32x4 w = *(const u32x4*)(ubuf + (size_t)row_of_tok(tok - 1) * D + ch);
#pragma unroll
            for (int e = 0; e < 4; ++e) { u1[2 * e] = bf2f(w[e] & 0xffffu); u1[2 * e + 1] = bf2f(w[e] >> 16); } }
        else if (sample) { const f32x4 a = *(const f32x4*)(st + ((size_t)seq * 2 + 1) * D + ch), b = *(const f32x4*)(st + ((size_t)seq * 2 + 1) * D + ch + 4);
#pragma unroll
            for (int e = 0; e < 4; ++e) { u1[e] = a[e]; u1[4 + e] = b[e]; } }
        else {
#pragma unroll
            for (int e = 0; e < 8; ++e) u1[e] = 0.f; }
        if (t >= 2) { const u32x4 w = *(const u32x4*)(ubuf + (size_t)row_of_tok(tok - 2) * D + ch);
#pragma unroll
            for (int e = 0; e < 4; ++e) { u0[2 * e] = bf2f(w[e] & 0xffffu); u0[2 * e + 1] = bf2f(w[e] >> 16); } }
        else if (sample) { const f32x4 a = *(const f32x4*)(st + ((size_t)seq * 2 + t) * D + ch), b = *(const f32x4*)(st + ((size_t)seq * 2 + t) * D + ch + 4);
#pragma unroll
            for (int e = 0; e < 4; ++e) { u0[e] = a[e]; u0[4 + e] = b[e]; } }
        else {
#pragma unroll
            for (int e = 0; e < 8; ++e) u0[e] = 0.f; }
        float o[8];
#pragma unroll
        for (int e = 0; e < 8; ++e) o[e] = bb[e] * (ck[ch + e] * u0[e] + ck[D + ch + e] * u1[e] + ck[2 * D + ch + e] * u2[e] + ckb[ch + e]);
        u32x4 w; w.x = pk2(o[0], o[1]); w.y = pk2(o[2], o[3]); w.z = pk2(o[4], o[5]); w.w = pk2(o[6], o[7]);
        *(u32x4*)(obuf + (size_t)R * D + ch) = w;
    }
}

__device__ __forceinline__ void phase_final() {
    const KA Params* q = kargs();
    const f32x2* part = (const f32x2*)(q->ws + WS_PART); const float* g = q->in[17] + D; const float* b = q->in[18] + D;
    const int tid = tid_fresh(), lane = tid & 63, gw = blockIdx.x * 8 + (tid >> 6), NGW = gridDim.x * 8;
    f32x4 gv[4], bv[4];
#pragma unroll
    for (int j = 0; j < 4; ++j) { gv[j] = *(const f32x4*)(g + 256 * j + 4 * lane); bv[j] = *(const f32x4*)(b + 256 * j + 4 * lane); }
    for (int tok = gw; tok < MROWS; tok += NGW) {
        const f32x2 s = row_stats(part, row_of_tok(tok));
        float* yr = q->out + (size_t)tok * D + 4 * lane;
#pragma unroll
        for (int j = 0; j < 4; ++j) { const f32x4 v = *(const f32x4*)(yr + 256 * j); *(f32x4*)(yr + 256 * j) = ((v - s.x) * s.y) * gv[j] + bv[j]; }
    }
}

#define XB_TMO      128
#define XB_XCNT(j)  (256  + 64 * (j))
#define XB_XSUB(j)  (1280 + 64 * (j))
#define XB_XGEN(j)  (2304 + 64 * (j))
#define XB_TOP      3328
#define XB_TOPGEN   3392
#define XCD_BAR_WORDS 3456
#define XB_SPIN_CAP (1u << 18)

__device__ __forceinline__ unsigned xb_ld(unsigned* p)              { return __hip_atomic_load(p, __ATOMIC_RELAXED, __HIP_MEMORY_SCOPE_AGENT); }
__device__ __forceinline__ unsigned xb_add(unsigned* p, unsigned v) { return __hip_atomic_fetch_add(p, v, __ATOMIC_RELAXED, __HIP_MEMORY_SCOPE_AGENT); }
__device__ __forceinline__ unsigned xb_xcc_id() { return (unsigned)__builtin_amdgcn_s_getreg((3 << 11) | 20) & 0xFu; }
#define XB_SPIN(cond, bar) do { unsigned _sp = 0; while (cond) { __builtin_amdgcn_s_sleep(1); \
    if ((++_sp & 255u) == 0u) { if (xb_ld(&(bar)[XB_TMO])) break; if (_sp > XB_SPIN_CAP) { atomicAdd(&(bar)[XB_TMO], 1u); break; } } } } while (0)

struct XcdBarrier {
    unsigned* bar; unsigned x;
    volatile LAS unsigned* st;
};

__device__ __forceinline__ XcdBarrier xcd_barrier_post(unsigned* bar, volatile LAS unsigned* st) {
    XcdBarrier b; b.bar = bar; b.x = xb_xcc_id(); b.st = st;
    if (threadIdx.x == 0) (void)xb_add(&bar[XB_XCNT(b.x)], 1u);
    return b;
}
__device__ __forceinline__ void xcd_barrier_complete(unsigned* bar, unsigned x, unsigned& nloc, unsigned& nx) {
    const unsigned G = gridDim.x * gridDim.y * gridDim.z;
    unsigned sum, cnt, mine, sp = 0u;
    for (;;) {
        sum = 0u; cnt = 0u; mine = 0u;
#pragma unroll
        for (unsigned j = 0; j < 16; ++j) { const unsigned c = xb_ld(&bar[XB_XCNT(j)]); sum += c; cnt += (c > 0u) ? 1u : 0u; mine = (j == x) ? c : mine; }
        if (sum == G) break;
        __builtin_amdgcn_s_sleep(1);
        if ((++sp & 255u) == 0u) { if (xb_ld(&bar[XB_TMO])) break; if (sp > XB_SPIN_CAP) { atomicAdd(&bar[XB_TMO], 1u); break; } }
    }
    nloc = mine > 0u ? mine : 1u; nx = cnt > 0u ? cnt : 1u;
}

__device__ __forceinline__ void xcd_barrier(const XcdBarrier& b) {
    asm volatile("s_waitcnt vmcnt(0)" ::: "memory");
    __syncthreads();
    if (threadIdx.x == 0) {
        unsigned* bar = b.bar;
        __builtin_amdgcn_s_waitcnt(0);
        unsigned nloc = b.st[0], nx = b.st[1];
        if (nloc == 0u) { xcd_barrier_complete(bar, b.x, nloc, nx); b.st[0] = nloc; b.st[1] = nx; }
        const unsigned old = xb_add(&bar[XB_XSUB(b.x)], 1u);
        const unsigned gen = old / nloc;
        if (old + 1u == (gen + 1u) * nloc) {
            __builtin_amdgcn_fence(__ATOMIC_RELEASE, "agent");
            asm volatile("s_waitcnt vmcnt(0)" ::: "memory");
            const unsigned og = xb_add(&bar[XB_TOP], 1u);
            const unsigned tg = og / nx;
            if (og + 1u == (tg + 1u) * nx) xb_add(&bar[XB_TOPGEN], 1u);
            else XB_SPIN(xb_ld(&bar[XB_TOPGEN]) == tg, bar);
            __builtin_amdgcn_fence(__ATOMIC_ACQUIRE, "agent");
            xb_add(&bar[XB_XGEN(b.x)], 1u);
            asm volatile("s_waitcnt vmcnt(0)" ::: "memory");
        } else {
            XB_SPIN(xb_ld(&bar[XB_XGEN(b.x)]) == gen, bar);
            __builtin_amdgcn_fence(__ATOMIC_ACQUIRE, "agent");
            asm volatile("s_waitcnt vmcnt(0)" ::: "memory");
        }
    }
    __syncthreads();
}


__global__ void __launch_bounds__(512, 2) fwd_megakernel(Params p) {
    extern __shared__ __attribute__((aligned(16))) unsigned char lds_raw[];
    LAS unsigned char* lds = (LAS unsigned char*)lds_raw;
    const int G = gridDim.x, cid = blockIdx.x;
    if (threadIdx.x < 2) ((LAS unsigned*)(lds + BARST_OFF))[threadIdx.x] = 0u;
    __syncthreads();
    const XcdBarrier bar = xcd_barrier_post((unsigned*)(kargs()->ws + WS_BAR), (volatile LAS unsigned*)(lds + BARST_OFF));
    using namespace pg8;
    constexpr int M_UP = (1 << K_UP0) | (1 << K_UP1), M_DNS = (1 << K_DNS0) | (1 << K_DNS1);
#if DIAG & 1
    for (int rep = 0; rep < ((REP & 1) ? 2 : 1); ++rep) phase0(lds);
#endif
    xcd_barrier(bar);
#if DIAG & 2
    for (int rep = 0; rep < ((REP & 2) ? 2 : 1); ++rep) phase1(lds);
#endif
    xcd_barrier(bar);
#if SEG & 1
    { SchedUp S; S.init(0, cid);
      const int lc = cid - 128;
      if (lc >= 76 && lc < 84) { S.first = 0; S.count = 4; gemm_stream<M_UP, false>(lds, S); finisher<0>(lds, (lc - 76) >> 2, (lc - 76) & 3); S.first = 4; S.count = 1; gemm_stream<M_UP, false>(lds, S); }
      else gemm_stream<M_UP | M_DNS | (1 << K_IN), true>(lds, S); }
#endif
    xcd_barrier(bar);
    phase_fixup(0);
    xcd_barrier(bar);
#if SEG & 2
    { SchedSimple S{K_DN0, NPANEL_P, 4, G, cid}; gemm_stream<(1 << K_DN0), false>(lds, S); }
#endif
    xcd_barrier(bar);
#if SEG & 4
    { SchedSimple S{K_IN, NPANEL_P, 12, G, cid}; gemm_stream<(1 << K_IN), false>(lds, S); }
#endif
    xcd_barrier(bar);
    phase_conv();
    xcd_barrier(bar);
#if SEG & 8
    { SchedSimple S{K_OUT, NPANEL_P, 4, G, cid}; gemm_stream<(1 << K_OUT), false>(lds, S); }
#endif
    xcd_barrier(bar);
#if SEG & 16
    { SchedUp S; S.init(1, cid);
      const int lc = cid - 128;
      gemm_stream<M_UP | M_DNS | (1 << K_OUT), true>(lds, S);
      if (lc >= 84 && lc < 92) finisher<1>(lds, (lc - 84) >> 2, (lc - 84) & 3); }
#endif
    xcd_barrier(bar);
    phase_fixup(1);
    xcd_barrier(bar);
#if SEG & 32
    { SchedSimple S{K_DN1, NPANEL_P, 4, G, cid}; gemm_stream<(1 << K_DN1), false>(lds, S); }
#endif
}

extern "C" void kernel_launch(void* const* d_in, const int* in_sizes, int n_in, void* d_out, int out_size, void* d_ws, size_t ws_size, hipStream_t stream) {
    static int grid_blocks = 0;
    if (grid_blocks == 0) {
        if (n_in != 19 || out_size != (int)O_END || ws_size < WS_END) { fprintf(stderr, "kernel_launch: unexpected shapes (n_in %d out %d ws %zu)\n", n_in, out_size, ws_size); grid_blocks = -1; return; }
        int dev = 0, cus = 0, per_cu = 0;
        hipGetDevice(&dev);
        hipDeviceGetAttribute(&cus, hipDeviceAttributeMultiprocessorCount, dev);
        if (hipFuncSetAttribute((const void*)fwd_megakernel, hipFuncAttributeMaxDynamicSharedMemorySize, LDS_BYTES) != hipSuccess) { fprintf(stderr, "kernel_launch: hipFuncSetAttribute failed\n"); grid_blocks = -1; return; }
        hipOccupancyMaxActiveBlocksPerMultiprocessor(&per_cu, (const void*)fwd_megakernel, 512, LDS_BYTES);
        if (per_cu < 1) { fprintf(stderr, "kernel_launch: occupancy query reports %d blocks per CU\n", per_cu); grid_blocks = -1; return; }
        if (cus != 256) { fprintf(stderr, "kernel_launch: the unit schedule is built for 256 CUs, this device has %d\n", cus); grid_blocks = -1; return; }
        grid_blocks = cus;
    }
    if (grid_blocks < 0) return;
    if (hipMemsetAsync((char*)d_ws + WS_BAR, 0, CTL_BYTES, stream) != hipSuccess) { fprintf(stderr, "kernel_launch: hipMemsetAsync failed\n"); return; }
    Params p{};
    for (int i = 0; i < 19; ++i) p.in[i] = (const float*)d_in[i];
    p.out = (float*)d_out; p.ws = (unsigned char*)d_ws;
    void* args[] = {&p};
    hipError_t e = hipLaunchCooperativeKernel((const void*)fwd_megakernel, dim3(grid_blocks), dim3(512), args, LDS_BYTES, stream);
    if (e != hipSuccess) fprintf(stderr, "cooperative launch failed: %s (grid %d)\n", hipGetErrorString(e), grid_blocks);
}
```

```cpp
#include <hip/hip_runtime.h>
#include <cstdio>
#include <cstdint>
#ifndef TPROBE
#define TPROBE 0
#endif
#ifndef SEG
#define SEG 255
#endif

#define LAS __attribute__((address_space(3)))
typedef unsigned short bf16_t;
typedef short bf16x8 __attribute__((ext_vector_type(8)));
typedef float f32x4 __attribute__((ext_vector_type(4)));
typedef float f32x2 __attribute__((ext_vector_type(2)));
typedef unsigned u32x4 __attribute__((ext_vector_type(4)));
typedef unsigned u32x2 __attribute__((ext_vector_type(2)));

constexpr int D = 1024, FF = 2816, FF2 = 5632, SEQ = 2048, NB_P = 8, NB_S = 128, TS = 4;
constexpr int NTOK_P = NB_P * SEQ;
constexpr int NTOK_S = NB_S * TS;
constexpr int MROWS = NTOK_P + NTOK_S;
constexpr int NPANEL = MROWS / 256;
constexpr int NPANEL_P = NTOK_P / 256;
constexpr float ALPHA = 1.41421356237309515f;
constexpr float LN_EPS = 1e-5f;

constexpr size_t O_Y = 0;
constexpr size_t O_POOL_P = (size_t)MROWS * D;
constexpr size_t O_POOL_S = O_POOL_P + (size_t)NB_P * 15 * D;
constexpr size_t O_CONV_P = O_POOL_S + (size_t)NB_S * 15 * D;
constexpr size_t O_CONV_S = O_CONV_P + (size_t)NB_P * 2 * D;
constexpr size_t O_FFN_P = O_CONV_S + (size_t)NB_S * 2 * D;
constexpr size_t O_FFN_S = O_FFN_P + (size_t)2 * NB_P * 2 * FF2;
constexpr size_t O_END = O_FFN_S + (size_t)2 * NB_S * 2 * FF2;

constexpr size_t WS_WUP = 0;
constexpr size_t WS_WDN = WS_WUP + (size_t)2 * FF2 * D * 2;
constexpr size_t WS_WIN = WS_WDN + (size_t)2 * D * FF * 2;
constexpr size_t WS_WOUT = WS_WIN + (size_t)3 * D * D * 2;
constexpr size_t WS_WPOOL = WS_WOUT + (size_t)D * D * 2;
constexpr size_t WS_CSP_UP = WS_WPOOL + (size_t)4 * 256 * 256 * 2;
constexpr size_t WS_CBP_UP = WS_CSP_UP + (size_t)2 * 16 * FF2 * 4;
constexpr size_t WS_CSP_IN = WS_CBP_UP + (size_t)2 * 16 * FF2 * 4;
constexpr size_t WS_CBP_IN = WS_CSP_IN + (size_t)16 * 3072 * 4;
constexpr size_t WS_CS_UP = WS_CBP_IN + (size_t)16 * 3072 * 4;
constexpr size_t WS_CB_UP = WS_CS_UP + (size_t)2 * FF2 * 4;
constexpr size_t WS_KC_UP = WS_CB_UP + (size_t)2 * FF2 * 4;
constexpr size_t WS_CS_IN = WS_KC_UP + (size_t)2 * 4 * FF2 * 4;
constexpr size_t WS_CB_IN = WS_CS_IN + (size_t)3072 * 4;
constexpr size_t WS_PART = WS_CB_IN + (size_t)3072 * 4;
constexpr size_t PART_BYTES = (size_t)MROWS * 4 * 8;
constexpr size_t WS_HF = WS_PART + 3 * PART_BYTES;
constexpr size_t HALO_BYTES = (size_t)132 * 2 * FF2 * 4;
constexpr size_t WS_HL = WS_HF + HALO_BYTES;
constexpr size_t WS_H1 = WS_HL + HALO_BYTES;
constexpr size_t WS_ACT = WS_H1 + (size_t)MROWS * D * 2;
constexpr size_t WS_BAR = WS_ACT + (size_t)MROWS * FF * 2;
constexpr size_t WS_CNT = WS_BAR + 16384;
constexpr size_t CTL_BYTES = 16384 + 32768;
constexpr size_t WS_SU = WS_BAR + CTL_BYTES;
constexpr size_t WS_SB = WS_SU + (size_t)NTOK_S * D * 2;
constexpr size_t WS_PBUF = WS_SB + (size_t)NTOK_S * D * 2;
constexpr size_t WS_END = WS_PBUF + (size_t)32 * 262144;
static_assert(WS_END <= (size_t)256 * 1024 * 1024, "workspace");
static_assert(WS_WDN % 256 == 0 && WS_WIN % 256 == 0 && WS_WOUT % 256 == 0 && WS_WPOOL % 256 == 0 && WS_PART % 256 == 0 && WS_HF % 256 == 0 && WS_H1 % 256 == 0 && WS_ACT % 256 == 0, "align");

constexpr int STAGE_BYTES = 131072;
constexpr int EPI_OFF = STAGE_BYTES;
constexpr int EPI_S = 8192, EPI_CST = 10240, EPI_PART = 16384;
constexpr int P1_T_OFF = 147456;
constexpr int BARST_OFF = 155648;
constexpr int LDS_BYTES = 159744;

struct Params {
    const float* in[19];
    float* out;
    unsigned char* ws;
};

__device__ __forceinline__ unsigned f2bf(float f) { unsigned u = __builtin_bit_cast(unsigned, f); return (u + 0x7fffu + ((u >> 16) & 1u)) >> 16; }
__device__ __forceinline__ float bf2f(unsigned b) { return __builtin_bit_cast(float, b << 16); }
typedef __bf16 bf16v2 __attribute__((ext_vector_type(2)));
__device__ __forceinline__ unsigned pk2(float lo, float hi) { const f32x2 v = {lo, hi}; return __builtin_bit_cast(unsigned, __builtin_convertvector(v, bf16v2)); }
__device__ __forceinline__ float dpp_shr1(float v) {
    return __builtin_bit_cast(float, __builtin_amdgcn_update_dpp(0, __builtin_bit_cast(int, v), 0x111, 0xf, 0xf, true));
}
__device__ __forceinline__ float silu_mul(float g, float v) { return g * v * __builtin_amdgcn_rcpf(1.0f + __expf(-g)); }
__device__ __forceinline__ int tid_fresh() { int t = threadIdx.x; asm volatile("" : "+v"(t)); return t; }
__device__ __forceinline__ int row_of_tok(int tok) {
    const int pm = tok >> 8, tau = tok & 255;
    return pm * 256 + 128 * ((tau >> 2) & 1) + 64 * (tau >> 7) + 16 * (tau & 3) + ((tau >> 3) & 15);
}
__device__ __forceinline__ void stats_compute(LAS unsigned char* elds) {
    int tx = threadIdx.x; asm volatile("" : "+v"(tx));
    if (tx < 256) { const f32x4 a = *(const LAS f32x4*)(elds + EPI_PART + tx * 32), b = *(const LAS f32x4*)(elds + EPI_PART + tx * 32 + 16);
        const float mean = ((a[0] + a[2]) + (b[0] + b[2])) * 0.25f;
        const float d0 = a[0] - mean, d1 = a[2] - mean, d2 = b[0] - mean, d3 = b[2] - mean;
        const float m2 = ((a[1] + a[3]) + (b[1] + b[3])) + 256.0f * ((d0 * d0 + d1 * d1) + (d2 * d2 + d3 * d3));
        const float rstd = __builtin_amdgcn_rsqf(m2 * (1.0f / 1024.0f) + LN_EPS);
        f32x2 t; t.x = rstd; t.y = -mean * rstd; ((LAS f32x2*)(elds + EPI_S))[tx] = t; }
}
__device__ __forceinline__ void stats_from_lds(LAS unsigned char* elds) {
    stats_compute(elds);
    asm volatile("s_waitcnt lgkmcnt(0)" ::: "memory"); __builtin_amdgcn_s_barrier(); asm volatile("" ::: "memory");
}
#define KA __attribute__((address_space(4)))
__device__ __forceinline__ const KA Params* kargs() { const KA Params* p = (const KA Params*)__builtin_amdgcn_kernarg_segment_ptr(); asm volatile("" : "+s"(p)); return p; }

__device__ __forceinline__ unsigned* cnt_word(int idx) { return (unsigned*)(kargs()->ws + WS_CNT) + 64 * idx; }
namespace pg8 {
constexpr int BM = 256, BK = 64, HALF = 128, HTB = HALF * BK * 2, NXCD = 8, WGM = 8;
__host__ __device__ __forceinline__ int lds_byte(int r, int c) { const int st = (r >> 4) * 2 + (c >> 5), rr = r & 15, cc = c & 31, ob = rr * 64 + cc * 2; return st * 1024 + (ob ^ (((ob >> 9) & 1) << 5)); }
__host__ __device__ __forceinline__ void stage_rc(int b, int& R, int& C) { const int st = b / 1024, sb = b % 1024, swz = sb ^ (((sb >> 9) & 1) << 5); R = (st >> 1) * 16 + swz / 64; C = (st & 1) * 32 + (swz % 64) / 2; }

struct Unit { int pm, pn; };
enum { K_UP0 = 0, K_UP1 = 1, K_DN0 = 2, K_DN1 = 3, K_IN = 4, K_OUT = 5, K_DNS0 = 6, K_DNS1 = 7 };
struct UnitD { unsigned w0, w1;
    __device__ __forceinline__ int kind() const { return (int)(w0 & 15u); }
    __device__ __forceinline__ int pm() const { return (int)((w0 >> 4) & 255u); }
    __device__ __forceinline__ int pn() const { return (int)((w0 >> 12) & 255u); }
    __device__ __forceinline__ int ks() const { return (int)((w0 >> 20) & 15u); }
    __device__ __forceinline__ int dep() const { return (int)(w1 & 255u) - 1; }
    __device__ __forceinline__ unsigned want() const { return (w1 >> 8) & 255u; }
    __device__ __forceinline__ int sig() const { return (int)((w1 >> 16) & 255u) - 1; }
    __device__ __forceinline__ void set(int kind_, int pm_, int pn_, int ks_, int dep_, int want_, int sig_) { w0 = (unsigned)kind_ | ((unsigned)pm_ << 4) | ((unsigned)pn_ << 12) | ((unsigned)ks_ << 20); w1 = (unsigned)(dep_ + 1) | ((unsigned)want_ << 8) | ((unsigned)(sig_ + 1) << 16); }
};
__device__ __forceinline__ void map_unit(int L, int nM, int nN, int& pm, int& pn) {
    const int nwg = nM * nN; int wgid = L; { const int q = nwg / NXCD, r = nwg % NXCD, xcd = wgid % NXCD, off = wgid / NXCD; wgid = (xcd < r ? xcd * (q + 1) : r * (q + 1) + (xcd - r) * q) + off; }
    const int nig = WGM * nN, gid = wgid / nig, fm = gid * WGM, gsz = (nM - fm) < WGM ? (nM - fm) : WGM;
    pm = fm + ((wgid % nig) % gsz); pn = (wgid % nig) / gsz;
}
}


template <int BJ> __device__ __forceinline__ void pin_half(f32x4 (&acc)[2][2][4][2]) {
#pragma unroll
    for (int ai = 0; ai < 2; ++ai)
        asm volatile("" : "+v"(acc[ai][BJ][0][0]), "+v"(acc[ai][BJ][0][1]), "+v"(acc[ai][BJ][1][0]), "+v"(acc[ai][BJ][1][1]), "+v"(acc[ai][BJ][2][0]), "+v"(acc[ai][BJ][2][1]), "+v"(acc[ai][BJ][3][0]), "+v"(acc[ai][BJ][3][1]) :: "memory");
}
template <int BJ, int N> __device__ __forceinline__ void pin_group(f32x4 (&acc)[2][2][4][2]) {
    asm volatile("" : "+v"(acc[0][BJ][0][N]), "+v"(acc[0][BJ][1][N]), "+v"(acc[0][BJ][2][N]), "+v"(acc[0][BJ][3][N]), "+v"(acc[1][BJ][0][N]), "+v"(acc[1][BJ][1][N]), "+v"(acc[1][BJ][2][N]), "+v"(acc[1][BJ][3][N]) :: "memory");
}
template <int N> __device__ __forceinline__ void pin_n(f32x4 (&acc)[2][2][4][2]) {
#pragma unroll
    for (int ai = 0; ai < 2; ++ai)
        asm volatile("" : "+v"(acc[ai][0][0][N]), "+v"(acc[ai][0][1][N]), "+v"(acc[ai][0][2][N]), "+v"(acc[ai][0][3][N]), "+v"(acc[ai][1][0][N]), "+v"(acc[ai][1][1][N]), "+v"(acc[ai][1][2][N]), "+v"(acc[ai][1][3][N]) :: "memory");
}
template <int BJ, int N, int J0, int LEN>
__device__ __forceinline__ void conv_chain(f32x4 (&acc)[2][2][4][2], const f32x4 k0, const f32x4 k1, const f32x4 k2, const f32x4 kb, const f32x4 p1, const f32x4 p2) {
#pragma unroll
    for (int i = LEN - 1; i >= 0; --i) {
        const int j = J0 + i;
        const f32x4 h0 = acc[j >> 2][BJ][j & 3][N];
        const f32x4 h1 = i >= 1 ? acc[(j - 1) >> 2][BJ][(j - 1) & 3][N] : p1;
        const f32x4 h2 = i >= 2 ? acc[(j - 2) >> 2][BJ][(j - 2) & 3][N] : (i == 1 ? p1 : p2);
        acc[j >> 2][BJ][j & 3][N] = k2 * h0 + k1 * h1 + k0 * h2 + kb;
    }
}
struct EpiUp {
    int l;
    template <int N>
    __device__ __forceinline__ void state_load(f32x4 (&sp)[8], int pm, int pn, int wr, int wc, int fr, int fq) const {
        asm volatile("" : "+v"(fr), "+v"(fq));
        const int useq0 = 64 * (pm - NPANEL_P) + 32 * wr, ufcol = 128 * pn + 32 * wc + 4 * N;
        const char* sb = (const char*)(kargs()->in[4] + ((size_t)l * NB_S + useq0) * 2 * FF2 + ufcol) + ((unsigned)(2 * fr * 2 * FF2 * 4) + (unsigned)(32 * fq));
        sp[0] = *(const f32x4*)(sb + FF2 * 4); sp[1] = *(const f32x4*)(sb); sp[2] = *(const f32x4*)(sb + 3 * FF2 * 4); sp[3] = *(const f32x4*)(sb + 2 * FF2 * 4);
        sp[4] = *(const f32x4*)(sb + (FF2 + FF) * 4); sp[5] = *(const f32x4*)(sb + FF * 4); sp[6] = *(const f32x4*)(sb + (3 * FF2 + FF) * 4); sp[7] = *(const f32x4*)(sb + (2 * FF2 + FF) * 4);
    }
    template <int N>
    __device__ __forceinline__ void half(f32x4 (&acc)[2][2][4][2], int pm, int pn, int wr, int wc, int fr, int fq, LAS unsigned char* elds) const {
        asm volatile("" : "+v"(fr), "+v"(fq));
        const KA Params* q = kargs(); unsigned char* ws = q->ws;
        const bool sample = pm >= NPANEL_P;
        const int chunk = 2 * pm + wr;
        const int ucol = 256 * pn + 32 * wc + 4 * N;
        const int ufcol = 128 * pn + 32 * wc + 4 * N;
        const unsigned lq = (unsigned)(32 * fq);
        const LAS unsigned char* kcl = elds + EPI_CST + 2048 + (32 * wc + 4 * N) * 4 + lq;
#define KC4(tap, vhalf) (*(const LAS f32x4*)(kcl + ((tap) * 256 + (vhalf) * 128) * 4))
        if (!sample) {
            f32x4 g2, g1;
#pragma unroll
            for (int e = 0; e < 4; ++e) { g2[e] = dpp_shr1(acc[1][0][2][N][e]); g1[e] = dpp_shr1(acc[1][0][3][N][e]); }
            if (fr == 0) {
                char* hf = (char*)((float*)(ws + WS_HF) + (size_t)chunk * 2 * FF2 + ucol) + lq;
                *(f32x4*)(hf) = acc[0][0][0][N]; *(f32x4*)(hf + FF2 * 4) = acc[0][0][1][N];
                *(f32x4*)(hf + 128 * 4) = acc[0][1][0][N]; *(f32x4*)(hf + (FF2 + 128) * 4) = acc[0][1][1][N];
            }
            if (fr == 15) {
                char* hl = (char*)((float*)(ws + WS_HL) + (size_t)chunk * 2 * FF2 + ucol) + lq;
                *(f32x4*)(hl) = acc[1][0][2][N]; *(f32x4*)(hl + FF2 * 4) = acc[1][0][3][N];
                *(f32x4*)(hl + 128 * 4) = acc[1][1][2][N]; *(f32x4*)(hl + (FF2 + 128) * 4) = acc[1][1][3][N];
                if ((pm & 7) == 7 && wr == 1) {
                    char* o = (char*)(q->out + O_FFN_P + ((size_t)l * NB_P + (pm >> 3)) * 2 * FF2 + ufcol) + lq;
                    *(f32x4*)(o) = acc[1][0][2][N]; *(f32x4*)(o + FF2 * 4) = acc[1][0][3][N];
                    *(f32x4*)(o + FF * 4) = acc[1][1][2][N]; *(f32x4*)(o + (FF2 + FF) * 4) = acc[1][1][3][N];
                }
            }
            pin_n<N>(acc);
            { const f32x4 k0 = KC4(0, 0), k1 = KC4(1, 0), k2 = KC4(2, 0), kb = KC4(3, 0); conv_chain<0, N, 0, 8>(acc, k0, k1, k2, kb, g1, g2); }
            pin_n<N>(acc);
            { f32x4 v2, v1;
#pragma unroll
              for (int e = 0; e < 4; ++e) { v2[e] = dpp_shr1(acc[1][1][2][N][e]); v1[e] = dpp_shr1(acc[1][1][3][N][e]); }
              const f32x4 k0 = KC4(0, 1), k1 = KC4(1, 1), k2 = KC4(2, 1), kb = KC4(3, 1); conv_chain<1, N, 0, 8>(acc, k0, k1, k2, kb, v1, v2); }
        } else {
            f32x4 sp[8]; state_load<N>(sp, pm, pn, wr, wc, fr, fq);
            if (N == 0) {
                const int useq0 = 64 * (pm - NPANEL_P) + 32 * wr;
                const unsigned ls = (unsigned)(2 * fr * 2 * FF2 * 4) + lq;
                char* ob = (char*)(q->out + O_FFN_S + ((size_t)l * NB_S + useq0) * 2 * FF2 + ufcol);
#pragma unroll
                for (int ai = 0; ai < 2; ++ai) { char* o = ob + ls + (unsigned)(ai * 2 * FF2 * 4);
#pragma unroll
                    for (int n = 0; n < 2; ++n) {
                        *(f32x4*)(o + 16 * n) = acc[ai][0][2][n]; *(f32x4*)(o + FF2 * 4 + 16 * n) = acc[ai][0][3][n];
                        *(f32x4*)(o + FF * 4 + 16 * n) = acc[ai][1][2][n]; *(f32x4*)(o + (FF2 + FF) * 4 + 16 * n) = acc[ai][1][3][n]; } }
            }
            pin_n<N>(acc);
            { const f32x4 k0 = KC4(0, 0), k1 = KC4(1, 0), k2 = KC4(2, 0), kb = KC4(3, 0);
              conv_chain<0, N, 0, 4>(acc, k0, k1, k2, kb, sp[0], sp[1]);
              conv_chain<0, N, 4, 4>(acc, k0, k1, k2, kb, sp[2], sp[3]); }
            pin_n<N>(acc);
            { const f32x4 k0 = KC4(0, 1), k1 = KC4(1, 1), k2 = KC4(2, 1), kb = KC4(3, 1);
              conv_chain<1, N, 0, 4>(acc, k0, k1, k2, kb, sp[4], sp[5]);
              conv_chain<1, N, 4, 4>(acc, k0, k1, k2, kb, sp[6], sp[7]); }
        }
#undef KC4
        pin_n<N>(acc);
        asm volatile("" ::: "memory");
    }
    __device__ __forceinline__ void operator()(f32x4 (&acc)[2][2][4][2], const pg8::Unit& u, int wr, int wc, int fr, int fq, LAS unsigned char* elds) const {
        const int pm = u.pm, pn = u.pn;
        LAS f32x2* S = (LAS f32x2*)(elds + EPI_S);
        { const LAS unsigned char* csl = elds + EPI_CST + (32 * wc) * 4 + 32 * fq;
          f32x2 st[8];
#pragma unroll
          for (int j = 0; j < 8; ++j) st[j] = S[128 * (j >> 2) + 64 * wr + 16 * (j & 3) + fr];
#pragma unroll
          for (int bj = 0; bj < 2; ++bj)
#pragma unroll
              for (int n = 0; n < 2; ++n) { const f32x4 csv = *(const LAS f32x4*)(csl + (128 * bj + 4 * n) * 4), cbv = *(const LAS f32x4*)(csl + 1024 + (128 * bj + 4 * n) * 4);
#pragma unroll
                  for (int j = 0; j < 8; ++j) acc[j >> 2][bj][j & 3][n] = acc[j >> 2][bj][j & 3][n] * st[j].x + (csv * st[j].y + cbv); }
        }
        pin_half<0>(acc); pin_half<1>(acc);
        half<0>(acc, pm, pn, wr, wc, fr, fq, elds);
        half<1>(acc, pm, pn, wr, wc, fr, fq, elds);
        asm volatile("" : "+v"(fr), "+v"(fq));
        char* ab = (char*)((bf16_t*)(kargs()->ws + WS_ACT) + (size_t)(pm * 256 + 64 * wr) * FF + 128 * pn + 32 * wc);
        const unsigned la = (unsigned)((fr * FF + 8 * fq) * 2);
#pragma unroll
        for (int j = 0; j < 8; ++j) {
            const f32x4 g0 = acc[j >> 2][0][j & 3][0], v0 = acc[j >> 2][1][j & 3][0], g1 = acc[j >> 2][0][j & 3][1], v1 = acc[j >> 2][1][j & 3][1];
            u32x4 w; w.x = pk2(silu_mul(g0[0], v0[0]), silu_mul(g0[1], v0[1])); w.y = pk2(silu_mul(g0[2], v0[2]), silu_mul(g0[3], v0[3]));
            w.z = pk2(silu_mul(g1[0], v1[0]), silu_mul(g1[1], v1[1])); w.w = pk2(silu_mul(g1[2], v1[2]), silu_mul(g1[3], v1[3]));
            *(u32x4*)(ab + la + (unsigned)((128 * (j >> 2) + 16 * (j & 3)) * FF * 2)) = w;
        }
    }
};

template <bool FINAL> struct EpiRes {
    int pprev, pnew, gi, goff;
    template <int BJ>
    __device__ __forceinline__ void resid(f32x4 (&acc)[2][2][4][2], int pm, int pn, int wr, int wc, int fr, int fq, LAS f32x2* S, const LAS unsigned char* cst) const {
        asm volatile("" : "+v"(fr), "+v"(fq));
        const KA Params* q = kargs();
        const int ucol = 256 * pn + 128 * BJ + 32 * wc;
        const char* vb = (const char*)((const bf16_t*)(q->ws + WS_H1) + (size_t)(pm * 256 + 64 * wr) * D + ucol);
        const unsigned lv = (unsigned)((fr * D + 8 * fq) * 2), lq = (unsigned)(32 * fq);
        u32x4 vp[8];
#pragma unroll
        for (int j = 0; j < 8; ++j) vp[j] = *(const u32x4*)(vb + lv + (unsigned)((128 * (j >> 2) + 16 * (j & 3)) * D * 2));
        f32x4 gv[2], bv[2];
#pragma unroll
        for (int n = 0; n < 2; ++n) { gv[n] = *(const LAS f32x4*)(cst + (128 * BJ + 32 * wc + 4 * n) * 4 + lq) * ALPHA; bv[n] = *(const LAS f32x4*)(cst + 1024 + (128 * BJ + 32 * wc + 4 * n) * 4 + lq) * ALPHA; }
        const LAS f32x2* Sl = S + 64 * wr + fr;
#pragma unroll
        for (int j = 0; j < 8; ++j) { const f32x2 s = Sl[128 * (j >> 2) + 16 * (j & 3)];
#pragma unroll
            for (int n = 0; n < 2; ++n) { const unsigned lo2 = n == 0 ? vp[j].x : vp[j].z, hi2 = n == 0 ? vp[j].y : vp[j].w;
                f32x4 v; v[0] = bf2f(lo2 & 0xffffu); v[1] = bf2f(lo2 >> 16); v[2] = bf2f(hi2 & 0xffffu); v[3] = bf2f(hi2 >> 16);
                acc[j >> 2][BJ][j & 3][n] = (v * s.x + s.y) * gv[n] + bv[n] + acc[j >> 2][BJ][j & 3][n]; } }
        pin_half<BJ>(acc);
    }
    __device__ __forceinline__ void operator()(f32x4 (&acc)[2][2][4][2], const pg8::Unit& u, int wr, int wc, int fr, int fq, LAS unsigned char* elds) const {
        const int pm = u.pm, pn = u.pn;
        LAS f32x2* P = (LAS f32x2*)elds;
        LAS f32x2* S = (LAS f32x2*)(elds + EPI_S);
        resid<0>(acc, pm, pn, wr, wc, fr, fq, S, elds + EPI_CST);
        resid<1>(acc, pm, pn, wr, wc, fr, fq, S, elds + EPI_CST);
        asm volatile("" : "+v"(fr), "+v"(fq));
        const KA Params* q = kargs();
        char* ob = (char*)((bf16_t*)(q->ws + WS_H1) + (size_t)(pm * 256 + 64 * wr) * D + 256 * pn + 32 * wc); const unsigned lo = (unsigned)((fr * D + 8 * fq) * 2);
        LAS f32x2* Pl = P + (64 * wr + fr) * 4 + wc;
#pragma unroll
        for (int j = 0; j < 8; ++j) {
            const int ai = j >> 2, m = j & 3;
            float sum = 0.f;
#pragma unroll
            for (int bj = 0; bj < 2; ++bj)
#pragma unroll
                for (int n = 0; n < 2; ++n) { const f32x4 vn = acc[ai][bj][m][n]; sum += (vn[0] + vn[1]) + (vn[2] + vn[3]); }
            sum += __shfl_xor(sum, 16); sum += __shfl_xor(sum, 32);
            const float mw = sum * (1.0f / 64.0f); float qq = 0.f;
#pragma unroll
            for (int bj = 0; bj < 2; ++bj)
#pragma unroll
                for (int n = 0; n < 2; ++n) { const f32x4 d = acc[ai][bj][m][n] - mw; qq += (d[0] * d[0] + d[1] * d[1]) + (d[2] * d[2] + d[3] * d[3]); }
            qq += __shfl_xor(qq, 16); qq += __shfl_xor(qq, 32);
            if (fq == 0) { f32x2 t; t.x = mw; t.y = qq; Pl[(128 * ai + 16 * m) * 4] = t; }
            if (!FINAL) {
#pragma unroll
                for (int bj = 0; bj < 2; ++bj) { const f32x4 v0 = acc[ai][bj][m][0], v1 = acc[ai][bj][m][1];
                    u32x4 w; w.x = pk2(v0[0], v0[1]); w.y = pk2(v0[2], v0[3]); w.z = pk2(v1[0], v1[1]); w.w = pk2(v1[2], v1[3]);
                    *(u32x4*)(ob + lo + (unsigned)(((128 * ai + 16 * m) * D + 128 * bj) * 2)) = w; } }
        }
        asm volatile("s_waitcnt lgkmcnt(0)" ::: "memory"); __builtin_amdgcn_s_barrier(); asm volatile("" ::: "memory");
        int rl = threadIdx.x; asm volatile("" : "+v"(rl));
        unsigned long long* slots = (unsigned long long*)(q->ws + WS_PART) + (size_t)pnew * MROWS * 4 + (size_t)pm * 256 * 4;
        if (rl < 256) {
            const f32x2 a = P[rl * 4 + 0], b2 = P[rl * 4 + 1], c2 = P[rl * 4 + 2], d2 = P[rl * 4 + 3];
            const float mt = (a.x + b2.x + c2.x + d2.x) * 0.25f;
            const float da = a.x - mt, db = b2.x - mt, dc = c2.x - mt, dd = d2.x - mt;
            const float m2 = (a.y + b2.y) + (c2.y + d2.y) + 64.0f * ((da * da + db * db) + (dc * dc + dd * dd));
            if (!FINAL) { f32x2 r; r.x = mt; r.y = m2; *(f32x2*)((char*)slots + (unsigned)(rl * 32 + pn * 8)) = r; }
            else __hip_atomic_store(slots + rl * 4 + pn, ((unsigned long long)__builtin_bit_cast(unsigned, m2) << 32) | __builtin_bit_cast(unsigned, mt), __ATOMIC_RELAXED, __HIP_MEMORY_SCOPE_AGENT);
        }
        if (FINAL) {
            unsigned* xc = cnt_word(40 + pm);
            if (rl < 256) { asm volatile("s_waitcnt vmcnt(0)" ::: "memory"); if ((rl & 63) == 0) __hip_atomic_fetch_add(xc, 1u, __ATOMIC_RELAXED, __HIP_MEMORY_SCOPE_AGENT); }
            if (rl < 64) { unsigned sp = 0;
                while ((unsigned)__builtin_amdgcn_readfirstlane(__hip_atomic_load(xc, __ATOMIC_RELAXED, __HIP_MEMORY_SCOPE_AGENT)) < 16u) { __builtin_amdgcn_s_sleep(2); if (++sp > (1u << 22)) break; }
                __builtin_amdgcn_fence(__ATOMIC_ACQUIRE, "agent"); asm volatile("s_waitcnt vmcnt(0)" ::: "memory"); }
            asm volatile("" ::: "memory"); __builtin_amdgcn_s_barrier(); asm volatile("" ::: "memory");
            if (rl < 256) { float mt[4], m2[4]; float ms = 0.f;
#pragma unroll
                for (int t = 0; t < 4; ++t) { const unsigned long long w = __hip_atomic_load(slots + rl * 4 + t, __ATOMIC_RELAXED, __HIP_MEMORY_SCOPE_AGENT); mt[t] = __builtin_bit_cast(float, (unsigned)w); m2[t] = __builtin_bit_cast(float, (unsigned)(w >> 32)); ms += mt[t]; }
                const float mean = ms * 0.25f; float qv = 0.f;
#pragma unroll
                for (int t = 0; t < 4; ++t) { const float dm = mt[t] - mean; qv += m2[t] + 256.0f * dm * dm; }
                const float rstd = __builtin_amdgcn_rsqf(qv * (1.0f / 1024.0f) + LN_EPS);
                f32x2 t2; t2.x = rstd; t2.y = -mean * rstd; S[rl] = t2; }
            asm volatile("s_waitcnt lgkmcnt(0)" ::: "memory"); __builtin_amdgcn_s_barrier(); asm volatile("" ::: "memory");
            asm volatile("" : "+v"(fr), "+v"(fq));
            char* yb = (char*)(q->out + O_Y + (size_t)(pm * 256 + 128 * wr) * D + 256 * pn + 32 * wc); const unsigned ly = (unsigned)((8 * fr * D + 8 * fq) * 4);
            const LAS unsigned char* cst = elds + EPI_CST + 2048 + (32 * wc) * 4 + 32 * fq;
            const LAS f32x2* Sl = S + 64 * wr + fr;
#pragma unroll
            for (int bj = 0; bj < 2; ++bj)
#pragma unroll
                for (int n = 0; n < 2; ++n) { const f32x4 g2 = *(const LAS f32x4*)(cst + (128 * bj + 4 * n) * 4), b2 = *(const LAS f32x4*)(cst + 1024 + (128 * bj + 4 * n) * 4);
#pragma unroll
                    for (int j = 0; j < 8; ++j) { const f32x2 s = Sl[128 * (j >> 2) + 16 * (j & 3)];
                        *(f32x4*)(yb + ly + (unsigned)((j * D + 128 * bj + 4 * n) * 4)) = (acc[j >> 2][bj][j & 3][n] * s.x + s.y) * g2 + b2; } }
        }
    }
};

template <bool PROMPT> struct EpiIn {
    int dummy;
    template <int N>
    __device__ __forceinline__ void half(f32x4 (&acc)[2][2][4][2], int pm, int pn, int wr, int wc, int fr, int fq, LAS unsigned char* elds) const {
        asm volatile("" : "+v"(fr), "+v"(fq));
        const KA Params* q = kargs(); unsigned char* ws = q->ws;
        const int chunk = 2 * pm + wr, ucol = 128 * pn + 32 * wc + 4 * N;
        const unsigned lq = (unsigned)(32 * fq);
        const LAS unsigned char* kcl = elds + EPI_CST + 2048 + (32 * wc + 4 * N) * 4 + lq;
        f32x4 g2, g1;
#pragma unroll
        for (int e = 0; e < 4; ++e) { g2[e] = dpp_shr1(acc[1][0][2][N][e]); g1[e] = dpp_shr1(acc[1][0][3][N][e]); }
        if (fr == 0) { char* hf = (char*)((float*)(ws + WS_HF) + (size_t)chunk * 2 * D + ucol) + lq; *(f32x4*)(hf) = acc[0][0][0][N]; *(f32x4*)(hf + D * 4) = acc[0][0][1][N]; }
        if (fr == 15) { char* hl = (char*)((float*)(ws + WS_HL) + (size_t)chunk * 2 * D + ucol) + lq; *(f32x4*)(hl) = acc[1][0][2][N]; *(f32x4*)(hl + D * 4) = acc[1][0][3][N];
            if ((pm & 7) == 7 && wr == 1) { char* o = (char*)(q->out + O_CONV_P + (size_t)(pm >> 3) * 2 * D + ucol) + lq; *(f32x4*)(o) = acc[1][0][2][N]; *(f32x4*)(o + D * 4) = acc[1][0][3][N]; } }
        pin_group<0, N>(acc);
        { const f32x4 k0 = *(const LAS f32x4*)(kcl), k1 = *(const LAS f32x4*)(kcl + 1024), k2 = *(const LAS f32x4*)(kcl + 2048), kb = *(const LAS f32x4*)(kcl + 3072);
          conv_chain<0, N, 0, 8>(acc, k0, k1, k2, kb, g1, g2); }
        pin_group<0, N>(acc);
        asm volatile("" ::: "memory");
    }
    __device__ __forceinline__ void operator()(f32x4 (&acc)[2][2][4][2], const pg8::Unit& u, int wr, int wc, int fr, int fq, LAS unsigned char* elds) const {
        const int pm = u.pm, pn = u.pn; constexpr bool sample = !PROMPT;
        LAS f32x2* S = (LAS f32x2*)(elds + EPI_S);
        const KA Params* q = kargs(); unsigned char* ws = q->ws;
        { const LAS unsigned char* csl = elds + EPI_CST + (32 * wc) * 4 + 32 * fq;
          f32x2 st[8];
#pragma unroll
          for (int j = 0; j < 8; ++j) st[j] = S[128 * (j >> 2) + 64 * wr + 16 * (j & 3) + fr];
#pragma unroll
          for (int bj = 0; bj < 2; ++bj)
#pragma unroll
              for (int n = 0; n < 2; ++n) { const f32x4 csv = *(const LAS f32x4*)(csl + (128 * bj + 4 * n) * 4), cbv = *(const LAS f32x4*)(csl + 1024 + (128 * bj + 4 * n) * 4);
#pragma unroll
                  for (int j = 0; j < 8; ++j) acc[j >> 2][bj][j & 3][n] = acc[j >> 2][bj][j & 3][n] * st[j].x + (csv * st[j].y + cbv); } }
        pin_half<0>(acc); pin_half<1>(acc);
        asm volatile("" : "+v"(fr), "+v"(fq));
        const unsigned lr = (unsigned)((fr * D + 8 * fq) * 2);
        if (pn < 8 && !sample) {
            const char* bbp = (const char*)((const bf16_t*)(ws + WS_ACT) + (size_t)MROWS * D + (size_t)(pm * 256 + 64 * wr) * D + 128 * pn + 32 * wc);
            u32x4 vb[8];
#pragma unroll
            for (int j = 0; j < 8; ++j) vb[j] = *(const u32x4*)(bbp + lr + (unsigned)((128 * (j >> 2) + 16 * (j & 3)) * D * 2));
#pragma unroll
            for (int j = 0; j < 8; ++j) { acc[j >> 2][0][j & 3][0] = acc[j >> 2][0][j & 3][0] * acc[j >> 2][1][j & 3][0]; acc[j >> 2][0][j & 3][1] = acc[j >> 2][0][j & 3][1] * acc[j >> 2][1][j & 3][1]; }
            pin_half<0>(acc);
            half<0>(acc, pm, pn, wr, wc, fr, fq, elds);
            half<1>(acc, pm, pn, wr, wc, fr, fq, elds);
            asm volatile("" : "+v"(fr), "+v"(fq));
            char* ob = (char*)((bf16_t*)kargs()->out + (size_t)(pm * 256 + 64 * wr) * D + 128 * pn + 32 * wc);
            const unsigned lo = (unsigned)((fr * D + 8 * fq) * 2);
#pragma unroll
            for (int j = 0; j < 8; ++j) { const f32x4 z0 = acc[j >> 2][0][j & 3][0], z1 = acc[j >> 2][0][j & 3][1]; const u32x4 b = vb[j];
                u32x4 w; w.x = pk2(bf2f(b.x & 0xffffu) * z0[0], bf2f(b.x >> 16) * z0[1]); w.y = pk2(bf2f(b.y & 0xffffu) * z0[2], bf2f(b.y >> 16) * z0[3]);
                w.z = pk2(bf2f(b.z & 0xffffu) * z1[0], bf2f(b.z >> 16) * z1[1]); w.w = pk2(bf2f(b.w & 0xffffu) * z1[2], bf2f(b.w >> 16) * z1[3]);
                *(u32x4*)(ob + lo + (unsigned)((128 * (j >> 2) + 16 * (j & 3)) * D * 2)) = w; }
        } else if (pn < 8) {
            char* ub = sample ? (char*)((bf16_t*)(ws + WS_SU) + (size_t)((pm - NPANEL_P) * 256 + 64 * wr) * D + 128 * pn + 32 * wc)
                              : (char*)((bf16_t*)(ws + WS_ACT) + (size_t)(pm * 256 + 64 * wr) * D + 128 * pn + 32 * wc);
#pragma unroll
            for (int j = 0; j < 8; ++j) { const int ai = j >> 2, m = j & 3; const f32x4 u0 = acc[ai][0][m][0] * acc[ai][1][m][0], u1 = acc[ai][0][m][1] * acc[ai][1][m][1];
                u32x4 w; w.x = pk2(u0[0], u0[1]); w.y = pk2(u0[2], u0[3]); w.z = pk2(u1[0], u1[1]); w.w = pk2(u1[2], u1[3]); *(u32x4*)(ub + lr + (unsigned)((128 * ai + 16 * m) * D * 2)) = w;
                if (sample) { if (m >= 2) { const int seq = 64 * (pm - NPANEL_P) + 32 * wr + 2 * fr + ai; float* o = q->out + O_CONV_S + ((size_t)seq * 2 + (m - 2)) * D + 128 * pn + 32 * wc + 8 * fq; *(f32x4*)o = u0; *(f32x4*)(o + 4) = u1; } }
                else if ((pm & 7) == 7 && wr == 1 && fr == 15 && j >= 6) { float* o = q->out + O_CONV_P + ((size_t)(pm >> 3) * 2 + (j - 6)) * D + 128 * pn + 32 * wc + 8 * fq; *(f32x4*)o = u0; *(f32x4*)(o + 4) = u1; } }
        } else {
            char* bb = sample ? (char*)((bf16_t*)(ws + WS_SB) + (size_t)((pm - NPANEL_P) * 256 + 64 * wr) * D + 256 * (pn - 8) + 32 * wc)
                              : (char*)((bf16_t*)(ws + WS_ACT) + (size_t)MROWS * D + (size_t)(pm * 256 + 64 * wr) * D + 256 * (pn - 8) + 32 * wc);
#pragma unroll
            for (int bj = 0; bj < 2; ++bj)
#pragma unroll
                for (int j = 0; j < 8; ++j) { const int ai = j >> 2, m = j & 3; const f32x4 v0 = acc[ai][bj][m][0], v1 = acc[ai][bj][m][1];
                    u32x4 w; w.x = pk2(v0[0], v0[1]); w.y = pk2(v0[2], v0[3]); w.z = pk2(v1[0], v1[1]); w.w = pk2(v1[2], v1[3]); *(u32x4*)(bb + lr + (unsigned)(((128 * ai + 16 * m) * D + 128 * bj) * 2)) = w; }
            asm volatile("s_waitcnt vmcnt(0)" ::: "memory");
        }
    }
};

struct EpiPartial {
    __device__ __forceinline__ void operator()(f32x4 (&acc)[2][2][4][2], const pg8::UnitD& u) const {
        const int tid = tid_fresh();
        char* pb = (char*)(kargs()->ws + WS_PBUF) + (size_t)((((u.pm() - NPANEL_P) * 4 + u.pn()) * 4 + u.ks()) * 32) * 8192;
#pragma unroll
        for (int ai = 0; ai < 2; ++ai)
#pragma unroll
            for (int bj = 0; bj < 2; ++bj)
#pragma unroll
                for (int m = 0; m < 4; ++m)
#pragma unroll
                    for (int n = 0; n < 2; ++n) *(f32x4*)(pb + (unsigned)(((((ai * 2 + bj) * 4 + m) * 2 + n) * 512 + tid) * 16)) = acc[ai][bj][m][n];
    }
};
__device__ __forceinline__ int C_UP(int l, int p) { return l * 16 + p; }
__device__ __forceinline__ int C_DNS(int l, int p, int pn) { return l * 16 + 2 + p * 4 + pn; }
__device__ __forceinline__ int C_FIN(int l, int p) { return l * 16 + 10 + p; }
__device__ __forceinline__ int C_OUT(int p) { return 32 + p; }
__device__ __forceinline__ void dep_wait(int idx, unsigned want) {
    int tid = tid_fresh();
    if (tid < 64) {
        unsigned* w = cnt_word(idx); unsigned sp = 0;
        while ((unsigned)__builtin_amdgcn_readfirstlane(__hip_atomic_load(w, __ATOMIC_RELAXED, __HIP_MEMORY_SCOPE_AGENT)) < want) { __builtin_amdgcn_s_sleep(2); if (++sp > (1u << 22)) break; }
        __builtin_amdgcn_fence(__ATOMIC_ACQUIRE, "agent");
        asm volatile("s_waitcnt vmcnt(0)" ::: "memory");
    }
    asm volatile("" ::: "memory"); __builtin_amdgcn_s_barrier(); asm volatile("" ::: "memory");
}
__device__ __forceinline__ void unit_signal(int idx) {
    asm volatile("s_waitcnt vmcnt(0)" ::: "memory"); __builtin_amdgcn_s_barrier(); asm volatile("" ::: "memory");
    if (tid_fresh() == 0) { __builtin_amdgcn_fence(__ATOMIC_RELEASE, "agent"); asm volatile("s_waitcnt vmcnt(0)" ::: "memory");
        __hip_atomic_fetch_add(cnt_word(idx), 1u, __ATOMIC_RELAXED, __HIP_MEMORY_SCOPE_AGENT); }
}

__device__ __forceinline__ void epi_prefetch(int kind, int pm, int pn, LAS unsigned char* elds, int wid, int lane) {
    if (kind == pg8::K_DNS0 || kind == pg8::K_DNS1) return;
    const KA Params* q = kargs(); unsigned char* ws = q->ws;
    const int bank = (kind == pg8::K_UP0 || kind == pg8::K_DN0) ? 0 : ((kind == pg8::K_UP1 || kind == pg8::K_DN1) ? 2 : 1);
    const char* pp = (const char*)(ws + WS_PART) + ((size_t)bank * MROWS * 4 + (size_t)pm * 256 * 4) * 8 + wid * 1024 + lane * 16;
    __builtin_amdgcn_global_load_lds((const unsigned*)pp, (LAS unsigned*)(elds + EPI_PART + wid * 1024), 16, 0, 0);
    const float* cp = nullptr;
    if (kind == pg8::K_UP0 || kind == pg8::K_UP1) { const int l = kind - pg8::K_UP0;
        if (wid < 2) cp = (const float*)(ws + (wid == 0 ? WS_CS_UP : WS_CB_UP)) + l * FF2 + 256 * pn;
        else if (wid < 6) cp = (const float*)(ws + WS_KC_UP) + ((size_t)l * 4 + (wid - 2)) * FF2 + 256 * pn; }
    else if (kind == pg8::K_IN) { if (wid < 2) cp = (const float*)(ws + (wid == 0 ? WS_CS_IN : WS_CB_IN)) + 256 * pn;
        else if (wid < 6 && pn < 8) { if (lane < 32) __builtin_amdgcn_global_load_lds((const unsigned*)((const char*)((wid < 5 ? q->in[10] + (wid - 2) * D : q->in[11]) + 128 * pn) + lane * 16), (LAS unsigned*)(elds + EPI_CST + wid * 1024), 16, 0, 0); } }
    else { if (wid < 2) { const int gi = kind == pg8::K_OUT ? 17 : 5, goff = kind == pg8::K_DN1 ? D : 0; cp = q->in[gi + wid] + goff + 256 * pn; }
           else if (wid < 4 && kind == pg8::K_DN1) cp = q->in[17 + (wid - 2)] + D + 256 * pn; }
    if (cp) __builtin_amdgcn_global_load_lds((const unsigned*)((const char*)cp + lane * 16), (LAS unsigned*)(elds + EPI_CST + wid * 1024), 16, 0, 0);
}

namespace pg8 {
__device__ __forceinline__ void unit_gemm(const UnitD& u, const char*& cA, const char*& cB, int& Kf, int& nt) {
    const KA Params* q = kargs(); unsigned char* ws = q->ws;
    const int kind = u.kind(), pm = u.pm(), pn = u.pn(), ks = u.ks();
    switch (kind) {
    case K_UP0: case K_UP1: Kf = D; nt = 16; cA = (const char*)(ws + WS_H1) + (size_t)pm * 256 * D * 2; cB = (const char*)(ws + WS_WUP) + ((size_t)(kind - K_UP0) * FF2 + (size_t)pn * 256) * D * 2; break;
    case K_DN0: case K_DN1: Kf = FF; nt = 44; cA = (const char*)(ws + WS_ACT) + (size_t)pm * 256 * FF * 2; cB = (const char*)(ws + WS_WDN) + ((size_t)(kind - K_DN0) * D + (size_t)pn * 256) * FF * 2; break;
    case K_DNS0: case K_DNS1: { const int k0 = ks < 2 ? ks * 768 : 1536 + (ks - 2) * 640; Kf = FF; nt = ks < 2 ? 12 : 10;
        cA = (const char*)(ws + WS_ACT) + ((size_t)pm * 256 * FF + k0) * 2; cB = (const char*)(ws + WS_WDN) + (((size_t)(kind - K_DNS0) * D + (size_t)pn * 256) * FF + k0) * 2; break; }
    case K_IN: Kf = D; nt = 16; cA = (const char*)(ws + WS_H1) + (size_t)pm * 256 * D * 2; cB = (const char*)(ws + WS_WIN) + (size_t)pn * 256 * D * 2; break;
    default: Kf = D; nt = 16; cA = (const char*)q->out + (size_t)pm * 256 * D * 2; cB = (const char*)(ws + WS_WOUT) + (size_t)pn * 256 * D * 2; break;
    }
}
template <int KINDS, bool MIXK, class Sched>
__device__ __forceinline__ void gemm_stream(LAS unsigned char* lds, const Sched& S) {
    const int tid = tid_fresh(), wid = __builtin_amdgcn_readfirstlane(tid >> 6), lane = tid & 63, wr = wid >> 2, wc = wid & 3, fr = lane & 15, fq = lane >> 4;
    int Rs[2], Cs[2];
#pragma unroll
    for (int i = 0; i < 2; ++i) stage_rc(tid * 16 + i * 8192, Rs[i], Cs[i]);
    const size_t kstep = (size_t)(BK * 2);
    const unsigned ldsw = (unsigned)wid * 1024u;
    const int aoff = lds_byte(wr * 64 + fr, fq * 8), boff = lds_byte(wc * 32 + fr, fq * 8);
#define PG8_SA(b, h) (((b) * 2 + (h)) * HTB)
#define PG8_SB(b, h) ((4 + (b) * 2 + (h)) * HTB)
#define PG8_STAGE(bufoff, gbase, vo) do { _Pragma("unroll") for (int _i = 0; _i < 2; ++_i) \
        __builtin_amdgcn_global_load_lds((const unsigned*)((const char*)(gbase) + (vo)[_i]), (LAS unsigned*)(lds + (bufoff) + ldsw + _i * 8192), 16, 0, 0); } while (0)
#define PG8_LDA(dst, b, h) do { _Pragma("unroll") for (int m = 0; m < 4; ++m) _Pragma("unroll") for (int k = 0; k < 2; ++k) dst[m][k] = *(const LAS bf16x8*)(lds + PG8_SA(b, h) + aoff + m * 2048 + k * 1024); } while (0)
#define PG8_LDB(dst, b, h) do { _Pragma("unroll") for (int n = 0; n < 2; ++n) _Pragma("unroll") for (int k = 0; k < 2; ++k) dst[n][k] = *(const LAS bf16x8*)(lds + PG8_SB(b, h) + boff + n * 2048 + k * 1024); } while (0)
#define PG8_MMA(ai, bj, At, Bt) do { __builtin_amdgcn_s_setprio(1); _Pragma("unroll") for (int m = 0; m < 4; ++m) _Pragma("unroll") for (int n = 0; n < 2; ++n) _Pragma("unroll") for (int k = 0; k < 2; ++k) \
        acc[ai][bj][m][n] = __builtin_amdgcn_mfma_f32_16x16x32_bf16(Bt[n][k], At[m][k], acc[ai][bj][m][n], 0, 0, 0); __builtin_amdgcn_s_setprio(0); } while (0)
#define PG8_WAIT_V(n) asm volatile("s_waitcnt vmcnt(" #n ")" ::: "memory")
#define PG8_WAIT_L(n) asm volatile("s_waitcnt lgkmcnt(" #n ")" ::: "memory")
#define PG8_BAR __builtin_amdgcn_s_barrier()
#define PG8_SCHED __builtin_amdgcn_sched_barrier(0)
    constexpr int M_DNS_ = (1 << K_DNS0) | (1 << K_DNS1);
    UnitD cur, nxt; int ui = 0;
    if (!S.next(0, cur)) return;
    const char* cA; const char* cB; int KfC, ntC; unit_gemm(cur, cA, cB, KfC, ntC);
    unsigned voffC[2], voffN[2];
#pragma unroll
    for (int i = 0; i < 2; ++i) { voffC[i] = (unsigned)(Rs[i] * KfC + Cs[i]) * 2u; voffN[i] = voffC[i]; }
    size_t hstepC = (size_t)HALF * KfC * 2, hstepN = hstepC;
    f32x4 acc[2][2][4][2];
#pragma unroll
    for (int a = 0; a < 2; ++a)
#pragma unroll
        for (int b = 0; b < 2; ++b)
#pragma unroll
            for (int m = 0; m < 4; ++m)
#pragma unroll
                for (int n = 0; n < 2; ++n) acc[a][b][m][n] = (f32x4){0.f, 0.f, 0.f, 0.f};
    bf16x8 At[4][2], B0[2][2], B1[2][2];
    if (cur.dep() >= 0) dep_wait(cur.dep(), cur.want());
    PG8_STAGE(PG8_SB(0, 0), cB, voffC); PG8_STAGE(PG8_SB(0, 1), cB + hstepC, voffC); PG8_STAGE(PG8_SA(0, 0), cA, voffC); PG8_STAGE(PG8_SA(0, 1), cA + hstepC, voffC);
    if (wr == 1) PG8_BAR;
    PG8_WAIT_V(2); PG8_BAR;
    PG8_STAGE(PG8_SB(1, 0), cB + kstep, voffC); PG8_STAGE(PG8_SA(1, 0), cA + kstep, voffC); PG8_STAGE(PG8_SB(1, 1), cB + hstepC + kstep, voffC);
    PG8_WAIT_V(6); PG8_BAR;
    for (;;) {
        const bool has_next = S.next(ui + 1, nxt);
        const char* nA = cA; const char* nB = cB; int KfN = KfC, ntN = ntC;
        if (has_next) unit_gemm(nxt, nA, nB, KfN, ntN);
        if (MIXK) {
#pragma unroll
            for (int i = 0; i < 2; ++i) voffN[i] = (unsigned)(Rs[i] * KfN + Cs[i]) * 2u;
            hstepN = (size_t)HALF * KfN * 2; }
        for (int t = 0; t < ntC; t += 2) {
            const bool last = (t == ntC - 2);
            const char* a1 = cA + (size_t)(t + 1) * kstep;
            const char* a2 = last ? nA : cA + (size_t)(t + 2) * kstep; const char* b2 = last ? nB : cB + (size_t)(t + 2) * kstep;
            const char* a3 = a2 + kstep; const char* b3 = b2 + kstep;
            unsigned vo2[2]; size_t hs2 = hstepC;
#pragma unroll
            for (int i = 0; i < 2; ++i) vo2[i] = voffC[i];
            if (MIXK) { if (last) {
#pragma unroll
                for (int i = 0; i < 2; ++i) vo2[i] = voffN[i];
                hs2 = hstepN; } }
            if (last && has_next && nxt.dep() >= 0) dep_wait(nxt.dep(), nxt.want());
            if (t == 2) epi_prefetch(cur.kind(), cur.pm(), cur.pn(), lds + EPI_OFF, wid, lane);
            PG8_LDB(B0, 0, 0); PG8_LDB(B1, 0, 1); PG8_SCHED; PG8_LDA(At, 0, 0); PG8_STAGE(PG8_SA(1, 1), a1 + hstepC, voffC);
            PG8_WAIT_V(8); PG8_WAIT_L(0); PG8_BAR; PG8_MMA(0, 0, At, B0); PG8_MMA(0, 1, At, B1); PG8_BAR; PG8_SCHED;
            PG8_LDA(At, 0, 1); PG8_STAGE(PG8_SB(0, 0), b2, vo2); PG8_STAGE(PG8_SB(0, 1), b2 + hs2, vo2); PG8_STAGE(PG8_SA(0, 0), a2, vo2);
            PG8_WAIT_V(8); PG8_WAIT_L(0); PG8_BAR; PG8_MMA(1, 0, At, B0); PG8_MMA(1, 1, At, B1); PG8_BAR; PG8_SCHED;
            PG8_LDB(B0, 1, 0); PG8_LDB(B1, 1, 1); PG8_SCHED; PG8_LDA(At, 1, 0); PG8_STAGE(PG8_SA(0, 1), a2 + hs2, vo2);
            PG8_WAIT_V(8); PG8_WAIT_L(0); PG8_BAR; PG8_MMA(0, 0, At, B0); PG8_MMA(0, 1, At, B1); PG8_BAR; PG8_SCHED;
            PG8_LDA(At, 1, 1); PG8_STAGE(PG8_SB(1, 0), b3, vo2); PG8_STAGE(PG8_SB(1, 1), b3 + hs2, vo2); PG8_STAGE(PG8_SA(1, 0), a3, vo2);
            PG8_WAIT_V(8); PG8_WAIT_L(0); PG8_BAR; PG8_MMA(1, 0, At, B0); PG8_MMA(1, 1, At, B1); PG8_BAR; PG8_SCHED;
        }
        if (wr == 0) {
            if (!((KINDS & M_DNS_) && (cur.kind() == K_DNS0 || cur.kind() == K_DNS1))) { stats_compute(lds + EPI_OFF); PG8_WAIT_L(0); }
            PG8_BAR; }
        { int fr_e = fr, fq_e = fq; asm volatile("" : "+v"(fr_e), "+v"(fq_e));
          const int ck = cur.kind(); const Unit uu{cur.pm(), cur.pn()}; LAS unsigned char* elds = lds + EPI_OFF;
          if ((KINDS & ((1 << K_UP0) | (1 << K_UP1))) && (ck == K_UP0 || ck == K_UP1)) { EpiUp E{ck - K_UP0}; E(acc, uu, wr, wc, fr_e, fq_e, elds); }
          if ((KINDS & (1 << K_DN0)) && ck == K_DN0) { EpiRes<false> E{0, 1, 5, 0}; E(acc, uu, wr, wc, fr_e, fq_e, elds); }
          if ((KINDS & (1 << K_DN1)) && ck == K_DN1) { EpiRes<true> E{2, 0, 5, D}; E(acc, uu, wr, wc, fr_e, fq_e, elds); }
          if ((KINDS & (1 << K_IN)) && ck == K_IN) { EpiIn<((KINDS >> 8) & 1) != 0> E{0}; E(acc, uu, wr, wc, fr_e, fq_e, elds); }
          if ((KINDS & (1 << K_OUT)) && ck == K_OUT) { EpiRes<false> E{1, 2, 17, 0}; E(acc, uu, wr, wc, fr_e, fq_e, elds); }
          if ((KINDS & ((1 << K_DNS0) | (1 << K_DNS1))) && (ck == K_DNS0 || ck == K_DNS1)) { EpiPartial E; E(acc, cur); }
          if (cur.sig() >= 0) unit_signal(cur.sig()); }
        if (!has_next) break;
#pragma unroll
        for (int a = 0; a < 2; ++a)
#pragma unroll
            for (int b = 0; b < 2; ++b)
#pragma unroll
                for (int m = 0; m < 4; ++m)
#pragma unroll
                    for (int n = 0; n < 2; ++n) acc[a][b][m][n] = (f32x4){0.f, 0.f, 0.f, 0.f};
        cur = nxt; cA = nA; cB = nB; KfC = KfN; ntC = ntN; ++ui;
        if (MIXK) {
#pragma unroll
            for (int i = 0; i < 2; ++i) voffC[i] = voffN[i];
            hstepC = hstepN; }
        if (wr == 1) PG8_BAR;
    }
    PG8_WAIT_V(0);
    PG8_BAR;
#undef PG8_SA
#undef PG8_SB
#undef PG8_STAGE
#undef PG8_LDA
#undef PG8_LDB
#undef PG8_MMA
#undef PG8_WAIT_V
#undef PG8_WAIT_L
#undef PG8_BAR
#undef PG8_SCHED
}
struct SchedSimple {
    int kind, nM, nN, G, c;
    __device__ __forceinline__ bool next(int i, UnitD& u) const {
        const long L = (long)i * G + c; if (L >= (long)nM * nN) return false;
        int pm, pn; map_unit((int)L, nM, nN, pm, pn); u.set(kind, pm, pn, 0, -1, 0, -1); return true; }
};
struct SchedIn {
    int c;
    __device__ __forceinline__ bool next(int i, UnitD& u) const {
        if (i >= 3) return false;
        const int idx = c >> 3, pm = 8 * (c & 7) + (idx & 7), cb = idx >> 3;
        u.set(K_IN, pm, i == 0 ? 8 + cb : 2 * cb + (i - 1), 0, -1, 0, -1); return true; }
};
struct SchedUp {
    int l, c, first, count;
    __device__ __forceinline__ int guest(UnitD& g) const {
        const int lc = c - 128; if (lc < 0) return -1;
        if (l == 0) {
            if (lc < 44) { g.set(K_UP0, NPANEL_P + lc / 22, lc % 22, 0, -1, 0, C_UP(0, lc / 22)); return 0; }
            if (lc < 76) { const int ix = lc - 44, p = ix >> 4, pn = (ix >> 2) & 3; g.set(K_DNS0, NPANEL_P + p, pn, ix & 3, C_UP(0, p), 22, C_DNS(0, p, pn)); return 2; }
            if (lc < 84) return -1;
            if (lc < 108) { const int ix = lc - 84, p = ix / 12; g.set(K_IN, NPANEL_P + p, ix % 12, 0, C_FIN(0, p), 4, -1); return 5; }
            return -1;
        }
        if (lc < 8) { g.set(K_OUT, NPANEL_P + (lc >> 2), lc & 3, 0, -1, 0, C_OUT(lc >> 2)); return 0; }
        if (lc < 52) { const int ix = lc - 8, p = ix / 22; g.set(K_UP1, NPANEL_P + p, ix % 22, 0, C_OUT(p), 4, C_UP(1, p)); return 2; }
        if (lc < 84) { const int ix = lc - 52, p = ix >> 4, pn = (ix >> 2) & 3; g.set(K_DNS1, NPANEL_P + p, pn, ix & 3, C_UP(1, p), 22, C_DNS(1, p, pn)); return 4; }
        return -1;
    }
    __device__ __forceinline__ bool next(int i, UnitD& u) const {
        if (i >= count) return false;
        const int pos = first + i; int ip = pos;
        UnitD g; const int gpos = guest(g);
        if (gpos >= 0) { if (pos == gpos) { u = g; return true; } if (pos > gpos) ip = pos - 1; }
        int L = ip * 256 + c;
        if (L >= NPANEL_P * 22) {
            const int lc = c - 128, xlo = l == 0 ? 108 : 92, flo = l == 0 ? 76 : 84;
            if (pos == 5 && lc >= xlo && lc < xlo + 8) L = 4 * 256 + 128 + flo + (lc - xlo); else return false; }
        int pm, pn; map_unit(L, NPANEL_P, 22, pm, pn); u.set(l == 0 ? K_UP0 : K_UP1, pm, pn, 0, -1, 0, -1); return true; }
};
}

template <int L_> __device__ __forceinline__ void finisher(LAS unsigned char* lds, int p, int pn) {
    dep_wait(C_DNS(L_, p, pn), 4u);
    const int tid = tid_fresh(), wid = __builtin_amdgcn_readfirstlane(tid >> 6), lane = tid & 63, wr = wid >> 2, wc = wid & 3, fr = lane & 15, fq = lane >> 4;
    f32x4 acc[2][2][4][2];
    const char* pb = (const char*)(kargs()->ws + WS_PBUF) + (size_t)(((p * 4 + pn) * 4) * 32) * 8192;
#pragma unroll
    for (int ai = 0; ai < 2; ++ai)
#pragma unroll
        for (int bj = 0; bj < 2; ++bj)
#pragma unroll
            for (int m = 0; m < 4; m += 2) {
#pragma unroll
                for (int mm = 0; mm < 2; ++mm)
#pragma unroll
                    for (int n = 0; n < 2; ++n) { const unsigned o = (unsigned)(((((ai * 2 + bj) * 4 + m + mm) * 2 + n) * 512 + tid) * 16);
                        acc[ai][bj][m + mm][n] = (*(const f32x4*)(pb + o) + *(const f32x4*)(pb + o + 262144u)) + (*(const f32x4*)(pb + o + 2u * 262144u) + *(const f32x4*)(pb + o + 3u * 262144u)); }
                asm volatile("" : "+v"(acc[ai][bj][m][0]), "+v"(acc[ai][bj][m][1]), "+v"(acc[ai][bj][m + 1][0]), "+v"(acc[ai][bj][m + 1][1]) :: "memory"); }
    epi_prefetch(L_ == 0 ? pg8::K_DN0 : pg8::K_DN1, NPANEL_P + p, pn, lds + EPI_OFF, wid, lane);
    asm volatile("s_waitcnt vmcnt(0)" ::: "memory"); __syncthreads();
    stats_from_lds(lds + EPI_OFF);
    const pg8::Unit uu{NPANEL_P + p, pn};
    if (L_ == 0) { EpiRes<false> E{0, 1, 5, 0}; E(acc, uu, wr, wc, fr, fq, lds + EPI_OFF); unit_signal(C_FIN(0, p)); }
    else { EpiRes<true> E{2, 0, 5, D}; E(acc, uu, wr, wc, fr, fq, lds + EPI_OFF); }
    asm volatile("s_waitcnt vmcnt(0) lgkmcnt(0)" ::: "memory"); __syncthreads();
}

__device__ __forceinline__ void p0_item(const float* W, int K, int N, int kb, int nb, bf16_t* WT, int dest_row0, const float* rowscale, const float* colscale,
                                        float* csp, const float* bvec, float* cbp, int pstride, LAS float* scr, int lane, bool perm = false) {
    const int k0 = 64 * kb, n0 = 32 * nb;
    { f32x4 t[8];
#pragma unroll
      for (int i = 0; i < 8; ++i) t[i] = __builtin_nontemporal_load((const f32x4*)(W + (size_t)(k0 + 8 * i + (lane >> 3)) * N + n0 + 4 * (lane & 7)));
#pragma unroll
      for (int i = 0; i < 8; ++i) { LAS float* d = scr + (8 * i + (lane >> 3)) * 33 + 4 * (lane & 7); d[0] = t[i][0]; d[1] = t[i][1]; d[2] = t[i][2]; d[3] = t[i][3]; } }
    asm volatile("s_waitcnt lgkmcnt(0)" ::: "memory");
    const int c = lane & 7;
    float rs[8], bb[8];
#pragma unroll
    for (int i = 0; i < 8; ++i) { rs[i] = rowscale ? rowscale[k0 + 8 * c + i] : 1.0f; bb[i] = bvec ? bvec[k0 + 8 * c + i] : 0.0f; }
#pragma unroll
    for (int j = 0; j < 4; ++j) { const int n = (lane >> 3) + 8 * j; const LAS float* s = scr + (8 * c) * 33 + n;
        const float sc = colscale ? colscale[n0 + n] : 1.0f;
        unsigned r[8]; float ps = 0.f, pb = 0.f;
#pragma unroll
        for (int i = 0; i < 8; ++i) { const float w = s[i * 33]; r[i] = f2bf(w * rs[i] * sc); ps += bf2f(r[i]); pb += w * bb[i]; }
        u32x4 o; o.x = r[0] | (r[1] << 16); o.y = r[2] | (r[3] << 16); o.z = r[4] | (r[5] << 16); o.w = r[6] | (r[7] << 16);
        const int np = perm ? 16 * ((n >> 2) & 1) + 4 * (n >> 3) + (n & 3) : n;
        *(u32x4*)(WT + (size_t)(dest_row0 + np) * K + k0 + 8 * c) = o;
        if (csp) {
            ps += __shfl_xor(ps, 1); ps += __shfl_xor(ps, 2); ps += __shfl_xor(ps, 4);
            pb += __shfl_xor(pb, 1); pb += __shfl_xor(pb, 2); pb += __shfl_xor(pb, 4);
            if (c == 0) { csp[(size_t)kb * pstride + dest_row0 + n] = ps; cbp[(size_t)kb * pstride + dest_row0 + n] = pb; }
        }
    }
    asm volatile("s_waitcnt lgkmcnt(0)" ::: "memory");
}
__device__ __forceinline__ int up_dest(int n) { return n < FF ? 256 * (n >> 7) + (n & 127) : 256 * ((n - FF) >> 7) + 128 + ((n - FF) & 127); }
__device__ __forceinline__ int in_dest(int n) { return n < D ? 2048 + n : (n < 2 * D ? 256 * ((n - D) >> 7) + ((n - D) & 127) : 256 * ((n - 2 * D) >> 7) + 128 + ((n - 2 * D) & 127)); }

__device__ __forceinline__ void phase0(LAS unsigned char* lds) {
    const KA Params* q = kargs();
    const int tid = tid_fresh(), lane = tid & 63, wave = tid >> 6;
    LAS float* scr = (LAS float*)(lds + wave * 8704);
    const int gw = blockIdx.x * 8 + wave, NGW = gridDim.x * 8;
    unsigned char* ws = q->ws;
    constexpr int I_UP = 16 * 176, I_IN = 16 * 96, I_OUT = 16 * 32, I_DN = 44 * 32, I_POOL = 4 * 8;
    constexpr int NITEMS = 2 * I_UP + I_IN + I_OUT + 2 * I_DN + 4 * I_POOL;
    for (int it = gw; it < NITEMS; it += NGW) {
        int r = it;
        if (r < 2 * I_UP) { const int l = r / I_UP; r -= l * I_UP; const int kb = r / 176, nb = r % 176;
            p0_item(q->in[13] + (size_t)l * D * FF2, D, FF2, kb, nb, (bf16_t*)(ws + WS_WUP) + (size_t)l * FF2 * D, up_dest(32 * nb), q->in[5] + l * D, nullptr,
                    (float*)(ws + WS_CSP_UP) + (size_t)l * 16 * FF2, q->in[6] + l * D, (float*)(ws + WS_CBP_UP) + (size_t)l * 16 * FF2, FF2, scr, lane, true); continue; }
        r -= 2 * I_UP;
        if (r < I_IN) { const int kb = r / 96, nb = r % 96;
            p0_item(q->in[9], D, 3 * D, kb, nb, (bf16_t*)(ws + WS_WIN), in_dest(32 * nb), q->in[17], nullptr, (float*)(ws + WS_CSP_IN), q->in[18], (float*)(ws + WS_CBP_IN), 3 * D, scr, lane, true); continue; }
        r -= I_IN;
        if (r < I_OUT) { const int kb = r / 32, nb = r % 32;
            p0_item(q->in[12], D, D, kb, nb, (bf16_t*)(ws + WS_WOUT), 32 * nb, nullptr, nullptr, nullptr, nullptr, nullptr, 0, scr, lane, true); continue; }
        r -= I_OUT;
        if (r < 2 * I_DN) { const int l = r / I_DN; r -= l * I_DN; const int kb = r / 32, nb = r % 32;
            p0_item(q->in[16] + (size_t)l * FF * D, FF, D, kb, nb, (bf16_t*)(ws + WS_WDN) + (size_t)l * D * FF, 32 * nb, nullptr, nullptr, nullptr, nullptr, nullptr, 0, scr, lane, true); continue; }
        r -= 2 * I_DN;
        { const int g = r / I_POOL; r -= g * I_POOL; const int kb = r / 8, nb = r % 8;
            p0_item(q->in[7] + (size_t)g * 256 * 256, 256, 256, kb, nb, (bf16_t*)(ws + WS_WPOOL) + (size_t)g * 256 * 256, 32 * nb, nullptr, q->in[8] + g * 256, nullptr, nullptr, nullptr, 0, scr, lane, true); }
    }
    const int gt = blockIdx.x * 512 + tid, NGT = gridDim.x * 512;
    for (int i = gt; i < 2 * FF2; i += NGT) { const int l = i / FF2, n = i % FF2, d = up_dest(n); float* kc = (float*)(ws + WS_KC_UP) + (size_t)l * 4 * FF2;
        kc[d] = q->in[14][(size_t)(l * 3 + 0) * FF2 + n]; kc[FF2 + d] = q->in[14][(size_t)(l * 3 + 1) * FF2 + n]; kc[2 * FF2 + d] = q->in[14][(size_t)(l * 3 + 2) * FF2 + n]; kc[3 * FF2 + d] = q->in[15][(size_t)l * FF2 + n]; }
    for (int i = gt; i < NB_P * 15 * (D / 4); i += NGT) { const int c4 = i % (D / 4), rr = (i / (D / 4)) % 15, b = i / (15 * (D / 4));
        ((f32x4*)(q->out + O_POOL_P))[i] = *(const f32x4*)(q->in[0] + ((size_t)b * SEQ + 2033 + rr) * D + c4 * 4); }
    for (int i = gt; i < NB_S * 15 * (D / 4); i += NGT) { const int c4 = i % (D / 4), rr = (i / (D / 4)) % 15, s = i / (15 * (D / 4));
        ((f32x4*)(q->out + O_POOL_S))[i] = rr < 11 ? *(const f32x4*)(q->in[2] + ((size_t)s * 15 + 4 + rr) * D + c4 * 4) : *(const f32x4*)(q->in[1] + ((size_t)s * TS + rr - 11) * D + c4 * 4); }
}

constexpr int P1_X_OFF = 36864, P1_XROW = 1040, P1_TB_OFF = P1_X_OFF + 72 * P1_XROW;
template <int G> __device__ __forceinline__ void p1_load(f32x4 (&a)[8 + (2 << G)], int tok0, int t0, int wave, int lane) {
    constexpr int W = 2 << G;
    asm volatile("" : "+v"(lane));
    const float* xseq = kargs()->in[0] + (size_t)(tok0 - t0) * D + 256 * G + 4 * lane;
    const int tp = t0 + 8 * wave;
#pragma unroll
    for (int k = 0; k < 8 + W; ++k) { const int t = tp - W + k, tc = t < 0 ? 0 : t; const f32x4 v = *(const f32x4*)(xseq + (size_t)tc * D); a[k] = t >= 0 ? v : (f32x4){0.f, 0.f, 0.f, 0.f}; }
}
template <int G> __device__ __forceinline__ void p1_hload(f32x4 (&h)[(2 << G) + 4], bool host, int seq0, int wave, int lane) {
    constexpr int W = 2 << G;
    asm volatile("" : "+v"(lane));
    if (host && wave < 2) {
        const KA Params* q = kargs();
        const float* hist = q->in[2] + (size_t)(seq0 + wave) * 15 * D + 256 * G + 4 * lane; const float* xs = q->in[1] + (size_t)(seq0 + wave) * TS * D + 256 * G + 4 * lane;
#pragma unroll
        for (int k = 0; k < W; ++k) { const int i = W - k; h[k] = i <= 15 ? *(const f32x4*)(hist + (size_t)(15 - i) * D) : (f32x4){0.f, 0.f, 0.f, 0.f}; }
#pragma unroll
        for (int t = 0; t < 4; ++t) h[W + t] = *(const f32x4*)(xs + (size_t)t * D);
    } else {
#pragma unroll
        for (int k = 0; k < W + 4; ++k) h[k] = (f32x4){0.f, 0.f, 0.f, 0.f};
    }
}
template <int G> __device__ __forceinline__ void p1_store(const f32x4 (&a)[8 + (2 << G)], const f32x4 (&h)[(2 << G) + 4], LAS unsigned char* lds, int t0, bool host, int wave, int lane) {
    constexpr int W = 2 << G;
    asm volatile("" : "+v"(lane));
    const int tp = t0 + 8 * wave;
    { f32x4 s = {0.f, 0.f, 0.f, 0.f};
#pragma unroll
      for (int k = 0; k < W; ++k) s += a[k];
#pragma unroll
      for (int j = 0; j < 8; ++j) { s += a[W + j] - a[j]; const int t = tp + j; const float inv = __builtin_amdgcn_rcpf((float)(t + 1 < W ? t + 1 : W)); const f32x4 d = s * inv - a[W + j];
          const int row = 8 * wave + j; u32x2 w; w.x = pk2(d[0], d[1]); w.y = pk2(d[2], d[3]);
          *(LAS u32x2*)(lds + row * 512 + ((((lane >> 1) ^ (row & 15))) << 4) + (lane & 1) * 8) = w;
          *(LAS f32x4*)(lds + P1_X_OFF + row * P1_XROW + lane * 16) = a[W + j]; } }
    if (host && wave < 2) {
        f32x4 s = {0.f, 0.f, 0.f, 0.f};
#pragma unroll
        for (int k = 0; k < W; ++k) s += h[k];
#pragma unroll
        for (int t = 0; t < 4; ++t) { s += h[W + t] - h[t]; const f32x4 d = s * (1.0f / (float)W) - h[W + t];
            const int row = 64 + 4 * wave + t; u32x2 w; w.x = pk2(d[0], d[1]); w.y = pk2(d[2], d[3]);
            *(LAS u32x2*)(lds + row * 512 + ((((lane >> 1) ^ (row & 15))) << 4) + (lane & 1) * 8) = w;
            *(LAS f32x4*)(lds + P1_X_OFF + row * P1_XROW + lane * 16) = h[W + t]; }
    }
}
template <int G> __device__ __forceinline__ void p1_bload(bf16x8 (&b)[8][2], int wave, int lane) {
    asm volatile("" : "+v"(lane));
    const int fr = lane & 15, fq = lane >> 4;
    const bf16_t* wb = (const bf16_t*)(kargs()->ws + WS_WPOOL) + ((size_t)G * 256 + 32 * wave + fr) * 256 + 8 * fq;
#pragma unroll
    for (int ks = 0; ks < 8; ++ks)
#pragma unroll
        for (int nb = 0; nb < 2; ++nb) b[ks][nb] = *(const bf16x8*)(wb + (size_t)(16 * nb) * 256 + 32 * ks);
}
template <int G>
__device__ __forceinline__ void p1_compute(const bf16x8 (&b)[8][2], LAS unsigned char* lds, int tok0, bool host, int seq0, int wave, int lane) {
    const KA Params* q = kargs();
    asm volatile("" : "+v"(lane));
    const int fr = lane & 15, fq = lane >> 4;
    f32x4 acc[5][2];
#pragma unroll
    for (int mb = 0; mb < 5; ++mb) { acc[mb][0] = (f32x4){0.f, 0.f, 0.f, 0.f}; acc[mb][1] = (f32x4){0.f, 0.f, 0.f, 0.f}; }
    __syncthreads();
#pragma unroll
    for (int ks = 0; ks < 8; ++ks) {
        const int chunk = 4 * ks + fq;
        bf16x8 a[5];
#pragma unroll
        for (int mb = 0; mb < 5; ++mb) { const int row = mb < 4 ? 16 * mb + fr : 64 + (fr & 7); a[mb] = *(const LAS bf16x8*)(lds + row * 512 + ((chunk ^ (row & 15)) << 4)); }
#pragma unroll
        for (int mb = 0; mb < 4; ++mb)
#pragma unroll
            for (int nb = 0; nb < 2; ++nb) acc[mb][nb] = __builtin_amdgcn_mfma_f32_16x16x32_bf16(b[ks][nb], a[mb], acc[mb][nb], 0, 0, 0);
        if (host) {
#pragma unroll
            for (int nb = 0; nb < 2; ++nb) acc[4][nb] = __builtin_amdgcn_mfma_f32_16x16x32_bf16(b[ks][nb], a[4], acc[4][nb], 0, 0, 0); }
        if (ks & 1) __builtin_amdgcn_sched_barrier(0);
    }
    bf16_t* vbf = (bf16_t*)(q->ws + WS_H1);
    LAS f32x2* T = (LAS f32x2*)(lds + P1_TB_OFF) + (size_t)G * 72 * 8;
    const int c0 = 256 * G + 32 * wave + 8 * fq;
    const LAS unsigned char* xl = lds + P1_X_OFF + (32 * wave + 8 * fq) * 4;
#pragma unroll
    for (int mb = 0; mb < 5; ++mb) {
        if (mb == 4 && !host) break;
        const int row = mb < 4 ? 16 * mb + fr : 64 + (fr & 7);
        const int tok = mb < 4 ? tok0 + row : NTOK_P + 4 * seq0 + (fr & 7);
        const f32x4 x0 = *(const LAS f32x4*)(xl + row * P1_XROW), x1 = *(const LAS f32x4*)(xl + row * P1_XROW + 16);
        const f32x4 v0 = x0 * ALPHA + acc[mb][0], v1 = x1 * ALPHA + acc[mb][1];
        float sum = ((v0[0] + v0[1]) + (v0[2] + v0[3])) + ((v1[0] + v1[1]) + (v1[2] + v1[3]));
        float sq = ((v0[0] * v0[0] + v0[1] * v0[1]) + (v0[2] * v0[2] + v0[3] * v0[3])) + ((v1[0] * v1[0] + v1[1] * v1[1]) + (v1[2] * v1[2] + v1[3] * v1[3]));
        if (mb < 4 || fr < 8) { u32x4 wv; wv.x = pk2(v0[0], v0[1]); wv.y = pk2(v0[2], v0[3]); wv.z = pk2(v1[0], v1[1]); wv.w = pk2(v1[2], v1[3]); *(u32x4*)(vbf + (size_t)row_of_tok(tok) * D + c0) = wv; }
        sum += __shfl_xor(sum, 16); sum += __shfl_xor(sum, 32); sq += __shfl_xor(sq, 16); sq += __shfl_xor(sq, 32);
        if (fq == 0 && (mb < 4 || fr < 8)) { f32x2 t; t.x = sum; t.y = sq; T[row * 8 + wave] = t; }
    }
    __syncthreads();
}
__device__ __forceinline__ void phase1(LAS unsigned char* lds) {
    const KA Params* q = kargs();
    const int tid = tid_fresh(), lane = tid & 63, wave = __builtin_amdgcn_readfirstlane(tid >> 6);
    unsigned char* ws = q->ws;
    for (int tile = blockIdx.x; tile < NTOK_P / 64; tile += gridDim.x) {
        const int tok0 = tile * 64, t0 = tok0 & (SEQ - 1);
        const bool host = (tile & 3) == 0; const int seq0 = 2 * (tile >> 2);
        bf16x8 b[8][2];
        { f32x4 a3[24], h3[20]; p1_load<3>(a3, tok0, t0, wave, lane); p1_hload<3>(h3, host, seq0, wave, lane); p1_bload<3>(b, wave, lane); p1_store<3>(a3, h3, lds, t0, host, wave, lane); }
        asm volatile("" ::: "memory");
        { f32x4 a2[16], h2[12]; p1_load<2>(a2, tok0, t0, wave, lane); p1_hload<2>(h2, host, seq0, wave, lane); p1_compute<3>(b, lds, tok0, host, seq0, wave, lane);
          p1_bload<2>(b, wave, lane); p1_store<2>(a2, h2, lds, t0, host, wave, lane); }
        asm volatile("" ::: "memory");
        { f32x4 a1[12], h1[8]; p1_load<1>(a1, tok0, t0, wave, lane); p1_hload<1>(h1, host, seq0, wave, lane); p1_compute<2>(b, lds, tok0, host, seq0, wave, lane);
          p1_bload<1>(b, wave, lane); p1_store<1>(a1, h1, lds, t0, host, wave, lane); }
        asm volatile("" ::: "memory");
        { f32x4 a0[10], h0[6]; p1_load<0>(a0, tok0, t0, wave, lane); p1_hload<0>(h0, host, seq0, wave, lane); p1_compute<1>(b, lds, tok0, host, seq0, wave, lane);
          p1_bload<0>(b, wave, lane); p1_store<0>(a0, h0, lds, t0, host, wave, lane); }
        asm volatile("" ::: "memory");
        p1_compute<0>(b, lds, tok0, host, seq0, wave, lane);
        const int tz = tid_fresh();
        if (tz < 4 * (host ? 72 : 64)) { const int row = tz >> 2, gg = tz & 3; const LAS f32x2* T = (const LAS f32x2*)(lds + P1_TB_OFF) + ((size_t)gg * 72 + row) * 8;
            float sx = 0.f, sy = 0.f;
#pragma unroll
            for (int w = 0; w < 8; ++w) { const f32x2 a = T[w]; sx += a.x; sy += a.y; }
            const float mt = sx * (1.0f / 256.0f); f32x2 r; r.x = mt; r.y = sy - 256.0f * mt * mt;
            const int tok = row < 64 ? tok0 + row : NTOK_P + 4 * seq0 + (row - 64);
            ((f32x2*)(ws + WS_PART))[(size_t)row_of_tok(tok) * 4 + gg] = r; }
        __syncthreads();
    }
    { const int gt = blockIdx.x * 512 + tid, NGT = gridDim.x * 512;
      for (int i = gt; i < 2 * FF2 + 3 * D; i += NGT) {
          float s = 0.f, b = 0.f;
          if (i < 2 * FF2) { const int l = i / FF2, c = i % FF2; const float* sp = (const float*)(ws + WS_CSP_UP) + (size_t)l * 16 * FF2 + c; const float* bp = (const float*)(ws + WS_CBP_UP) + (size_t)l * 16 * FF2 + c;
              for (int k = 0; k < 16; ++k) { s += sp[(size_t)k * FF2]; b += bp[(size_t)k * FF2]; }
              ((float*)(ws + WS_CS_UP))[i] = s; ((float*)(ws + WS_CB_UP))[i] = b; }
          else { const int c = i - 2 * FF2; const float* sp = (const float*)(ws + WS_CSP_IN) + c; const float* bp = (const float*)(ws + WS_CBP_IN) + c;
              for (int k = 0; k < 16; ++k) { s += sp[(size_t)k * 3 * D]; b += bp[(size_t)k * 3 * D]; }
              ((float*)(ws + WS_CS_IN))[c] = s; ((float*)(ws + WS_CB_IN))[c] = b; } } }
}

__device__ __forceinline__ void fixup_panel(int l, int pm) {
    const KA Params* q = kargs();
    const float* kc = (const float*)(q->ws + WS_KC_UP) + (size_t)l * 4 * FF2; bf16_t* act = (bf16_t*)(q->ws + WS_ACT);
    const float* Hf = (const float*)(q->ws + WS_HF); const float* Hl = (const float*)(q->ws + WS_HL);
    for (int cgp = tid_fresh(); cgp < FF / 4; cgp += 512) {
        const int f = cgp * 4, cg_ = 256 * (f >> 7) + (f & 127), cv_ = cg_ + 128;
        const bool do0 = ((2 * pm) & 15) != 0;
        const float* hf0 = Hf + (size_t)(2 * pm) * 2 * FF2; const float* hl0 = Hl + (size_t)(do0 ? 2 * pm - 1 : 2 * pm) * 2 * FF2;
        const float* hf1 = hf0 + 2 * FF2; const float* hl1 = Hl + (size_t)(2 * pm) * 2 * FF2;
        const f32x4 k0g = *(const f32x4*)(kc + cg_), k1g = *(const f32x4*)(kc + FF2 + cg_), k2g = *(const f32x4*)(kc + 2 * FF2 + cg_), kbg = *(const f32x4*)(kc + 3 * FF2 + cg_);
        const f32x4 k0v = *(const f32x4*)(kc + cv_), k1v = *(const f32x4*)(kc + FF2 + cv_), k2v = *(const f32x4*)(kc + 2 * FF2 + cv_), kbv = *(const f32x4*)(kc + 3 * FF2 + cv_);
        f32x4 g2[2], g1[2], a0[2], a1[2], v2[2], v1[2], b0[2], b1[2];
        g2[0] = *(const f32x4*)(hl0 + cg_); g1[0] = *(const f32x4*)(hl0 + FF2 + cg_); a0[0] = *(const f32x4*)(hf0 + cg_); a1[0] = *(const f32x4*)(hf0 + FF2 + cg_);
        v2[0] = *(const f32x4*)(hl0 + cv_); v1[0] = *(const f32x4*)(hl0 + FF2 + cv_); b0[0] = *(const f32x4*)(hf0 + cv_); b1[0] = *(const f32x4*)(hf0 + FF2 + cv_);
        g2[1] = *(const f32x4*)(hl1 + cg_); g1[1] = *(const f32x4*)(hl1 + FF2 + cg_); a0[1] = *(const f32x4*)(hf1 + cg_); a1[1] = *(const f32x4*)(hf1 + FF2 + cg_);
        v2[1] = *(const f32x4*)(hl1 + cv_); v1[1] = *(const f32x4*)(hl1 + FF2 + cv_); b0[1] = *(const f32x4*)(hf1 + cv_); b1[1] = *(const f32x4*)(hf1 + FF2 + cv_);
#pragma unroll
        for (int h = 0; h < 2; ++h) {
            if (h == 0 && !do0) continue;
            const f32x4 zg0 = k2g * a0[h] + k1g * g1[h] + k0g * g2[h] + kbg, zv0 = k2v * b0[h] + k1v * v1[h] + k0v * v2[h] + kbv;
            const f32x4 zg1 = k2g * a1[h] + k1g * a0[h] + k0g * g1[h] + kbg, zv1 = k2v * b1[h] + k1v * b0[h] + k0v * v1[h] + kbv;
            const int R0 = pm * 256 + 64 * h;
            u32x2 w0, w1; w0.x = pk2(silu_mul(zg0[0], zv0[0]), silu_mul(zg0[1], zv0[1])); w0.y = pk2(silu_mul(zg0[2], zv0[2]), silu_mul(zg0[3], zv0[3]));
            w1.x = pk2(silu_mul(zg1[0], zv1[0]), silu_mul(zg1[1], zv1[1])); w1.y = pk2(silu_mul(zg1[2], zv1[2]), silu_mul(zg1[3], zv1[3]));
            *(u32x2*)(act + (size_t)R0 * FF + f) = w0; *(u32x2*)(act + (size_t)(R0 + 16) * FF + f) = w1;
        }
    }
    asm volatile("s_waitcnt vmcnt(0)" ::: "memory"); __syncthreads();
}

__device__ __forceinline__ void conv_item(const KA Params* q, int tok, int ch, const f32x4 (&kk)[4][2], bf16_t* obuf) {
    int t, seq = 0; const bool sample = tok >= NTOK_P;
    if (!sample) t = tok & (SEQ - 1); else { seq = (tok - NTOK_P) >> 2; t = tok & 3; }
    const bf16_t* ubuf = sample ? (const bf16_t*)(q->ws + WS_SU) - (size_t)NTOK_P * D : (const bf16_t*)(q->ws + WS_ACT);
    const bf16_t* bbuf = sample ? (const bf16_t*)(q->ws + WS_SB) - (size_t)NTOK_P * D : (const bf16_t*)(q->ws + WS_ACT) + (size_t)MROWS * D;
    const int R = row_of_tok(tok), R1 = row_of_tok(tok - (t >= 1 ? 1 : 0)), R2 = row_of_tok(tok - (t >= 2 ? 2 : 0));
    const u32x4 w2 = *(const u32x4*)(ubuf + (size_t)R * D + ch), wb = __builtin_nontemporal_load((const u32x4*)(bbuf + (size_t)R * D + ch));
    const u32x4 w1 = *(const u32x4*)(ubuf + (size_t)R1 * D + ch), w0 = *(const u32x4*)(ubuf + (size_t)R2 * D + ch);
    float u0[8], u1[8], u2[8], bb[8];
#pragma unroll
    for (int e = 0; e < 4; ++e) { u2[2 * e] = bf2f(w2[e] & 0xffffu); u2[2 * e + 1] = bf2f(w2[e] >> 16); bb[2 * e] = bf2f(wb[e] & 0xffffu); bb[2 * e + 1] = bf2f(wb[e] >> 16);
        u1[2 * e] = bf2f(w1[e] & 0xffffu); u1[2 * e + 1] = bf2f(w1[e] >> 16); u0[2 * e] = bf2f(w0[e] & 0xffffu); u0[2 * e + 1] = bf2f(w0[e] >> 16); }
    if (t < 2) {
        const float* st = q->in[3] + (size_t)seq * 2 * D + ch;
        if (t < 1) {
#pragma unroll
            for (int e = 0; e < 8; ++e) u1[e] = sample ? st[D + e] : 0.f; }
#pragma unroll
        for (int e = 0; e < 8; ++e) u0[e] = sample ? st[(size_t)t * D + e] : 0.f;
    }
    float o[8];
#pragma unroll
    for (int e = 0; e < 8; ++e) o[e] = bb[e] * (kk[0][e >> 2][e & 3] * u0[e] + kk[1][e >> 2][e & 3] * u1[e] + kk[2][e >> 2][e & 3] * u2[e] + kk[3][e >> 2][e & 3]);
    u32x4 w; w.x = pk2(o[0], o[1]); w.y = pk2(o[2], o[3]); w.z = pk2(o[4], o[5]); w.w = pk2(o[6], o[7]);
    *(u32x4*)(obuf + (size_t)R * D + ch) = w;
}
__device__ __forceinline__ void fixup_mix(int pm) {
    const KA Params* q = kargs();
    const int i = tid_fresh();
    { const int q2 = 2 * pm + (i >> 8), ch = (i & 255) * 4;
      if ((q2 & 15) != 0) {
          const float* hf = (const float*)(q->ws + WS_HF) + (size_t)q2 * 2 * D + ch; const float* hl = (const float*)(q->ws + WS_HL) + (size_t)(q2 - 1) * 2 * D + ch;
          const f32x4 k0 = *(const f32x4*)(q->in[10] + ch), k1 = *(const f32x4*)(q->in[10] + D + ch), k2 = *(const f32x4*)(q->in[10] + 2 * D + ch), kb = *(const f32x4*)(q->in[11] + ch);
          const f32x4 g2 = *(const f32x4*)(hl), g1 = *(const f32x4*)(hl + D), a0 = *(const f32x4*)(hf), a1 = *(const f32x4*)(hf + D);
          const int R0 = (q2 >> 1) * 256 + 64 * (q2 & 1);
          const bf16_t* bb = (const bf16_t*)(q->ws + WS_ACT) + (size_t)MROWS * D; bf16_t* ob = (bf16_t*)q->out;
          const u32x2 b0 = *(const u32x2*)(bb + (size_t)R0 * D + ch), b1 = *(const u32x2*)(bb + (size_t)(R0 + 16) * D + ch);
          const f32x4 z0 = k2 * a0 + k1 * g1 + k0 * g2 + kb, z1 = k2 * a1 + k1 * a0 + k0 * g1 + kb;
          u32x2 w0, w1; w0.x = pk2(bf2f(b0.x & 0xffffu) * z0[0], bf2f(b0.x >> 16) * z0[1]); w0.y = pk2(bf2f(b0.y & 0xffffu) * z0[2], bf2f(b0.y >> 16) * z0[3]);
          w1.x = pk2(bf2f(b1.x & 0xffffu) * z1[0], bf2f(b1.x >> 16) * z1[1]); w1.y = pk2(bf2f(b1.y & 0xffffu) * z1[2], bf2f(b1.y >> 16) * z1[3]);
          *(u32x2*)(ob + (size_t)R0 * D + ch) = w0; *(u32x2*)(ob + (size_t)(R0 + 16) * D + ch) = w1; } }
    if (i < 256) { const int gt = blockIdx.x * 256 + i;
        if (gt < NTOK_S * 128) { const int ch = (gt & 127) * 8;
            f32x4 kk[4][2];
#pragma unroll
            for (int h = 0; h < 2; ++h) { kk[0][h] = *(const f32x4*)(q->in[10] + ch + 4 * h); kk[1][h] = *(const f32x4*)(q->in[10] + D + ch + 4 * h); kk[2][h] = *(const f32x4*)(q->in[10] + 2 * D + ch + 4 * h); kk[3][h] = *(const f32x4*)(q->in[11] + ch + 4 * h); }
            conv_item(q, NTOK_P + (gt >> 7), ch, kk, (bf16_t*)q->out); } }
    asm volatile("s_waitcnt vmcnt(0)" ::: "memory"); __syncthreads();
}

#define XB_TMO      128
#define XB_XCNT(j)  (256  + 64 * (j))
#define XB_XSUB(j)  (1280 + 64 * (j))
#define XB_XGEN(j)  (2304 + 64 * (j))
#define XB_TOP      3328
#define XB_TOPGEN   3392
#define XCD_BAR_WORDS 3456
#define XB_SPIN_CAP (1u << 18)

__device__ __forceinline__ unsigned xb_ld(unsigned* p)              { return __hip_atomic_load(p, __ATOMIC_RELAXED, __HIP_MEMORY_SCOPE_AGENT); }
__device__ __forceinline__ unsigned xb_add(unsigned* p, unsigned v) { return __hip_atomic_fetch_add(p, v, __ATOMIC_RELAXED, __HIP_MEMORY_SCOPE_AGENT); }
__device__ __forceinline__ unsigned xb_xcc_id() { return (unsigned)__builtin_amdgcn_s_getreg((3 << 11) | 20) & 0xFu; }
#define XB_SPIN(cond, bar) do { unsigned _sp = 0; while (cond) { __builtin_amdgcn_s_sleep(1); \
    if ((++_sp & 255u) == 0u) { if (xb_ld(&(bar)[XB_TMO])) break; if (_sp > XB_SPIN_CAP) { atomicAdd(&(bar)[XB_TMO], 1u); break; } } } } while (0)

struct XcdBarrier {
    unsigned* bar; unsigned x;
    volatile LAS unsigned* st;
};

__device__ __forceinline__ XcdBarrier xcd_barrier_post(unsigned* bar, volatile LAS unsigned* st) {
    XcdBarrier b; b.bar = bar; b.x = xb_xcc_id(); b.st = st;
    if (threadIdx.x == 0) (void)xb_add(&bar[XB_XCNT(b.x)], 1u);
    return b;
}
__device__ __forceinline__ void xcd_barrier_complete(unsigned* bar, unsigned x, unsigned& nloc, unsigned& nx) {
    const unsigned G = gridDim.x * gridDim.y * gridDim.z;
    unsigned sum, cnt, mine, sp = 0u;
    for (;;) {
        sum = 0u; cnt = 0u; mine = 0u;
#pragma unroll
        for (unsigned j = 0; j < 16; ++j) { const unsigned c = xb_ld(&bar[XB_XCNT(j)]); sum += c; cnt += (c > 0u) ? 1u : 0u; mine = (j == x) ? c : mine; }
        if (sum == G) break;
        __builtin_amdgcn_s_sleep(1);
        if ((++sp & 255u) == 0u) { if (xb_ld(&bar[XB_TMO])) break; if (sp > XB_SPIN_CAP) { atomicAdd(&bar[XB_TMO], 1u); break; } }
    }
    nloc = mine > 0u ? mine : 1u; nx = cnt > 0u ? cnt : 1u;
}

__device__ __forceinline__ void xcd_barrier(const XcdBarrier& b) {
    asm volatile("s_waitcnt vmcnt(0)" ::: "memory");
    __syncthreads();
    if (threadIdx.x == 0) {
        unsigned* bar = b.bar;
        __builtin_amdgcn_s_waitcnt(0);
        unsigned nloc = b.st[0], nx = b.st[1];
        if (nloc == 0u) { xcd_barrier_complete(bar, b.x, nloc, nx); b.st[0] = nloc; b.st[1] = nx; }
        const unsigned old = xb_add(&bar[XB_XSUB(b.x)], 1u);
        const unsigned gen = old / nloc;
        if (old + 1u == (gen + 1u) * nloc) {
            __builtin_amdgcn_fence(__ATOMIC_RELEASE, "agent");
            asm volatile("s_waitcnt vmcnt(0)" ::: "memory");
            const unsigned og = xb_add(&bar[XB_TOP], 1u);
            const unsigned tg = og / nx;
            if (og + 1u == (tg + 1u) * nx) xb_add(&bar[XB_TOPGEN], 1u);
            else XB_SPIN(xb_ld(&bar[XB_TOPGEN]) == tg, bar);
            __builtin_amdgcn_fence(__ATOMIC_ACQUIRE, "agent");
            xb_add(&bar[XB_XGEN(b.x)], 1u);
            asm volatile("s_waitcnt vmcnt(0)" ::: "memory");
        } else {
            XB_SPIN(xb_ld(&bar[XB_XGEN(b.x)]) == gen, bar);
            __builtin_amdgcn_fence(__ATOMIC_ACQUIRE, "agent");
            asm volatile("s_waitcnt vmcnt(0)" ::: "memory");
        }
    }
    __syncthreads();
}


__global__ void __launch_bounds__(512, 2) fwd_megakernel(Params p) {
    extern __shared__ __attribute__((aligned(16))) unsigned char lds_raw[];
    LAS unsigned char* lds = (LAS unsigned char*)lds_raw;
    const int G = gridDim.x, cid = blockIdx.x;
    if (threadIdx.x < 2) ((LAS unsigned*)(lds + BARST_OFF))[threadIdx.x] = 0u;
    __syncthreads();
    const XcdBarrier bar = xcd_barrier_post((unsigned*)(kargs()->ws + WS_BAR), (volatile LAS unsigned*)(lds + BARST_OFF));
#if TPROBE
    int n_stamp = 0;
#define STAMP() do { if (blockIdx.x == 0 && threadIdx.x == 0) ((volatile LAS unsigned long long*)(lds + BARST_OFF + 64))[n_stamp] = __builtin_amdgcn_s_memrealtime(); ++n_stamp; } while (0)
#else
#define STAMP() do { } while (0)
#endif
    STAMP();
    using namespace pg8;
    constexpr int M_UP = (1 << K_UP0) | (1 << K_UP1), M_DNS = (1 << K_DNS0) | (1 << K_DNS1);
    phase0(lds);
    xcd_barrier(bar); STAMP();
    phase1(lds);
    xcd_barrier(bar); STAMP();
#if SEG & 1
    { SchedUp S{0, cid, 0, 6};
      const int lc = cid - 128;
      if (lc >= 76 && lc < 84) { S.first = 0; S.count = 3; gemm_stream<M_UP, false>(lds, S); finisher<0>(lds, (lc - 76) >> 2, (lc - 76) & 3); S.first = 3; S.count = 1; gemm_stream<M_UP, false>(lds, S); }
      else gemm_stream<M_UP | M_DNS | (1 << K_IN), true>(lds, S); }
#endif
    xcd_barrier(bar); STAMP();
#if SEG & 2
    { SchedSimple S{K_DN0, NPANEL_P, 4, G, cid}; UnitD u0; if (S.next(0, u0)) fixup_panel(0, u0.pm());
      gemm_stream<(1 << K_DN0), false>(lds, S); }
#endif
    xcd_barrier(bar); STAMP();
#if SEG & 4
    { SchedIn S{cid}; gemm_stream<(1 << K_IN) | 256, false>(lds, S); }
#endif
    xcd_barrier(bar); STAMP();
#if SEG & 8
    { SchedSimple S{K_OUT, NPANEL_P, 4, G, cid}; UnitD u0; if (S.next(0, u0)) fixup_mix(u0.pm());
      gemm_stream<(1 << K_OUT), false>(lds, S); }
#endif
    xcd_barrier(bar); STAMP();
#if SEG & 16
    { SchedUp S{1, cid, 0, 6};
      const int lc = cid - 128;
      if (lc >= 84 && lc < 92) { S.count = 4; gemm_stream<M_UP, false>(lds, S); finisher<1>(lds, (lc - 84) >> 2, (lc - 84) & 3); }
      else gemm_stream<M_UP | M_DNS | (1 << K_OUT), true>(lds, S); }
#endif
    xcd_barrier(bar); STAMP();
#if SEG & 32
    { SchedSimple S{K_DN1, NPANEL_P, 4, G, cid}; UnitD u0; if (S.next(0, u0)) fixup_panel(1, u0.pm());
      gemm_stream<(1 << K_DN1), false>(lds, S); }
#endif
    STAMP();
#if TPROBE
    if (blockIdx.x == 0 && threadIdx.x == 0) { volatile LAS unsigned long long* st = (volatile LAS unsigned long long*)(lds + BARST_OFF + 64);
        const unsigned long long T = st[TPROBE & 255] - st[TPROBE >> 8], t_end = __builtin_amdgcn_s_memrealtime() + 4ull * T;
        while (__builtin_amdgcn_s_memrealtime() < t_end) __builtin_amdgcn_s_sleep(8); }
#endif
}

extern "C" void kernel_launch(void* const* d_in, const int* in_sizes, int n_in, void* d_out, int out_size, void* d_ws, size_t ws_size, hipStream_t stream) {
    static int grid_blocks = 0;
    if (grid_blocks == 0) {
        if (n_in != 19 || out_size != (int)O_END || ws_size < WS_END) { fprintf(stderr, "kernel_launch: unexpected shapes (n_in %d out %d ws %zu)\n", n_in, out_size, ws_size); grid_blocks = -1; return; }
        int dev = 0, cus = 0, per_cu = 0;
        hipGetDevice(&dev);
        hipDeviceGetAttribute(&cus, hipDeviceAttributeMultiprocessorCount, dev);
        if (hipFuncSetAttribute((const void*)fwd_megakernel, hipFuncAttributeMaxDynamicSharedMemorySize, LDS_BYTES) != hipSuccess) { fprintf(stderr, "kernel_launch: hipFuncSetAttribute failed\n"); grid_blocks = -1; return; }
        hipOccupancyMaxActiveBlocksPerMultiprocessor(&per_cu, (const void*)fwd_megakernel, 512, LDS_BYTES);
        if (per_cu < 1) { fprintf(stderr, "kernel_launch: occupancy query reports %d blocks per CU\n", per_cu); grid_blocks = -1; return; }
        if (cus != 256) { fprintf(stderr, "kernel_launch: the unit schedule is built for 256 CUs, this device has %d\n", cus); grid_blocks = -1; return; }
        grid_blocks = cus;
    }
    if (grid_blocks < 0) return;
    if (hipMemsetAsync((char*)d_ws + WS_BAR, 0, CTL_BYTES, stream) != hipSuccess) { fprintf(stderr, "kernel_launch: hipMemsetAsync failed\n"); return; }
    Params p{};
    for (int i = 0; i < 19; ++i) p.in[i] = (const float*)d_in[i];
    p.out = (float*)d_out; p.ws = (unsigned char*)d_ws;
    void* args[] = {&p};
    hipError_t e = hipLaunchCooperativeKernel((const void*)fwd_megakernel, dim3(grid_blocks), dim3(512), args, LDS_BYTES, stream);
    if (e != hipSuccess) fprintf(stderr, "cooperative launch failed: %s (grid %d)\n", hipGetErrorString(e), grid_blocks);
}
```

```cpp
#include <hip/hip_runtime.h>
#include <cstdio>
#include <cstdint>
#ifndef TPROBE
#define TPROBE 0
#endif
#ifndef SEG
#define SEG 255
#endif

#define LAS __attribute__((address_space(3)))
typedef unsigned short bf16_t;
typedef short bf16x8 __attribute__((ext_vector_type(8)));
typedef float f32x4 __attribute__((ext_vector_type(4)));
typedef float f32x2 __attribute__((ext_vector_type(2)));
typedef unsigned u32x4 __attribute__((ext_vector_type(4)));
typedef unsigned u32x2 __attribute__((ext_vector_type(2)));

constexpr int D = 1024, FF = 2816, FF2 = 5632, SEQ = 2048, NB_P = 8, NB_S = 128, TS = 4;
constexpr int NTOK_P = NB_P * SEQ;
constexpr int NTOK_S = NB_S * TS;
constexpr int MROWS = NTOK_P + NTOK_S;
constexpr int NPANEL = MROWS / 256;
constexpr int NPANEL_P = NTOK_P / 256;
constexpr float ALPHA = 1.41421356237309515f;
constexpr float LN_EPS = 1e-5f;

constexpr size_t O_Y = 0;
constexpr size_t O_POOL_P = (size_t)MROWS * D;
constexpr size_t O_POOL_S = O_POOL_P + (size_t)NB_P * 15 * D;
constexpr size_t O_CONV_P = O_POOL_S + (size_t)NB_S * 15 * D;
constexpr size_t O_CONV_S = O_CONV_P + (size_t)NB_P * 2 * D;
constexpr size_t O_FFN_P = O_CONV_S + (size_t)NB_S * 2 * D;
constexpr size_t O_FFN_S = O_FFN_P + (size_t)2 * NB_P * 2 * FF2;
constexpr size_t O_END = O_FFN_S + (size_t)2 * NB_S * 2 * FF2;

constexpr size_t WS_WUP = 0;
constexpr size_t WS_WDN = WS_WUP + (size_t)2 * FF2 * D * 2;
constexpr size_t WS_WIN = WS_WDN + (size_t)2 * D * FF * 2;
constexpr size_t WS_WOUT = WS_WIN + (size_t)3 * D * D * 2;
constexpr size_t WS_WPOOL = WS_WOUT + (size_t)D * D * 2;
constexpr size_t WS_CSP_UP = WS_WPOOL + (size_t)4 * 256 * 256 * 2;
constexpr size_t WS_CBP_UP = WS_CSP_UP + (size_t)2 * 16 * FF2 * 4;
constexpr size_t WS_CSP_IN = WS_CBP_UP + (size_t)2 * 16 * FF2 * 4;
constexpr size_t WS_CBP_IN = WS_CSP_IN + (size_t)16 * 3072 * 4;
constexpr size_t WS_CS_UP = WS_CBP_IN + (size_t)16 * 3072 * 4;
constexpr size_t WS_CB_UP = WS_CS_UP + (size_t)2 * FF2 * 4;
constexpr size_t WS_KC_UP = WS_CB_UP + (size_t)2 * FF2 * 4;
constexpr size_t WS_CS_IN = WS_KC_UP + (size_t)2 * 4 * FF2 * 4;
constexpr size_t WS_CB_IN = WS_CS_IN + (size_t)3072 * 4;
constexpr size_t WS_PART = WS_CB_IN + (size_t)3072 * 4;
constexpr size_t PART_BYTES = (size_t)MROWS * 4 * 8;
constexpr size_t WS_HF = WS_PART + 3 * PART_BYTES;
constexpr size_t HALO_BYTES = (size_t)132 * 2 * FF2 * 4;
constexpr size_t WS_HL = WS_HF + HALO_BYTES;
constexpr size_t WS_H1 = WS_HL + HALO_BYTES;
constexpr size_t WS_ACT = WS_H1 + (size_t)MROWS * D * 2;
constexpr size_t WS_BAR = WS_ACT + (size_t)MROWS * FF * 2;
constexpr size_t WS_CNT = WS_BAR + 16384;
constexpr size_t CTL_BYTES = 16384 + 32768;
constexpr size_t WS_SU = WS_BAR + CTL_BYTES;
constexpr size_t WS_SB = WS_SU + (size_t)NTOK_S * D * 2;
constexpr size_t WS_PBUF = WS_SB + (size_t)NTOK_S * D * 2;
constexpr size_t WS_END = WS_PBUF + (size_t)32 * 262144;
static_assert(WS_END <= (size_t)256 * 1024 * 1024, "workspace");
static_assert(WS_WDN % 256 == 0 && WS_WIN % 256 == 0 && WS_WOUT % 256 == 0 && WS_WPOOL % 256 == 0 && WS_PART % 256 == 0 && WS_HF % 256 == 0 && WS_H1 % 256 == 0 && WS_ACT % 256 == 0, "align");

constexpr int STAGE_BYTES = 131072;
constexpr int EPI_OFF = STAGE_BYTES;
constexpr int EPI_S = 8192, EPI_CST = 10240, EPI_PART = 16384;
constexpr int P1_T_OFF = 147456;
constexpr int BARST_OFF = 155648;
constexpr int LDS_BYTES = 159744;

struct Params {
    const float* in[19];
    float* out;
    unsigned char* ws;
};

__device__ __forceinline__ unsigned f2bf(float f) { unsigned u = __builtin_bit_cast(unsigned, f); return (u + 0x7fffu + ((u >> 16) & 1u)) >> 16; }
__device__ __forceinline__ float bf2f(unsigned b) { return __builtin_bit_cast(float, b << 16); }
typedef __bf16 bf16v2 __attribute__((ext_vector_type(2)));
__device__ __forceinline__ unsigned pk2(float lo, float hi) { const f32x2 v = {lo, hi}; return __builtin_bit_cast(unsigned, __builtin_convertvector(v, bf16v2)); }
__device__ __forceinline__ float dpp_shr1(float v) {
    return __builtin_bit_cast(float, __builtin_amdgcn_update_dpp(0, __builtin_bit_cast(int, v), 0x111, 0xf, 0xf, true));
}
__device__ __forceinline__ float silu_mul(float gs, float vs) { return gs * vs * __builtin_amdgcn_rcpf(1.0f + __builtin_amdgcn_exp2f(gs)); }
__device__ __forceinline__ f32x2 silu_mul2(f32x2 gs, f32x2 vs) {
    f32x2 d; d.x = __builtin_amdgcn_exp2f(gs.x); d.y = __builtin_amdgcn_exp2f(gs.y);
    d = d + 1.0f;
    f32x2 r; r.x = __builtin_amdgcn_rcpf(d.x); r.y = __builtin_amdgcn_rcpf(d.y);
    return gs * vs * r;
}
__device__ __forceinline__ unsigned pk2v(f32x2 v) { return __builtin_bit_cast(unsigned, __builtin_convertvector(v, bf16v2)); }
__device__ __forceinline__ int tid_fresh() { int t = threadIdx.x; asm volatile("" : "+v"(t)); return t; }
__device__ __forceinline__ int row_of_tok(int tok) {
    const int pm = tok >> 8, tau = tok & 255;
    return pm * 256 + 128 * ((tau >> 2) & 1) + 64 * (tau >> 7) + 16 * (tau & 3) + ((tau >> 3) & 15);
}
__device__ __forceinline__ void stats_compute(LAS unsigned char* elds) {
    int tx = threadIdx.x; asm volatile("" : "+v"(tx));
    if (tx < 256) { const f32x4 a = *(const LAS f32x4*)(elds + EPI_PART + tx * 32), b = *(const LAS f32x4*)(elds + EPI_PART + tx * 32 + 16);
        const float mean = ((a[0] + a[2]) + (b[0] + b[2])) * 0.25f;
        const float d0 = a[0] - mean, d1 = a[2] - mean, d2 = b[0] - mean, d3 = b[2] - mean;
        const float m2 = ((a[1] + a[3]) + (b[1] + b[3])) + 256.0f * ((d0 * d0 + d1 * d1) + (d2 * d2 + d3 * d3));
        const float rstd = __builtin_amdgcn_rsqf(m2 * (1.0f / 1024.0f) + LN_EPS);
        f32x2 t; t.x = rstd; t.y = -mean * rstd; ((LAS f32x2*)(elds + EPI_S))[tx] = t; }
}
__device__ __forceinline__ void stats_from_lds(LAS unsigned char* elds) {
    stats_compute(elds);
    asm volatile("s_waitcnt lgkmcnt(0)" ::: "memory"); __builtin_amdgcn_s_barrier(); asm volatile("" ::: "memory");
}
#define KA __attribute__((address_space(4)))
__device__ __forceinline__ const KA Params* kargs() { const KA Params* p = (const KA Params*)__builtin_amdgcn_kernarg_segment_ptr(); asm volatile("" : "+s"(p)); return p; }

__device__ __forceinline__ unsigned* cnt_word(int idx) { return (unsigned*)(kargs()->ws + WS_CNT) + 64 * idx; }
namespace pg8 {
constexpr int BM = 256, BK = 64, HALF = 128, HTB = HALF * BK * 2, NXCD = 8, WGM = 8;
__host__ __device__ __forceinline__ int lds_byte(int r, int c) { const int st = (r >> 4) * 2 + (c >> 5), rr = r & 15, cc = c & 31, ob = rr * 64 + cc * 2; return st * 1024 + (ob ^ (((ob >> 9) & 1) << 5)); }
__host__ __device__ __forceinline__ void stage_rc(int b, int& R, int& C) { const int st = b / 1024, sb = b % 1024, swz = sb ^ (((sb >> 9) & 1) << 5); R = (st >> 1) * 16 + swz / 64; C = (st & 1) * 32 + (swz % 64) / 2; }

struct Unit { int pm, pn; };
enum { K_UP0 = 0, K_UP1 = 1, K_DN0 = 2, K_DN1 = 3, K_IN = 4, K_OUT = 5, K_DNS0 = 6, K_DNS1 = 7 };
struct UnitD { unsigned w0, w1;
    __device__ __forceinline__ int kind() const { return (int)(w0 & 15u); }
    __device__ __forceinline__ int pm() const { return (int)((w0 >> 4) & 255u); }
    __device__ __forceinline__ int pn() const { return (int)((w0 >> 12) & 255u); }
    __device__ __forceinline__ int ks() const { return (int)((w0 >> 20) & 15u); }
    __device__ __forceinline__ int dep() const { return (int)(w1 & 255u) - 1; }
    __device__ __forceinline__ unsigned want() const { return (w1 >> 8) & 255u; }
    __device__ __forceinline__ int sig() const { return (int)((w1 >> 16) & 255u) - 1; }
    __device__ __forceinline__ void set(int kind_, int pm_, int pn_, int ks_, int dep_, int want_, int sig_) { w0 = (unsigned)kind_ | ((unsigned)pm_ << 4) | ((unsigned)pn_ << 12) | ((unsigned)ks_ << 20); w1 = (unsigned)(dep_ + 1) | ((unsigned)want_ << 8) | ((unsigned)(sig_ + 1) << 16); }
};
__device__ __forceinline__ void map_unit(int L, int nM, int nN, int& pm, int& pn) {
    const int nwg = nM * nN; int wgid = L; { const int q = nwg / NXCD, r = nwg % NXCD, xcd = wgid % NXCD, off = wgid / NXCD; wgid = (xcd < r ? xcd * (q + 1) : r * (q + 1) + (xcd - r) * q) + off; }
    const int nig = WGM * nN, gid = wgid / nig, fm = gid * WGM, gsz = (nM - fm) < WGM ? (nM - fm) : WGM;
    pm = fm + ((wgid % nig) % gsz); pn = (wgid % nig) / gsz;
}
}


template <int BJ> __device__ __forceinline__ void pin_half(f32x4 (&acc)[2][2][4][2]) {
#pragma unroll
    for (int ai = 0; ai < 2; ++ai)
        asm volatile("" : "+v"(acc[ai][BJ][0][0]), "+v"(acc[ai][BJ][0][1]), "+v"(acc[ai][BJ][1][0]), "+v"(acc[ai][BJ][1][1]), "+v"(acc[ai][BJ][2][0]), "+v"(acc[ai][BJ][2][1]), "+v"(acc[ai][BJ][3][0]), "+v"(acc[ai][BJ][3][1]) :: "memory");
}
template <int BJ, int N> __device__ __forceinline__ void pin_group(f32x4 (&acc)[2][2][4][2]) {
    asm volatile("" : "+v"(acc[0][BJ][0][N]), "+v"(acc[0][BJ][1][N]), "+v"(acc[0][BJ][2][N]), "+v"(acc[0][BJ][3][N]), "+v"(acc[1][BJ][0][N]), "+v"(acc[1][BJ][1][N]), "+v"(acc[1][BJ][2][N]), "+v"(acc[1][BJ][3][N]) :: "memory");
}
template <int N> __device__ __forceinline__ void pin_n(f32x4 (&acc)[2][2][4][2]) {
#pragma unroll
    for (int ai = 0; ai < 2; ++ai)
        asm volatile("" : "+v"(acc[ai][0][0][N]), "+v"(acc[ai][0][1][N]), "+v"(acc[ai][0][2][N]), "+v"(acc[ai][0][3][N]), "+v"(acc[ai][1][0][N]), "+v"(acc[ai][1][1][N]), "+v"(acc[ai][1][2][N]), "+v"(acc[ai][1][3][N]) :: "memory");
}
template <int BJ, int N, int J0, int LEN>
__device__ __forceinline__ void conv_chain(f32x4 (&acc)[2][2][4][2], const f32x4 k0, const f32x4 k1, const f32x4 k2, const f32x4 kb, const f32x4 p1, const f32x4 p2) {
#pragma unroll
    for (int i = LEN - 1; i >= 0; --i) {
        const int j = J0 + i;
        const f32x4 h0 = acc[j >> 2][BJ][j & 3][N];
        const f32x4 h1 = i >= 1 ? acc[(j - 1) >> 2][BJ][(j - 1) & 3][N] : p1;
        const f32x4 h2 = i >= 2 ? acc[(j - 2) >> 2][BJ][(j - 2) & 3][N] : (i == 1 ? p1 : p2);
        acc[j >> 2][BJ][j & 3][N] = __builtin_elementwise_fma(k0, h2, __builtin_elementwise_fma(k1, h1, __builtin_elementwise_fma(k2, h0, kb)));
    }
}
struct EpiUp {
    int l;
    template <int N>
    __device__ __forceinline__ void half(f32x4 (&acc)[2][2][4][2], int pm, int pn, int wr, int wc, int fr, int fq, LAS unsigned char* elds) const {
        asm volatile("" : "+v"(fr), "+v"(fq));
        const KA Params* q = kargs(); unsigned char* ws = q->ws;
        const bool sample = pm >= NPANEL_P;
        const int chunk = 2 * pm + wr;
        const int ucol = 256 * pn + 32 * wc + 4 * N;
        const int ufcol = 128 * pn + 32 * wc + 4 * N;
        const unsigned lq = (unsigned)(32 * fq);
        const LAS unsigned char* kcl = elds + EPI_CST + 2048 + (32 * wc + 4 * N) * 4 + lq;
#define KC4(tap, vhalf) (*(const LAS f32x4*)(kcl + ((tap) * 256 + (vhalf) * 128) * 4))
        if (!sample) {
            f32x4 g2, g1;
#pragma unroll
            for (int e = 0; e < 4; ++e) { g2[e] = dpp_shr1(acc[1][0][2][N][e]); g1[e] = dpp_shr1(acc[1][0][3][N][e]); }
            if (fr == 0) {
                char* hf = (char*)((float*)(ws + WS_HF) + (size_t)chunk * 2 * FF2 + ucol) + lq;
                *(f32x4*)(hf) = acc[0][0][0][N]; *(f32x4*)(hf + FF2 * 4) = acc[0][0][1][N];
                *(f32x4*)(hf + 128 * 4) = acc[0][1][0][N]; *(f32x4*)(hf + (FF2 + 128) * 4) = acc[0][1][1][N];
            }
            if (fr == 15) {
                char* hl = (char*)((float*)(ws + WS_HL) + (size_t)chunk * 2 * FF2 + ucol) + lq;
                *(f32x4*)(hl) = acc[1][0][2][N]; *(f32x4*)(hl + FF2 * 4) = acc[1][0][3][N];
                *(f32x4*)(hl + 128 * 4) = acc[1][1][2][N]; *(f32x4*)(hl + (FF2 + 128) * 4) = acc[1][1][3][N];
                if ((pm & 7) == 7 && wr == 1) {
                    char* o = (char*)(q->out + O_FFN_P + ((size_t)l * NB_P + (pm >> 3)) * 2 * FF2 + ufcol) + lq;
                    *(f32x4*)(o) = acc[1][0][2][N]; *(f32x4*)(o + FF2 * 4) = acc[1][0][3][N];
                    *(f32x4*)(o + FF * 4) = acc[1][1][2][N]; *(f32x4*)(o + (FF2 + FF) * 4) = acc[1][1][3][N];
                }
            }
            pin_n<N>(acc);
            { const f32x4 k0 = KC4(0, 0), k1 = KC4(1, 0), k2 = KC4(2, 0), kb = KC4(3, 0); conv_chain<0, N, 0, 8>(acc, k0, k1, k2, kb, g1, g2); }
            pin_n<N>(acc);
            { f32x4 v2, v1;
#pragma unroll
              for (int e = 0; e < 4; ++e) { v2[e] = dpp_shr1(acc[1][1][2][N][e]); v1[e] = dpp_shr1(acc[1][1][3][N][e]); }
              const f32x4 k0 = KC4(0, 1), k1 = KC4(1, 1), k2 = KC4(2, 1), kb = KC4(3, 1); conv_chain<1, N, 0, 8>(acc, k0, k1, k2, kb, v1, v2); }
        } else {
            const int useq0 = 64 * (pm - NPANEL_P) + 32 * wr;
            const unsigned ls = (unsigned)(2 * fr * 2 * FF2 * 4) + lq;
            char* ob = (char*)(q->out + O_FFN_S + ((size_t)l * NB_S + useq0) * 2 * FF2 + ufcol);
#pragma unroll
            for (int ai = 0; ai < 2; ++ai) { char* o = ob + ls + (unsigned)(ai * 2 * FF2 * 4);
                *(f32x4*)(o) = acc[ai][0][2][N]; *(f32x4*)(o + FF2 * 4) = acc[ai][0][3][N];
                *(f32x4*)(o + FF * 4) = acc[ai][1][2][N]; *(f32x4*)(o + (FF2 + FF) * 4) = acc[ai][1][3][N]; }
            pin_n<N>(acc);
            const char* sb = (const char*)(q->in[4] + ((size_t)l * NB_S + useq0) * 2 * FF2 + ufcol);
            { const f32x4 k0 = KC4(0, 0), k1 = KC4(1, 0), k2 = KC4(2, 0), kb = KC4(3, 0);
              conv_chain<0, N, 0, 4>(acc, k0, k1, k2, kb, *(const f32x4*)(sb + ls + FF2 * 4), *(const f32x4*)(sb + ls));
              conv_chain<0, N, 4, 4>(acc, k0, k1, k2, kb, *(const f32x4*)(sb + ls + 3 * FF2 * 4), *(const f32x4*)(sb + ls + 2 * FF2 * 4)); }
            pin_n<N>(acc);
            { const f32x4 k0 = KC4(0, 1), k1 = KC4(1, 1), k2 = KC4(2, 1), kb = KC4(3, 1);
              conv_chain<1, N, 0, 4>(acc, k0, k1, k2, kb, *(const f32x4*)(sb + ls + (FF2 + FF) * 4), *(const f32x4*)(sb + ls + FF * 4));
              conv_chain<1, N, 4, 4>(acc, k0, k1, k2, kb, *(const f32x4*)(sb + ls + (3 * FF2 + FF) * 4), *(const f32x4*)(sb + ls + (2 * FF2 + FF) * 4)); }
        }
#undef KC4
        pin_n<N>(acc);
        asm volatile("" ::: "memory");
    }
    __device__ __forceinline__ void operator()(f32x4 (&acc)[2][2][4][2], const pg8::Unit& u, int wr, int wc, int fr, int fq, LAS unsigned char* elds) const {
        const int pm = u.pm, pn = u.pn;
        LAS f32x2* S = (LAS f32x2*)(elds + EPI_S);
        { const LAS unsigned char* csl = elds + EPI_CST + (32 * wc) * 4 + 32 * fq;
          f32x2 st[8];
#pragma unroll
          for (int j = 0; j < 8; ++j) st[j] = S[128 * (j >> 2) + 64 * wr + 16 * (j & 3) + fr];
#pragma unroll
          for (int bj = 0; bj < 2; ++bj)
#pragma unroll
              for (int n = 0; n < 2; ++n) { const f32x4 csv = *(const LAS f32x4*)(csl + (128 * bj + 4 * n) * 4), cbv = *(const LAS f32x4*)(csl + 1024 + (128 * bj + 4 * n) * 4);
#pragma unroll
                  for (int j = 0; j < 8; ++j) acc[j >> 2][bj][j & 3][n] = acc[j >> 2][bj][j & 3][n] * st[j].x + (csv * st[j].y + cbv); }
        }
        pin_half<0>(acc); pin_half<1>(acc);
        half<0>(acc, pm, pn, wr, wc, fr, fq, elds);
        half<1>(acc, pm, pn, wr, wc, fr, fq, elds);
        asm volatile("" : "+v"(fr), "+v"(fq));
        char* ab = (char*)((bf16_t*)(kargs()->ws + WS_ACT) + (size_t)(pm * 256 + 64 * wr) * FF + 128 * pn + 32 * wc);
        const unsigned la = (unsigned)((fr * FF + 8 * fq) * 2);
#pragma unroll
        for (int j = 0; j < 8; ++j) {
            const f32x4 g0 = acc[j >> 2][0][j & 3][0], v0 = acc[j >> 2][1][j & 3][0], g1 = acc[j >> 2][0][j & 3][1], v1 = acc[j >> 2][1][j & 3][1];
            u32x4 w; w.x = pk2v(silu_mul2((f32x2){g0[0], g0[1]}, (f32x2){v0[0], v0[1]})); w.y = pk2v(silu_mul2((f32x2){g0[2], g0[3]}, (f32x2){v0[2], v0[3]}));
            w.z = pk2v(silu_mul2((f32x2){g1[0], g1[1]}, (f32x2){v1[0], v1[1]})); w.w = pk2v(silu_mul2((f32x2){g1[2], g1[3]}, (f32x2){v1[2], v1[3]}));
            *(u32x4*)(ab + la + (unsigned)((128 * (j >> 2) + 16 * (j & 3)) * FF * 2)) = w;
        }
    }
};

template <bool FINAL, bool RL = false> struct EpiRes {
    int pprev, pnew, gi, goff;
    const LAS unsigned char* stg;
    template <int BJ>
    __device__ __forceinline__ void resid(f32x4 (&acc)[2][2][4][2], int pm, int pn, int wr, int wc, int fr, int fq, LAS f32x2* S, const LAS unsigned char* cst) const {
        asm volatile("" : "+v"(fr), "+v"(fq));
        const KA Params* q = kargs();
        const int ucol = 256 * pn + 128 * BJ + 32 * wc;
        const char* vb = (const char*)((const bf16_t*)(q->ws + WS_H1) + (size_t)(pm * 256 + 64 * wr) * D + ucol);
        const unsigned lv = (unsigned)((fr * D + 8 * fq) * 2), lq = (unsigned)(32 * fq);
        u32x4 vp[8];
        if (RL) {
            const LAS unsigned char* sl = stg + ((wc >> 1) * 2 + 4 * BJ) * 16384 + pg8::lds_byte(64 * wr + fr, 32 * (wc & 1) + 8 * fq);
#pragma unroll
            for (int j = 0; j < 8; ++j) vp[j] = *(const LAS u32x4*)(sl + (j >> 2) * 16384 + (j & 3) * 2048);
        } else {
#pragma unroll
            for (int j = 0; j < 8; ++j) vp[j] = *(const u32x4*)(vb + lv + (unsigned)((128 * (j >> 2) + 16 * (j & 3)) * D * 2));
        }
        f32x4 gv[2], bv[2];
#pragma unroll
        for (int n = 0; n < 2; ++n) { gv[n] = *(const LAS f32x4*)(cst + (128 * BJ + 32 * wc + 4 * n) * 4 + lq) * ALPHA; bv[n] = *(const LAS f32x4*)(cst + 1024 + (128 * BJ + 32 * wc + 4 * n) * 4 + lq) * ALPHA; }
        const LAS f32x2* Sl = S + 64 * wr + fr;
#pragma unroll
        for (int j = 0; j < 8; ++j) { const f32x2 s = Sl[128 * (j >> 2) + 16 * (j & 3)];
#pragma unroll
            for (int n = 0; n < 2; ++n) { const unsigned lo2 = n == 0 ? vp[j].x : vp[j].z, hi2 = n == 0 ? vp[j].y : vp[j].w;
                f32x4 v; v[0] = bf2f(lo2 & 0xffffu); v[1] = bf2f(lo2 >> 16); v[2] = bf2f(hi2 & 0xffffu); v[3] = bf2f(hi2 >> 16);
                acc[j >> 2][BJ][j & 3][n] = (v * s.x + s.y) * gv[n] + bv[n] + acc[j >> 2][BJ][j & 3][n]; } }
        pin_half<BJ>(acc);
    }
    __device__ __forceinline__ void operator()(f32x4 (&acc)[2][2][4][2], const pg8::Unit& u, int wr, int wc, int fr, int fq, LAS unsigned char* elds) const {
        const int pm = u.pm, pn = u.pn;
        LAS f32x2* P = (LAS f32x2*)elds;
        LAS f32x2* S = (LAS f32x2*)(elds + EPI_S);
        resid<0>(acc, pm, pn, wr, wc, fr, fq, S, elds + EPI_CST);
        resid<1>(acc, pm, pn, wr, wc, fr, fq, S, elds + EPI_CST);
        asm volatile("" : "+v"(fr), "+v"(fq));
        const KA Params* q = kargs();
        char* ob = (char*)((bf16_t*)(q->ws + WS_H1) + (size_t)(pm * 256 + 64 * wr) * D + 256 * pn + 32 * wc); const unsigned lo = (unsigned)((fr * D + 8 * fq) * 2);
        LAS f32x2* Pl = P + (64 * wr + fr) * 4 + wc;
#pragma unroll
        for (int j = 0; j < 8; ++j) {
            const int ai = j >> 2, m = j & 3;
            f32x4 s4 = {0.f, 0.f, 0.f, 0.f}, q4 = {0.f, 0.f, 0.f, 0.f};
#pragma unroll
            for (int bj = 0; bj < 2; ++bj)
#pragma unroll
                for (int n = 0; n < 2; ++n) { const f32x4 vn = acc[ai][bj][m][n]; s4 += vn; q4 = __builtin_elementwise_fma(vn, vn, q4); }
            float sum = (s4[0] + s4[1]) + (s4[2] + s4[3]), sq = (q4[0] + q4[1]) + (q4[2] + q4[3]);
            { const float s16 = __shfl_xor(sum, 16), q16 = __shfl_xor(sq, 16); sum += s16; sq += q16; }
            { const float s32 = __shfl_xor(sum, 32), q32 = __shfl_xor(sq, 32); sum += s32; sq += q32; }
            const float mw = sum * (1.0f / 64.0f); const float qq = __builtin_fmaf(-64.0f * mw, mw, sq);
            if (fq == 0) { f32x2 t; t.x = mw; t.y = qq; Pl[(128 * ai + 16 * m) * 4] = t; }
            if (!FINAL) {
#pragma unroll
                for (int bj = 0; bj < 2; ++bj) { const f32x4 v0 = acc[ai][bj][m][0], v1 = acc[ai][bj][m][1];
                    u32x4 w; w.x = pk2(v0[0], v0[1]); w.y = pk2(v0[2], v0[3]); w.z = pk2(v1[0], v1[1]); w.w = pk2(v1[2], v1[3]);
                    *(u32x4*)(ob + lo + (unsigned)(((128 * ai + 16 * m) * D + 128 * bj) * 2)) = w; } }
        }
        asm volatile("s_waitcnt lgkmcnt(0)" ::: "memory"); __builtin_amdgcn_s_barrier(); asm volatile("" ::: "memory");
        int rl = threadIdx.x; asm volatile("" : "+v"(rl));
        unsigned long long* slots = (unsigned long long*)(q->ws + WS_PART) + (size_t)pnew * MROWS * 4 + (size_t)pm * 256 * 4;
        if (rl < 256) {
            const f32x2 a = P[rl * 4 + 0], b2 = P[rl * 4 + 1], c2 = P[rl * 4 + 2], d2 = P[rl * 4 + 3];
            const float mt = (a.x + b2.x + c2.x + d2.x) * 0.25f;
            const float da = a.x - mt, db = b2.x - mt, dc = c2.x - mt, dd = d2.x - mt;
            const float m2 = (a.y + b2.y) + (c2.y + d2.y) + 64.0f * ((da * da + db * db) + (dc * dc + dd * dd));
            if (!FINAL) { f32x2 r; r.x = mt; r.y = m2; *(f32x2*)((char*)slots + (unsigned)(rl * 32 + pn * 8)) = r; }
            else __hip_atomic_store(slots + rl * 4 + pn, ((unsigned long long)__builtin_bit_cast(unsigned, m2) << 32) | __builtin_bit_cast(unsigned, mt), __ATOMIC_RELAXED, __HIP_MEMORY_SCOPE_AGENT);
        }
        if (FINAL) {
            unsigned* xc = cnt_word(40 + pm);
            if (rl < 256) { asm volatile("s_waitcnt vmcnt(0)" ::: "memory"); if ((rl & 63) == 0) __hip_atomic_fetch_add(xc, 1u, __ATOMIC_RELAXED, __HIP_MEMORY_SCOPE_AGENT); }
            if (rl < 64) { unsigned sp = 0;
                while ((unsigned)__builtin_amdgcn_readfirstlane(__hip_atomic_load(xc, __ATOMIC_RELAXED, __HIP_MEMORY_SCOPE_AGENT)) < 16u) { __builtin_amdgcn_s_sleep(1); if (++sp > (1u << 22)) break; }
                asm volatile("s_waitcnt vmcnt(0)" ::: "memory"); }
            asm volatile("" ::: "memory"); __builtin_amdgcn_s_barrier(); asm volatile("" ::: "memory");
            if (rl < 256) { float mt[4], m2[4]; float ms = 0.f;
#pragma unroll
                for (int t = 0; t < 4; ++t) { const unsigned long long w = __hip_atomic_load(slots + rl * 4 + t, __ATOMIC_RELAXED, __HIP_MEMORY_SCOPE_AGENT); mt[t] = __builtin_bit_cast(float, (unsigned)w); m2[t] = __builtin_bit_cast(float, (unsigned)(w >> 32)); ms += mt[t]; }
                const float mean = ms * 0.25f; float qv = 0.f;
#pragma unroll
                for (int t = 0; t < 4; ++t) { const float dm = mt[t] - mean; qv += m2[t] + 256.0f * dm * dm; }
                const float rstd = __builtin_amdgcn_rsqf(qv * (1.0f / 1024.0f) + LN_EPS);
                f32x2 t2; t2.x = rstd; t2.y = -mean * rstd; S[rl] = t2; }
            asm volatile("s_waitcnt lgkmcnt(0)" ::: "memory"); __builtin_amdgcn_s_barrier(); asm volatile("" ::: "memory");
            asm volatile("" : "+v"(fr), "+v"(fq));
            char* yb = (char*)(q->out + O_Y + (size_t)(pm * 256 + 128 * wr) * D + 256 * pn + 32 * wc); const unsigned ly = (unsigned)((8 * fr * D + 8 * fq) * 4);
            const LAS unsigned char* cst = elds + EPI_CST + 2048 + (32 * wc) * 4 + 32 * fq;
            const LAS f32x2* Sl = S + 64 * wr + fr;
#pragma unroll
            for (int bj = 0; bj < 2; ++bj)
#pragma unroll
                for (int n = 0; n < 2; ++n) { const f32x4 g2 = *(const LAS f32x4*)(cst + (128 * bj + 4 * n) * 4), b2 = *(const LAS f32x4*)(cst + 1024 + (128 * bj + 4 * n) * 4);
#pragma unroll
                    for (int j = 0; j < 8; ++j) { const f32x2 s = Sl[128 * (j >> 2) + 16 * (j & 3)];
                        *(f32x4*)(yb + ly + (unsigned)((j * D + 128 * bj + 4 * n) * 4)) = (acc[j >> 2][bj][j & 3][n] * s.x + s.y) * g2 + b2; } }
        }
    }
};

template <bool PROMPT> struct EpiIn {
    int dummy;
    template <int N>
    __device__ __forceinline__ void half(f32x4 (&acc)[2][2][4][2], int pm, int pn, int wr, int wc, int fr, int fq, LAS unsigned char* elds) const {
        asm volatile("" : "+v"(fr), "+v"(fq));
        const KA Params* q = kargs(); unsigned char* ws = q->ws;
        const int chunk = 2 * pm + wr, ucol = 128 * pn + 32 * wc + 4 * N;
        const unsigned lq = (unsigned)(32 * fq);
        const LAS unsigned char* kcl = elds + EPI_CST + 2048 + (32 * wc + 4 * N) * 4 + lq;
        f32x4 g2, g1;
#pragma unroll
        for (int e = 0; e < 4; ++e) { g2[e] = dpp_shr1(acc[1][0][2][N][e]); g1[e] = dpp_shr1(acc[1][0][3][N][e]); }
        if (fr == 0) { char* hf = (char*)((float*)(ws + WS_HF) + (size_t)chunk * 2 * D + ucol) + lq; *(f32x4*)(hf) = acc[0][0][0][N]; *(f32x4*)(hf + D * 4) = acc[0][0][1][N]; }
        if (fr == 15) { char* hl = (char*)((float*)(ws + WS_HL) + (size_t)chunk * 2 * D + ucol) + lq; *(f32x4*)(hl) = acc[1][0][2][N]; *(f32x4*)(hl + D * 4) = acc[1][0][3][N];
            if ((pm & 7) == 7 && wr == 1) { char* o = (char*)(q->out + O_CONV_P + (size_t)(pm >> 3) * 2 * D + ucol) + lq; *(f32x4*)(o) = acc[1][0][2][N]; *(f32x4*)(o + D * 4) = acc[1][0][3][N]; } }
        pin_group<0, N>(acc);
        { const f32x4 k0 = *(const LAS f32x4*)(kcl), k1 = *(const LAS f32x4*)(kcl + 1024), k2 = *(const LAS f32x4*)(kcl + 2048), kb = *(const LAS f32x4*)(kcl + 3072);
          conv_chain<0, N, 0, 8>(acc, k0, k1, k2, kb, g1, g2); }
        pin_group<0, N>(acc);
        asm volatile("" ::: "memory");
    }
    __device__ __forceinline__ void operator()(f32x4 (&acc)[2][2][4][2], const pg8::Unit& u, int wr, int wc, int fr, int fq, LAS unsigned char* elds) const {
        const int pm = u.pm, pn = u.pn; constexpr bool sample = !PROMPT;
        LAS f32x2* S = (LAS f32x2*)(elds + EPI_S);
        const KA Params* q = kargs(); unsigned char* ws = q->ws;
        { const LAS unsigned char* csl = elds + EPI_CST + (32 * wc) * 4 + 32 * fq;
          f32x2 st[8];
#pragma unroll
          for (int j = 0; j < 8; ++j) st[j] = S[128 * (j >> 2) + 64 * wr + 16 * (j & 3) + fr];
#pragma unroll
          for (int bj = 0; bj < 2; ++bj)
#pragma unroll
              for (int n = 0; n < 2; ++n) { const f32x4 csv = *(const LAS f32x4*)(csl + (128 * bj + 4 * n) * 4), cbv = *(const LAS f32x4*)(csl + 1024 + (128 * bj + 4 * n) * 4);
#pragma unroll
                  for (int j = 0; j < 8; ++j) acc[j >> 2][bj][j & 3][n] = acc[j >> 2][bj][j & 3][n] * st[j].x + (csv * st[j].y + cbv); } }
        pin_half<0>(acc); pin_half<1>(acc);
        asm volatile("" : "+v"(fr), "+v"(fq));
        const unsigned lr = (unsigned)((fr * D + 8 * fq) * 2);
        if (pn < 8 && !sample) {
            const char* bbp = (const char*)((const bf16_t*)(ws + WS_ACT) + (size_t)MROWS * D + (size_t)(pm * 256 + 64 * wr) * D + 128 * pn + 32 * wc);
            u32x4 vb[8];
#pragma unroll
            for (int j = 0; j < 8; ++j) vb[j] = *(const u32x4*)(bbp + lr + (unsigned)((128 * (j >> 2) + 16 * (j & 3)) * D * 2));
#pragma unroll
            for (int j = 0; j < 8; ++j) { acc[j >> 2][0][j & 3][0] = acc[j >> 2][0][j & 3][0] * acc[j >> 2][1][j & 3][0]; acc[j >> 2][0][j & 3][1] = acc[j >> 2][0][j & 3][1] * acc[j >> 2][1][j & 3][1]; }
            pin_half<0>(acc);
            half<0>(acc, pm, pn, wr, wc, fr, fq, elds);
            half<1>(acc, pm, pn, wr, wc, fr, fq, elds);
            asm volatile("" : "+v"(fr), "+v"(fq));
            char* ob = (char*)((bf16_t*)kargs()->out + (size_t)(pm * 256 + 64 * wr) * D + 128 * pn + 32 * wc);
            const unsigned lo = (unsigned)((fr * D + 8 * fq) * 2);
#pragma unroll
            for (int j = 0; j < 8; ++j) { const f32x4 z0 = acc[j >> 2][0][j & 3][0], z1 = acc[j >> 2][0][j & 3][1]; const u32x4 b = vb[j];
                u32x4 w; w.x = pk2(bf2f(b.x & 0xffffu) * z0[0], bf2f(b.x >> 16) * z0[1]); w.y = pk2(bf2f(b.y & 0xffffu) * z0[2], bf2f(b.y >> 16) * z0[3]);
                w.z = pk2(bf2f(b.z & 0xffffu) * z1[0], bf2f(b.z >> 16) * z1[1]); w.w = pk2(bf2f(b.w & 0xffffu) * z1[2], bf2f(b.w >> 16) * z1[3]);
                *(u32x4*)(ob + lo + (unsigned)((128 * (j >> 2) + 16 * (j & 3)) * D * 2)) = w; }
        } else if (pn < 8) {
            char* ub = sample ? (char*)((bf16_t*)(ws + WS_SU) + (size_t)((pm - NPANEL_P) * 256 + 64 * wr) * D + 128 * pn + 32 * wc)
                              : (char*)((bf16_t*)(ws + WS_ACT) + (size_t)(pm * 256 + 64 * wr) * D + 128 * pn + 32 * wc);
#pragma unroll
            for (int j = 0; j < 8; ++j) { const int ai = j >> 2, m = j & 3; const f32x4 u0 = acc[ai][0][m][0] * acc[ai][1][m][0], u1 = acc[ai][0][m][1] * acc[ai][1][m][1];
                u32x4 w; w.x = pk2(u0[0], u0[1]); w.y = pk2(u0[2], u0[3]); w.z = pk2(u1[0], u1[1]); w.w = pk2(u1[2], u1[3]); *(u32x4*)(ub + lr + (unsigned)((128 * ai + 16 * m) * D * 2)) = w;
                if (sample) { if (m >= 2) { const int seq = 64 * (pm - NPANEL_P) + 32 * wr + 2 * fr + ai; float* o = q->out + O_CONV_S + ((size_t)seq * 2 + (m - 2)) * D + 128 * pn + 32 * wc + 8 * fq; *(f32x4*)o = u0; *(f32x4*)(o + 4) = u1; } }
                else if ((pm & 7) == 7 && wr == 1 && fr == 15 && j >= 6) { float* o = q->out + O_CONV_P + ((size_t)(pm >> 3) * 2 + (j - 6)) * D + 128 * pn + 32 * wc + 8 * fq; *(f32x4*)o = u0; *(f32x4*)(o + 4) = u1; } }
        } else {
            char* bb = sample ? (char*)((bf16_t*)(ws + WS_SB) + (size_t)((pm - NPANEL_P) * 256 + 64 * wr) * D + 256 * (pn - 8) + 32 * wc)
                              : (char*)((bf16_t*)(ws + WS_ACT) + (size_t)MROWS * D + (size_t)(pm * 256 + 64 * wr) * D + 256 * (pn - 8) + 32 * wc);
#pragma unroll
            for (int bj = 0; bj < 2; ++bj)
#pragma unroll
                for (int j = 0; j < 8; ++j) { const int ai = j >> 2, m = j & 3; const f32x4 v0 = acc[ai][bj][m][0], v1 = acc[ai][bj][m][1];
                    u32x4 w; w.x = pk2(v0[0], v0[1]); w.y = pk2(v0[2], v0[3]); w.z = pk2(v1[0], v1[1]); w.w = pk2(v1[2], v1[3]); *(u32x4*)(bb + lr + (unsigned)(((128 * ai + 16 * m) * D + 128 * bj) * 2)) = w; }
            asm volatile("s_waitcnt vmcnt(0)" ::: "memory");
        }
    }
};

struct EpiPartial {
    __device__ __forceinline__ void operator()(f32x4 (&acc)[2][2][4][2], const pg8::UnitD& u) const {
        const int tid = tid_fresh();
        char* pb = (char*)(kargs()->ws + WS_PBUF) + (size_t)((((u.pm() - NPANEL_P) * 4 + u.pn()) * 4 + u.ks()) * 32) * 8192;
#pragma unroll
        for (int ai = 0; ai < 2; ++ai)
#pragma unroll
            for (int bj = 0; bj < 2; ++bj)
#pragma unroll
                for (int m = 0; m < 4; ++m)
#pragma unroll
                    for (int n = 0; n < 2; ++n) *(f32x4*)(pb + (unsigned)(((((ai * 2 + bj) * 4 + m) * 2 + n) * 512 + tid) * 16)) = acc[ai][bj][m][n];
    }
};
__device__ __forceinline__ int C_UP(int l, int p) { return l * 16 + p; }
__device__ __forceinline__ int C_DNS(int l, int p, int pn) { return l * 16 + 2 + p * 4 + pn; }
__device__ __forceinline__ int C_FIN(int l, int p) { return l * 16 + 10 + p; }
__device__ __forceinline__ int C_OUT(int p) { return 32 + p; }
__device__ __forceinline__ void dep_wait(int idx, unsigned want) {
    int tid = tid_fresh();
    if (tid < 64) {
        unsigned* w = cnt_word(idx); unsigned sp = 0;
        while ((unsigned)__builtin_amdgcn_readfirstlane(__hip_atomic_load(w, __ATOMIC_RELAXED, __HIP_MEMORY_SCOPE_AGENT)) < want) { __builtin_amdgcn_s_sleep(2); if (++sp > (1u << 22)) break; }
        __builtin_amdgcn_fence(__ATOMIC_ACQUIRE, "agent");
        asm volatile("s_waitcnt vmcnt(0)" ::: "memory");
    }
    asm volatile("" ::: "memory"); __builtin_amdgcn_s_barrier(); asm volatile("" ::: "memory");
}
__device__ __forceinline__ void unit_signal(int idx) {
    asm volatile("s_waitcnt vmcnt(0)" ::: "memory"); __builtin_amdgcn_s_barrier(); asm volatile("" ::: "memory");
    if (tid_fresh() == 0) { __builtin_amdgcn_fence(__ATOMIC_RELEASE, "agent"); asm volatile("s_waitcnt vmcnt(0)" ::: "memory");
        __hip_atomic_fetch_add(cnt_word(idx), 1u, __ATOMIC_RELAXED, __HIP_MEMORY_SCOPE_AGENT); }
}

__device__ __forceinline__ void epi_prefetch(int kind, int pm, int pn, LAS unsigned char* elds, int wid, int lane) {
    if (kind == pg8::K_DNS0 || kind == pg8::K_DNS1) return;
    const KA Params* q = kargs(); unsigned char* ws = q->ws;
    const int bank = (kind == pg8::K_UP0 || kind == pg8::K_DN0) ? 0 : ((kind == pg8::K_UP1 || kind == pg8::K_DN1) ? 2 : 1);
    const char* pp = (const char*)(ws + WS_PART) + ((size_t)bank * MROWS * 4 + (size_t)pm * 256 * 4) * 8 + wid * 1024 + lane * 16;
    __builtin_amdgcn_global_load_lds((const unsigned*)pp, (LAS unsigned*)(elds + EPI_PART + wid * 1024), 16, 0, 0);
    const float* cp = nullptr;
    if (kind == pg8::K_UP0 || kind == pg8::K_UP1) { const int l = kind - pg8::K_UP0;
        if (wid < 2) cp = (const float*)(ws + (wid == 0 ? WS_CS_UP : WS_CB_UP)) + l * FF2 + 256 * pn;
        else if (wid < 6) cp = (const float*)(ws + WS_KC_UP) + ((size_t)l * 4 + (wid - 2)) * FF2 + 256 * pn; }
    else if (kind == pg8::K_IN) { if (wid < 2) cp = (const float*)(ws + (wid == 0 ? WS_CS_IN : WS_CB_IN)) + 256 * pn;
        else if (wid < 6 && pn < 8) { if (lane < 32) __builtin_amdgcn_global_load_lds((const unsigned*)((const char*)((wid < 5 ? q->in[10] + (wid - 2) * D : q->in[11]) + 128 * pn) + lane * 16), (LAS unsigned*)(elds + EPI_CST + wid * 1024), 16, 0, 0); } }
    else { if (wid < 2) { const int gi = kind == pg8::K_OUT ? 17 : 5, goff = kind == pg8::K_DN1 ? D : 0; cp = q->in[gi + wid] + goff + 256 * pn; }
           else if (wid < 4 && kind == pg8::K_DN1) cp = q->in[17 + (wid - 2)] + D + 256 * pn; }
    if (cp) __builtin_amdgcn_global_load_lds((const unsigned*)((const char*)cp + lane * 16), (LAS unsigned*)(elds + EPI_CST + wid * 1024), 16, 0, 0);
}

namespace pg8 {
__device__ __forceinline__ void unit_gemm(const UnitD& u, const char*& cA, const char*& cB, int& Kf, int& nt) {
    const KA Params* q = kargs(); unsigned char* ws = q->ws;
    const int kind = u.kind(), pm = u.pm(), pn = u.pn(), ks = u.ks();
    switch (kind) {
    case K_UP0: case K_UP1: Kf = D; nt = 16; cA = (const char*)(ws + WS_H1) + (size_t)pm * 256 * D * 2; cB = (const char*)(ws + WS_WUP) + ((size_t)(kind - K_UP0) * FF2 + (size_t)pn * 256) * D * 2; break;
    case K_DN0: case K_DN1: Kf = FF; nt = 44; cA = (const char*)(ws + WS_ACT) + (size_t)pm * 256 * FF * 2; cB = (const char*)(ws + WS_WDN) + ((size_t)(kind - K_DN0) * D + (size_t)pn * 256) * FF * 2; break;
    case K_DNS0: case K_DNS1: { const int k0 = ks < 2 ? ks * 768 : 1536 + (ks - 2) * 640; Kf = FF; nt = ks < 2 ? 12 : 10;
        cA = (const char*)(ws + WS_ACT) + ((size_t)pm * 256 * FF + k0) * 2; cB = (const char*)(ws + WS_WDN) + (((size_t)(kind - K_DNS0) * D + (size_t)pn * 256) * FF + k0) * 2; break; }
    case K_IN: Kf = D; nt = 16; cA = (const char*)(ws + WS_H1) + (size_t)pm * 256 * D * 2; cB = (const char*)(ws + WS_WIN) + (size_t)pn * 256 * D * 2; break;
    default: Kf = D; nt = 16; cA = (const char*)q->out + (size_t)pm * 256 * D * 2; cB = (const char*)(ws + WS_WOUT) + (size_t)pn * 256 * D * 2; break;
    }
}
template <int KINDS, bool MIXK, class Sched, bool RESLDS = false>
__device__ __forceinline__ void gemm_stream(LAS unsigned char* lds, const Sched& S) {
    const int tid = tid_fresh(), wid = __builtin_amdgcn_readfirstlane(tid >> 6), lane = tid & 63, wr = wid >> 2, wc = wid & 3, fr = lane & 15, fq = lane >> 4;
    int Rs[2], Cs[2];
#pragma unroll
    for (int i = 0; i < 2; ++i) stage_rc(tid * 16 + i * 8192, Rs[i], Cs[i]);
    const size_t kstep = (size_t)(BK * 2);
    const unsigned ldsw = (unsigned)wid * 1024u;
    const int aoff = lds_byte(wr * 64 + fr, fq * 8), boff = lds_byte(wc * 32 + fr, fq * 8);
#define PG8_SA(b, h) (((b) * 2 + (h)) * HTB)
#define PG8_SB(b, h) ((4 + (b) * 2 + (h)) * HTB)
#define PG8_STAGE(bufoff, gbase, vo) do { _Pragma("unroll") for (int _i = 0; _i < 2; ++_i) \
        __builtin_amdgcn_global_load_lds((const unsigned*)((const char*)(gbase) + (vo)[_i]), (LAS unsigned*)(lds + (bufoff) + ldsw + _i * 8192), 16, 0, 0); } while (0)
#define PG8_LDA(dst, b, h) do { _Pragma("unroll") for (int m = 0; m < 4; ++m) _Pragma("unroll") for (int k = 0; k < 2; ++k) dst[m][k] = *(const LAS bf16x8*)(lds + PG8_SA(b, h) + aoff + m * 2048 + k * 1024); } while (0)
#define PG8_LDB(dst, b, h) do { _Pragma("unroll") for (int n = 0; n < 2; ++n) _Pragma("unroll") for (int k = 0; k < 2; ++k) dst[n][k] = *(const LAS bf16x8*)(lds + PG8_SB(b, h) + boff + n * 2048 + k * 1024); } while (0)
#define PG8_MMA(ai, bj, At, Bt) do { __builtin_amdgcn_s_setprio(1); _Pragma("unroll") for (int m = 0; m < 4; ++m) _Pragma("unroll") for (int n = 0; n < 2; ++n) _Pragma("unroll") for (int k = 0; k < 2; ++k) \
        acc[ai][bj][m][n] = __builtin_amdgcn_mfma_f32_16x16x32_bf16(Bt[n][k], At[m][k], acc[ai][bj][m][n], 0, 0, 0); __builtin_amdgcn_s_setprio(0); } while (0)
#define PG8_WAIT_V(n) asm volatile("s_waitcnt vmcnt(" #n ")" ::: "memory")
#define PG8_WAIT_L(n) asm volatile("s_waitcnt lgkmcnt(" #n ")" ::: "memory")
#define PG8_BAR __builtin_amdgcn_s_barrier()
#define PG8_SCHED __builtin_amdgcn_sched_barrier(0)
    constexpr int M_DNS_ = (1 << K_DNS0) | (1 << K_DNS1);
    UnitD cur, nxt; int ui = 0;
    if (!S.next(0, cur)) return;
    const char* cA; const char* cB; int KfC, ntC; unit_gemm(cur, cA, cB, KfC, ntC);
    unsigned voffC[2], voffN[2];
#pragma unroll
    for (int i = 0; i < 2; ++i) { voffC[i] = (unsigned)(Rs[i] * KfC + Cs[i]) * 2u; voffN[i] = voffC[i]; }
    size_t hstepC = (size_t)HALF * KfC * 2, hstepN = hstepC;
    f32x4 acc[2][2][4][2];
#pragma unroll
    for (int a = 0; a < 2; ++a)
#pragma unroll
        for (int b = 0; b < 2; ++b)
#pragma unroll
            for (int m = 0; m < 4; ++m)
#pragma unroll
                for (int n = 0; n < 2; ++n) acc[a][b][m][n] = (f32x4){0.f, 0.f, 0.f, 0.f};
    bf16x8 At[4][2], B0[2][2], B1[2][2];
    if (cur.dep() >= 0) dep_wait(cur.dep(), cur.want());
    PG8_STAGE(PG8_SB(0, 0), cB, voffC); PG8_STAGE(PG8_SB(0, 1), cB + hstepC, voffC); PG8_STAGE(PG8_SA(0, 0), cA, voffC); PG8_STAGE(PG8_SA(0, 1), cA + hstepC, voffC);
    if (wr == 1) PG8_BAR;
    PG8_WAIT_V(2); PG8_BAR;
    PG8_STAGE(PG8_SB(1, 0), cB + kstep, voffC); PG8_STAGE(PG8_SA(1, 0), cA + kstep, voffC); PG8_STAGE(PG8_SB(1, 1), cB + hstepC + kstep, voffC);
    PG8_WAIT_V(6); PG8_BAR;
    for (;;) {
        const bool has_next = S.next(ui + 1, nxt);
        const char* nA = cA; const char* nB = cB; int KfN = KfC, ntN = ntC;
        if (has_next) unit_gemm(nxt, nA, nB, KfN, ntN);
        if (RESLDS) { if (!has_next) { nA = (const char*)(kargs()->ws + WS_H1) + ((size_t)cur.pm() * 256 * D + (size_t)cur.pn() * 256) * 2; nB = nA + 256; KfN = D; } }
        if (MIXK) {
#pragma unroll
            for (int i = 0; i < 2; ++i) voffN[i] = (unsigned)(Rs[i] * KfN + Cs[i]) * 2u;
            hstepN = (size_t)HALF * KfN * 2; }
        for (int t = 0; t < ntC; t += 2) {
            const bool last = (t == ntC - 2);
            const char* a1 = cA + (size_t)(t + 1) * kstep;
            const char* a2 = last ? nA : cA + (size_t)(t + 2) * kstep; const char* b2 = last ? nB : cB + (size_t)(t + 2) * kstep;
            const char* a3 = a2 + kstep; const char* b3 = b2 + kstep;
            unsigned vo2[2]; size_t hs2 = hstepC;
#pragma unroll
            for (int i = 0; i < 2; ++i) vo2[i] = voffC[i];
            if (MIXK) { if (last) {
#pragma unroll
                for (int i = 0; i < 2; ++i) vo2[i] = voffN[i];
                hs2 = hstepN; } }
            if (last && has_next && nxt.dep() >= 0) dep_wait(nxt.dep(), nxt.want());
            if (t == 2) epi_prefetch(cur.kind(), cur.pm(), cur.pn(), lds + EPI_OFF, wid, lane);
            PG8_LDB(B0, 0, 0); PG8_LDB(B1, 0, 1); PG8_SCHED; PG8_LDA(At, 0, 0); PG8_STAGE(PG8_SA(1, 1), a1 + hstepC, voffC);
            PG8_WAIT_V(8); PG8_WAIT_L(0); PG8_BAR; PG8_MMA(0, 0, At, B0); PG8_MMA(0, 1, At, B1); PG8_BAR; PG8_SCHED;
            PG8_LDA(At, 0, 1); PG8_STAGE(PG8_SB(0, 0), b2, vo2); PG8_STAGE(PG8_SB(0, 1), b2 + hs2, vo2); PG8_STAGE(PG8_SA(0, 0), a2, vo2);
            PG8_WAIT_V(8); PG8_WAIT_L(0); PG8_BAR; PG8_MMA(1, 0, At, B0); PG8_MMA(1, 1, At, B1); PG8_BAR; PG8_SCHED;
            PG8_LDB(B0, 1, 0); PG8_LDB(B1, 1, 1); PG8_SCHED; PG8_LDA(At, 1, 0); PG8_STAGE(PG8_SA(0, 1), a2 + hs2, vo2);
            PG8_WAIT_V(8); PG8_WAIT_L(0); PG8_BAR; PG8_MMA(0, 0, At, B0); PG8_MMA(0, 1, At, B1); PG8_BAR; PG8_SCHED;
            PG8_LDA(At, 1, 1); PG8_STAGE(PG8_SB(1, 0), b3, vo2); PG8_STAGE(PG8_SB(1, 1), b3 + hs2, vo2); PG8_STAGE(PG8_SA(1, 0), a3, vo2);
            PG8_WAIT_V(8); PG8_WAIT_L(0); PG8_BAR; PG8_MMA(1, 0, At, B0); PG8_MMA(1, 1, At, B1); PG8_BAR; PG8_SCHED;
        }
        if (RESLDS) PG8_STAGE(PG8_SA(1, 1), nA + kstep + hstepN, voffN);
        if (wr == 0) {
            if (!((KINDS & M_DNS_) && (cur.kind() == K_DNS0 || cur.kind() == K_DNS1))) { stats_compute(lds + EPI_OFF); PG8_WAIT_L(0); }
            PG8_BAR; }
        if (RESLDS) { PG8_WAIT_V(0); PG8_BAR; }
        { int fr_e = fr, fq_e = fq; asm volatile("" : "+v"(fr_e), "+v"(fq_e));
          const int ck = cur.kind(); const Unit uu{cur.pm(), cur.pn()}; LAS unsigned char* elds = lds + EPI_OFF;
          if ((KINDS & ((1 << K_UP0) | (1 << K_UP1))) && (ck == K_UP0 || ck == K_UP1)) { EpiUp E{ck - K_UP0}; E(acc, uu, wr, wc, fr_e, fq_e, elds); }
          if ((KINDS & (1 << K_DN0)) && ck == K_DN0) { EpiRes<false, RESLDS> E{0, 1, 5, 0, lds}; E(acc, uu, wr, wc, fr_e, fq_e, elds); }
          if ((KINDS & (1 << K_DN1)) && ck == K_DN1) { EpiRes<true, RESLDS> E{2, 0, 5, D, lds}; E(acc, uu, wr, wc, fr_e, fq_e, elds); }
          if ((KINDS & (1 << K_IN)) && ck == K_IN) { EpiIn<((KINDS >> 8) & 1) != 0> E{0}; E(acc, uu, wr, wc, fr_e, fq_e, elds); }
          if ((KINDS & (1 << K_OUT)) && ck == K_OUT) { EpiRes<false, RESLDS> E{1, 2, 17, 0, lds}; E(acc, uu, wr, wc, fr_e, fq_e, elds); }
          if ((KINDS & ((1 << K_DNS0) | (1 << K_DNS1))) && (ck == K_DNS0 || ck == K_DNS1)) { EpiPartial E; E(acc, cur); }
          if (cur.sig() >= 0) unit_signal(cur.sig()); }
        if (!has_next) break;
#pragma unroll
        for (int a = 0; a < 2; ++a)
#pragma unroll
            for (int b = 0; b < 2; ++b)
#pragma unroll
                for (int m = 0; m < 4; ++m)
#pragma unroll
                    for (int n = 0; n < 2; ++n) acc[a][b][m][n] = (f32x4){0.f, 0.f, 0.f, 0.f};
        cur = nxt; cA = nA; cB = nB; KfC = KfN; ntC = ntN; ++ui;
        if (MIXK) {
#pragma unroll
            for (int i = 0; i < 2; ++i) voffC[i] = voffN[i];
            hstepC = hstepN; }
        if (wr == 1) PG8_BAR;
    }
    PG8_WAIT_V(0);
    PG8_BAR;
#undef PG8_SA
#undef PG8_SB
#undef PG8_STAGE
#undef PG8_LDA
#undef PG8_LDB
#undef PG8_MMA
#undef PG8_WAIT_V
#undef PG8_WAIT_L
#undef PG8_BAR
#undef PG8_SCHED
}
struct SchedSimple {
    int kind, nM, nN, G, c;
    __device__ __forceinline__ bool next(int i, UnitD& u) const {
        const long L = (long)i * G + c; if (L >= (long)nM * nN) return false;
        int pm, pn; map_unit((int)L, nM, nN, pm, pn); u.set(kind, pm, pn, 0, -1, 0, -1); return true; }
};
struct SchedIn {
    int c;
    __device__ __forceinline__ bool next(int i, UnitD& u) const {
        if (i >= 3) return false;
        const int idx = c >> 3, pm = 8 * (c & 7) + (idx & 7), cb = idx >> 3;
        u.set(K_IN, pm, i == 0 ? 8 + cb : 2 * cb + (i - 1), 0, -1, 0, -1); return true; }
};
struct SchedUp {
    int l, c, first, count;
    __device__ __forceinline__ int guest(UnitD& g) const {
        const int lc = c - 128; if (lc < 0) return -1;
        if (l == 0) {
            if (lc < 44) { g.set(K_UP0, NPANEL_P + lc / 22, lc % 22, 0, -1, 0, C_UP(0, lc / 22)); return 0; }
            if (lc < 76) { const int ix = lc - 44, p = ix >> 4, pn = (ix >> 2) & 3; g.set(K_DNS0, NPANEL_P + p, pn, ix & 3, C_UP(0, p), 22, C_DNS(0, p, pn)); return 2; }
            if (lc < 84) return -1;
            if (lc < 108) { const int ix = lc - 84, p = ix / 12; g.set(K_IN, NPANEL_P + p, ix % 12, 0, C_FIN(0, p), 4, -1); return 5; }
            return -1;
        }
        if (lc < 8) { g.set(K_OUT, NPANEL_P + (lc >> 2), lc & 3, 0, -1, 0, C_OUT(lc >> 2)); return 0; }
        if (lc < 52) { const int ix = lc - 8, p = ix / 22; g.set(K_UP1, NPANEL_P + p, ix % 22, 0, C_OUT(p), 4, C_UP(1, p)); return 2; }
        if (lc < 84) { const int ix = lc - 52, p = ix >> 4, pn = (ix >> 2) & 3; g.set(K_DNS1, NPANEL_P + p, pn, ix & 3, C_UP(1, p), 22, C_DNS(1, p, pn)); return 4; }
        return -1;
    }
    __device__ __forceinline__ bool next(int i, UnitD& u) const {
        if (i >= count) return false;
        const int pos = first + i; int ip = pos;
        UnitD g; const int gpos = guest(g);
        if (gpos >= 0) { if (pos == gpos) { u = g; return true; } if (pos > gpos) ip = pos - 1; }
        int L = ip * 256 + c;
        if (L >= NPANEL_P * 22) {
            const int lc = c - 128, xlo = l == 0 ? 108 : 92, flo = l == 0 ? 76 : 84;
            if (pos == 5 && lc >= xlo && lc < xlo + 8) L = 4 * 256 + 128 + flo + (lc - xlo); else return false; }
        int pm, pn; map_unit(L, NPANEL_P, 22, pm, pn); u.set(l == 0 ? K_UP0 : K_UP1, pm, pn, 0, -1, 0, -1); return true; }
};
}

template <int L_> __device__ __forceinline__ void finisher(LAS unsigned char* lds, int p, int pn) {
    dep_wait(C_DNS(L_, p, pn), 4u);
    const int tid = tid_fresh(), wid = __builtin_amdgcn_readfirstlane(tid >> 6), lane = tid & 63, wr = wid >> 2, wc = wid & 3, fr = lane & 15, fq = lane >> 4;
    f32x4 acc[2][2][4][2];
    const char* pb = (const char*)(kargs()->ws + WS_PBUF) + (size_t)(((p * 4 + pn) * 4) * 32) * 8192;
#pragma unroll
    for (int ai = 0; ai < 2; ++ai)
#pragma unroll
        for (int bj = 0; bj < 2; ++bj)
#pragma unroll
            for (int m = 0; m < 4; m += 2) {
#pragma unroll
                for (int mm = 0; mm < 2; ++mm)
#pragma unroll
                    for (int n = 0; n < 2; ++n) { const unsigned o = (unsigned)(((((ai * 2 + bj) * 4 + m + mm) * 2 + n) * 512 + tid) * 16);
                        acc[ai][bj][m + mm][n] = (*(const f32x4*)(pb + o) + *(const f32x4*)(pb + o + 262144u)) + (*(const f32x4*)(pb + o + 2u * 262144u) + *(const f32x4*)(pb + o + 3u * 262144u)); }
                asm volatile("" : "+v"(acc[ai][bj][m][0]), "+v"(acc[ai][bj][m][1]), "+v"(acc[ai][bj][m + 1][0]), "+v"(acc[ai][bj][m + 1][1]) :: "memory"); }
    epi_prefetch(L_ == 0 ? pg8::K_DN0 : pg8::K_DN1, NPANEL_P + p, pn, lds + EPI_OFF, wid, lane);
    asm volatile("s_waitcnt vmcnt(0)" ::: "memory"); __syncthreads();
    stats_from_lds(lds + EPI_OFF);
    const pg8::Unit uu{NPANEL_P + p, pn};
    if (L_ == 0) { EpiRes<false> E{0, 1, 5, 0, nullptr}; E(acc, uu, wr, wc, fr, fq, lds + EPI_OFF); unit_signal(C_FIN(0, p)); }
    else { EpiRes<true> E{2, 0, 5, D, nullptr}; E(acc, uu, wr, wc, fr, fq, lds + EPI_OFF); }
    asm volatile("s_waitcnt vmcnt(0) lgkmcnt(0)" ::: "memory"); __syncthreads();
}

__device__ __forceinline__ void p0_item(const float* W, int K, int N, int kb, int nb, bf16_t* WT, int dest_row0, const float* rowscale, const float* colscale,
                                        float* csp, const float* bvec, float* cbp, int pstride, LAS float* scr, int lane, bool perm = false) {
    const int k0 = 64 * kb, n0 = 32 * nb;
    { f32x4 t[8];
#pragma unroll
      for (int i = 0; i < 8; ++i) t[i] = __builtin_nontemporal_load((const f32x4*)(W + (size_t)(k0 + 8 * i + (lane >> 3)) * N + n0 + 4 * (lane & 7)));
#pragma unroll
      for (int i = 0; i < 8; ++i) { LAS float* d = scr + (8 * i + (lane >> 3)) * 33 + 4 * (lane & 7); d[0] = t[i][0]; d[1] = t[i][1]; d[2] = t[i][2]; d[3] = t[i][3]; } }
    asm volatile("s_waitcnt lgkmcnt(0)" ::: "memory");
    const int c = lane & 7;
    float rs[8], bb[8];
#pragma unroll
    for (int i = 0; i < 8; ++i) { rs[i] = rowscale ? rowscale[k0 + 8 * c + i] : 1.0f; bb[i] = bvec ? bvec[k0 + 8 * c + i] : 0.0f; }
#pragma unroll
    for (int j = 0; j < 4; ++j) { const int n = (lane >> 3) + 8 * j; const LAS float* s = scr + (8 * c) * 33 + n;
        const float sc = colscale ? colscale[n0 + n] : 1.0f;
        unsigned r[8]; float ps = 0.f, pb = 0.f;
#pragma unroll
        for (int i = 0; i < 8; ++i) { const float w = s[i * 33]; r[i] = f2bf(w * rs[i] * sc); ps += bf2f(r[i]); pb += w * bb[i]; }
        u32x4 o; o.x = r[0] | (r[1] << 16); o.y = r[2] | (r[3] << 16); o.z = r[4] | (r[5] << 16); o.w = r[6] | (r[7] << 16);
        const int np = perm ? 16 * ((n >> 2) & 1) + 4 * (n >> 3) + (n & 3) : n;
        *(u32x4*)(WT + (size_t)(dest_row0 + np) * K + k0 + 8 * c) = o;
        if (csp) {
            ps += __shfl_xor(ps, 1); ps += __shfl_xor(ps, 2); ps += __shfl_xor(ps, 4);
            pb += __shfl_xor(pb, 1); pb += __shfl_xor(pb, 2); pb += __shfl_xor(pb, 4);
            if (c == 0) { csp[(size_t)kb * pstride + dest_row0 + n] = ps; cbp[(size_t)kb * pstride + dest_row0 + n] = pb; }
        }
    }
    asm volatile("s_waitcnt lgkmcnt(0)" ::: "memory");
}
__device__ __forceinline__ int up_dest(int n) { return n < FF ? 256 * (n >> 7) + (n & 127) : 256 * ((n - FF) >> 7) + 128 + ((n - FF) & 127); }
__device__ __forceinline__ int in_dest(int n) { return n < D ? 2048 + n : (n < 2 * D ? 256 * ((n - D) >> 7) + ((n - D) & 127) : 256 * ((n - 2 * D) >> 7) + 128 + ((n - 2 * D) & 127)); }

__device__ __forceinline__ void phase0(LAS unsigned char* lds) {
    const KA Params* q = kargs();
    const int tid = tid_fresh(), lane = tid & 63, wave = tid >> 6;
    LAS float* scr = (LAS float*)(lds + wave * 8704);
    const int gw = blockIdx.x * 8 + wave, NGW = gridDim.x * 8;
    unsigned char* ws = q->ws;
    constexpr int I_UP = 16 * 176, I_IN = 16 * 96, I_OUT = 16 * 32, I_DN = 44 * 32, I_POOL = 4 * 8;
    constexpr int NITEMS = 2 * I_UP + I_IN + I_OUT + 2 * I_DN + 4 * I_POOL;
    constexpr int DEFER0 = 2 * I_UP + I_IN, NDEF = I_OUT;
    for (int itp = gw; itp < NITEMS - NDEF; itp += NGW) {
        const int it = itp < DEFER0 ? itp : itp + NDEF;
        int r = it;
        if (r < 2 * I_UP) { const int l = r / I_UP; r -= l * I_UP; const int kb = r / 176, nb = r % 176;
            p0_item(q->in[13] + (size_t)l * D * FF2, D, FF2, kb, nb, (bf16_t*)(ws + WS_WUP) + (size_t)l * FF2 * D, up_dest(32 * nb), q->in[5] + l * D, nullptr,
                    (float*)(ws + WS_CSP_UP) + (size_t)l * 16 * FF2, q->in[6] + l * D, (float*)(ws + WS_CBP_UP) + (size_t)l * 16 * FF2, FF2, scr, lane, true); continue; }
        r -= 2 * I_UP;
        if (r < I_IN) { const int kb = r / 96, nb = r % 96;
            p0_item(q->in[9], D, 3 * D, kb, nb, (bf16_t*)(ws + WS_WIN), in_dest(32 * nb), q->in[17], nullptr, (float*)(ws + WS_CSP_IN), q->in[18], (float*)(ws + WS_CBP_IN), 3 * D, scr, lane, true); continue; }
        r -= I_IN;
        if (r < I_OUT) { const int kb = r / 32, nb = r % 32;
            p0_item(q->in[12], D, D, kb, nb, (bf16_t*)(ws + WS_WOUT), 32 * nb, nullptr, nullptr, nullptr, nullptr, nullptr, 0, scr, lane, true); continue; }
        r -= I_OUT;
        if (r < 2 * I_DN) { const int l = r / I_DN; r -= l * I_DN; const int kb = r / 32, nb = r % 32;
            p0_item(q->in[16] + (size_t)l * FF * D, FF, D, kb, nb, (bf16_t*)(ws + WS_WDN) + (size_t)l * D * FF, 32 * nb, nullptr, nullptr, nullptr, nullptr, nullptr, 0, scr, lane, true); continue; }
        r -= 2 * I_DN;
        { const int g = r / I_POOL; r -= g * I_POOL; const int kb = r / 8, nb = r % 8;
            p0_item(q->in[7] + (size_t)g * 256 * 256, 256, 256, kb, nb, (bf16_t*)(ws + WS_WPOOL) + (size_t)g * 256 * 256, 32 * nb, nullptr, q->in[8] + g * 256, nullptr, nullptr, nullptr, 0, scr, lane, true); }
    }
    const int gt = blockIdx.x * 512 + tid, NGT = gridDim.x * 512;
    for (int i = gt; i < 2 * FF2; i += NGT) { const int l = i / FF2, n = i % FF2, d = up_dest(n); float* kc = (float*)(ws + WS_KC_UP) + (size_t)l * 4 * FF2;
        const float sc = n < FF ? -1.44269504088896341f : -0.693147180559945309f;
        kc[d] = sc * q->in[14][(size_t)(l * 3 + 0) * FF2 + n]; kc[FF2 + d] = sc * q->in[14][(size_t)(l * 3 + 1) * FF2 + n]; kc[2 * FF2 + d] = sc * q->in[14][(size_t)(l * 3 + 2) * FF2 + n]; kc[3 * FF2 + d] = sc * q->in[15][(size_t)l * FF2 + n]; }
}

__device__ __forceinline__ void wout_convert(LAS unsigned char* lds, int part, int nparts) {
    const KA Params* q = kargs();
    const int tid = tid_fresh(), lane = tid & 63, wave = tid >> 6;
    LAS float* scr = (LAS float*)(lds + wave * 8704);
#pragma unroll 1
    for (int r = part * 8 + wave; r < 16 * 32; r += nparts * 8)
        p0_item(q->in[12], D, D, r / 32, r % 32, (bf16_t*)(q->ws + WS_WOUT), 32 * (r % 32), nullptr, nullptr, nullptr, nullptr, nullptr, 0, scr, lane, true);
}

__device__ __forceinline__ void state_copies(int part, int nparts) {
    const KA Params* q = kargs();
    const int gt = part * 512 + tid_fresh(), NGT = nparts * 512;
    constexpr int NP = NB_P * 15 * (D / 4), NS = NB_S * 15 * (D / 4);
#pragma unroll 1
    for (int base = gt; base < NP + NS; base += 8 * NGT) {
        f32x4 v[8];
#pragma unroll
        for (int u = 0; u < 8; ++u) { const int i0 = base + u * NGT; v[u] = (f32x4){0.f, 0.f, 0.f, 0.f};
            if (i0 < NP) { const int i = i0, c4 = i % (D / 4), rr = (i / (D / 4)) % 15, b_ = i / (15 * (D / 4)); v[u] = *(const f32x4*)(q->in[0] + ((size_t)b_ * SEQ + 2033 + rr) * D + c4 * 4); }
            else if (i0 < NP + NS) { const int i = i0 - NP, c4 = i % (D / 4), rr = (i / (D / 4)) % 15, s_ = i / (15 * (D / 4));
                v[u] = rr < 11 ? *(const f32x4*)(q->in[2] + ((size_t)s_ * 15 + 4 + rr) * D + c4 * 4) : *(const f32x4*)(q->in[1] + ((size_t)s_ * TS + rr - 11) * D + c4 * 4); } }
#pragma unroll
        for (int u = 0; u < 8; ++u) { const int i0 = base + u * NGT; if (i0 < NP + NS) ((f32x4*)(q->out + O_POOL_P))[i0] = v[u]; }
    }
}

constexpr int P1_X_OFF = 36864, P1_XROW = 1040, P1_TB_OFF = P1_X_OFF + 72 * P1_XROW;
template <int G> __device__ __forceinline__ void p1_load(f32x4 (&a)[8 + (2 << G)], int tok0, int t0, int wave, int lane) {
    constexpr int W = 2 << G;
    asm volatile("" : "+v"(lane));
    const float* xseq = kargs()->in[0] + (size_t)(tok0 - t0) * D + 256 * G + 4 * lane;
    const int tp = t0 + 8 * wave;
#pragma unroll
    for (int k = 0; k < 8 + W; ++k) { const int t = tp - W + k, tc = t < 0 ? 0 : t; const f32x4 v = *(const f32x4*)(xseq + (size_t)tc * D); a[k] = t >= 0 ? v : (f32x4){0.f, 0.f, 0.f, 0.f}; }
}
template <int G> __device__ __forceinline__ void p1_hload(f32x4 (&h)[(2 << G) + 4], bool host, int seq0, int wave, int lane) {
    constexpr int W = 2 << G;
    asm volatile("" : "+v"(lane));
    if (host && wave < 2) {
        const KA Params* q = kargs();
        const float* hist = q->in[2] + (size_t)(seq0 + wave) * 15 * D + 256 * G + 4 * lane; const float* xs = q->in[1] + (size_t)(seq0 + wave) * TS * D + 256 * G + 4 * lane;
#pragma unroll
        for (int k = 0; k < W; ++k) { const int i = W - k; h[k] = i <= 15 ? *(const f32x4*)(hist + (size_t)(15 - i) * D) : (f32x4){0.f, 0.f, 0.f, 0.f}; }
#pragma unroll
        for (int t = 0; t < 4; ++t) h[W + t] = *(const f32x4*)(xs + (size_t)t * D);
    } else {
#pragma unroll
        for (int k = 0; k < W + 4; ++k) h[k] = (f32x4){0.f, 0.f, 0.f, 0.f};
    }
}
template <int G> __device__ __forceinline__ void p1_store(const f32x4 (&a)[8 + (2 << G)], const f32x4 (&h)[(2 << G) + 4], LAS unsigned char* lds, int t0, bool host, int wave, int lane) {
    constexpr int W = 2 << G;
    asm volatile("" : "+v"(lane));
    const int tp = t0 + 8 * wave;
    { f32x4 s = {0.f, 0.f, 0.f, 0.f};
#pragma unroll
      for (int k = 0; k < W; ++k) s += a[k];
#pragma unroll
      for (int j = 0; j < 8; ++j) { s += a[W + j] - a[j]; const int t = tp + j; const float inv = __builtin_amdgcn_rcpf((float)(t + 1 < W ? t + 1 : W)); const f32x4 d = s * inv - a[W + j];
          const int row = 8 * wave + j; u32x2 w; w.x = pk2(d[0], d[1]); w.y = pk2(d[2], d[3]);
          *(LAS u32x2*)(lds + row * 512 + ((((lane >> 1) ^ (row & 15))) << 4) + (lane & 1) * 8) = w;
          *(LAS f32x4*)(lds + P1_X_OFF + row * P1_XROW + lane * 16) = a[W + j]; } }
    if (host && wave < 2) {
        f32x4 s = {0.f, 0.f, 0.f, 0.f};
#pragma unroll
        for (int k = 0; k < W; ++k) s += h[k];
#pragma unroll
        for (int t = 0; t < 4; ++t) { s += h[W + t] - h[t]; const f32x4 d = s * (1.0f / (float)W) - h[W + t];
            const int row = 64 + 4 * wave + t; u32x2 w; w.x = pk2(d[0], d[1]); w.y = pk2(d[2], d[3]);
            *(LAS u32x2*)(lds + row * 512 + ((((lane >> 1) ^ (row & 15))) << 4) + (lane & 1) * 8) = w;
            *(LAS f32x4*)(lds + P1_X_OFF + row * P1_XROW + lane * 16) = h[W + t]; }
    }
}
template <int G> __device__ __forceinline__ void p1_bload(bf16x8 (&b)[8][2], int wave, int lane) {
    asm volatile("" : "+v"(lane));
    const int fr = lane & 15, fq = lane >> 4;
    const bf16_t* wb = (const bf16_t*)(kargs()->ws + WS_WPOOL) + ((size_t)G * 256 + 32 * wave + fr) * 256 + 8 * fq;
#pragma unroll
    for (int ks = 0; ks < 8; ++ks)
#pragma unroll
        for (int nb = 0; nb < 2; ++nb) b[ks][nb] = *(const bf16x8*)(wb + (size_t)(16 * nb) * 256 + 32 * ks);
}
template <int G>
__device__ __forceinline__ void p1_compute(const bf16x8 (&b)[8][2], LAS unsigned char* lds, int tok0, bool host, int seq0, int wave, int lane) {
    const KA Params* q = kargs();
    asm volatile("" : "+v"(lane));
    const int fr = lane & 15, fq = lane >> 4;
    f32x4 acc[5][2];
#pragma unroll
    for (int mb = 0; mb < 5; ++mb) { acc[mb][0] = (f32x4){0.f, 0.f, 0.f, 0.f}; acc[mb][1] = (f32x4){0.f, 0.f, 0.f, 0.f}; }
    __syncthreads();
#pragma unroll
    for (int ks = 0; ks < 8; ++ks) {
        const int chunk = 4 * ks + fq;
        bf16x8 a[5];
#pragma unroll
        for (int mb = 0; mb < 5; ++mb) { const int row = mb < 4 ? 16 * mb + fr : 64 + (fr & 7); a[mb] = *(const LAS bf16x8*)(lds + row * 512 + ((chunk ^ (row & 15)) << 4)); }
#pragma unroll
        for (int mb = 0; mb < 4; ++mb)
#pragma unroll
            for (int nb = 0; nb < 2; ++nb) acc[mb][nb] = __builtin_amdgcn_mfma_f32_16x16x32_bf16(b[ks][nb], a[mb], acc[mb][nb], 0, 0, 0);
        if (host) {
#pragma unroll
            for (int nb = 0; nb < 2; ++nb) acc[4][nb] = __builtin_amdgcn_mfma_f32_16x16x32_bf16(b[ks][nb], a[4], acc[4][nb], 0, 0, 0); }
        if (ks & 1) __builtin_amdgcn_sched_barrier(0);
    }
    bf16_t* vbf = (bf16_t*)(q->ws + WS_H1);
    LAS f32x2* T = (LAS f32x2*)(lds + P1_TB_OFF) + (size_t)G * 72 * 8;
    const int c0 = 256 * G + 32 * wave + 8 * fq;
    const LAS unsigned char* xl = lds + P1_X_OFF + (32 * wave + 8 * fq) * 4;
#pragma unroll
    for (int mb = 0; mb < 5; ++mb) {
        if (mb == 4 && !host) break;
        const int row = mb < 4 ? 16 * mb + fr : 64 + (fr & 7);
        const int tok = mb < 4 ? tok0 + row : NTOK_P + 4 * seq0 + (fr & 7);
        const f32x4 x0 = *(const LAS f32x4*)(xl + row * P1_XROW), x1 = *(const LAS f32x4*)(xl + row * P1_XROW + 16);
        const f32x4 v0 = x0 * ALPHA + acc[mb][0], v1 = x1 * ALPHA + acc[mb][1];
        float sum = ((v0[0] + v0[1]) + (v0[2] + v0[3])) + ((v1[0] + v1[1]) + (v1[2] + v1[3]));
        float sq = ((v0[0] * v0[0] + v0[1] * v0[1]) + (v0[2] * v0[2] + v0[3] * v0[3])) + ((v1[0] * v1[0] + v1[1] * v1[1]) + (v1[2] * v1[2] + v1[3] * v1[3]));
        if (mb < 4 || fr < 8) { u32x4 wv; wv.x = pk2(v0[0], v0[1]); wv.y = pk2(v0[2], v0[3]); wv.z = pk2(v1[0], v1[1]); wv.w = pk2(v1[2], v1[3]); *(u32x4*)(vbf + (size_t)row_of_tok(tok) * D + c0) = wv; }
        sum += __shfl_xor(sum, 16); sum += __shfl_xor(sum, 32); sq += __shfl_xor(sq, 16); sq += __shfl_xor(sq, 32);
        if (fq == 0 && (mb < 4 || fr < 8)) { f32x2 t; t.x = sum; t.y = sq; T[row * 8 + wave] = t; }
    }
    __syncthreads();
}
__device__ __forceinline__ void phase1(LAS unsigned char* lds) {
    const KA Params* q = kargs();
    const int tid = tid_fresh(), lane = tid & 63, wave = __builtin_amdgcn_readfirstlane(tid >> 6);
    unsigned char* ws = q->ws;
    for (int tile = blockIdx.x; tile < NTOK_P / 64; tile += gridDim.x) {
        const int tok0 = tile * 64, t0 = tok0 & (SEQ - 1);
        const bool host = (tile & 3) == 0; const int seq0 = 2 * (tile >> 2);
        bf16x8 b[8][2];
        { f32x4 a3[24], h3[20]; p1_load<3>(a3, tok0, t0, wave, lane); p1_hload<3>(h3, host, seq0, wave, lane); p1_bload<3>(b, wave, lane); p1_store<3>(a3, h3, lds, t0, host, wave, lane); }
        asm volatile("" ::: "memory");
        { f32x4 a2[16], h2[12]; p1_load<2>(a2, tok0, t0, wave, lane); p1_hload<2>(h2, host, seq0, wave, lane); p1_compute<3>(b, lds, tok0, host, seq0, wave, lane);
          p1_bload<2>(b, wave, lane); p1_store<2>(a2, h2, lds, t0, host, wave, lane); }
        asm volatile("" ::: "memory");
        { f32x4 a1[12], h1[8]; p1_load<1>(a1, tok0, t0, wave, lane); p1_hload<1>(h1, host, seq0, wave, lane); p1_compute<2>(b, lds, tok0, host, seq0, wave, lane);
          p1_bload<1>(b, wave, lane); p1_store<1>(a1, h1, lds, t0, host, wave, lane); }
        asm volatile("" ::: "memory");
        { f32x4 a0[10], h0[6]; p1_load<0>(a0, tok0, t0, wave, lane); p1_hload<0>(h0, host, seq0, wave, lane); p1_compute<1>(b, lds, tok0, host, seq0, wave, lane);
          p1_bload<0>(b, wave, lane); p1_store<0>(a0, h0, lds, t0, host, wave, lane); }
        asm volatile("" ::: "memory");
        p1_compute<0>(b, lds, tok0, host, seq0, wave, lane);
        const int tz = tid_fresh();
        if (tz < 4 * (host ? 72 : 64)) { const int row = tz >> 2, gg = tz & 3; const LAS f32x2* T = (const LAS f32x2*)(lds + P1_TB_OFF) + ((size_t)gg * 72 + row) * 8;
            float sx = 0.f, sy = 0.f;
#pragma unroll
            for (int w = 0; w < 8; ++w) { const f32x2 a = T[w]; sx += a.x; sy += a.y; }
            const float mt = sx * (1.0f / 256.0f); f32x2 r; r.x = mt; r.y = sy - 256.0f * mt * mt;
            const int tok = row < 64 ? tok0 + row : NTOK_P + 4 * seq0 + (row - 64);
            ((f32x2*)(ws + WS_PART))[(size_t)row_of_tok(tok) * 4 + gg] = r; }
        __syncthreads();
    }
    { const int gt = blockIdx.x * 512 + tid, NGT = gridDim.x * 512;
      for (int i = gt; i < 2 * FF2 + 3 * D; i += NGT) {
          float s = 0.f, b = 0.f;
          if (i < 2 * FF2) { const int l = i / FF2, c = i % FF2; const float* sp = (const float*)(ws + WS_CSP_UP) + (size_t)l * 16 * FF2 + c; const float* bp = (const float*)(ws + WS_CBP_UP) + (size_t)l * 16 * FF2 + c;
              for (int k = 0; k < 16; ++k) { s += sp[(size_t)k * FF2]; b += bp[(size_t)k * FF2]; }
              ((float*)(ws + WS_CS_UP))[i] = s; ((float*)(ws + WS_CB_UP))[i] = b; }
          else { const int c = i - 2 * FF2; const float* sp = (const float*)(ws + WS_CSP_IN) + c; const float* bp = (const float*)(ws + WS_CBP_IN) + c;
              for (int k = 0; k < 16; ++k) { s += sp[(size_t)k * 3 * D]; b += bp[(size_t)k * 3 * D]; }
              ((float*)(ws + WS_CS_IN))[c] = s; ((float*)(ws + WS_CB_IN))[c] = b; } } }
}

__device__ __forceinline__ void fixup_panel(int l, int pm) {
    const KA Params* q = kargs();
    const float* kc = (const float*)(q->ws + WS_KC_UP) + (size_t)l * 4 * FF2; bf16_t* act = (bf16_t*)(q->ws + WS_ACT);
    const float* Hf = (const float*)(q->ws + WS_HF); const float* Hl = (const float*)(q->ws + WS_HL);
    for (int cgp = tid_fresh(); cgp < FF / 4; cgp += 512) {
        const int f = cgp * 4, cg_ = 256 * (f >> 7) + (f & 127), cv_ = cg_ + 128;
        const bool do0 = ((2 * pm) & 15) != 0;
        const float* hf0 = Hf + (size_t)(2 * pm) * 2 * FF2; const float* hl0 = Hl + (size_t)(do0 ? 2 * pm - 1 : 2 * pm) * 2 * FF2;
        const float* hf1 = hf0 + 2 * FF2; const float* hl1 = Hl + (size_t)(2 * pm) * 2 * FF2;
        const f32x4 k0g = *(const f32x4*)(kc + cg_), k1g = *(const f32x4*)(kc + FF2 + cg_), k2g = *(const f32x4*)(kc + 2 * FF2 + cg_), kbg = *(const f32x4*)(kc + 3 * FF2 + cg_);
        const f32x4 k0v = *(const f32x4*)(kc + cv_), k1v = *(const f32x4*)(kc + FF2 + cv_), k2v = *(const f32x4*)(kc + 2 * FF2 + cv_), kbv = *(const f32x4*)(kc + 3 * FF2 + cv_);
        f32x4 g2[2], g1[2], a0[2], a1[2], v2[2], v1[2], b0[2], b1[2];
        g2[0] = *(const f32x4*)(hl0 + cg_); g1[0] = *(const f32x4*)(hl0 + FF2 + cg_); a0[0] = *(const f32x4*)(hf0 + cg_); a1[0] = *(const f32x4*)(hf0 + FF2 + cg_);
        v2[0] = *(const f32x4*)(hl0 + cv_); v1[0] = *(const f32x4*)(hl0 + FF2 + cv_); b0[0] = *(const f32x4*)(hf0 + cv_); b1[0] = *(const f32x4*)(hf0 + FF2 + cv_);
        g2[1] = *(const f32x4*)(hl1 + cg_); g1[1] = *(const f32x4*)(hl1 + FF2 + cg_); a0[1] = *(const f32x4*)(hf1 + cg_); a1[1] = *(const f32x4*)(hf1 + FF2 + cg_);
        v2[1] = *(const f32x4*)(hl1 + cv_); v1[1] = *(const f32x4*)(hl1 + FF2 + cv_); b0[1] = *(const f32x4*)(hf1 + cv_); b1[1] = *(const f32x4*)(hf1 + FF2 + cv_);
#pragma unroll
        for (int h = 0; h < 2; ++h) {
            if (h == 0 && !do0) continue;
            const f32x4 zg0 = k2g * a0[h] + k1g * g1[h] + k0g * g2[h] + kbg, zv0 = k2v * b0[h] + k1v * v1[h] + k0v * v2[h] + kbv;
            const f32x4 zg1 = k2g * a1[h] + k1g * a0[h] + k0g * g1[h] + kbg, zv1 = k2v * b1[h] + k1v * b0[h] + k0v * v1[h] + kbv;
            const int R0 = pm * 256 + 64 * h;
            u32x2 w0, w1; w0.x = pk2(silu_mul(zg0[0], zv0[0]), silu_mul(zg0[1], zv0[1])); w0.y = pk2(silu_mul(zg0[2], zv0[2]), silu_mul(zg0[3], zv0[3]));
            w1.x = pk2(silu_mul(zg1[0], zv1[0]), silu_mul(zg1[1], zv1[1])); w1.y = pk2(silu_mul(zg1[2], zv1[2]), silu_mul(zg1[3], zv1[3]));
            *(u32x2*)(act + (size_t)R0 * FF + f) = w0; *(u32x2*)(act + (size_t)(R0 + 16) * FF + f) = w1;
        }
    }
    asm volatile("s_waitcnt vmcnt(0)" ::: "memory"); __syncthreads();
}

__device__ __forceinline__ void conv_item(const KA Params* q, int tok, int ch, const f32x4 (&kk)[4][2], bf16_t* obuf) {
    int t, seq = 0; const bool sample = tok >= NTOK_P;
    if (!sample) t = tok & (SEQ - 1); else { seq = (tok - NTOK_P) >> 2; t = tok & 3; }
    const bf16_t* ubuf = sample ? (const bf16_t*)(q->ws + WS_SU) - (size_t)NTOK_P * D : (const bf16_t*)(q->ws + WS_ACT);
    const bf16_t* bbuf = sample ? (const bf16_t*)(q->ws + WS_SB) - (size_t)NTOK_P * D : (const bf16_t*)(q->ws + WS_ACT) + (size_t)MROWS * D;
    const int R = row_of_tok(tok), R1 = row_of_tok(tok - (t >= 1 ? 1 : 0)), R2 = row_of_tok(tok - (t >= 2 ? 2 : 0));
    const u32x4 w2 = *(const u32x4*)(ubuf + (size_t)R * D + ch), wb = __builtin_nontemporal_load((const u32x4*)(bbuf + (size_t)R * D + ch));
    const u32x4 w1 = *(const u32x4*)(ubuf + (size_t)R1 * D + ch), w0 = *(const u32x4*)(ubuf + (size_t)R2 * D + ch);
    float u0[8], u1[8], u2[8], bb[8];
#pragma unroll
    for (int e = 0; e < 4; ++e) { u2[2 * e] = bf2f(w2[e] & 0xffffu); u2[2 * e + 1] = bf2f(w2[e] >> 16); bb[2 * e] = bf2f(wb[e] & 0xffffu); bb[2 * e + 1] = bf2f(wb[e] >> 16);
        u1[2 * e] = bf2f(w1[e] & 0xffffu); u1[2 * e + 1] = bf2f(w1[e] >> 16); u0[2 * e] = bf2f(w0[e] & 0xffffu); u0[2 * e + 1] = bf2f(w0[e] >> 16); }
    if (t < 2) {
        const float* st = q->in[3] + (size_t)seq * 2 * D + ch;
        if (t < 1) {
#pragma unroll
            for (int e = 0; e < 8; ++e) u1[e] = sample ? st[D + e] : 0.f; }
#pragma unroll
        for (int e = 0; e < 8; ++e) u0[e] = sample ? st[(size_t)t * D + e] : 0.f;
    }
    float o[8];
#pragma unroll
    for (int e = 0; e < 8; ++e) o[e] = bb[e] * (kk[0][e >> 2][e & 3] * u0[e] + kk[1][e >> 2][e & 3] * u1[e] + kk[2][e >> 2][e & 3] * u2[e] + kk[3][e >> 2][e & 3]);
    u32x4 w; w.x = pk2(o[0], o[1]); w.y = pk2(o[2], o[3]); w.z = pk2(o[4], o[5]); w.w = pk2(o[6], o[7]);
    *(u32x4*)(obuf + (size_t)R * D + ch) = w;
}
__device__ __forceinline__ void fixup_mix(int pm) {
    const KA Params* q = kargs();
    const int i = tid_fresh();
    { const int q2 = 2 * pm + (i >> 8), ch = (i & 255) * 4;
      if ((q2 & 15) != 0) {
          const float* hf = (const float*)(q->ws + WS_HF) + (size_t)q2 * 2 * D + ch; const float* hl = (const float*)(q->ws + WS_HL) + (size_t)(q2 - 1) * 2 * D + ch;
          const f32x4 k0 = *(const f32x4*)(q->in[10] + ch), k1 = *(const f32x4*)(q->in[10] + D + ch), k2 = *(const f32x4*)(q->in[10] + 2 * D + ch), kb = *(const f32x4*)(q->in[11] + ch);
          const f32x4 g2 = *(const f32x4*)(hl), g1 = *(const f32x4*)(hl + D), a0 = *(const f32x4*)(hf), a1 = *(const f32x4*)(hf + D);
          const int R0 = (q2 >> 1) * 256 + 64 * (q2 & 1);
          const bf16_t* bb = (const bf16_t*)(q->ws + WS_ACT) + (size_t)MROWS * D; bf16_t* ob = (bf16_t*)q->out;
          const u32x2 b0 = *(const u32x2*)(bb + (size_t)R0 * D + ch), b1 = *(const u32x2*)(bb + (size_t)(R0 + 16) * D + ch);
          const f32x4 z0 = k2 * a0 + k1 * g1 + k0 * g2 + kb, z1 = k2 * a1 + k1 * a0 + k0 * g1 + kb;
          u32x2 w0, w1; w0.x = pk2(bf2f(b0.x & 0xffffu) * z0[0], bf2f(b0.x >> 16) * z0[1]); w0.y = pk2(bf2f(b0.y & 0xffffu) * z0[2], bf2f(b0.y >> 16) * z0[3]);
          w1.x = pk2(bf2f(b1.x & 0xffffu) * z1[0], bf2f(b1.x >> 16) * z1[1]); w1.y = pk2(bf2f(b1.y & 0xffffu) * z1[2], bf2f(b1.y >> 16) * z1[3]);
          *(u32x2*)(ob + (size_t)R0 * D + ch) = w0; *(u32x2*)(ob + (size_t)(R0 + 16) * D + ch) = w1; } }
    if (i < 256) { const int gt = blockIdx.x * 256 + i;
        if (gt < NTOK_S * 128) { const int ch = (gt & 127) * 8;
            f32x4 kk[4][2];
#pragma unroll
            for (int h = 0; h < 2; ++h) { kk[0][h] = *(const f32x4*)(q->in[10] + ch + 4 * h); kk[1][h] = *(const f32x4*)(q->in[10] + D + ch + 4 * h); kk[2][h] = *(const f32x4*)(q->in[10] + 2 * D + ch + 4 * h); kk[3][h] = *(const f32x4*)(q->in[11] + ch + 4 * h); }
            conv_item(q, NTOK_P + (gt >> 7), ch, kk, (bf16_t*)q->out); } }
    asm volatile("s_waitcnt vmcnt(0)" ::: "memory"); __syncthreads();
}

#define XB_TMO      128
#define XB_XCNT(j)  (256  + 64 * (j))
#define XB_XSUB(j)  (1280 + 64 * (j))
#define XB_XGEN(j)  (2304 + 64 * (j))
#define XB_TOP      3328
#define XB_TOPGEN   3392
#define XCD_BAR_WORDS 3456
#define XB_SPIN_CAP (1u << 18)

__device__ __forceinline__ unsigned xb_ld(unsigned* p)              { return __hip_atomic_load(p, __ATOMIC_RELAXED, __HIP_MEMORY_SCOPE_AGENT); }
__device__ __forceinline__ unsigned xb_add(unsigned* p, unsigned v) { return __hip_atomic_fetch_add(p, v, __ATOMIC_RELAXED, __HIP_MEMORY_SCOPE_AGENT); }
__device__ __forceinline__ unsigned xb_xcc_id() { return (unsigned)__builtin_amdgcn_s_getreg((3 << 11) | 20) & 0xFu; }
#define XB_SPIN(cond, bar) do { unsigned _sp = 0; while (cond) { __builtin_amdgcn_s_sleep(1); \
    if ((++_sp & 255u) == 0u) { if (xb_ld(&(bar)[XB_TMO])) break; if (_sp > XB_SPIN_CAP) { atomicAdd(&(bar)[XB_TMO], 1u); break; } } } } while (0)

struct XcdBarrier {
    unsigned* bar; unsigned x;
    volatile LAS unsigned* st;
};

__device__ __forceinline__ XcdBarrier xcd_barrier_post(unsigned* bar, volatile LAS unsigned* st) {
    XcdBarrier b; b.bar = bar; b.x = xb_xcc_id(); b.st = st;
    if (threadIdx.x == 0) (void)xb_add(&bar[XB_XCNT(b.x)], 1u);
    return b;
}
__device__ __forceinline__ void xcd_barrier_complete(unsigned* bar, unsigned x, unsigned& nloc, unsigned& nx) {
    const unsigned G = gridDim.x * gridDim.y * gridDim.z;
    unsigned sum, cnt, mine, sp = 0u;
    for (;;) {
        sum = 0u; cnt = 0u; mine = 0u;
#pragma unroll
        for (unsigned j = 0; j < 16; ++j) { const unsigned c = xb_ld(&bar[XB_XCNT(j)]); sum += c; cnt += (c > 0u) ? 1u : 0u; mine = (j == x) ? c : mine; }
        if (sum == G) break;
        __builtin_amdgcn_s_sleep(1);
        if ((++sp & 255u) == 0u) { if (xb_ld(&bar[XB_TMO])) break; if (sp > XB_SPIN_CAP) { atomicAdd(&bar[XB_TMO], 1u); break; } }
    }
    nloc = mine > 0u ? mine : 1u; nx = cnt > 0u ? cnt : 1u;
}

__device__ __forceinline__ void xcd_barrier(const XcdBarrier& b) {
    asm volatile("s_waitcnt vmcnt(0)" ::: "memory");
    __syncthreads();
    if (threadIdx.x == 0) {
        unsigned* bar = b.bar;
        __builtin_amdgcn_s_waitcnt(0);
        unsigned nloc = b.st[0], nx = b.st[1];
        if (nloc == 0u) { xcd_barrier_complete(bar, b.x, nloc, nx); b.st[0] = nloc; b.st[1] = nx; }
        const unsigned old = xb_add(&bar[XB_XSUB(b.x)], 1u);
        const unsigned gen = old / nloc;
        if (old + 1u == (gen + 1u) * nloc) {
            __builtin_amdgcn_fence(__ATOMIC_RELEASE, "agent");
            asm volatile("s_waitcnt vmcnt(0)" ::: "memory");
            const unsigned og = xb_add(&bar[XB_TOP], 1u);
            const unsigned tg = og / nx;
            if (og + 1u == (tg + 1u) * nx) xb_add(&bar[XB_TOPGEN], 1u);
            else XB_SPIN(xb_ld(&bar[XB_TOPGEN]) == tg, bar);
            __builtin_amdgcn_fence(__ATOMIC_ACQUIRE, "agent");
            xb_add(&bar[XB_XGEN(b.x)], 1u);
            asm volatile("s_waitcnt vmcnt(0)" ::: "memory");
        } else {
            XB_SPIN(xb_ld(&bar[XB_XGEN(b.x)]) == gen, bar);
            __builtin_amdgcn_fence(__ATOMIC_ACQUIRE, "agent");
            asm volatile("s_waitcnt vmcnt(0)" ::: "memory");
        }
    }
    __syncthreads();
}


__global__ void __launch_bounds__(512, 2) fwd_megakernel(Params p) {
    extern __shared__ __attribute__((aligned(16))) unsigned char lds_raw[];
    LAS unsigned char* lds = (LAS unsigned char*)lds_raw;
    const int G = gridDim.x, cid = blockIdx.x;
    if (threadIdx.x < 2) ((LAS unsigned*)(lds + BARST_OFF))[threadIdx.x] = 0u;
    __syncthreads();
    const XcdBarrier bar = xcd_barrier_post((unsigned*)(kargs()->ws + WS_BAR), (volatile LAS unsigned*)(lds + BARST_OFF));
#if TPROBE
    int n_stamp = 0;
#define STAMP() do { if (blockIdx.x == 0 && threadIdx.x == 0) ((volatile LAS unsigned long long*)(lds + BARST_OFF + 64))[n_stamp] = __builtin_amdgcn_s_memrealtime(); ++n_stamp; } while (0)
#else
#define STAMP() do { } while (0)
#endif
    STAMP();
    using namespace pg8;
    constexpr int M_UP = (1 << K_UP0) | (1 << K_UP1), M_DNS = (1 << K_DNS0) | (1 << K_DNS1);
    phase0(lds);
    xcd_barrier(bar); STAMP();
    phase1(lds);
    xcd_barrier(bar); STAMP();
#if SEG & 1
    { SchedUp S{0, cid, 0, 6};
      const int lc = cid - 128;
      if (lc >= 76 && lc < 84) { S.first = 0; S.count = 3; gemm_stream<M_UP, false>(lds, S); finisher<0>(lds, (lc - 76) >> 2, (lc - 76) & 3); S.first = 3; S.count = 1; gemm_stream<M_UP, false>(lds, S); state_copies(lc - 76, 20); wout_convert(lds, lc - 76, 20); }
      else { gemm_stream<M_UP | M_DNS | (1 << K_IN), true>(lds, S); if (lc >= 116) { state_copies(8 + lc - 116, 20); wout_convert(lds, 8 + lc - 116, 20); } } }
#endif
    xcd_barrier(bar); STAMP();
#if SEG & 2
    { SchedSimple S{K_DN0, NPANEL_P, 4, G, cid}; UnitD u0; if (S.next(0, u0)) fixup_panel(0, u0.pm());
      gemm_stream<(1 << K_DN0), true, SchedSimple, true>(lds, S); }
#endif
    xcd_barrier(bar); STAMP();
#if SEG & 4
    { SchedIn S{cid}; gemm_stream<(1 << K_IN) | 256, false>(lds, S); }
#endif
    xcd_barrier(bar); STAMP();
#if SEG & 8
    { SchedSimple S{K_OUT, NPANEL_P, 4, G, cid}; UnitD u0; if (S.next(0, u0)) fixup_mix(u0.pm());
      gemm_stream<(1 << K_OUT), false, SchedSimple, true>(lds, S); }
#endif
    xcd_barrier(bar); STAMP();
#if SEG & 16
    { SchedUp S{1, cid, 0, 6};
      const int lc = cid - 128;
      if (lc >= 84 && lc < 92) { S.count = 4; gemm_stream<M_UP, false>(lds, S); finisher<1>(lds, (lc - 84) >> 2, (lc - 84) & 3); }
      else gemm_stream<M_UP | M_DNS | (1 << K_OUT), true>(lds, S); }
#endif
    xcd_barrier(bar); STAMP();
#if SEG & 32
    { SchedSimple S{K_DN1, NPANEL_P, 4, G, cid}; UnitD u0; if (S.next(0, u0)) fixup_panel(1, u0.pm());
      gemm_stream<(1 << K_DN1), true, SchedSimple, true>(lds, S); }
#endif
    STAMP();
#if TPROBE
    if (blockIdx.x == 0 && threadIdx.x == 0) { volatile LAS unsigned long long* st = (volatile LAS unsigned long long*)(lds + BARST_OFF + 64);
        const unsigned long long T = st[TPROBE & 255] - st[TPROBE >> 8], t_end = __builtin_amdgcn_s_memrealtime() + 4ull * T;
        while (__builtin_amdgcn_s_memrealtime() < t_end) __builtin_amdgcn_s_sleep(8); }
#endif
}

extern "C" void kernel_launch(void* const* d_in, const int* in_sizes, int n_in, void* d_out, int out_size, void* d_ws, size_t ws_size, hipStream_t stream) {
    static int grid_blocks = 0;
    if (grid_blocks == 0) {
        if (n_in != 19 || out_size != (int)O_END || ws_size < WS_END) { fprintf(stderr, "kernel_launch: unexpected shapes (n_in %d out %d ws %zu)\n", n_in, out_size, ws_size); grid_blocks = -1; return; }
        int dev = 0, cus = 0, per_cu = 0;
        hipGetDevice(&dev);
        hipDeviceGetAttribute(&cus, hipDeviceAttributeMultiprocessorCount, dev);
        if (hipFuncSetAttribute((const void*)fwd_megakernel, hipFuncAttributeMaxDynamicSharedMemorySize, LDS_BYTES) != hipSuccess) { fprintf(stderr, "kernel_launch: hipFuncSetAttribute failed\n"); grid_blocks = -1; return; }
        hipOccupancyMaxActiveBlocksPerMultiprocessor(&per_cu, (const void*)fwd_megakernel, 512, LDS_BYTES);
        if (per_cu < 1) { fprintf(stderr, "kernel_launch: occupancy query reports %d blocks per CU\n", per_cu); grid_blocks = -1; return; }
        if (cus != 256) { fprintf(stderr, "kernel_launch: the unit schedule is built for 256 CUs, this device has %d\n", cus); grid_blocks = -1; return; }
        grid_blocks = cus;
    }
    if (grid_blocks < 0) return;
    if (hipMemsetAsync((char*)d_ws + WS_BAR, 0, CTL_BYTES, stream) != hipSuccess) { fprintf(stderr, "kernel_launch: hipMemsetAsync failed\n"); return; }
    Params p{};
    for (int i = 0; i < 19; ++i) p.in[i] = (const float*)d_in[i];
    p.out = (float*)d_out; p.ws = (unsigned char*)d_ws;
    void* args[] = {&p};
    hipError_t e = hipLaunchCooperativeKernel((const void*)fwd_megakernel, dim3(grid_blocks), dim3(512), args, LDS_BYTES, stream);
    if (e != hipSuccess) fprintf(stderr, "cooperative launch failed: %s (grid %d)\n", hipGetErrorString(e), grid_blocks);
}
```
